# Optimizing an MI355X kernel written in HIP

```python
import jax, jax.numpy as jnp
from jax import lax
import numpy as np

D_MODEL = 2048
BATCH = 4
SEQ = 2048
DEPTH = 2

HEAD_DIM = 128
N_HEADS = D_MODEL // HEAD_DIM
MLA_HEADS = N_HEADS // 4
DIL_HEADS = (N_HEADS - MLA_HEADS) // 2
NSA_HEADS = N_HEADS - MLA_HEADS - DIL_HEADS
MLA_Q_RANK = 384
MLA_KV_RANK = 128
MLA_NOPE_DIM = 128
MLA_ROPE_DIM = 64
MLA_V_DIM = HEAD_DIM
DIL_PAIRS = ((128, 1), (512, 4), (2048, 16))
NSA_CMP_LEN = 32
NSA_CMP_STRIDE = 16
NSA_CMP_HIDDEN = 256
NSA_SEL_BLOCK = 64
NSA_TOP_N = 16
NSA_WINDOW = 512
NSA_BRANCHES = 3
NSA_FORCE_SCORE = 1e4
ROPE_THETA = 500000.0
ROT_DIM = HEAD_DIM // 4
N_GROUPS = 4
EXPERTS_PER_GROUP = 8
N_EXPERTS = N_GROUPS * EXPERTS_PER_GROUP
EXPERT_FF = 512
MOE_TOP_K = 2
MOE_ROWS = 256
Q_BLOCK = 128
DN_ALPHA = (2 * DEPTH) ** 0.25
DN_BETA = (8 * DEPTH) ** -0.25
LN_EPS = 1e-5
RMS_EPS = 1e-6
NEG_INF = -1e30
D_MIX = MLA_HEADS * MLA_V_DIM + (DIL_HEADS + NSA_HEADS) * HEAD_DIM
IN_SPLITS = (MLA_Q_RANK, MLA_KV_RANK, MLA_ROPE_DIM,
             DIL_HEADS * HEAD_DIM, DIL_HEADS * HEAD_DIM, DIL_HEADS * HEAD_DIM,
             NSA_HEADS * HEAD_DIM, HEAD_DIM, HEAD_DIM, HEAD_DIM, HEAD_DIM, HEAD_DIM, HEAD_DIM,
             NSA_HEADS * NSA_BRANCHES)
IN_COLS = sum(IN_SPLITS)

kernel_name = 'hybrid_mla_dilated_nsa_hmoe'


def layer_norm(x, g, b):
    xf = x.astype(jnp.float32)
    mu = jnp.mean(xf, -1, keepdims=True)
    var = jnp.mean(jnp.square(xf - mu), -1, keepdims=True)
    return ((xf - mu) * lax.rsqrt(var + LN_EPS) * g.astype(jnp.float32) + b.astype(jnp.float32)).astype(x.dtype)


def rms_norm(x, g):
    xf = x.astype(jnp.float32)
    return (xf * lax.rsqrt(jnp.mean(jnp.square(xf), -1, keepdims=True) + RMS_EPS) * g.astype(jnp.float32)).astype(x.dtype)


def rope(x, pos, rot_dim):
    half = rot_dim // 2
    inv_freq = ROPE_THETA ** (-jnp.arange(half, dtype=jnp.float32) / half)
    ang = pos.astype(jnp.float32)[:, None] * inv_freq[None, :]
    cos = jnp.cos(ang)[:, None, :]
    sin = jnp.sin(ang)[:, None, :]
    x1 = x[..., :half].astype(jnp.float32)
    x2 = x[..., half:rot_dim].astype(jnp.float32)
    rot = jnp.concatenate([x1 * cos - x2 * sin, x2 * cos + x1 * sin], axis=-1).astype(x.dtype)
    return jnp.concatenate([rot, x[..., rot_dim:]], axis=-1)


def split_cols(h, widths):
    cuts = [int(c) for c in np.cumsum(widths)[:-1]]
    return jnp.split(h, cuts, axis=-1)


def causal_block_attention(q, k, v):
    B, S, H, dq = q.shape
    nq = S // Q_BLOCK
    scale = dq ** -0.5
    qb = q.reshape(B, nq, Q_BLOCK, H, dq).swapaxes(0, 1)
    kpos = jnp.arange(S)

    def one_block(args):
        qi, i = args
        s = jnp.einsum('bqhd,bkhd->bhqk', qi, k).astype(jnp.float32) * scale
        qpos = i * Q_BLOCK + jnp.arange(Q_BLOCK)
        mask = kpos[None, :] <= qpos[:, None]
        p = jax.nn.softmax(jnp.where(mask, s, NEG_INF), axis=-1)
        return jnp.einsum('bhqk,bkhd->bqhd', p.astype(v.dtype), v)

    out = lax.map(one_block, (qb, jnp.arange(nq)))
    return out.swapaxes(0, 1).reshape(B, S, H, v.shape[-1])


def banded_attention(q, k, v, max_dist):
    N, L, H, d = q.shape
    Hk = k.shape[2]
    R = H // Hk
    dv = v.shape[-1]
    nblk = -(-L // Q_BLOCK)
    Lp = nblk * Q_BLOCK
    nprev = -(-max_dist // Q_BLOCK)
    tail = Lp - L
    qp = jnp.pad(q, ((0, 0), (0, tail), (0, 0), (0, 0)))
    kp = jnp.pad(k, ((0, 0), (nprev * Q_BLOCK, tail), (0, 0), (0, 0)))
    vp = jnp.pad(v, ((0, 0), (nprev * Q_BLOCK, tail), (0, 0), (0, 0)))
    kb = kp.reshape(N, nprev + nblk, Q_BLOCK, Hk, d)
    vb = vp.reshape(N, nprev + nblk, Q_BLOCK, Hk, dv)
    kw = jnp.concatenate([kb[:, j:j + nblk] for j in range(nprev + 1)], axis=2)
    vw = jnp.concatenate([vb[:, j:j + nblk] for j in range(nprev + 1)], axis=2)
    qb = qp.reshape(N, nblk, Q_BLOCK, Hk, R, d)
    s = jnp.einsum('nbqgrd,nbkgd->nbgrqk', qb, kw).astype(jnp.float32) * d ** -0.5
    qpos = jnp.arange(nblk)[:, None] * Q_BLOCK + jnp.arange(Q_BLOCK)[None, :]
    kpos = jnp.arange(nblk)[:, None] * Q_BLOCK - nprev * Q_BLOCK + jnp.arange((nprev + 1) * Q_BLOCK)[None, :]
    dist = qpos[:, :, None] - kpos[:, None, :]
    mask = (dist >= 0) & (dist <= max_dist) & (kpos[:, None, :] >= 0)
    s = jnp.where(mask[None, :, None, None], s, NEG_INF)
    lse = jax.nn.logsumexp(s, axis=-1, keepdims=True)
    p = jnp.exp(s - lse)
    o = jnp.einsum('nbgrqk,nbkgd->nbqgrd', p.astype(v.dtype), vw).reshape(N, Lp, H, dv)[:, :L]
    lse = lse[..., 0].transpose(0, 1, 4, 2, 3).reshape(N, Lp, H)[:, :L]
    return o, lse


def mla_attention(q_lat, kv_lat, k_rope, q_lat_norm, w_q_up, kv_lat_norm, w_kv_up, pos):
    B, S, _ = q_lat.shape
    q = (rms_norm(q_lat, q_lat_norm) @ w_q_up).reshape(B, S, MLA_HEADS, MLA_NOPE_DIM + MLA_ROPE_DIM)
    q = jnp.concatenate([q[..., :MLA_NOPE_DIM], rope(q[..., MLA_NOPE_DIM:], pos, MLA_ROPE_DIM)], -1)
    kv = (rms_norm(kv_lat, kv_lat_norm) @ w_kv_up).reshape(B, S, MLA_HEADS, MLA_NOPE_DIM + MLA_V_DIM)
    k_nope, v = kv[..., :MLA_NOPE_DIM], kv[..., MLA_NOPE_DIM:]
    k_pe = rope(k_rope[:, :, None, :], pos, MLA_ROPE_DIM)
    k = jnp.concatenate([k_nope, jnp.broadcast_to(k_pe, (B, S, MLA_HEADS, MLA_ROPE_DIM))], -1)
    return causal_block_attention(q, k, v)


def dilated_attention(q, k, v):
    B, S, H, d = q.shape
    outs, lses = [], []
    for window, dil in DIL_PAIRS:
        L = S // dil

        def to_sub(t):
            return t.reshape(B, L, dil, H, d).transpose(0, 2, 1, 3, 4).reshape(B * dil, L, H, d)

        o, lse = banded_attention(to_sub(q), to_sub(k), to_sub(v), window // dil)
        outs.append(o.reshape(B, dil, L, H, d).transpose(0, 2, 1, 3, 4).reshape(B, S, H, d))
        lses.append(lse.reshape(B, dil, L, H).transpose(0, 2, 1, 3).reshape(B, S, H))
    wts = jax.nn.softmax(jnp.stack(lses, 0), axis=0)
    return jnp.einsum('nbsh,nbshd->bshd', wts.astype(q.dtype), jnp.stack(outs, 0))


def selected_block_attention(q, k, v, sel_idx):
    B, S, H, d = q.shape
    n_blocks = S // NSA_SEL_BLOCK
    n = sel_idx.shape[-1]
    kb = k.reshape(B, n_blocks, NSA_SEL_BLOCK, d)
    vb = v.reshape(B, n_blocks, NSA_SEL_BLOCK, v.shape[-1])
    nq = S // Q_BLOCK
    qc = q.reshape(B, nq, Q_BLOCK, H, d).swapaxes(0, 1)
    ic = sel_idx.reshape(B, nq, Q_BLOCK, n).swapaxes(0, 1)
    offs = jnp.arange(NSA_SEL_BLOCK)
    gather = jax.vmap(lambda blocks, ids: blocks[ids])

    def one_chunk(args):
        qi, ii, c = args
        kg = gather(kb, ii).reshape(B, Q_BLOCK, n * NSA_SEL_BLOCK, d)
        vg = gather(vb, ii).reshape(B, Q_BLOCK, n * NSA_SEL_BLOCK, v.shape[-1])
        kpos = (ii[..., None] * NSA_SEL_BLOCK + offs).reshape(B, Q_BLOCK, n * NSA_SEL_BLOCK)
        qpos = c * Q_BLOCK + jnp.arange(Q_BLOCK)
        mask = kpos <= qpos[None, :, None]
        s = jnp.einsum('bqhd,bqkd->bqhk', qi, kg).astype(jnp.float32) * d ** -0.5
        p = jax.nn.softmax(jnp.where(mask[:, :, None, :], s, NEG_INF), axis=-1)
        return jnp.einsum('bqhk,bqkd->bqhd', p.astype(v.dtype), vg)

    out = lax.map(one_chunk, (qc, ic, jnp.arange(nq)))
    return out.swapaxes(0, 1).reshape(B, S, H, v.shape[-1])


def nsa_attention(q, k_cmp, v_cmp, k_slc, v_slc, k_win, v_win, gates,
                  cmp_pos_k, cmp_w1_k, cmp_w2_k, cmp_pos_v, cmp_w1_v, cmp_w2_v, pos):
    B, S, H, d = q.shape
    q = rope(q, pos, ROT_DIM)
    n_chunk = S // NSA_CMP_STRIDE
    n_cmp = n_chunk - 1

    def compress(t, pe, w1, w2):
        ch = t.reshape(B, n_chunk, NSA_CMP_STRIDE, d)
        blocks = jnp.concatenate([ch[:, :-1], ch[:, 1:]], axis=2)
        h = jax.nn.gelu((blocks + pe).reshape(B, n_cmp, NSA_CMP_LEN * d) @ w1)
        return h @ w2

    cmp_start = jnp.arange(n_cmp) * NSA_CMP_STRIDE
    cmp_end = cmp_start + NSA_CMP_LEN - 1
    kc = rope(compress(k_cmp, cmp_pos_k, cmp_w1_k, cmp_w2_k)[:, :, None, :], cmp_end, ROT_DIM)[:, :, 0]
    vc = compress(v_cmp, cmp_pos_v, cmp_w1_v, cmp_w2_v)
    valid_c = cmp_end[None, :] <= pos[:, None]
    s = jnp.einsum('bshd,bcd->bhsc', q, kc).astype(jnp.float32) * d ** -0.5
    p_cmp = jax.nn.softmax(jnp.where(valid_c, s, NEG_INF), axis=-1) * valid_c
    o_cmp = jnp.einsum('bhsc,bcd->bshd', p_cmp.astype(q.dtype), vc)
    n_sel_blocks = S // NSA_SEL_BLOCK
    sel_start = jnp.arange(n_sel_blocks) * NSA_SEL_BLOCK
    cover = ((cmp_start[:, None] < sel_start[None, :] + NSA_SEL_BLOCK) &
             (cmp_start[:, None] + NSA_CMP_LEN > sel_start[None, :])).astype(jnp.float32)
    imp = jnp.einsum('bhsc,cj->bsj', p_cmp, cover)
    jj = jnp.arange(n_sel_blocks)[None, :]
    qblk = (pos // NSA_SEL_BLOCK)[:, None]
    valid_s = sel_start[None, :] <= pos[:, None]
    forced = (jj == 0) | (jj == qblk) | (jj == qblk - 1)
    score = jnp.where(valid_s, jnp.where(forced, NSA_FORCE_SCORE, imp), -1.0)
    _, sel_idx = lax.top_k(score, min(NSA_TOP_N, n_sel_blocks))
    o_slc = selected_block_attention(q, rope(k_slc[:, :, None, :], pos, ROT_DIM)[:, :, 0], v_slc, sel_idx)
    o_win, _ = banded_attention(q, rope(k_win[:, :, None, :], pos, ROT_DIM), v_win[:, :, None, :], NSA_WINDOW - 1)
    g = jax.nn.sigmoid(gates.astype(jnp.float32)).reshape(B, S, H, NSA_BRANCHES).astype(q.dtype)
    return g[..., 0:1] * o_cmp + g[..., 1:2] * o_slc + g[..., 2:3] * o_win


def hybrid_mixer(x, w_in, q_lat_norm, w_q_up, kv_lat_norm, w_kv_up,
                 cmp_pos_k, cmp_w1_k, cmp_w2_k, cmp_pos_v, cmp_w1_v, cmp_w2_v, w_out):
    B, S, _ = x.shape
    pos = jnp.arange(S, dtype=jnp.int32)
    (q_lat, kv_lat, k_rope, dq, dk, dv, nq, nkc, nvc, nks, nvs, nkw, nvw, ngate) = split_cols(x @ w_in, IN_SPLITS)

    def heads(t, h):
        return t.reshape(B, S, h, -1)

    o_mla = mla_attention(q_lat, kv_lat, k_rope, q_lat_norm, w_q_up, kv_lat_norm, w_kv_up, pos)
    o_dil = dilated_attention(rope(heads(dq, DIL_HEADS), pos, ROT_DIM),
                              rope(heads(dk, DIL_HEADS), pos, ROT_DIM), heads(dv, DIL_HEADS))
    o_nsa = nsa_attention(heads(nq, NSA_HEADS), nkc, nvc, nks, nvs, nkw, nvw, ngate,
                          cmp_pos_k, cmp_w1_k, cmp_w2_k, cmp_pos_v, cmp_w1_v, cmp_w2_v, pos)
    o = jnp.concatenate([o_mla.reshape(B, S, -1), o_dil.reshape(B, S, -1), o_nsa.reshape(B, S, -1)], -1)
    return o @ w_out


def hier_moe(x, w_grp, w_exp, w_gate, w_up, w_down):
    B, S, D = x.shape
    T = B * S
    xf = x.reshape(T, D)
    grp_prob = jax.nn.softmax((xf @ w_grp).astype(jnp.float32), axis=-1)
    g_idx = jnp.argmax(grp_prob, axis=-1)
    p_g = jnp.take_along_axis(grp_prob, g_idx[:, None], 1)[:, 0]
    e_logits = (xf @ w_exp).astype(jnp.float32).reshape(T, N_GROUPS, EXPERTS_PER_GROUP)
    e_logits = jnp.take_along_axis(e_logits, g_idx[:, None, None], 1)[:, 0]
    top_v, top_i = lax.top_k(e_logits, MOE_TOP_K)
    gate = p_g[:, None] * jax.nn.softmax(top_v, axis=-1)
    eid = g_idx[:, None].astype(jnp.int32) * EXPERTS_PER_GROUP + top_i.astype(jnp.int32)
    M = T * MOE_TOP_K
    n_blocks = -(-M // MOE_ROWS) + N_EXPERTS
    tok = jnp.repeat(jnp.arange(T, dtype=jnp.int32), MOE_TOP_K)
    ex = eid.reshape(M)
    order = jnp.argsort(ex)
    ex_s, tok_s, gw_s = ex[order], tok[order], gate.reshape(M)[order]
    counts = jnp.zeros((N_EXPERTS,), jnp.int32).at[ex].add(1)
    seg_start = jnp.cumsum(counts) - counts
    padded = (counts + MOE_ROWS - 1) // MOE_ROWS * MOE_ROWS
    pad_end = jnp.cumsum(padded)
    dest = (pad_end - padded)[ex_s] + jnp.arange(M, dtype=jnp.int32) - seg_start[ex_s]
    buf_tok = jnp.full((n_blocks * MOE_ROWS,), T, jnp.int32).at[dest].set(tok_s)
    buf_w = jnp.zeros((n_blocks * MOE_ROWS,), x.dtype).at[dest].set(gw_s.astype(x.dtype))
    blk_start = jnp.arange(n_blocks, dtype=jnp.int32) * MOE_ROWS
    blk_ex = jnp.minimum(jnp.searchsorted(pad_end, blk_start, side='right'), N_EXPERTS - 1)
    x_pad = jnp.concatenate([xf, jnp.zeros((1, D), xf.dtype)], axis=0)
    xb = x_pad[buf_tok].reshape(n_blocks, MOE_ROWS, D)

    def expert_rows(args):
        rows, e = args
        h = jax.nn.silu(rows @ w_gate[e]) * (rows @ w_up[e])
        return h @ w_down[e]

    yb = lax.map(expert_rows, (xb, blk_ex)).reshape(n_blocks * MOE_ROWS, D)
    out = jnp.zeros((T + 1, D), x.dtype).at[buf_tok].add(yb * buf_w[:, None])[:T]
    return out.reshape(B, S, D)


def setup_inputs(seed: int = 0) -> dict:
    key = jax.random.key(seed)
    ks = jax.random.split(key, 24)
    L = DEPTH

    def nrm(k, shape, scale):
        return jax.random.normal(k, shape, jnp.float32) * scale

    cmp_in = NSA_CMP_LEN * HEAD_DIM
    return {
        'x': nrm(ks[0], (BATCH, SEQ, D_MODEL), 1.0),
        'w_in': nrm(ks[1], (L, D_MODEL, IN_COLS), D_MODEL ** -0.5),
        'q_lat_norm': 1.0 + nrm(ks[2], (L, MLA_Q_RANK), 0.02),
        'w_q_up': nrm(ks[3], (L, MLA_Q_RANK, MLA_HEADS * (MLA_NOPE_DIM + MLA_ROPE_DIM)), MLA_Q_RANK ** -0.5),
        'kv_lat_norm': 1.0 + nrm(ks[4], (L, MLA_KV_RANK), 0.02),
        'w_kv_up': nrm(ks[5], (L, MLA_KV_RANK, MLA_HEADS * (MLA_NOPE_DIM + MLA_V_DIM)), MLA_KV_RANK ** -0.5),
        'cmp_pos_k': nrm(ks[6], (L, NSA_CMP_LEN, HEAD_DIM), 0.1),
        'cmp_w1_k': nrm(ks[7], (L, cmp_in, NSA_CMP_HIDDEN), cmp_in ** -0.5),
        'cmp_w2_k': nrm(ks[8], (L, NSA_CMP_HIDDEN, HEAD_DIM), NSA_CMP_HIDDEN ** -0.5),
        'cmp_pos_v': nrm(ks[9], (L, NSA_CMP_LEN, HEAD_DIM), 0.1),
        'cmp_w1_v': nrm(ks[10], (L, cmp_in, NSA_CMP_HIDDEN), cmp_in ** -0.5),
        'cmp_w2_v': nrm(ks[11], (L, NSA_CMP_HIDDEN, HEAD_DIM), NSA_CMP_HIDDEN ** -0.5),
        'w_out': nrm(ks[12], (L, D_MIX, D_MODEL), D_MIX ** -0.5 * DN_BETA),
        'ln1_g': 1.0 + nrm(ks[13], (L, D_MODEL), 0.02),
        'ln1_b': nrm(ks[14], (L, D_MODEL), 0.02),
        'w_grp': nrm(ks[15], (L, D_MODEL, N_GROUPS), D_MODEL ** -0.5),
        'w_exp': nrm(ks[16], (L, D_MODEL, N_EXPERTS), D_MODEL ** -0.5),
        'w_gate': nrm(ks[17], (L, N_EXPERTS, D_MODEL, EXPERT_FF), D_MODEL ** -0.5),
        'w_up': nrm(ks[18], (L, N_EXPERTS, D_MODEL, EXPERT_FF), D_MODEL ** -0.5),
        'w_down': nrm(ks[19], (L, N_EXPERTS, EXPERT_FF, D_MODEL), EXPERT_FF ** -0.5 * DN_BETA),
        'ln2_g': 1.0 + nrm(ks[20], (L, D_MODEL), 0.02),
        'ln2_b': nrm(ks[21], (L, D_MODEL), 0.02),
    }


def reference(x, w_in, q_lat_norm, w_q_up, kv_lat_norm, w_kv_up, cmp_pos_k, cmp_w1_k, cmp_w2_k,
              cmp_pos_v, cmp_w1_v, cmp_w2_v, w_out, ln1_g, ln1_b, w_grp, w_exp, w_gate, w_up, w_down,
              ln2_g, ln2_b):
    for l in range(DEPTH):
        mix = hybrid_mixer(x, w_in[l], q_lat_norm[l], w_q_up[l], kv_lat_norm[l], w_kv_up[l],
                           cmp_pos_k[l], cmp_w1_k[l], cmp_w2_k[l], cmp_pos_v[l], cmp_w1_v[l], cmp_w2_v[l],
                           w_out[l])
        x = layer_norm(DN_ALPHA * x + mix, ln1_g[l], ln1_b[l])
        ffn = hier_moe(x, w_grp[l], w_exp[l], w_gate[l], w_up[l], w_down[l])
        x = layer_norm(DN_ALPHA * x + ffn, ln2_g[l], ln2_b[l])
    return x
```

```cpp
#include <hip/hip_runtime.h>
#include <stdint.h>
#include <stdio.h>

#define LAS __attribute__((address_space(3)))
typedef unsigned short bf16_t;
typedef short bf16x8 __attribute__((ext_vector_type(8)));
typedef short s16x4 __attribute__((ext_vector_type(4)));
typedef float f32x16 __attribute__((ext_vector_type(16)));
typedef float f32x4 __attribute__((ext_vector_type(4)));
typedef float f32x2 __attribute__((ext_vector_type(2)));
typedef unsigned u32x4 __attribute__((ext_vector_type(4)));
typedef unsigned u32x2 __attribute__((ext_vector_type(2)));

constexpr int NB = 4, SEQ = 2048, NT = NB * SEQ, DM = 2048, DEPTH = 2;
constexpr int INC = 4434, LDH = 4480;
constexpr int C_QLAT = 0, C_KVLAT = 384, C_KROPE = 512, C_DQ = 576, C_DK = 1344, C_DV = 2112, C_NQ = 2880, C_NKC = 3648, C_NVC = 3776,
              C_NKS = 3904, C_NVS = 4032, C_NKW = 4160, C_NVW = 4288, C_GATE = 4416;
constexpr int NEXP = 32, EFF = 512;
constexpr float DN_ALPHA = 1.41421356237309515f;
constexpr float LOG2E = 1.4426950408889634f;

constexpr size_t al256(size_t x) { return (x + 255) & ~(size_t)255; }
constexpr size_t OFF_BAR = 0;
constexpr size_t OFF_CTR = 16384;
constexpr size_t ZERO_BYTES = 20480;
constexpr size_t OFF_ECNT = ZERO_BYTES;
constexpr size_t OFF_CS16 = OFF_ECNT + 256;
constexpr size_t OFF_CS32 = OFF_CS16 + (size_t)SEQ * 16 * 8;
constexpr size_t OFF_WIN_T = OFF_CS32 + (size_t)SEQ * 32 * 8;
constexpr size_t OFF_WQ_T = OFF_WIN_T + (size_t)LDH * DM * 2;
constexpr size_t OFF_WKV_T = OFF_WQ_T + (size_t)768 * 384 * 2;
constexpr size_t OFF_W1K_T = OFF_WKV_T + (size_t)1024 * 128 * 2;
constexpr size_t OFF_W1V_T = OFF_W1K_T + (size_t)256 * 4096 * 2;
constexpr size_t OFF_W2K_T = OFF_W1V_T + (size_t)256 * 4096 * 2;
constexpr size_t OFF_W2V_T = OFF_W2K_T + (size_t)128 * 256 * 2;
constexpr size_t OFF_WOUT_T = OFF_W2V_T + (size_t)128 * 256 * 2;
constexpr size_t OFF_WGU_T = OFF_WOUT_T + (size_t)DM * DM * 2;
constexpr size_t OFF_WD_T = OFF_WGU_T + (size_t)NEXP * 1024 * DM * 2;
constexpr size_t OFF_B1P = OFF_WD_T + (size_t)NEXP * DM * EFF * 2;
constexpr size_t OFF_XB = OFF_B1P + (size_t)2 * 16 * 256 * 4;
constexpr size_t OFF_H = OFF_XB + (size_t)NT * DM * 2;
constexpr size_t OFF_GATES = OFF_H + (size_t)NT * LDH * 2;
constexpr size_t OFF_QM = OFF_GATES + al256((size_t)NT * 18 * 4);
constexpr size_t OFF_KN = OFF_QM + (size_t)NT * 768 * 2;
constexpr size_t OFF_VM = OFF_KN + (size_t)NT * 512 * 2;
static_assert(OFF_VM == OFF_KN + (size_t)NT * 512 * 2, "Vm must follow Kn");
constexpr size_t OFF_HC = OFF_VM + (size_t)NT * 512 * 2;
constexpr size_t OFF_KC = OFF_HC + (size_t)2 * 512 * 256 * 2;
constexpr size_t OFF_VC = OFF_KC + (size_t)512 * 128 * 2;
constexpr size_t OFF_IMP = OFF_VC + (size_t)512 * 128 * 2;
constexpr size_t OFF_ODIL = OFF_IMP + (size_t)NT * 32 * 4;
constexpr size_t OFF_LDIL = OFF_ODIL + (size_t)3 * NT * 768 * 2;
constexpr size_t OFF_PC = OFF_LDIL + (size_t)3 * NT * 6 * 4;
constexpr size_t OFF_PS = OFF_PC + (size_t)NT * 768 * 2;
constexpr size_t OFF_PW = OFF_PS + (size_t)NT * 768 * 2;
constexpr size_t OFF_MIX = OFF_PW + (size_t)NT * 768 * 2;
constexpr size_t OFF_YB = OFF_MIX + (size_t)NT * DM * 2;
constexpr size_t OFF_XA = OFF_YB + (size_t)NT * DM * 4;
constexpr size_t OFF_X1 = OFF_XA + (size_t)NT * DM * 4;
constexpr size_t OFF_X1B = OFF_X1 + (size_t)NT * DM * 4;
constexpr size_t OFF_HM = OFF_X1B + (size_t)NT * DM * 2;
constexpr size_t OFF_Y = OFF_HM + (size_t)(2 * NT + 128) * EFF * 2;
constexpr size_t OFF_LIST = OFF_Y + (size_t)2 * NT * DM * 2;
constexpr size_t OFF_GW = OFF_LIST + (size_t)NEXP * NT * 4;
constexpr size_t WS_TOTAL = OFF_GW + (size_t)2 * NT * 4;

struct Params { const float* in[22]; float* out; char* ws; };
enum { I_X = 0, I_WIN, I_QLN, I_WQUP, I_KVLN, I_WKVUP, I_PEK, I_W1K, I_W2K, I_PEV, I_W1V, I_W2V, I_WOUT, I_LN1G, I_LN1B, I_WGRP, I_WEXP, I_WGATE, I_WUP, I_WDOWN, I_LN2G, I_LN2B };

#define XB_TMO      128
#define XB_XCNT(j)  (256  + 64 * (j))
#define XB_XSUB(j)  (1280 + 64 * (j))
#define XB_XGEN(j)  (2304 + 64 * (j))
#define XB_TOP      3328
#define XB_TOPGEN   3392
#define XCD_BAR_WORDS 3456
#define XB_SPIN_CAP (1u << 18)

__device__ __forceinline__ unsigned xb_ld(unsigned* p)              { return __hip_atomic_load(p, __ATOMIC_RELAXED, __HIP_MEMORY_SCOPE_AGENT); }
__device__ __forceinline__ unsigned xb_add(unsigned* p, unsigned v) { return __hip_atomic_fetch_add(p, v, __ATOMIC_RELAXED, __HIP_MEMORY_SCOPE_AGENT); }
__device__ __forceinline__ unsigned xb_xcc_id() { return (unsigned)__builtin_amdgcn_s_getreg((3 << 11) | 20) & 0xFu; }
#define XB_SPIN(cond, bar) do { unsigned _sp = 0; while (cond) { __builtin_amdgcn_s_sleep(1); \
    if ((++_sp & 255u) == 0u) { if (xb_ld(&(bar)[XB_TMO])) break; if (_sp > XB_SPIN_CAP) { atomicAdd(&(bar)[XB_TMO], 1u); break; } } } } while (0)

struct XcdBarrier { unsigned* bar; unsigned x; volatile LAS unsigned* st; };

__device__ __forceinline__ XcdBarrier xcd_barrier_post(unsigned* bar, volatile LAS unsigned* st) {
    XcdBarrier b; b.bar = bar; b.x = xb_xcc_id(); b.st = st;
    if (threadIdx.x == 0) (void)xb_add(&bar[XB_XCNT(b.x)], 1u);
    return b;
}
__device__ __forceinline__ void xcd_barrier_complete(unsigned* bar, unsigned x, unsigned& nloc, unsigned& nx) {
    const unsigned G = gridDim.x * gridDim.y * gridDim.z;
    unsigned sum, cnt, mine, sp = 0u;
    for (;;) {
        sum = 0u; cnt = 0u; mine = 0u;
#pragma unroll
        for (unsigned j = 0; j < 16; ++j) { const unsigned c = xb_ld(&bar[XB_XCNT(j)]); sum += c; cnt += (c > 0u) ? 1u : 0u; mine = (j == x) ? c : mine; }
        if (sum == G) break;
        __builtin_amdgcn_s_sleep(1);
        if ((++sp & 255u) == 0u) { if (xb_ld(&bar[XB_TMO])) break; if (sp > XB_SPIN_CAP) { atomicAdd(&bar[XB_TMO], 1u); break; } }
    }
    nloc = mine > 0u ? mine : 1u; nx = cnt > 0u ? cnt : 1u;
}
__device__ __forceinline__ void xcd_barrier(const XcdBarrier& b) {
    asm volatile("s_waitcnt vmcnt(0)" ::: "memory");
    __syncthreads();
    if (threadIdx.x == 0) {
        unsigned* bar = b.bar;
        __builtin_amdgcn_s_waitcnt(0);
        unsigned nloc = b.st[0], nx = b.st[1];
        if (nloc == 0u) { xcd_barrier_complete(bar, b.x, nloc, nx); b.st[0] = nloc; b.st[1] = nx; }
        const unsigned old = xb_add(&bar[XB_XSUB(b.x)], 1u);
        const unsigned gen = old / nloc;
        if (old + 1u == (gen + 1u) * nloc) {
            __builtin_amdgcn_fence(__ATOMIC_RELEASE, "agent");
            asm volatile("s_waitcnt vmcnt(0)" ::: "memory");
            const unsigned og = xb_add(&bar[XB_TOP], 1u);
            const unsigned tg = og / nx;
            if (og + 1u == (tg + 1u) * nx) xb_add(&bar[XB_TOPGEN], 1u);
            else XB_SPIN(xb_ld(&bar[XB_TOPGEN]) == tg, bar);
            __builtin_amdgcn_fence(__ATOMIC_ACQUIRE, "agent");
            xb_add(&bar[XB_XGEN(b.x)], 1u);
            asm volatile("s_waitcnt vmcnt(0)" ::: "memory");
        } else {
            XB_SPIN(xb_ld(&bar[XB_XGEN(b.x)]) == gen, bar);
            __builtin_amdgcn_fence(__ATOMIC_ACQUIRE, "agent");
            asm volatile("s_waitcnt vmcnt(0)" ::: "memory");
        }
    }
    __syncthreads();
}

__device__ __forceinline__ unsigned cvtpk(float lo, float hi) { unsigned r; asm volatile("v_cvt_pk_bf16_f32 %0, %1, %2" : "=v"(r) : "v"(lo), "v"(hi)); return r; }
__device__ __forceinline__ float bf_lo(unsigned u) { return __uint_as_float(u << 16); }
__device__ __forceinline__ float bf_hi(unsigned u) { return __uint_as_float(u & 0xffff0000u); }
__device__ __forceinline__ float bf2f(bf16_t b) { return __uint_as_float((unsigned)b << 16); }
__device__ __forceinline__ float wave_sum(float v) {
#pragma unroll
    for (int o = 32; o >= 1; o >>= 1) v += __shfl_xor(v, o);
    return v;
}
__device__ __forceinline__ int otid() { int t = threadIdx.x; asm volatile("" : "+v"(t)); return t; }
__device__ __forceinline__ int oblk() { int b = blockIdx.x; asm volatile("" : "+s"(b)); return b; }
__device__ __forceinline__ char* ows(const char* w) { char* q = const_cast<char*>(w); asm volatile("" : "+s"(q)); return q; }
__device__ __forceinline__ int crow(int r, int hi) { return (r & 3) + 8 * (r >> 2) + 4 * hi; }

constexpr int LDS_BYTES = 65536;
constexpr int LDS_CTL = 65024;

constexpr int GS = 40;
constexpr int G_TILE = 128 * GS * 2;
constexpr int G_ROWSS = 4 * G_TILE;

template <bool ROWSS, class EPI>
__device__ __forceinline__ void gemm_unit(LAS char* lds, const bf16_t* a0, const bf16_t* a1, int ajump, const bf16_t* b0, const bf16_t* b1, int nkt, const EPI& epi) {
    const int tid = otid(), lane = tid & 63, w = tid >> 6, l32 = lane & 31, hi = lane >> 5;
    const int wm = w >> 1, wn = w & 1;
    const int sr = tid >> 2, sc = (tid & 3) * 8;
    const int st_off = (sr * GS + sc) * 2;
    const int a_rd = ((wm * 64 + l32) * GS + hi * 8) * 2;
    const int b_rd = 2 * G_TILE + ((wn * 64 + l32) * GS + hi * 8) * 2;
    f32x16 acc[2][2];
#pragma unroll
    for (int i = 0; i < 2; ++i)
#pragma unroll
        for (int j = 0; j < 2; ++j)
#pragma unroll
            for (int r = 0; r < 16; ++r) acc[i][j][r] = 0.f;
    bf16x8 ra0, ra1, rb0, rb1;
    float ss0 = 0.f, ss1 = 0.f;
    ra0 = *(const bf16x8*)a0; ra1 = *(const bf16x8*)a1; rb0 = *(const bf16x8*)b0; rb1 = *(const bf16x8*)b1;
    if (ROWSS) {
#pragma unroll
        for (int j = 0; j < 8; ++j) { const float x0 = bf2f((bf16_t)ra0[j]), x1 = bf2f((bf16_t)ra1[j]); ss0 += x0 * x0; ss1 += x1 * x1; }
    }
    *(LAS bf16x8*)(lds + st_off) = ra0; *(LAS bf16x8*)(lds + st_off + 64 * GS * 2) = ra1;
    *(LAS bf16x8*)(lds + 2 * G_TILE + st_off) = rb0; *(LAS bf16x8*)(lds + 2 * G_TILE + st_off + 64 * GS * 2) = rb1;
    __syncthreads();
    for (int kt = 0; kt < nkt; ++kt) {
        const int cur = kt & 1;
        const bool more = kt + 1 < nkt;
        if (more) {
            const int k = (kt + 1) * 32;
            const int ao = (k >> 7) * ajump + (k & 127);
            ra0 = *(const bf16x8*)(a0 + ao); ra1 = *(const bf16x8*)(a1 + ao); rb0 = *(const bf16x8*)(b0 + k); rb1 = *(const bf16x8*)(b1 + k);
        }
        const LAS char* la = lds + cur * G_TILE + a_rd;
        const LAS char* lb = lds + cur * G_TILE + b_rd;
#pragma unroll
        for (int ks = 0; ks < 2; ++ks) {
            bf16x8 af[2], bfr[2];
#pragma unroll
            for (int i = 0; i < 2; ++i) { af[i] = *(const LAS bf16x8*)(la + i * 32 * GS * 2 + ks * 32); bfr[i] = *(const LAS bf16x8*)(lb + i * 32 * GS * 2 + ks * 32); }
#pragma unroll
            for (int i = 0; i < 2; ++i)
#pragma unroll
                for (int j = 0; j < 2; ++j) acc[i][j] = __builtin_amdgcn_mfma_f32_32x32x16_bf16(bfr[j], af[i], acc[i][j], 0, 0, 0);
        }
        if (more) {
            if (ROWSS) {
#pragma unroll
                for (int j = 0; j < 8; ++j) { const float x0 = bf2f((bf16_t)ra0[j]), x1 = bf2f((bf16_t)ra1[j]); ss0 += x0 * x0; ss1 += x1 * x1; }
            }
            LAS char* wb = lds + (cur ^ 1) * G_TILE;
            *(LAS bf16x8*)(wb + st_off) = ra0; *(LAS bf16x8*)(wb + st_off + 64 * GS * 2) = ra1;
            *(LAS bf16x8*)(wb + 2 * G_TILE + st_off) = rb0; *(LAS bf16x8*)(wb + 2 * G_TILE + st_off + 64 * GS * 2) = rb1;
        }
        __syncthreads();
    }
    if (ROWSS) {
        ss0 += __shfl_xor(ss0, 1); ss0 += __shfl_xor(ss0, 2); ss1 += __shfl_xor(ss1, 1); ss1 += __shfl_xor(ss1, 2);
        LAS float* rs = (LAS float*)(lds + G_ROWSS);
        if ((tid & 3) == 0) { rs[sr] = ss0; rs[sr + 64] = ss1; }
        __syncthreads();
    }
    epi(acc, wm, wn, l32, hi, lds);
    if (ROWSS) __syncthreads();
}

__device__ __forceinline__ void store_bf4(bf16_t* p, float a, float b, float c, float d) { u32x2 w; w.x = cvtpk(a, b); w.y = cvtpk(c, d); *(u32x2*)p = w; }

struct EpiWin {
    bf16_t* H; float* gates; const f32x2* cs16; const f32x2* cs32; int m0, n0;
    __device__ __forceinline__ void operator()(f32x16 (&acc)[2][2], int wm, int wn, int l32, int hi, LAS char*) const {
        const int nw = n0 + 64 * wn;
        const bool r16 = (((nw - C_DQ) & 127) == 0) && ((nw >= C_DQ && nw < C_DV) || (nw >= C_NQ && nw < C_NKC) || nw == C_NKS || nw == C_NKW);
#pragma unroll
        for (int mi = 0; mi < 2; ++mi) {
            const int row = m0 + 64 * wm + 32 * mi + l32, pos = row & (SEQ - 1);
            if (nw == C_KROPE) {
#pragma unroll
                for (int r = 0; r < 16; ++r) { const f32x2 cs = cs32[pos * 32 + crow(r, hi)]; const float x1 = acc[mi][0][r], x2 = acc[mi][1][r];
                    acc[mi][0][r] = x1 * cs.x - x2 * cs.y; acc[mi][1][r] = x2 * cs.x + x1 * cs.y; }
            } else if (r16) {
#pragma unroll
                for (int r = 0; r < 8; ++r) { const f32x2 cs = cs16[pos * 16 + crow(r, hi)]; const float x1 = acc[mi][0][r], x2 = acc[mi][0][r + 8];
                    acc[mi][0][r] = x1 * cs.x - x2 * cs.y; acc[mi][0][r + 8] = x2 * cs.x + x1 * cs.y; }
            }
            if (nw == C_GATE) {
#pragma unroll
                for (int r = 0; r < 16; ++r) { const int c = crow(r, hi); if (c < 18) gates[(size_t)row * 18 + c] = 1.f / (1.f + __expf(-acc[mi][0][r])); }
            }
            bf16_t* hp = H + (size_t)row * LDH + nw + 4 * hi;
#pragma unroll
            for (int ni = 0; ni < 2; ++ni)
#pragma unroll
                for (int q = 0; q < 4; ++q) store_bf4(hp + 32 * ni + 8 * q, acc[mi][ni][4 * q], acc[mi][ni][4 * q + 1], acc[mi][ni][4 * q + 2], acc[mi][ni][4 * q + 3]);
        }
    }
};
struct EpiQup {
    bf16_t* Q; const f32x2* cs32; int m0, n0;
    __device__ __forceinline__ void operator()(f32x16 (&acc)[2][2], int wm, int wn, int l32, int hi, LAS char* lds) const {
        const int nw = n0 + 64 * wn; const LAS float* rs = (const LAS float*)(lds + G_ROWSS);
#pragma unroll
        for (int mi = 0; mi < 2; ++mi) {
            const int rl = 64 * wm + 32 * mi + l32, row = m0 + rl, pos = row & (SEQ - 1);
            const float sc = __builtin_amdgcn_rsqf(rs[rl] * (1.f / 384.f) + 1e-6f);
#pragma unroll
            for (int ni = 0; ni < 2; ++ni)
#pragma unroll
                for (int r = 0; r < 16; ++r) acc[mi][ni][r] *= sc;
            if ((nw % 192) == 128) {
#pragma unroll
                for (int r = 0; r < 16; ++r) { const f32x2 cs = cs32[pos * 32 + crow(r, hi)]; const float x1 = acc[mi][0][r], x2 = acc[mi][1][r];
                    acc[mi][0][r] = x1 * cs.x - x2 * cs.y; acc[mi][1][r] = x2 * cs.x + x1 * cs.y; }
            }
            bf16_t* qp = Q + (size_t)row * 768 + nw + 4 * hi;
#pragma unroll
            for (int ni = 0; ni < 2; ++ni)
#pragma unroll
                for (int q = 0; q < 4; ++q) store_bf4(qp + 32 * ni + 8 * q, acc[mi][ni][4 * q], acc[mi][ni][4 * q + 1], acc[mi][ni][4 * q + 2], acc[mi][ni][4 * q + 3]);
        }
    }
};
struct EpiKVup {
    bf16_t* Kn; int m0, n0;
    __device__ __forceinline__ void operator()(f32x16 (&acc)[2][2], int wm, int wn, int l32, int hi, LAS char* lds) const {
        const int nw = n0 + 64 * wn; const LAS float* rs = (const LAS float*)(lds + G_ROWSS);
        const int head = nw >> 8, within = nw & 255;
        bf16_t* base = Kn + (within < 128 ? (size_t)0 : (size_t)NT * 512) + head * 128 + (within & 127) + 4 * hi;
#pragma unroll
        for (int mi = 0; mi < 2; ++mi) {
            const int rl = 64 * wm + 32 * mi + l32, row = m0 + rl;
            const float sc = __builtin_amdgcn_rsqf(rs[rl] * (1.f / 128.f) + 1e-6f);
            bf16_t* p = base + (size_t)row * 512;
#pragma unroll
            for (int ni = 0; ni < 2; ++ni)
#pragma unroll
                for (int q = 0; q < 4; ++q) store_bf4(p + 32 * ni + 8 * q, acc[mi][ni][4 * q] * sc, acc[mi][ni][4 * q + 1] * sc, acc[mi][ni][4 * q + 2] * sc, acc[mi][ni][4 * q + 3] * sc);
        }
    }
};
__device__ __forceinline__ float gelu_tanh(float x) {
    const float u = 0.7978845608028654f * (x + 0.044715f * x * x * x);
    const float e = __expf(-2.f * fabsf(u)); const float t = (1.f - e) / (1.f + e);
    return 0.5f * x * (1.f + (u < 0.f ? -t : t));
}
struct EpiCmp1 {
    bf16_t* Hc; const float* b1p; int m0, n0;
    __device__ __forceinline__ void operator()(f32x16 (&acc)[2][2], int wm, int wn, int l32, int hi, LAS char*) const {
        const int nw = n0 + 64 * wn;
#pragma unroll
        for (int ni = 0; ni < 2; ++ni)
#pragma unroll
            for (int q = 0; q < 4; ++q) {
                const int c = nw + 32 * ni + 8 * q + 4 * hi;
                f32x4 bs = {0.f, 0.f, 0.f, 0.f};
                for (int p = 0; p < 16; ++p) bs += *(const f32x4*)(b1p + p * 256 + c);
#pragma unroll
                for (int mi = 0; mi < 2; ++mi) {
                    const int row = m0 + 64 * wm + 32 * mi + l32;
                    store_bf4(Hc + (size_t)row * 256 + c, gelu_tanh(acc[mi][ni][4 * q] + bs[0]), gelu_tanh(acc[mi][ni][4 * q + 1] + bs[1]),
                              gelu_tanh(acc[mi][ni][4 * q + 2] + bs[2]), gelu_tanh(acc[mi][ni][4 * q + 3] + bs[3]));
                }
            }
    }
};
struct EpiCmp2 {
    bf16_t* O; const f32x2* cs16; int dorope; int m0, n0;
    __device__ __forceinline__ void operator()(f32x16 (&acc)[2][2], int wm, int wn, int l32, int hi, LAS char*) const {
        const int nw = n0 + 64 * wn;
#pragma unroll
        for (int mi = 0; mi < 2; ++mi) {
            const int row = m0 + 64 * wm + 32 * mi + l32, c = row & 127, pos = 16 * c + 31;
            if (dorope && nw == 0 && c < 127) {
#pragma unroll
                for (int r = 0; r < 8; ++r) { const f32x2 cs = cs16[pos * 16 + crow(r, hi)]; const float x1 = acc[mi][0][r], x2 = acc[mi][0][r + 8];
                    acc[mi][0][r] = x1 * cs.x - x2 * cs.y; acc[mi][0][r + 8] = x2 * cs.x + x1 * cs.y; }
            }
            const float z = c < 127 ? 1.f : 0.f;
            bf16_t* p = O + (size_t)row * 128 + nw + 4 * hi;
#pragma unroll
            for (int ni = 0; ni < 2; ++ni)
#pragma unroll
                for (int q = 0; q < 4; ++q) store_bf4(p + 32 * ni + 8 * q, acc[mi][ni][4 * q] * z, acc[mi][ni][4 * q + 1] * z, acc[mi][ni][4 * q + 2] * z, acc[mi][ni][4 * q + 3] * z);
        }
    }
};
struct EpiOut {
    float* Y; const float* X; int m0, n0;
    __device__ __forceinline__ void operator()(f32x16 (&acc)[2][2], int wm, int wn, int l32, int hi, LAS char*) const {
        const int nw = n0 + 64 * wn;
#pragma unroll
        for (int mi = 0; mi < 2; ++mi) {
            const size_t off = (size_t)(m0 + 64 * wm + 32 * mi + l32) * DM + nw + 4 * hi;
#pragma unroll
            for (int ni = 0; ni < 2; ++ni)
#pragma unroll
                for (int q = 0; q < 4; ++q) { const f32x4 xv = *(const f32x4*)(X + off + 32 * ni + 8 * q);
                    f32x4 o; o[0] = DN_ALPHA * xv[0] + acc[mi][ni][4 * q]; o[1] = DN_ALPHA * xv[1] + acc[mi][ni][4 * q + 1]; o[2] = DN_ALPHA * xv[2] + acc[mi][ni][4 * q + 2]; o[3] = DN_ALPHA * xv[3] + acc[mi][ni][4 * q + 3];
                    *(f32x4*)(Y + off + 32 * ni + 8 * q) = o; }
        }
    }
};
struct EpiMoe1 {
    bf16_t* Hm; int rowbase, nvalid, ntile;
    __device__ __forceinline__ void operator()(f32x16 (&acc)[2][2], int wm, int wn, int l32, int hi, LAS char*) const {
#pragma unroll
        for (int mi = 0; mi < 2; ++mi) {
            const int rl = 64 * wm + 32 * mi + l32;
            if (rl < nvalid) {
                bf16_t* p = Hm + (size_t)(rowbase + rl) * EFF + 64 * ntile + 32 * wn + 4 * hi;
#pragma unroll
                for (int q = 0; q < 4; ++q) { float v[4];
#pragma unroll
                    for (int j = 0; j < 4; ++j) { const float g = acc[mi][0][4 * q + j], u = acc[mi][1][4 * q + j]; v[j] = g / (1.f + __expf(-g)) * u; }
                    store_bf4(p + 8 * q, v[0], v[1], v[2], v[3]); }
            }
        }
    }
};
struct EpiMoe2 {
    bf16_t* Y; const int* list; const float* gw; int nvalid, n0;
    __device__ __forceinline__ void operator()(f32x16 (&acc)[2][2], int wm, int wn, int l32, int hi, LAS char*) const {
        const int nw = n0 + 64 * wn;
#pragma unroll
        for (int mi = 0; mi < 2; ++mi) {
            const int rl = 64 * wm + 32 * mi + l32;
            if (rl < nvalid) {
                const int slot = list[rl]; const float g = gw[slot];
                bf16_t* p = Y + (size_t)slot * DM + nw + 4 * hi;
#pragma unroll
                for (int ni = 0; ni < 2; ++ni)
#pragma unroll
                    for (int q = 0; q < 4; ++q) store_bf4(p + 32 * ni + 8 * q, acc[mi][ni][4 * q] * g, acc[mi][ni][4 * q + 1] * g, acc[mi][ni][4 * q + 2] * g, acc[mi][ni][4 * q + 3] * g);
            }
        }
    }
};

constexpr int VS = 160;
struct KeySrc { const bf16_t* k0; size_t kstride; const bf16_t* kr; size_t krstride; const bf16_t* v0; size_t vstride; };

template <int DQK> __device__ __forceinline__ void attn_stage(LAS char* lds, const KeySrc& ks, int jt, bool withv) {
    constexpr int KS = DQK + 8, KCH = DQK / 8, NKL = KCH * 64 / 256;
    const int tid = otid();
    bf16x8 kreg[NKL], vreg[4];
#pragma unroll
    for (int i = 0; i < NKL; ++i) { const int idx = tid + i * 256, key = idx / KCH, ch = idx - key * KCH; const size_t kk = (size_t)(jt * 64 + key);
        const bf16_t* src = (DQK == 128 || ch < 16) ? ks.k0 + kk * ks.kstride + ch * 8 : ks.kr + kk * ks.krstride + (ch - 16) * 8;
        kreg[i] = *(const bf16x8*)src; }
    if (withv) {
#pragma unroll
        for (int i = 0; i < 4; ++i) { const int idx = tid + i * 256, key = idx >> 4, ch = idx & 15; vreg[i] = *(const bf16x8*)(ks.v0 + (size_t)(jt * 64 + key) * ks.vstride + ch * 8); }
    }
#pragma unroll
    for (int i = 0; i < NKL; ++i) { const int idx = tid + i * 256, key = idx / KCH, ch = idx - key * KCH; *(LAS bf16x8*)(lds + (key * KS + ch * 8) * 2) = kreg[i]; }
    if (withv) {
#pragma unroll
        for (int i = 0; i < 4; ++i) { const int idx = tid + i * 256, key = idx >> 4, ch = idx & 15; *(LAS bf16x8*)(lds + 64 * KS * 2 + (key * VS + ch * 8) * 2) = vreg[i]; }
    }
}
template <int DQK> __device__ __forceinline__ void attn_scores(const LAS char* lds, const bf16x8 (&qf)[DQK / 16], f32x16& p0, f32x16& p1, int l32, int hi) {
    constexpr int KS = DQK + 8;
    const int sg = (l32 & ~12) | ((l32 & 4) << 1) | ((l32 & 8) >> 1);
    const LAS char* kb = lds + (sg * KS + hi * 8) * 2;
#pragma unroll
    for (int r = 0; r < 16; ++r) { p0[r] = 0.f; p1[r] = 0.f; }
#pragma unroll
    for (int ds = 0; ds < DQK / 16; ++ds) {
        const bf16x8 a0 = *(const LAS bf16x8*)(kb + ds * 32), a1 = *(const LAS bf16x8*)(kb + 32 * KS * 2 + ds * 32);
        p0 = __builtin_amdgcn_mfma_f32_32x32x16_bf16(a0, qf[ds], p0, 0, 0, 0);
        p1 = __builtin_amdgcn_mfma_f32_32x32x16_bf16(a1, qf[ds], p1, 0, 0, 0);
    }
}
template <int DQK, bool SEL>
__device__ __forceinline__ void attn_run(LAS char* lds, const KeySrc& ks, int jt_lo, int jt_hi, unsigned tile_union, const bf16x8 (&qf)[DQK / 16],
                                         int qi, unsigned maxd, unsigned sel, float c2, f32x16 (&o)[4], float& m_run, float& l_run) {
    constexpr int KS = DQK + 8;
    const int lane = otid() & 63, l32 = lane & 31, hi = lane >> 5;
    const int g = lane >> 4, i16 = lane & 15;
    const LAS char* vb = (lds + 64 * KS * 2 + ((8 * hi + (i16 >> 2)) * VS + 16 * (g & 1) + 4 * (i16 & 3)) * 2);
    const float NEG = -__builtin_inff();
    for (int jt = jt_lo; jt < jt_hi; ++jt) {
        if (SEL && !((tile_union >> jt) & 1u)) continue;
        attn_stage<DQK>(lds, ks, jt, true);
        __syncthreads();
        f32x16 p0, p1;
        attn_scores<DQK>(lds, qf, p0, p1, l32, hi);
        const bool ok = SEL ? (((sel >> jt) & 1u) != 0u) : true;
        const int dq = qi - jt * 64 - 8 * hi;
        float mx = NEG;
#pragma unroll
        for (int r = 0; r < 16; ++r) {
            const int ko = 16 * (r >> 3) + (r & 7);
            const float s0 = (ok && (unsigned)(dq - ko) <= maxd) ? p0[r] * c2 : NEG;
            const float s1 = (ok && (unsigned)(dq - ko - 32) <= maxd) ? p1[r] * c2 : NEG;
            p0[r] = s0; p1[r] = s1; mx = fmaxf(mx, fmaxf(s0, s1));
        }
        mx = fmaxf(mx, __shfl_xor(mx, 32));
        const float mn = fmaxf(m_run, mx);
        const float alpha = __builtin_amdgcn_exp2f(m_run - mn);
        float rs = 0.f;
#pragma unroll
        for (int r = 0; r < 16; ++r) { p0[r] = __builtin_amdgcn_exp2f(p0[r] - mn); p1[r] = __builtin_amdgcn_exp2f(p1[r] - mn); rs += p0[r] + p1[r]; }
        rs += __shfl_xor(rs, 32);
        l_run = l_run * alpha + rs; m_run = mn;
#pragma unroll
        for (int dt = 0; dt < 4; ++dt)
#pragma unroll
            for (int r = 0; r < 16; ++r) o[dt][r] *= alpha;
#pragma unroll
        for (int s4 = 0; s4 < 4; ++s4) {
            u32x4 pw;
            if (s4 == 0)      { pw.x = cvtpk(p0[0], p0[1]);  pw.y = cvtpk(p0[2], p0[3]);   pw.z = cvtpk(p0[4], p0[5]);   pw.w = cvtpk(p0[6], p0[7]); }
            else if (s4 == 1) { pw.x = cvtpk(p0[8], p0[9]);  pw.y = cvtpk(p0[10], p0[11]); pw.z = cvtpk(p0[12], p0[13]); pw.w = cvtpk(p0[14], p0[15]); }
            else if (s4 == 2) { pw.x = cvtpk(p1[0], p1[1]);  pw.y = cvtpk(p1[2], p1[3]);   pw.z = cvtpk(p1[4], p1[5]);   pw.w = cvtpk(p1[6], p1[7]); }
            else              { pw.x = cvtpk(p1[8], p1[9]);  pw.y = cvtpk(p1[10], p1[11]); pw.z = cvtpk(p1[12], p1[13]); pw.w = cvtpk(p1[14], p1[15]); }
            const bf16x8 pb = *reinterpret_cast<bf16x8*>(&pw);
#pragma unroll
            for (int dt = 0; dt < 4; ++dt) {
                const s16x4 v0 = __builtin_amdgcn_ds_read_tr16_b64_v4i16((LAS s16x4*)(vb + (s4 * 16 * VS + dt * 32) * 2));
                const s16x4 v1 = __builtin_amdgcn_ds_read_tr16_b64_v4i16((LAS s16x4*)(vb + (s4 * 16 * VS + 4 * VS + dt * 32) * 2));
                const bf16x8 va = {v0[0], v0[1], v0[2], v0[3], v1[0], v1[1], v1[2], v1[3]};
                o[dt] = __builtin_amdgcn_mfma_f32_32x32x16_bf16(va, pb, o[dt], 0, 0, 0);
            }
        }
        __syncthreads();
    }
}
template <int DQK> __device__ __forceinline__ void load_q(const bf16_t* qptr, int hi, bf16x8 (&qf)[DQK / 16]) {
#pragma unroll
    for (int ds = 0; ds < DQK / 16; ++ds) qf[ds] = *(const bf16x8*)(qptr + ds * 16 + hi * 8);
}
__device__ __forceinline__ void store_o(bf16_t* optr, const f32x16 (&o)[4], float inv, int hi) {
#pragma unroll
    for (int dt = 0; dt < 4; ++dt)
#pragma unroll
        for (int q = 0; q < 4; ++q) store_bf4(optr + 32 * dt + 8 * q + 4 * hi, o[dt][4 * q] * inv, o[dt][4 * q + 1] * inv, o[dt][4 * q + 2] * inv, o[dt][4 * q + 3] * inv);
}
__device__ __forceinline__ void zero_o(f32x16 (&o)[4]) {
#pragma unroll
    for (int dt = 0; dt < 4; ++dt)
#pragma unroll
        for (int r = 0; r < 16; ++r) o[dt][r] = 0.f;
}

__device__ __forceinline__ int claim(unsigned* ctr, LAS char* lds) {
    volatile LAS int* slot = (volatile LAS int*)(lds + LDS_CTL + 64);
    __syncthreads();
    if (otid() == 0) *slot = (int)atomicAdd(ctr, 1u);
    __syncthreads();
    return *slot;
}

__device__ __forceinline__ void conv_tile(LAS char* lds, const float* src, int N, int k0, int n0, bf16_t* dst, int ldd, int rowmap, const float* kscale) {
    LAS float* tile = (LAS float*)lds;
    const int tid = otid();
    __syncthreads();
    {
        const int kr = tid >> 6, nc = tid & 63; const bool inb = n0 + nc < N;
#pragma unroll
        for (int i = 0; i < 16; ++i) { const int k = kr + 4 * i; float v = inb ? src[(size_t)(k0 + k) * N + n0 + nc] : 0.f; if (kscale) v *= kscale[k0 + k]; tile[k * 65 + nc] = v; }
    }
    __syncthreads();
    {
        const int n = tid >> 2, kq = (tid & 3) * 16; const int c = n0 + n;
        const int drow = rowmap == 0 ? c : (128 * (c >> 6) + 64 * ((c >> 5) & 1) + 32 * (rowmap - 1) + (c & 31));
        u32x4 w0, w1;
        w0.x = cvtpk(tile[(kq + 0) * 65 + n], tile[(kq + 1) * 65 + n]);   w0.y = cvtpk(tile[(kq + 2) * 65 + n], tile[(kq + 3) * 65 + n]);
        w0.z = cvtpk(tile[(kq + 4) * 65 + n], tile[(kq + 5) * 65 + n]);   w0.w = cvtpk(tile[(kq + 6) * 65 + n], tile[(kq + 7) * 65 + n]);
        w1.x = cvtpk(tile[(kq + 8) * 65 + n], tile[(kq + 9) * 65 + n]);   w1.y = cvtpk(tile[(kq + 10) * 65 + n], tile[(kq + 11) * 65 + n]);
        w1.z = cvtpk(tile[(kq + 12) * 65 + n], tile[(kq + 13) * 65 + n]); w1.w = cvtpk(tile[(kq + 14) * 65 + n], tile[(kq + 15) * 65 + n]);
        bf16_t* d = dst + (size_t)drow * ldd + k0 + kq;
        *(u32x4*)d = w0; *(u32x4*)(d + 8) = w1;
    }
}

__device__ __forceinline__ void phase_prep(const Params& p, int layer, LAS char* lds) {
    char* ws = ows(p.ws);
    const int tid = otid();
    constexpr int N_WIN = 32 * 70, N_WQ = 6 * 12, N_WKV = 2 * 16, N_W1 = 64 * 4, N_W2 = 4 * 2, N_WOUT = 32 * 32, N_EG = NEXP * 32 * 8, N_ED = NEXP * 8 * 32;
    constexpr int E0 = 0, E1 = E0 + N_WIN, E2 = E1 + N_WQ, E3 = E2 + N_WKV, E4 = E3 + N_W1, E5 = E4 + N_W1, E6 = E5 + N_W2, E7 = E6 + N_W2, E8 = E7 + N_WOUT,
                  E9 = E8 + N_EG, E10 = E9 + N_EG, E11 = E10 + N_ED, E12 = E11 + 32  , E13 = E12 + 64  , E14 = E13 + 4096  ;
    const int total = layer == 0 ? E14 : E12;
    for (int it = oblk(); it < total; it += gridDim.x) {
        if (it < E1) { const int u = it - E0, kt = u % 32, nt = u / 32;
            conv_tile(lds, p.in[I_WIN] + (size_t)layer * DM * INC, INC, kt * 64, nt * 64, (bf16_t*)(ws + OFF_WIN_T), DM, 0, nullptr);
        } else if (it < E2) { const int u = it - E1, kt = u % 6, nt = u / 6;
            conv_tile(lds, p.in[I_WQUP] + (size_t)layer * 384 * 768, 768, kt * 64, nt * 64, (bf16_t*)(ws + OFF_WQ_T), 384, 0, p.in[I_QLN] + layer * 384);
        } else if (it < E3) { const int u = it - E2, kt = u % 2, nt = u / 2;
            conv_tile(lds, p.in[I_WKVUP] + (size_t)layer * 128 * 1024, 1024, kt * 64, nt * 64, (bf16_t*)(ws + OFF_WKV_T), 128, 0, p.in[I_KVLN] + layer * 128);
        } else if (it < E5) { const int which = it >= E4, u = it - (which ? E4 : E3), kt = u % 64, nt = u / 64;
            conv_tile(lds, p.in[which ? I_W1V : I_W1K] + (size_t)layer * 4096 * 256, 256, kt * 64, nt * 64, (bf16_t*)(ws + (which ? OFF_W1V_T : OFF_W1K_T)), 4096, 0, nullptr);
        } else if (it < E7) { const int which = it >= E6, u = it - (which ? E6 : E5), kt = u % 4, nt = u / 4;
            conv_tile(lds, p.in[which ? I_W2V : I_W2K] + (size_t)layer * 256 * 128, 128, kt * 64, nt * 64, (bf16_t*)(ws + (which ? OFF_W2V_T : OFF_W2K_T)), 256, 0, nullptr);
        } else if (it < E8) { const int u = it - E7, kt = u % 32, nt = u / 32;
            conv_tile(lds, p.in[I_WOUT] + (size_t)layer * DM * DM, DM, kt * 64, nt * 64, (bf16_t*)(ws + OFF_WOUT_T), DM, 0, nullptr);
        } else if (it < E10) { const int isup = it >= E9, u = it - (isup ? E9 : E8), e = u / 256, r = u % 256, kt = r % 32, nt = r / 32;
            conv_tile(lds, p.in[isup ? I_WUP : I_WGATE] + ((size_t)layer * NEXP + e) * DM * EFF, EFF, kt * 64, nt * 64, (bf16_t*)(ws + OFF_WGU_T) + (size_t)e * 1024 * DM, DM, 1 + isup, nullptr);
        } else if (it < E11) { const int u = it - E10, e = u / 256, r = u % 256, kt = r % 8, nt = r / 8;
            conv_tile(lds, p.in[I_WDOWN] + ((size_t)layer * NEXP + e) * EFF * DM, DM, kt * 64, nt * 64, (bf16_t*)(ws + OFF_WD_T) + (size_t)e * DM * EFF, EFF, 0, nullptr);
        } else if (it < E12) { const int u = it - E11, which = u >> 4, kc = u & 15;
            const float* pe = p.in[which ? I_PEV : I_PEK] + (size_t)layer * 4096 + kc * 256;
            const float* w1 = p.in[which ? I_W1V : I_W1K] + (size_t)layer * 4096 * 256 + (size_t)kc * 256 * 256;
            float a0 = 0.f, a1 = 0.f, a2 = 0.f, a3 = 0.f;
            for (int k = 0; k < 256; k += 4) { a0 += pe[k] * w1[(size_t)k * 256 + tid]; a1 += pe[k + 1] * w1[(size_t)(k + 1) * 256 + tid]; a2 += pe[k + 2] * w1[(size_t)(k + 2) * 256 + tid]; a3 += pe[k + 3] * w1[(size_t)(k + 3) * 256 + tid]; }
            ((float*)(ws + OFF_B1P))[(which * 16 + kc) * 256 + tid] = (a0 + a1) + (a2 + a3);
        } else if (it < E13) { const int u = it - E12;
            f32x2* cs16 = (f32x2*)(ws + OFF_CS16); f32x2* cs32 = (f32x2*)(ws + OFF_CS32);
            for (int e = tid; e < 32 * 48; e += 256) { const int pos = u * 32 + e / 48, j = e % 48;
                const int half = j < 16 ? 16 : 32, i = j < 16 ? j : j - 16;
                const float invf = (float)pow(500000.0, -(double)i / (double)half);
                const float ang = (float)pos * invf;
                f32x2 cs; cs.x = (float)cos((double)ang); cs.y = (float)sin((double)ang);
                if (j < 16) cs16[pos * 16 + i] = cs; else cs32[pos * 32 + i] = cs; }
        } else { const int u = it - E13;
            const float* x = p.in[I_X] + (size_t)u * 4096; bf16_t* xb = (bf16_t*)(ws + OFF_XB) + (size_t)u * 4096;
            for (int e = tid * 4; e < 4096; e += 1024) { const f32x4 v = *(const f32x4*)(x + e); store_bf4(xb + e, v[0], v[1], v[2], v[3]); }
        }
    }
    if (oblk() == 0 && tid < NEXP) ((unsigned*)(ws + OFF_ECNT))[tid] = 0u;
    { unsigned* imp = (unsigned*)(ws + OFF_IMP); for (size_t e = (size_t)oblk() * 256 + tid; e < (size_t)NT * 32; e += (size_t)gridDim.x * 256) imp[e] = 0u; }
}

__device__ __forceinline__ void phase_win(const Params& p, int layer, LAS char* lds) {
    char* ws = ows(p.ws); const int tid = otid(), sr = tid >> 2, sc = (tid & 3) * 8;
    const bf16_t* A = (const bf16_t*)(ws + OFF_XB); const bf16_t* Bt = (const bf16_t*)(ws + OFF_WIN_T);
    for (int u = oblk(); u < 64 * 35; u += gridDim.x) {
        const int mt = u & 63, nt = u >> 6;
        EpiWin e{(bf16_t*)(ws + OFF_H), (float*)(ws + OFF_GATES), (const f32x2*)(ws + OFF_CS16), (const f32x2*)(ws + OFF_CS32), mt * 128, nt * 128};
        const bf16_t* a0 = A + (size_t)(mt * 128 + sr) * DM + sc; const bf16_t* b0 = Bt + (size_t)(nt * 128 + sr) * DM + sc;
        gemm_unit<false>(lds, a0, a0 + (size_t)64 * DM, 128, b0, b0 + (size_t)64 * DM, DM / 32, e);
    }
}
__device__ __forceinline__ void phase_up(const Params& p, int layer, LAS char* lds) {
    char* ws = ows(p.ws); const int tid = otid(), sr = tid >> 2, sc = (tid & 3) * 8;
    const bf16_t* H = (const bf16_t*)(ws + OFF_H);
    constexpr int U0 = 16, U1 = U0 + 64 * 6, U2 = U1 + 64 * 8;
    for (int u = oblk(); u < U2; u += gridDim.x) {
        if (u < U0) {
            const int which = u >> 3, mt = (u >> 1) & 3, nt = u & 1;
            const int col = which ? C_NVC : C_NKC;
            int c0 = sr, c1 = sr + 64; if (c1 > 126) c1 = 126;
            const bf16_t* a0 = H + (size_t)(mt * SEQ + 16 * c0) * LDH + col + sc;
            const bf16_t* a1 = H + (size_t)(mt * SEQ + 16 * c1) * LDH + col + sc;
            const bf16_t* b0 = (const bf16_t*)(ws + (which ? OFF_W1V_T : OFF_W1K_T)) + (size_t)(nt * 128 + sr) * 4096 + sc;
            EpiCmp1 e{(bf16_t*)(ws + OFF_HC) + (size_t)which * 512 * 256, (const float*)(ws + OFF_B1P) + which * 16 * 256, mt * 128, nt * 128};
            gemm_unit<false>(lds, a0, a1, LDH, b0, b0 + (size_t)64 * 4096, 4096 / 32, e);
        } else if (u < U1) {
            const int v = u - U0, mt = v & 63, nt = v >> 6;
            const bf16_t* a0 = H + (size_t)(mt * 128 + sr) * LDH + C_QLAT + sc; const bf16_t* b0 = (const bf16_t*)(ws + OFF_WQ_T) + (size_t)(nt * 128 + sr) * 384 + sc;
            EpiQup e{(bf16_t*)(ws + OFF_QM), (const f32x2*)(ws + OFF_CS32), mt * 128, nt * 128};
            gemm_unit<true>(lds, a0, a0 + (size_t)64 * LDH, 128, b0, b0 + (size_t)64 * 384, 384 / 32, e);
        } else {
            const int v = u - U1, mt = v & 63, nt = v >> 6;
            const bf16_t* a0 = H + (size_t)(mt * 128 + sr) * LDH + C_KVLAT + sc; const bf16_t* b0 = (const bf16_t*)(ws + OFF_WKV_T) + (size_t)(nt * 128 + sr) * 128 + sc;
            EpiKVup e{(bf16_t*)(ws + OFF_KN), mt * 128, nt * 128};
            gemm_unit<true>(lds, a0, a0 + (size_t)64 * LDH, 128, b0, b0 + (size_t)64 * 128, 128 / 32, e);
        }
    }
}
__device__ __forceinline__ void phase_cmp2(const Params& p, int layer, LAS char* lds) {
    char* ws = ows(p.ws); const int tid = otid(), sr = tid >> 2, sc = (tid & 3) * 8;
    for (int u = oblk(); u < 8; u += gridDim.x) {
        const int which = u >> 2, mt = u & 3;
        const bf16_t* a0 = (const bf16_t*)(ws + OFF_HC) + (size_t)which * 512 * 256 + (size_t)(mt * 128 + sr) * 256 + sc;
        const bf16_t* b0 = (const bf16_t*)(ws + (which ? OFF_W2V_T : OFF_W2K_T)) + (size_t)sr * 256 + sc;
        EpiCmp2 e{(bf16_t*)(ws + (which ? OFF_VC : OFF_KC)), (const f32x2*)(ws + OFF_CS16), which == 0, mt * 128, 0};
        gemm_unit<false>(lds, a0, a0 + (size_t)64 * 256, 128, b0, b0 + (size_t)64 * 256, 256 / 32, e);
    }
}
__device__ __forceinline__ void phase_out(const Params& p, int layer, LAS char* lds) {
    char* ws = ows(p.ws); const int tid = otid(), sr = tid >> 2, sc = (tid & 3) * 8;
    const bf16_t* A = (const bf16_t*)(ws + OFF_MIX); const bf16_t* Bt = (const bf16_t*)(ws + OFF_WOUT_T);
    const float* X = layer == 0 ? p.in[I_X] : (const float*)(ws + OFF_XA);
    for (int u = oblk(); u < 64 * 16; u += gridDim.x) {
        const int mt = u & 63, nt = u >> 6;
        EpiOut e{(float*)(ws + OFF_YB), X, mt * 128, nt * 128};
        const bf16_t* a0 = A + (size_t)(mt * 128 + sr) * DM + sc; const bf16_t* b0 = Bt + (size_t)(nt * 128 + sr) * DM + sc;
        gemm_unit<false>(lds, a0, a0 + (size_t)64 * DM, 128, b0, b0 + (size_t)64 * DM, DM / 32, e);
    }
}

__device__ __forceinline__ void item_mla(const Params& p, int it, LAS char* lds) {
    char* ws = ows(p.ws); const int tid = otid(), lane = tid & 63, w = tid >> 6, l32 = lane & 31, hi = lane >> 5;
    const int qb = 15 - (it >> 4), h = it & 3, b = (it >> 2) & 3;
    const int token = qb * 128 + 32 * w + l32; const size_t row = (size_t)b * SEQ + token;
    bf16x8 qf[12]; load_q<192>((const bf16_t*)(ws + OFF_QM) + row * 768 + h * 192, hi, qf);
    KeySrc ks; ks.k0 = (const bf16_t*)(ws + OFF_KN) + (size_t)b * SEQ * 512 + h * 128; ks.kstride = 512;
    ks.kr = (const bf16_t*)(ws + OFF_H) + (size_t)b * SEQ * LDH + C_KROPE; ks.krstride = LDH;
    ks.v0 = (const bf16_t*)(ws + OFF_VM) + (size_t)b * SEQ * 512 + h * 128; ks.vstride = 512;
    f32x16 o[4]; zero_o(o); float m = -1e30f, l = 0.f;
    attn_run<192, false>(lds, ks, 0, 2 * qb + 2, 0u, qf, token, 0x7fffffffu, 0u, 0.07216878364870322f * LOG2E, o, m, l);
    store_o((bf16_t*)(ws + OFF_MIX) + row * DM + h * 128, o, 1.f / l, hi);
}
__device__ __forceinline__ void item_dil(const Params& p, int it, LAS char* lds) {
    char* ws = ows(p.ws); const int tid = otid(), lane = tid & 63, w = tid >> 6, l32 = lane & 31, hi = lane >> 5;
    const int rem = it % 48, bh = it / 48, h = bh % 6, b = bh / 6;
    const int n = rem >> 4, r2 = rem & 15;
    const int dil = n == 0 ? 1 : (n == 1 ? 4 : 16);
    const int rho = n == 0 ? 0 : (n == 1 ? (r2 >> 2) : r2), qb = n == 0 ? r2 : (n == 1 ? (r2 & 3) : 0);
    const int i = qb * 128 + 32 * w + l32, token = rho + i * dil; const size_t row = (size_t)b * SEQ + token;
    const bf16_t* H = (const bf16_t*)(ws + OFF_H);
    bf16x8 qf[8]; load_q<128>(H + row * LDH + C_DQ + h * 128, hi, qf);
    KeySrc ks; ks.k0 = H + ((size_t)b * SEQ + rho) * LDH + C_DK + h * 128; ks.kstride = (size_t)dil * LDH; ks.kr = ks.k0; ks.krstride = 0;
    ks.v0 = H + ((size_t)b * SEQ + rho) * LDH + C_DV + h * 128; ks.vstride = (size_t)dil * LDH;
    f32x16 o[4]; zero_o(o); float m = -1e30f, l = 0.f;
    const int jlo = 2 * qb - 2 < 0 ? 0 : 2 * qb - 2;
    attn_run<128, false>(lds, ks, jlo, 2 * qb + 2, 0u, qf, i, 128u, 0u, 0.08838834764831845f * LOG2E, o, m, l);
    store_o((bf16_t*)(ws + OFF_ODIL) + ((size_t)n * NT + row) * 768 + h * 128, o, 1.f / l, hi);
    if (hi == 0) ((float*)(ws + OFF_LDIL))[((size_t)n * NT + row) * 6 + h] = m + __log2f(l);
}
__device__ __forceinline__ void item_win(const Params& p, int it, LAS char* lds) {
    char* ws = ows(p.ws); const int tid = otid(), lane = tid & 63, w = tid >> 6, l32 = lane & 31, hi = lane >> 5;
    const int hp = it % 3, b = (it / 3) & 3, tb = 31 - it / 12;
    const int head = 2 * hp + (w >> 1), token = 64 * tb + 32 * (w & 1) + l32; const size_t row = (size_t)b * SEQ + token;
    const bf16_t* H = (const bf16_t*)(ws + OFF_H);
    bf16x8 qf[8]; load_q<128>(H + row * LDH + C_NQ + head * 128, hi, qf);
    KeySrc ks; ks.k0 = H + (size_t)b * SEQ * LDH + C_NKW; ks.kstride = LDH; ks.kr = ks.k0; ks.krstride = 0; ks.v0 = H + (size_t)b * SEQ * LDH + C_NVW; ks.vstride = LDH;
    f32x16 o[4]; zero_o(o); float m = -1e30f, l = 0.f;
    attn_run<128, false>(lds, ks, tb - 8 < 0 ? 0 : tb - 8, tb + 1, 0u, qf, token, 511u, 0u, 0.08838834764831845f * LOG2E, o, m, l);
    store_o((bf16_t*)(ws + OFF_PW) + row * 768 + head * 128, o, 1.f / l, hi);
}
__device__ __forceinline__ void item_cmp(const Params& p, int it, LAS char* lds) {
    char* ws = ows(p.ws); const int tid = otid(), lane = tid & 63, w = tid >> 6, l32 = lane & 31, hi = lane >> 5;
    const int hp = it % 3, tb = (it / 3) % 32, b = it / 96;
    const int head = 2 * hp + (w >> 1), token = 64 * tb + 32 * (w & 1) + l32; const size_t row = (size_t)b * SEQ + token;
    const bf16_t* H = (const bf16_t*)(ws + OFF_H);
    bf16x8 qf[8]; load_q<128>(H + row * LDH + C_NQ + head * 128, hi, qf);
    KeySrc ks; ks.k0 = (const bf16_t*)(ws + OFF_KC) + (size_t)b * 128 * 128; ks.kstride = 128; ks.kr = ks.k0; ks.krstride = 0; ks.v0 = (const bf16_t*)(ws + OFF_VC) + (size_t)b * 128 * 128; ks.vstride = 128;
    const int qi = (token - 31) >> 4;
    const int qimax = (64 * tb + 63 - 31) >> 4;
    const int jhi = qimax < 0 ? 0 : (qimax >> 6) + 1;
    const float c2 = 0.08838834764831845f * LOG2E;
    f32x16 o[4]; zero_o(o); float m = -1e30f, l = 0.f;
    attn_run<128, false>(lds, ks, 0, jhi, 0u, qf, qi, 0x7fffffffu, 0u, c2, o, m, l);
    const float inv = l > 0.f ? 1.f / l : 0.f;
    store_o((bf16_t*)(ws + OFF_PC) + row * 768 + head * 128, o, inv, hi);
    unsigned* imp = (unsigned*)(ws + OFF_IMP) + row * 32;
    for (int jt = 0; jt < jhi; ++jt) {
        attn_stage<128>(lds, ks, jt, false);
        __syncthreads();
        f32x16 p0, p1; attn_scores<128>(lds, qf, p0, p1, l32, hi);
        const int dq = qi - jt * 64 - 8 * hi;
#pragma unroll
        for (int r = 0; r < 16; ++r) { const int ko = 16 * (r >> 3) + (r & 7);
            p0[r] = (dq - ko >= 0) ? __builtin_amdgcn_exp2f(p0[r] * c2 - m) * inv : 0.f;
            p1[r] = (dq - ko - 32 >= 0) ? __builtin_amdgcn_exp2f(p1[r] * c2 - m) * inv : 0.f; }
#pragma unroll
        for (int t = 0; t < 2; ++t)
#pragma unroll
            for (int u = 0; u < 2; ++u) {
                unsigned q[8];
#pragma unroll
                for (int j = 0; j < 8; ++j) q[j] = (unsigned)((t ? p1[8 * u + j] : p0[8 * u + j]) * 16777216.f + 0.5f);
                const int j0 = (64 * jt + 32 * t + 16 * u + 8 * hi) >> 2;
                const unsigned a0 = q[0] + q[1] + q[2] + q[3], a1 = q[4] + q[5] + q[6] + q[7] + q[3], a2 = q[7];
                if (a0) atomicAdd(imp + j0, a0);
                if (a1) atomicAdd(imp + j0 + 1, a1);
                if (a2 && j0 + 2 < 32) atomicAdd(imp + j0 + 2, a2);
            }
        __syncthreads();
    }
}
__device__ __forceinline__ void item_slc(const Params& p, int it, LAS char* lds) {
    char* ws = ows(p.ws); const int tid = otid(), lane = tid & 63, w = tid >> 6, l32 = lane & 31, hi = lane >> 5;
    const int hp = it % 3, b = (it / 3) & 3, tb = 31 - it / 12;
    LAS int* sc = (LAS int*)(lds + 47104); LAS unsigned* msk = (LAS unsigned*)(lds + 47104 + 8192);
    __syncthreads();
    if (tid < 65) msk[tid] = 0u;
    const unsigned* imp = (const unsigned*)(ws + OFF_IMP) + ((size_t)b * SEQ + 64 * tb) * 32;
#pragma unroll
    for (int i = 0; i < 8; ++i) { const int e = tid + i * 256, tk = e >> 5, j = e & 31, pos = 64 * tb + tk, qblk = pos >> 6;
        const bool valid = 64 * j <= pos, forced = (j == 0) || (j == qblk) || (j == qblk - 1);
        sc[e] = valid ? (forced ? 0x7fffffff : (int)imp[e]) : -1; }
    __syncthreads();
#pragma unroll
    for (int i = 0; i < 8; ++i) { const int e = tid + i * 256, tk = e >> 5, j = e & 31; const int s = sc[e]; int rank = 0;
        for (int k = 0; k < 32; ++k) { const int sk = sc[tk * 32 + k]; rank += (sk > s || (sk == s && k < j)) ? 1 : 0; }
        if (rank < 16) { __hip_atomic_fetch_or(&msk[tk], 1u << j, __ATOMIC_RELAXED, __HIP_MEMORY_SCOPE_WORKGROUP); __hip_atomic_fetch_or(&msk[64], 1u << j, __ATOMIC_RELAXED, __HIP_MEMORY_SCOPE_WORKGROUP); } }
    __syncthreads();
    const int head = 2 * hp + (w >> 1), tk = 32 * (w & 1) + l32, token = 64 * tb + tk; const size_t row = (size_t)b * SEQ + token;
    const unsigned sel = msk[tk], uni = msk[64];
    const bf16_t* H = (const bf16_t*)(ws + OFF_H);
    bf16x8 qf[8]; load_q<128>(H + row * LDH + C_NQ + head * 128, hi, qf);
    KeySrc ks; ks.k0 = H + (size_t)b * SEQ * LDH + C_NKS; ks.kstride = LDH; ks.kr = ks.k0; ks.krstride = 0; ks.v0 = H + (size_t)b * SEQ * LDH + C_NVS; ks.vstride = LDH;
    f32x16 o[4]; zero_o(o); float m = -1e30f, l = 0.f;
    attn_run<128, true>(lds, ks, 0, tb + 1, uni, qf, token, 0x7fffffffu, sel, 0.08838834764831845f * LOG2E, o, m, l);
    store_o((bf16_t*)(ws + OFF_PS) + row * 768 + head * 128, o, 1.f / l, hi);
}
__device__ __forceinline__ void phase_attn_d(const Params& p, unsigned* ctr, LAS char* lds) {
    constexpr int NWIN = 384, NDIL = NB * 6 * 48, NCMP = 384;
    for (;;) { const int it = claim(ctr, lds); if (it >= NWIN + NDIL + NCMP) break;
        if (it < NWIN) item_win(p, it, lds); else if (it < NWIN + NDIL) item_dil(p, it - NWIN, lds); else item_cmp(p, it - NWIN - NDIL, lds); }
}
__device__ __forceinline__ void phase_attn_e(const Params& p, unsigned* ctr, LAS char* lds) {
    constexpr int NMLA = 256, NSLC = 384;
    for (;;) { const int it = claim(ctr, lds); if (it >= NMLA + NSLC) break;
        if (it < NMLA) item_mla(p, it, lds); else item_slc(p, it - NMLA, lds); }
}
__device__ __forceinline__ void phase_combine(const Params& p) {
    char* ws = ows(p.ws);
    const bf16_t* OD = (const bf16_t*)(ws + OFF_ODIL); const float* LD = (const float*)(ws + OFF_LDIL);
    const bf16_t* PC = (const bf16_t*)(ws + OFF_PC); const bf16_t* PS = (const bf16_t*)(ws + OFF_PS); const bf16_t* PW = (const bf16_t*)(ws + OFF_PW);
    const float* G = (const float*)(ws + OFF_GATES); bf16_t* MIX = (bf16_t*)(ws + OFF_MIX);
    for (size_t e = (size_t)oblk() * 256 + otid(); e < (size_t)NT * 192; e += (size_t)gridDim.x * 256) {
        const size_t row = e / 192; const int c = (int)(e % 192), isn = c >= 96, cc = (isn ? c - 96 : c) * 8, h = cc >> 7;
        float w0, w1, w2; const bf16_t *s0, *s1, *s2;
        if (!isn) { const float L0 = LD[row * 6 + h], L1 = LD[((size_t)NT + row) * 6 + h], L2 = LD[((size_t)2 * NT + row) * 6 + h];
            const float M = fmaxf(L0, fmaxf(L1, L2)); w0 = __builtin_amdgcn_exp2f(L0 - M); w1 = __builtin_amdgcn_exp2f(L1 - M); w2 = __builtin_amdgcn_exp2f(L2 - M);
            const float inv = 1.f / (w0 + w1 + w2); w0 *= inv; w1 *= inv; w2 *= inv;
            s0 = OD + row * 768 + cc; s1 = OD + ((size_t)NT + row) * 768 + cc; s2 = OD + ((size_t)2 * NT + row) * 768 + cc;
        } else { w0 = G[row * 18 + h * 3]; w1 = G[row * 18 + h * 3 + 1]; w2 = G[row * 18 + h * 3 + 2]; s0 = PC + row * 768 + cc; s1 = PS + row * 768 + cc; s2 = PW + row * 768 + cc; }
        const u32x4 a = *(const u32x4*)s0, bq = *(const u32x4*)s1, cq = *(const u32x4*)s2; u32x4 r;
#pragma unroll
        for (int j = 0; j < 4; ++j) r[j] = cvtpk(w0 * bf_lo(a[j]) + w1 * bf_lo(bq[j]) + w2 * bf_lo(cq[j]), w0 * bf_hi(a[j]) + w1 * bf_hi(bq[j]) + w2 * bf_hi(cq[j]));
        *(u32x4*)(MIX + row * DM + 512 + (isn ? 768 : 0) + cc) = r;
    }
}

__device__ __forceinline__ void phase_ln(const Params& p, int layer, int mode) {
    char* ws = ows(p.ws); const int tid = otid(), lane = tid & 63, wv = (oblk() * 256 + tid) >> 6, nw = gridDim.x * 4;
    const float* g = p.in[mode ? I_LN2G : I_LN1G] + layer * DM; const float* bb = p.in[mode ? I_LN2B : I_LN1B] + layer * DM;
    for (int row = wv; row < NT; row += nw) {
        f32x4 v[8];
        if (mode == 0) { const float* y = (const float*)(ws + OFF_YB) + (size_t)row * DM;
#pragma unroll
            for (int i = 0; i < 8; ++i) v[i] = *(const f32x4*)(y + (i * 64 + lane) * 4);
        } else { const float* x1 = (const float*)(ws + OFF_X1) + (size_t)row * DM; const bf16_t* y0 = (const bf16_t*)(ws + OFF_Y) + (size_t)(2 * row) * DM; const bf16_t* y1 = y0 + DM;
#pragma unroll
            for (int i = 0; i < 8; ++i) { const int c = (i * 64 + lane) * 4; const f32x4 xv = *(const f32x4*)(x1 + c); const u32x2 a = *(const u32x2*)(y0 + c), b2 = *(const u32x2*)(y1 + c);
                v[i][0] = DN_ALPHA * xv[0] + bf_lo(a.x) + bf_lo(b2.x); v[i][1] = DN_ALPHA * xv[1] + bf_hi(a.x) + bf_hi(b2.x);
                v[i][2] = DN_ALPHA * xv[2] + bf_lo(a.y) + bf_lo(b2.y); v[i][3] = DN_ALPHA * xv[3] + bf_hi(a.y) + bf_hi(b2.y); }
        }
        float s = 0.f;
#pragma unroll
        for (int i = 0; i < 8; ++i) s += (v[i][0] + v[i][1]) + (v[i][2] + v[i][3]);
        const float mu = wave_sum(s) * (1.f / DM);
        float q = 0.f;
#pragma unroll
        for (int i = 0; i < 8; ++i) { const f32x4 d = v[i] - mu; q += (d[0] * d[0] + d[1] * d[1]) + (d[2] * d[2] + d[3] * d[3]); }
        const float rstd = 1.f / sqrtf(wave_sum(q) * (1.f / DM) + 1e-5f);
        float* of = mode == 0 ? (float*)(ws + OFF_X1) + (size_t)row * DM : (layer == DEPTH - 1 ? p.out + (size_t)row * DM : (float*)(ws + OFF_XA) + (size_t)row * DM);
        bf16_t* ob = mode == 0 ? (bf16_t*)(ws + OFF_X1B) + (size_t)row * DM : (bf16_t*)(ws + OFF_XB) + (size_t)row * DM;
#pragma unroll
        for (int i = 0; i < 8; ++i) { const int c = (i * 64 + lane) * 4; const f32x4 gv = *(const f32x4*)(g + c), bv = *(const f32x4*)(bb + c);
            f32x4 o = (v[i] - mu) * rstd * gv + bv; *(f32x4*)(of + c) = o;
            if (mode == 0 || layer < DEPTH - 1) store_bf4(ob + c, o[0], o[1], o[2], o[3]); }
    }
}
__device__ __forceinline__ void phase_router(const Params& p, int layer, LAS char* lds) {
    char* ws = ows(p.ws); const int tid = otid(), lane = tid & 63, w = tid >> 6, l32 = lane & 31, hi = lane >> 5;
    const float* X1 = (const float*)(ws + OFF_X1); const float* We = p.in[I_WEXP] + (size_t)layer * DM * 32; const float* Wg = p.in[I_WGRP] + (size_t)layer * DM * 4;
    LAS float* red = (LAS float*)lds;
    unsigned* ecnt = (unsigned*)(ws + OFF_ECNT); int* list = (int*)(ws + OFF_LIST); float* gw = (float*)(ws + OFF_GW);
    for (int it = oblk(); it < NT / 32; it += gridDim.x) {
        const int t0 = it * 32;
        f32x16 ae, ag;
#pragma unroll
        for (int r = 0; r < 16; ++r) { ae[r] = 0.f; ag[r] = 0.f; }
        const float* xr = X1 + (size_t)(t0 + l32) * DM + w * 512 + 4 * hi;
        const float* wer = We + (size_t)(w * 512 + 4 * hi) * 32 + l32;
        const float* wgr = Wg + (size_t)(w * 512 + 4 * hi) * 4 + (l32 & 3);
        for (int kc = 0; kc < 512; kc += 8) {
            const f32x4 xv = *(const f32x4*)(xr + kc);
            float we[4], wg[4];
#pragma unroll
            for (int j = 0; j < 4; ++j) { we[j] = wer[(size_t)(kc + j) * 32]; wg[j] = l32 < 4 ? wgr[(size_t)(kc + j) * 4] : 0.f; }
#pragma unroll
            for (int j = 0; j < 4; ++j) { ae = __builtin_amdgcn_mfma_f32_32x32x2f32(xv[j], we[j], ae, 0, 0, 0); ag = __builtin_amdgcn_mfma_f32_32x32x2f32(xv[j], wg[j], ag, 0, 0, 0); }
        }
        __syncthreads();
#pragma unroll
        for (int r = 0; r < 16; ++r) { const int tk = crow(r, hi); red[(w * 32 + tk) * 36 + l32] = ae[r]; if (l32 < 4) red[(w * 32 + tk) * 36 + 32 + l32] = ag[r]; }
        __syncthreads();
        if (tid < 32) {
            const int tk = tid;
            float lg[4];
#pragma unroll
            for (int j = 0; j < 4; ++j) lg[j] = (red[(0 * 32 + tk) * 36 + 32 + j] + red[(1 * 32 + tk) * 36 + 32 + j]) + (red[(2 * 32 + tk) * 36 + 32 + j] + red[(3 * 32 + tk) * 36 + 32 + j]);
            int gi = 0; float gm = lg[0];
#pragma unroll
            for (int j = 1; j < 4; ++j) if (lg[j] > gm) { gm = lg[j]; gi = j; }
            float den = 0.f;
#pragma unroll
            for (int j = 0; j < 4; ++j) den += __expf(lg[j] - gm);
            const float pg = 1.f / den;
            float b0 = -__builtin_inff(), b1 = -__builtin_inff(); int i0 = 0, i1 = 0;
#pragma unroll
            for (int j = 0; j < 8; ++j) { const int n = gi * 8 + j;
                const float v = (red[(0 * 32 + tk) * 36 + n] + red[(1 * 32 + tk) * 36 + n]) + (red[(2 * 32 + tk) * 36 + n] + red[(3 * 32 + tk) * 36 + n]);
                if (v > b0) { b1 = b0; i1 = i0; b0 = v; i0 = j; } else if (v > b1) { b1 = v; i1 = j; } }
            const float w1 = __expf(b1 - b0), g0 = pg / (1.f + w1), g1 = pg * w1 / (1.f + w1);
            const int tok = t0 + tk, e0 = gi * 8 + i0, e1 = gi * 8 + i1;
            const unsigned p0 = atomicAdd(&ecnt[e0], 1u), p1 = atomicAdd(&ecnt[e1], 1u);
            list[(size_t)e0 * NT + p0] = 2 * tok; list[(size_t)e1 * NT + p1] = 2 * tok + 1;
            gw[2 * tok] = g0; gw[2 * tok + 1] = g1;
        }
        __syncthreads();
    }
}
__device__ __forceinline__ int moe_table(const Params& p, LAS char* lds) {
    LAS int* off = (LAS int*)(lds + LDS_CTL + 128); LAS int* toff = off + 33;
    __syncthreads();
    if (otid() == 0) { const unsigned* ecnt = (const unsigned*)(ows(p.ws) + OFF_ECNT); int a = 0, t = 0;
        for (int e = 0; e < NEXP; ++e) { off[e] = a; toff[e] = t; const int c = (int)ecnt[e]; a += c; t += (c + 127) >> 7; } off[NEXP] = a; toff[NEXP] = t; }
    __syncthreads();
    return toff[NEXP];
}
__device__ __forceinline__ void phase_moe1(const Params& p, LAS char* lds) {
    char* ws = ows(p.ws); const int tid = otid(), sr = tid >> 2, sc = (tid & 3) * 8;
    const int ntile = moe_table(p, lds); const LAS int* off = (const LAS int*)(lds + LDS_CTL + 128); const LAS int* toff = off + 33;
    const unsigned* ecnt = (const unsigned*)(ws + OFF_ECNT); const int* list = (const int*)(ws + OFF_LIST);
    const bf16_t* X1B = (const bf16_t*)(ws + OFF_X1B);
    for (int u = oblk(); u < ntile * 8; u += gridDim.x) {
        int e = 0; { const int tix8 = u; for (int k = 1; k < NEXP; ++k) if (tix8 >= toff[k] * 8) e = k; }
        const int mte = toff[e + 1] - toff[e], v = u - toff[e] * 8, nt = v / mte, mt = v - nt * mte;
        const int cnt = (int)ecnt[e], nvalid = cnt - mt * 128 < 128 ? cnt - mt * 128 : 128;
        const int* le = list + (size_t)e * NT + mt * 128;
        const int t0 = le[sr < nvalid ? sr : 0] >> 1, t1 = le[sr + 64 < nvalid ? sr + 64 : 0] >> 1;
        const bf16_t* a0 = X1B + (size_t)t0 * DM + sc; const bf16_t* a1 = X1B + (size_t)t1 * DM + sc;
        const bf16_t* b0 = (const bf16_t*)(ws + OFF_WGU_T) + ((size_t)e * 1024 + nt * 128 + sr) * DM + sc;
        EpiMoe1 ep{(bf16_t*)(ws + OFF_HM), off[e] + mt * 128, nvalid, nt};
        gemm_unit<false>(lds, a0, a1, 128, b0, b0 + (size_t)64 * DM, DM / 32, ep);
    }
}
__device__ __forceinline__ void phase_moe2(const Params& p, LAS char* lds) {
    char* ws = ows(p.ws); const int tid = otid(), sr = tid >> 2, sc = (tid & 3) * 8;
    const int ntile = moe_table(p, lds); const LAS int* off = (const LAS int*)(lds + LDS_CTL + 128); const LAS int* toff = off + 33;
    const unsigned* ecnt = (const unsigned*)(ws + OFF_ECNT); const int* list = (const int*)(ws + OFF_LIST);
    const bf16_t* HM = (const bf16_t*)(ws + OFF_HM);
    for (int u = oblk(); u < ntile * 16; u += gridDim.x) {
        int e = 0; for (int k = 1; k < NEXP; ++k) if (u >= toff[k] * 16) e = k;
        const int mte = toff[e + 1] - toff[e], v = u - toff[e] * 16, nt = v / mte, mt = v - nt * mte;
        const int cnt = (int)ecnt[e], nvalid = cnt - mt * 128 < 128 ? cnt - mt * 128 : 128;
        const bf16_t* a0 = HM + (size_t)(off[e] + mt * 128 + sr) * EFF + sc;
        const bf16_t* b0 = (const bf16_t*)(ws + OFF_WD_T) + ((size_t)e * DM + nt * 128 + sr) * EFF + sc;
        EpiMoe2 ep{(bf16_t*)(ws + OFF_Y), list + (size_t)e * NT + mt * 128, (const float*)(ws + OFF_GW), nvalid, nt * 128};
        gemm_unit<false>(lds, a0, a0 + (size_t)64 * EFF, 128, b0, b0 + (size_t)64 * EFF, EFF / 32, ep);
    }
}

__global__ void __launch_bounds__(256, 2) fwd_kernel(Params p) {
    extern __shared__ __attribute__((aligned(16))) char lds_raw[];
    LAS char* lds = (LAS char*)lds_raw;
    if (threadIdx.x == 0) { *(LAS u32x4*)(lds + LDS_CTL) = (u32x4){0u, 0u, 0u, 0u}; }
    __syncthreads();
    XcdBarrier bar = xcd_barrier_post((unsigned*)(p.ws + OFF_BAR), (volatile LAS unsigned*)(lds + LDS_CTL));
    unsigned* ctr = (unsigned*)(p.ws + OFF_CTR);
    for (int layer = 0; layer < DEPTH; ++layer) {
        phase_prep(p, layer, lds);              xcd_barrier(bar);
        phase_win(p, layer, lds);               xcd_barrier(bar);
        phase_up(p, layer, lds);                xcd_barrier(bar);
        phase_cmp2(p, layer, lds);              xcd_barrier(bar);
        phase_attn_d(p, ctr + 64 * (2 * layer), lds);       xcd_barrier(bar);
        phase_attn_e(p, ctr + 64 * (2 * layer + 1), lds);   xcd_barrier(bar);
        phase_combine(p);                       xcd_barrier(bar);
        phase_out(p, layer, lds);               xcd_barrier(bar);
        phase_ln(p, layer, 0);                  xcd_barrier(bar);
        phase_router(p, layer, lds);            xcd_barrier(bar);
        phase_moe1(p, lds);                     xcd_barrier(bar);
        phase_moe2(p, lds);                     xcd_barrier(bar);
        phase_ln(p, layer, 1);                  xcd_barrier(bar);
    }
}

extern "C" void kernel_launch(void* const* d_in, const int* in_sizes, int n_in, void* d_out, int out_size, void* d_ws, size_t ws_size, hipStream_t stream) {
    (void)in_sizes; (void)out_size;
    static int grid = 0;
    if (!grid) {
        int dev = 0, cus = 0, per_cu = 0;
        (void)hipGetDevice(&dev);
        (void)hipDeviceGetAttribute(&cus, hipDeviceAttributeMultiprocessorCount, dev);
        (void)hipFuncSetAttribute((const void*)fwd_kernel, hipFuncAttributeMaxDynamicSharedMemorySize, LDS_BYTES);
        (void)hipOccupancyMaxActiveBlocksPerMultiprocessor(&per_cu, (const void*)fwd_kernel, 256, LDS_BYTES);
        if (cus <= 0) cus = 256;
        if (per_cu < 1) per_cu = 1;
        grid = cus * (per_cu < 2 ? per_cu : 2);
    }
    if (n_in < 22 || ws_size < WS_TOTAL) { fprintf(stderr, "kernel_launch: bad arguments (n_in %d, ws %zu < %zu)\n", n_in, ws_size, (size_t)WS_TOTAL); return; }
    Params p;
    for (int i = 0; i < 22; ++i) p.in[i] = (const float*)d_in[i];
    p.out = (float*)d_out; p.ws = (char*)d_ws;
    (void)hipMemsetAsync(d_ws, 0, ZERO_BYTES, stream);
    fwd_kernel<<<dim3(grid), dim3(256), LDS_BYTES, stream>>>(p);
}
```

```cpp
#include <hip/hip_runtime.h>
#include <stdint.h>
#include <stdio.h>

#define LAS __attribute__((address_space(3)))
#define GAS __attribute__((address_space(1)))
#define CAS __attribute__((address_space(4)))
typedef unsigned short bf16_t;
typedef short bf16x8 __attribute__((ext_vector_type(8)));
typedef short s16x4 __attribute__((ext_vector_type(4)));
typedef float f32x16 __attribute__((ext_vector_type(16)));
typedef float f32x4 __attribute__((ext_vector_type(4)));
typedef float f32x2 __attribute__((ext_vector_type(2)));
typedef unsigned u32x4 __attribute__((ext_vector_type(4)));
typedef unsigned u32x2 __attribute__((ext_vector_type(2)));

constexpr int NB = 4, SEQ = 2048, NT = NB * SEQ, DM = 2048, DEPTH = 2;
constexpr int INC = 4434, LDH = 4608;
constexpr int C_QLAT = 0, C_KVLAT = 384, C_KROPE = 512, C_DQ = 576, C_DK = 1344, C_DV = 2112, C_NQ = 2880, C_NKC = 3648, C_NVC = 3776,
              C_NKS = 3904, C_NVS = 4032, C_NKW = 4160, C_NVW = 4288, C_GATE = 4416;
constexpr int NEXP = 32, EFF = 512;
constexpr float DN_ALPHA = 1.41421356237309515f;
constexpr float LOG2E = 1.4426950408889634f;

constexpr size_t al256(size_t x) { return (x + 255) & ~(size_t)255; }
constexpr size_t OFF_BAR = 0;
constexpr size_t OFF_CTR = 16384;
constexpr size_t ZERO_BYTES = 20480;
constexpr size_t OFF_ECNT = ZERO_BYTES;
constexpr size_t OFF_CS16 = OFF_ECNT + 256;
constexpr size_t OFF_CS32 = OFF_CS16 + (size_t)SEQ * 16 * 8;
constexpr size_t OFF_WIN_T = OFF_CS32 + (size_t)SEQ * 32 * 8;
constexpr size_t OFF_WQ_T = OFF_WIN_T + (size_t)LDH * DM * 2;
constexpr size_t OFF_WKV_T = OFF_WQ_T + (size_t)768 * 384 * 2;
constexpr size_t OFF_W1K_T = OFF_WKV_T + (size_t)1024 * 128 * 2;
constexpr size_t OFF_W1V_T = OFF_W1K_T + (size_t)256 * 4096 * 2;
constexpr size_t OFF_W2K_T = OFF_W1V_T + (size_t)256 * 4096 * 2;
constexpr size_t OFF_W2V_T = OFF_W2K_T + (size_t)256 * 256 * 2;
constexpr size_t OFF_WOUT_T = OFF_W2V_T + (size_t)256 * 256 * 2;
constexpr size_t OFF_WGU_T = OFF_WOUT_T + (size_t)DM * DM * 2;
constexpr size_t OFF_WD_T = OFF_WGU_T + (size_t)NEXP * 1024 * DM * 2;
constexpr size_t OFF_B1P = OFF_WD_T + (size_t)NEXP * DM * EFF * 2;
constexpr size_t OFF_XB = OFF_B1P + (size_t)2 * 16 * 256 * 4;
constexpr size_t OFF_H = OFF_XB + (size_t)NT * DM * 2;
constexpr size_t OFF_GATES = OFF_H + (size_t)NT * LDH * 2;
constexpr size_t OFF_QM = OFF_GATES + al256((size_t)NT * 18 * 4);
constexpr size_t OFF_KN = OFF_QM + (size_t)NT * 768 * 2;
constexpr size_t OFF_VM = OFF_KN + (size_t)NT * 512 * 2;
static_assert(OFF_VM == OFF_KN + (size_t)NT * 512 * 2, "Vm must follow Kn");
constexpr size_t OFF_HC = OFF_VM + (size_t)NT * 512 * 2;
constexpr size_t OFF_HCP = OFF_HC + (size_t)2 * 512 * 256 * 2;
constexpr size_t OFF_KC = OFF_HCP + (size_t)8 * 2 * 512 * 256 * 4;
constexpr size_t OFF_VC = OFF_KC + (size_t)512 * 128 * 2;
constexpr size_t OFF_IMP = OFF_VC + (size_t)512 * 128 * 2;
constexpr size_t OFF_ODIL = OFF_IMP + (size_t)NT * 32 * 4;
constexpr size_t OFF_LDIL = OFF_ODIL + (size_t)3 * NT * 768 * 2;
constexpr size_t OFF_PC = OFF_LDIL + (size_t)3 * NT * 6 * 4;
constexpr size_t OFF_PS = OFF_PC + (size_t)NT * 768 * 2;
constexpr size_t OFF_PW = OFF_PS + (size_t)NT * 768 * 2;
constexpr size_t OFF_MIX = OFF_PW + (size_t)NT * 768 * 2;
constexpr size_t OFF_YB = OFF_MIX + (size_t)NT * DM * 2;
constexpr size_t OFF_XA = OFF_YB + (size_t)NT * DM * 4;
constexpr size_t OFF_X1 = OFF_XA + (size_t)NT * DM * 4;
constexpr size_t OFF_X1B = OFF_X1 + (size_t)NT * DM * 4;
constexpr size_t OFF_HM = OFF_X1B + (size_t)NT * DM * 2;
constexpr size_t OFF_Y = OFF_HM + (size_t)(2 * NT + 128) * EFF * 2;
constexpr size_t OFF_LIST = OFF_Y + (size_t)2 * NT * DM * 2;
constexpr size_t OFF_GW = OFF_LIST + (size_t)NEXP * NT * 4;
constexpr size_t WS_TOTAL = OFF_GW + (size_t)2 * NT * 4;

struct Params { const float* in[22]; float* out; char* ws; };
enum { I_X = 0, I_WIN, I_QLN, I_WQUP, I_KVLN, I_WKVUP, I_PEK, I_W1K, I_W2K, I_PEV, I_W1V, I_W2V, I_WOUT, I_LN1G, I_LN1B, I_WGRP, I_WEXP, I_WGATE, I_WUP, I_WDOWN, I_LN2G, I_LN2B };

#define XB_TMO      128
#define XB_XCNT(j)  (256  + 64 * (j))
#define XB_XSUB(j)  (1280 + 64 * (j))
#define XB_XGEN(j)  (2304 + 64 * (j))
#define XB_TOP      3328
#define XB_TOPGEN   3392
#define XCD_BAR_WORDS 3456
#define XB_SPIN_CAP (1u << 18)

__device__ __forceinline__ unsigned xb_ld(unsigned* p)              { return __hip_atomic_load(p, __ATOMIC_RELAXED, __HIP_MEMORY_SCOPE_AGENT); }
__device__ __forceinline__ unsigned xb_add(unsigned* p, unsigned v) { return __hip_atomic_fetch_add(p, v, __ATOMIC_RELAXED, __HIP_MEMORY_SCOPE_AGENT); }
__device__ __forceinline__ unsigned xb_xcc_id() { return (unsigned)__builtin_amdgcn_s_getreg((3 << 11) | 20) & 0xFu; }
#define XB_SPIN(cond, bar) do { unsigned _sp = 0; while (cond) { __builtin_amdgcn_s_sleep(1); \
    if ((++_sp & 255u) == 0u) { if (xb_ld(&(bar)[XB_TMO])) break; if (_sp > XB_SPIN_CAP) { atomicAdd(&(bar)[XB_TMO], 1u); break; } } } } while (0)

struct XcdBarrier { unsigned* bar; unsigned x; volatile LAS unsigned* st; };

__device__ __forceinline__ XcdBarrier xcd_barrier_post(unsigned* bar, volatile LAS unsigned* st) {
    XcdBarrier b; b.bar = bar; b.x = xb_xcc_id(); b.st = st;
    if (threadIdx.x == 0) (void)xb_add(&bar[XB_XCNT(b.x)], 1u);
    return b;
}
__device__ __forceinline__ void xcd_barrier_complete(unsigned* bar, unsigned x, unsigned& nloc, unsigned& nx) {
    const unsigned G = gridDim.x * gridDim.y * gridDim.z;
    unsigned sum, cnt, mine, sp = 0u;
    for (;;) {
        sum = 0u; cnt = 0u; mine = 0u;
#pragma unroll
        for (unsigned j = 0; j < 16; ++j) { const unsigned c = xb_ld(&bar[XB_XCNT(j)]); sum += c; cnt += (c > 0u) ? 1u : 0u; mine = (j == x) ? c : mine; }
        if (sum == G) break;
        __builtin_amdgcn_s_sleep(1);
        if ((++sp & 255u) == 0u) { if (xb_ld(&bar[XB_TMO])) break; if (sp > XB_SPIN_CAP) { atomicAdd(&bar[XB_TMO], 1u); break; } }
    }
    nloc = mine > 0u ? mine : 1u; nx = cnt > 0u ? cnt : 1u;
}
__device__ __forceinline__ void xcd_barrier(const XcdBarrier& b) {
    asm volatile("s_waitcnt vmcnt(0)" ::: "memory");
    __syncthreads();
    if (threadIdx.x == 0) {
        unsigned* bar = b.bar;
        __builtin_amdgcn_s_waitcnt(0);
        unsigned nloc = b.st[0], nx = b.st[1];
        if (nloc == 0u) { xcd_barrier_complete(bar, b.x, nloc, nx); b.st[0] = nloc; b.st[1] = nx; }
        const unsigned old = xb_add(&bar[XB_XSUB(b.x)], 1u);
        const unsigned gen = old / nloc;
        if (old + 1u == (gen + 1u) * nloc) {
            __builtin_amdgcn_fence(__ATOMIC_RELEASE, "agent");
            asm volatile("s_waitcnt vmcnt(0)" ::: "memory");
            const unsigned og = xb_add(&bar[XB_TOP], 1u);
            const unsigned tg = og / nx;
            if (og + 1u == (tg + 1u) * nx) xb_add(&bar[XB_TOPGEN], 1u);
            else XB_SPIN(xb_ld(&bar[XB_TOPGEN]) == tg, bar);
            __builtin_amdgcn_fence(__ATOMIC_ACQUIRE, "agent");
            xb_add(&bar[XB_XGEN(b.x)], 1u);
            asm volatile("s_waitcnt vmcnt(0)" ::: "memory");
        } else {
            XB_SPIN(xb_ld(&bar[XB_XGEN(b.x)]) == gen, bar);
            __builtin_amdgcn_fence(__ATOMIC_ACQUIRE, "agent");
            asm volatile("s_waitcnt vmcnt(0)" ::: "memory");
        }
    }
    __syncthreads();
}

template <class T> __device__ __forceinline__ T gld(const void* p) { return *(const GAS T*)p; }
template <class T> __device__ __forceinline__ void gst(void* p, const T& v) { *(GAS T*)p = v; }
__device__ __forceinline__ __amdgpu_buffer_rsrc_t mk_rsrc(const void* p) {
    const unsigned long long v = (unsigned long long)p;
    const unsigned lo = __builtin_amdgcn_readfirstlane((unsigned)v), hi = __builtin_amdgcn_readfirstlane((unsigned)(v >> 32));
    return __builtin_amdgcn_make_buffer_rsrc((void*)(((unsigned long long)hi << 32) | lo), 0, 0xFFFFFFF0u, 0x00020000);
}
__device__ __forceinline__ bf16x8 bld8(__amdgpu_buffer_rsrc_t r, unsigned voff, int soff) { const u32x4 v = __builtin_amdgcn_raw_buffer_load_b128(r, (int)voff, soff, 0); return __builtin_bit_cast(bf16x8, v); }
__device__ __forceinline__ unsigned cvtpk(float lo, float hi) { unsigned r; asm volatile("v_cvt_pk_bf16_f32 %0, %1, %2" : "=v"(r) : "v"(lo), "v"(hi)); return r; }
__device__ __forceinline__ float bf_lo(unsigned u) { return __uint_as_float(u << 16); }
__device__ __forceinline__ float bf_hi(unsigned u) { return __uint_as_float(u & 0xffff0000u); }
__device__ __forceinline__ float bf2f(bf16_t b) { return __uint_as_float((unsigned)b << 16); }
__device__ __forceinline__ float wave_sum(float v) {
#pragma unroll
    for (int o = 32; o >= 1; o >>= 1) v += __shfl_xor(v, o);
    return v;
}
__device__ __forceinline__ int otid() { int t = threadIdx.x; asm volatile("" : "+v"(t)); return t; }
__device__ __forceinline__ int oblk() { int b = blockIdx.x; asm volatile("" : "+s"(b)); return b; }
__device__ __forceinline__ char* ows(const char* w) { char* q = const_cast<char*>(w); asm volatile("" : "+s"(q)); return q; }
__device__ __forceinline__ int crow(int r, int hi) { return (r & 3) + 8 * (r >> 2) + 4 * hi; }

constexpr int LDS_BYTES = 65536;
constexpr int LDS_CTL = 65024;

constexpr int GS = 72;
constexpr int G_BOFF = 128 * GS * 2;
constexpr int G_ROWSS = 384 * GS * 2;

template <class EPI>
__device__ __forceinline__ void gemm_unit(LAS char* lds, const bf16_t* abase, const unsigned (&aoff)[4], int ajump, const bf16_t* bbase, unsigned boff, size_t ldb32, int nkt, const EPI& epi) {
    const int tid = otid(), lane = tid & 63, w = tid >> 6, l32 = lane & 31, hi = lane >> 5;
    const int wm = w >> 1, wn = w & 1;
    const int sr = tid >> 3, sc = (tid & 7) * 8;
    const int st_off = (sr * GS + sc) * 2;
    const int a_rd = ((wm * 64 + l32) * GS + hi * 8) * 2;
    const int b_rd = G_BOFF + ((wn * 128 + l32) * GS + hi * 8) * 2;
    f32x16 acc[2][4];
#pragma unroll
    for (int i = 0; i < 2; ++i)
#pragma unroll
        for (int j = 0; j < 4; ++j)
#pragma unroll
            for (int r = 0; r < 16; ++r) acc[i][j][r] = 0.f;
    bf16x8 ra[4], rb[8];
    const __amdgpu_buffer_rsrc_t rsa = mk_rsrc(abase), rsb = mk_rsrc(bbase);
    const int lb2 = (int)(ldb32 * 2);
#pragma unroll
    for (int i = 0; i < 4; ++i) ra[i] = bld8(rsa, 2u * aoff[i], 0);
#pragma unroll
    for (int i = 0; i < 8; ++i) rb[i] = bld8(rsb, 2u * boff, i * lb2);
    for (int kt = 0; kt < nkt; ++kt) {
#pragma unroll
        for (int i = 0; i < 4; ++i) *(LAS bf16x8*)(lds + st_off + i * 32 * GS * 2) = ra[i];
#pragma unroll
        for (int i = 0; i < 8; ++i) *(LAS bf16x8*)(lds + G_BOFF + st_off + i * 32 * GS * 2) = rb[i];
        __syncthreads();
        if (kt + 1 < nkt) {
            const int k = (kt + 1) * 64;
            const int ao = (k >> 7) * ajump + (k & 127);
#pragma unroll
            for (int i = 0; i < 4; ++i) ra[i] = bld8(rsa, 2u * aoff[i], 2 * ao);
#pragma unroll
            for (int i = 0; i < 8; ++i) rb[i] = bld8(rsb, 2u * boff, i * lb2 + 2 * k);
        }
#pragma unroll
        for (int ks = 0; ks < 4; ++ks) {
            bf16x8 af[2], bfr[4];
#pragma unroll
            for (int i = 0; i < 2; ++i) af[i] = *(const LAS bf16x8*)(lds + a_rd + i * 32 * GS * 2 + ks * 32);
#pragma unroll
            for (int j = 0; j < 4; ++j) bfr[j] = *(const LAS bf16x8*)(lds + b_rd + j * 32 * GS * 2 + ks * 32);
#pragma unroll
            for (int i = 0; i < 2; ++i)
#pragma unroll
                for (int j = 0; j < 4; ++j) acc[i][j] = __builtin_amdgcn_mfma_f32_32x32x16_bf16(bfr[j], af[i], acc[i][j], 0, 0, 0);
            if (ks & 1) asm volatile("" ::: "memory");
        }
        __syncthreads();
    }
    epi(acc, wm, wn, l32, hi, lds);
}
template <int K> __device__ __forceinline__ void row_sumsq(LAS char* lds, const bf16_t* A, int ld) {
    const int tid = otid(), row = tid >> 1, half = tid & 1;
    const bf16_t* ptr = A + (size_t)row * ld + half * (K / 2);
    float ss = 0.f;
#pragma unroll
    for (int c = 0; c < K / 16; ++c) { const u32x4 v = gld<u32x4>(ptr + c * 8);
#pragma unroll
        for (int j = 0; j < 4; ++j) { const float a = bf_lo(v[j]), b = bf_hi(v[j]); ss += a * a + b * b; } }
    ss += __shfl_xor(ss, 1);
    __syncthreads();
    if (half == 0) ((LAS float*)(lds + G_ROWSS))[row] = ss;
}

__device__ __forceinline__ void store_bf4(bf16_t* p, float a, float b, float c, float d) { u32x2 w; w.x = cvtpk(a, b); w.y = cvtpk(c, d); gst<u32x2>(p, w); }

__device__ __forceinline__ void store_tiles4(bf16_t* p, const f32x16 (&a)[4], float sc) {
#pragma unroll
    for (int ni = 0; ni < 4; ++ni)
#pragma unroll
        for (int q = 0; q < 4; ++q) store_bf4(p + 32 * ni + 8 * q, a[ni][4 * q] * sc, a[ni][4 * q + 1] * sc, a[ni][4 * q + 2] * sc, a[ni][4 * q + 3] * sc);
}
__device__ __forceinline__ void rope_pair32(f32x16& lo, f32x16& hi16, const f32x2* cs32, int pos, int hi, bool on = true) {
#pragma unroll
    for (int r = 0; r < 16; ++r) { f32x2 cs = {1.f, 0.f}; if (on) cs = gld<f32x2>(cs32 + pos * 32 + crow(r, hi)); const float x1 = lo[r], x2 = hi16[r]; lo[r] = x1 * cs.x - x2 * cs.y; hi16[r] = x2 * cs.x + x1 * cs.y; }
}
__device__ __forceinline__ void rope_first32(f32x16& t, const f32x2* cs16, int pos, int hi) {
#pragma unroll
    for (int r = 0; r < 8; ++r) { const f32x2 cs = gld<f32x2>(cs16 + pos * 16 + crow(r, hi)); const float x1 = t[r], x2 = t[r + 8]; t[r] = x1 * cs.x - x2 * cs.y; t[r + 8] = x2 * cs.x + x1 * cs.y; }
}
__device__ __forceinline__ bool is_rope16(int c0) {
    return (((c0 - C_DQ) & 127) == 0) && ((c0 >= C_DQ && c0 < C_DV) || (c0 >= C_NQ && c0 < C_NKC) || c0 == C_NKS || c0 == C_NKW);
}
struct EpiWin {
    bf16_t* H; float* gates; const f32x2* cs16; const f32x2* cs32; int m0, n0;
    __device__ __forceinline__ void operator()(f32x16 (&acc)[2][4], int wm, int wn, int l32, int hi, LAS char*) const {
        const int nw = n0 + 128 * wn;
#pragma unroll
        for (int mi = 0; mi < 2; ++mi) {
            const int row = m0 + 64 * wm + 32 * mi + l32, pos = row & (SEQ - 1);
            if (nw == C_KROPE) rope_pair32(acc[mi][0], acc[mi][1], cs32, pos, hi);
#pragma unroll
            for (int ni = 0; ni < 4; ++ni) if (is_rope16(nw + 32 * ni)) rope_first32(acc[mi][ni], cs16, pos, hi);
            if (nw == C_GATE - 64) {
#pragma unroll
                for (int r = 0; r < 16; ++r) { const int c = crow(r, hi); if (c < 18) gst<float>(gates + (size_t)row * 18 + c, 1.f / (1.f + __expf(-acc[mi][2][r]))); }
            }
            store_tiles4(H + (size_t)row * LDH + nw + 4 * hi, acc[mi], 1.f);
        }
    }
};
struct EpiQup {
    bf16_t* Q; const f32x2* cs32; int m0, n0;
    __device__ __forceinline__ void operator()(f32x16 (&acc)[2][4], int wm, int wn, int l32, int hi, LAS char* lds) const {
        const int nw = n0 + 128 * wn; const LAS float* rs = (const LAS float*)(lds + G_ROWSS);
#pragma unroll
        for (int mi = 0; mi < 2; ++mi) {
            const int rl = 64 * wm + 32 * mi + l32, row = m0 + rl, pos = row & (SEQ - 1);
            const float sc = __builtin_amdgcn_rsqf(rs[rl] * (1.f / 384.f) + 1e-6f);
#pragma unroll
            for (int ni = 0; ni < 4; ++ni)
#pragma unroll
                for (int r = 0; r < 16; ++r) acc[mi][ni][r] *= sc;
            rope_pair32(acc[mi][0], acc[mi][1], cs32, pos, hi, (nw % 192) == 128);
            rope_pair32(acc[mi][2], acc[mi][3], cs32, pos, hi, ((nw + 64) % 192) == 128);
            store_tiles4(Q + (size_t)row * 768 + nw + 4 * hi, acc[mi], 1.f);
        }
    }
};
struct EpiKVup {
    bf16_t* Kn; int m0, n0;
    __device__ __forceinline__ void operator()(f32x16 (&acc)[2][4], int wm, int wn, int l32, int hi, LAS char* lds) const {
        const int nw = n0 + 128 * wn; const LAS float* rs = (const LAS float*)(lds + G_ROWSS);
        const int head = nw >> 8, within = nw & 255;
        bf16_t* base = Kn + (within < 128 ? (size_t)0 : (size_t)NT * 512) + head * 128 + 4 * hi;
#pragma unroll
        for (int mi = 0; mi < 2; ++mi) {
            const int rl = 64 * wm + 32 * mi + l32, row = m0 + rl;
            const float sc = __builtin_amdgcn_rsqf(rs[rl] * (1.f / 128.f) + 1e-6f);
            store_tiles4(base + (size_t)row * 512, acc[mi], sc);
        }
    }
};
__device__ __forceinline__ float gelu_tanh(float x) {
    const float u = 0.7978845608028654f * (x + 0.044715f * x * x * x);
    const float e = __expf(-2.f * fabsf(u)); const float t = (1.f - e) / (1.f + e);
    return 0.5f * x * (1.f + (u < 0.f ? -t : t));
}
struct EpiCmp1 {
    float* P; int m0;
    __device__ __forceinline__ void operator()(f32x16 (&acc)[2][4], int wm, int wn, int l32, int hi, LAS char*) const {
#pragma unroll
        for (int mi = 0; mi < 2; ++mi) {
            float* p = P + (size_t)(m0 + 64 * wm + 32 * mi + l32) * 256 + 128 * wn + 4 * hi;
#pragma unroll
            for (int ni = 0; ni < 4; ++ni)
#pragma unroll
                for (int q = 0; q < 4; ++q) { f32x4 v = {acc[mi][ni][4 * q], acc[mi][ni][4 * q + 1], acc[mi][ni][4 * q + 2], acc[mi][ni][4 * q + 3]}; gst<f32x4>(p + 32 * ni + 8 * q, v); }
        }
    }
};
struct EpiCmp2 {
    bf16_t* O; const f32x2* cs16; int dorope; int m0;
    __device__ __forceinline__ void operator()(f32x16 (&acc)[2][4], int wm, int wn, int l32, int hi, LAS char*) const {
        if (wn != 0) return;
#pragma unroll
        for (int mi = 0; mi < 2; ++mi) {
            const int row = m0 + 64 * wm + 32 * mi + l32, c = row & 127, pos = 16 * c + 31;
            if (dorope && c < 127) rope_first32(acc[mi][0], cs16, pos, hi);
            store_tiles4(O + (size_t)row * 128 + 4 * hi, acc[mi], c < 127 ? 1.f : 0.f);
        }
    }
};
struct EpiOut {
    float* Y; const float* X; int m0, n0;
    __device__ __forceinline__ void operator()(f32x16 (&acc)[2][4], int wm, int wn, int l32, int hi, LAS char*) const {
        const int nw = n0 + 128 * wn;
#pragma unroll
        for (int mi = 0; mi < 2; ++mi) {
            const size_t off = (size_t)(m0 + 64 * wm + 32 * mi + l32) * DM + nw + 4 * hi;
#pragma unroll
            for (int ni = 0; ni < 4; ++ni)
#pragma unroll
                for (int q = 0; q < 4; ++q) { const f32x4 xv = gld<f32x4>(X + off + 32 * ni + 8 * q);
                    f32x4 o; o[0] = DN_ALPHA * xv[0] + acc[mi][ni][4 * q]; o[1] = DN_ALPHA * xv[1] + acc[mi][ni][4 * q + 1]; o[2] = DN_ALPHA * xv[2] + acc[mi][ni][4 * q + 2]; o[3] = DN_ALPHA * xv[3] + acc[mi][ni][4 * q + 3];
                    gst<f32x4>(Y + off + 32 * ni + 8 * q, o);
                    if (q == 3) asm volatile("" ::: "memory"); }
        }
    }
};
struct EpiMoe1 {
    bf16_t* Hm; int rowbase, nvalid, n0;
    __device__ __forceinline__ void operator()(f32x16 (&acc)[2][4], int wm, int wn, int l32, int hi, LAS char*) const {
        const int ff0 = (n0 + 128 * wn) >> 1;
#pragma unroll
        for (int mi = 0; mi < 2; ++mi) {
            const int rl = 64 * wm + 32 * mi + l32;
            if (rl < nvalid) {
                bf16_t* p = Hm + (size_t)(rowbase + rl) * EFF + ff0 + 4 * hi;
#pragma unroll
                for (int h2 = 0; h2 < 2; ++h2)
#pragma unroll
                    for (int q = 0; q < 4; ++q) { float v[4];
#pragma unroll
                        for (int j = 0; j < 4; ++j) { const float g = acc[mi][2 * h2][4 * q + j], u = acc[mi][2 * h2 + 1][4 * q + j]; v[j] = g / (1.f + __expf(-g)) * u; }
                        store_bf4(p + 32 * h2 + 8 * q, v[0], v[1], v[2], v[3]); }
            }
        }
    }
};
struct EpiMoe2 {
    bf16_t* Y; const int* list; const float* gw; int nvalid, n0;
    __device__ __forceinline__ void operator()(f32x16 (&acc)[2][4], int wm, int wn, int l32, int hi, LAS char*) const {
        const int nw = n0 + 128 * wn;
#pragma unroll
        for (int mi = 0; mi < 2; ++mi) {
            const int rl = 64 * wm + 32 * mi + l32;
            if (rl < nvalid) { const int slot = gld<int>(list + rl); store_tiles4(Y + (size_t)slot * DM + nw + 4 * hi, acc[mi], gld<float>(gw + slot)); }
        }
    }
};

constexpr int VS = 160;
struct KeySrc { const bf16_t* k0; size_t kstride; const bf16_t* kr; size_t krstride; const bf16_t* v0; size_t vstride; };

template <int DQK> struct AttnRegs { bf16x8 k[DQK / 8 * 64 / 256]; bf16x8 v[4]; };
template <int DQK> struct AttnSrc { __amdgpu_buffer_rsrc_t rk, rr, rv; unsigned ko[DQK / 8 * 64 / 256]; unsigned vo[4]; unsigned ktile, rtile, vtile; };
template <int DQK> __device__ __forceinline__ AttnSrc<DQK> attn_src(const KeySrc& ks, int tid) {
    constexpr int KCH = DQK / 8, NKL = KCH * 64 / 256;
    AttnSrc<DQK> a; a.rk = mk_rsrc(ks.k0); a.rr = mk_rsrc(ks.kr); a.rv = mk_rsrc(ks.v0);
#pragma unroll
    for (int i = 0; i < NKL; ++i) { const int idx = tid + i * 256, key = idx / KCH, ch = idx - key * KCH;
        a.ko[i] = (DQK == 128 || ch < 16) ? (unsigned)(key * (unsigned)ks.kstride + ch * 8) * 2u : (unsigned)(key * (unsigned)ks.krstride + (ch - 16) * 8) * 2u; }
#pragma unroll
    for (int i = 0; i < 4; ++i) { const int idx = tid + i * 256, key = idx >> 4, ch = idx & 15; a.vo[i] = (unsigned)(key * (unsigned)ks.vstride + ch * 8) * 2u; }
    a.ktile = 128u * (unsigned)ks.kstride; a.rtile = 128u * (unsigned)ks.krstride; a.vtile = 128u * (unsigned)ks.vstride;
    return a;
}
template <int DQK> __device__ __forceinline__ void attn_gload(const AttnSrc<DQK>& a, int jt, AttnRegs<DQK>& R, bool withv, int tid) {
    constexpr int KCH = DQK / 8, NKL = KCH * 64 / 256;
#pragma unroll
    for (int i = 0; i < NKL; ++i) { const int idx = tid + i * 256, key = idx / KCH, ch = idx - key * KCH;
        R.k[i] = (DQK == 128 || ch < 16) ? bld8(a.rk, a.ko[i], (int)(jt * a.ktile)) : bld8(a.rr, a.ko[i], (int)(jt * a.rtile)); }
    if (withv) {
#pragma unroll
        for (int i = 0; i < 4; ++i) R.v[i] = bld8(a.rv, a.vo[i], (int)(jt * a.vtile));
    }
}
template <int DQK> __device__ __forceinline__ void attn_lwrite(LAS char* lds, const AttnRegs<DQK>& R, bool withv, int tid) {
    constexpr int KS = DQK + 8, KCH = DQK / 8, NKL = KCH * 64 / 256;
#pragma unroll
    for (int i = 0; i < NKL; ++i) { const int idx = tid + i * 256, key = idx / KCH, ch = idx - key * KCH; *(LAS bf16x8*)(lds + (key * KS + ch * 8) * 2) = R.k[i]; }
    if (withv) {
#pragma unroll
        for (int i = 0; i < 4; ++i) { const int idx = tid + i * 256, key = idx >> 4, ch = idx & 15; *(LAS bf16x8*)(lds + 64 * KS * 2 + (key * VS + ch * 8) * 2) = R.v[i]; }
    }
}
template <int DQK> __device__ __forceinline__ void attn_stage(LAS char* lds, const AttnSrc<DQK>& a, int jt, bool withv, int tid) { AttnRegs<DQK> R; attn_gload<DQK>(a, jt, R, withv, tid); attn_lwrite<DQK>(lds, R, withv, tid); }
template <int DQK> __device__ __forceinline__ void attn_scores(const LAS char* lds, const bf16x8 (&qf)[DQK / 16], f32x16& p0, f32x16& p1, int l32, int hi) {
    constexpr int KS = DQK + 8;
    const int sg = (l32 & ~12) | ((l32 & 4) << 1) | ((l32 & 8) >> 1);
    const LAS char* kb = lds + (sg * KS + hi * 8) * 2;
#pragma unroll
    for (int r = 0; r < 16; ++r) { p0[r] = 0.f; p1[r] = 0.f; }
#pragma unroll
    for (int ds = 0; ds < DQK / 16; ++ds) {
        const bf16x8 a0 = *(const LAS bf16x8*)(kb + ds * 32), a1 = *(const LAS bf16x8*)(kb + 32 * KS * 2 + ds * 32);
        p0 = __builtin_amdgcn_mfma_f32_32x32x16_bf16(a0, qf[ds], p0, 0, 0, 0);
        p1 = __builtin_amdgcn_mfma_f32_32x32x16_bf16(a1, qf[ds], p1, 0, 0, 0);
    }
}
template <int DQK, bool SEL>
__device__ __forceinline__ void attn_run(LAS char* lds, const KeySrc& ks, int jt_lo, int jt_hi, unsigned tile_union, const bf16x8 (&qf)[DQK / 16],
                                         int qi, unsigned maxd, unsigned sel, float c2, f32x16 (&o)[4], float& m_run, float& l_run, int tid) {
    constexpr int KS = DQK + 8;
    const int lane = tid & 63, l32 = lane & 31, hi = lane >> 5;
    const int g = lane >> 4, i16 = lane & 15;
    const LAS char* vb = (lds + 64 * KS * 2 + ((8 * hi + (i16 >> 2)) * VS + 16 * (g & 1) + 4 * (i16 & 3)) * 2);
    const float NEG = -__builtin_inff();
    int qmin = qi, qmax = qi;
#pragma unroll
    for (int sft = 32; sft >= 1; sft >>= 1) { qmin = min(qmin, __shfl_xor(qmin, sft)); qmax = max(qmax, __shfl_xor(qmax, sft)); }
    int jt = jt_lo;
    if (SEL) { while (jt < jt_hi && !((tile_union >> jt) & 1u)) ++jt; }
    if (jt >= jt_hi) return;
    AttnRegs<DQK> R;
    const AttnSrc<DQK> asrc = attn_src<DQK>(ks, tid);
    constexpr bool PF = DQK == 128;
    if (PF) attn_gload<DQK>(asrc, jt, R, true, tid);
    for (;;) {
        if (!PF) attn_gload<DQK>(asrc, jt, R, true, tid);
        attn_lwrite<DQK>(lds, R, true, tid);
        __syncthreads();
        int jn = jt + 1;
        if (SEL) { while (jn < jt_hi && !((tile_union >> jn) & 1u)) ++jn; }
        if (PF && jn < jt_hi) attn_gload<DQK>(asrc, jn, R, true, tid);
        f32x16 p0, p1;
        attn_scores<DQK>(lds, qf, p0, p1, l32, hi);
        const bool ok = SEL ? (((sel >> jt) & 1u) != 0u) : true;
        const bool interior = (qmin - (jt * 64 + 63) >= 0) && ((unsigned)(qmax - jt * 64) <= maxd) && (SEL ? __all(ok) : true);
        float mx = NEG;
        if (interior) {
#pragma unroll
            for (int r = 0; r < 16; ++r) mx = fmaxf(mx, fmaxf(p0[r], p1[r]));
        } else {
            const int dq = qi - jt * 64 - 8 * hi;
#pragma unroll
            for (int r = 0; r < 16; ++r) {
                const int ko = 16 * (r >> 3) + (r & 7);
                const float s0 = (ok && (unsigned)(dq - ko) <= maxd) ? p0[r] : NEG;
                const float s1 = (ok && (unsigned)(dq - ko - 32) <= maxd) ? p1[r] : NEG;
                p0[r] = s0; p1[r] = s1; mx = fmaxf(mx, fmaxf(s0, s1));
            }
        }
        mx = fmaxf(mx, __shfl_xor(mx, 32));
        const float mn = fmaxf(m_run, mx * c2);
        const float alpha = __builtin_amdgcn_exp2f(m_run - mn);
        const float nmn = -mn;
        float rs = 0.f;
#pragma unroll
        for (int r = 0; r < 16; ++r) { p0[r] = __builtin_amdgcn_exp2f(fmaf(p0[r], c2, nmn)); p1[r] = __builtin_amdgcn_exp2f(fmaf(p1[r], c2, nmn)); rs += p0[r] + p1[r]; }
        rs += __shfl_xor(rs, 32);
        l_run = l_run * alpha + rs; m_run = mn;
        if (!__all(alpha == 1.f)) {
#pragma unroll
            for (int dt = 0; dt < 4; ++dt)
#pragma unroll
                for (int r = 0; r < 16; ++r) o[dt][r] *= alpha;
        }
#pragma unroll
        for (int s4 = 0; s4 < 4; ++s4) {
            u32x4 pw;
            if (s4 == 0)      { pw.x = cvtpk(p0[0], p0[1]);  pw.y = cvtpk(p0[2], p0[3]);   pw.z = cvtpk(p0[4], p0[5]);   pw.w = cvtpk(p0[6], p0[7]); }
            else if (s4 == 1) { pw.x = cvtpk(p0[8], p0[9]);  pw.y = cvtpk(p0[10], p0[11]); pw.z = cvtpk(p0[12], p0[13]); pw.w = cvtpk(p0[14], p0[15]); }
            else if (s4 == 2) { pw.x = cvtpk(p1[0], p1[1]);  pw.y = cvtpk(p1[2], p1[3]);   pw.z = cvtpk(p1[4], p1[5]);   pw.w = cvtpk(p1[6], p1[7]); }
            else              { pw.x = cvtpk(p1[8], p1[9]);  pw.y = cvtpk(p1[10], p1[11]); pw.z = cvtpk(p1[12], p1[13]); pw.w = cvtpk(p1[14], p1[15]); }
            const bf16x8 pb = *reinterpret_cast<bf16x8*>(&pw);
#pragma unroll
            for (int dt = 0; dt < 4; ++dt) {
                const s16x4 v0 = __builtin_amdgcn_ds_read_tr16_b64_v4i16((LAS s16x4*)(vb + (s4 * 16 * VS + dt * 32) * 2));
                const s16x4 v1 = __builtin_amdgcn_ds_read_tr16_b64_v4i16((LAS s16x4*)(vb + (s4 * 16 * VS + 4 * VS + dt * 32) * 2));
                const bf16x8 va = {v0[0], v0[1], v0[2], v0[3], v1[0], v1[1], v1[2], v1[3]};
                o[dt] = __builtin_amdgcn_mfma_f32_32x32x16_bf16(va, pb, o[dt], 0, 0, 0);
            }
        }
        __syncthreads();
        if (jn >= jt_hi) break;
        jt = jn;
    }
}
template <int DQK> __device__ __forceinline__ void load_q(const bf16_t* qptr, int hi, bf16x8 (&qf)[DQK / 16]) {
#pragma unroll
    for (int ds = 0; ds < DQK / 16; ++ds) qf[ds] = gld<bf16x8>(qptr + ds * 16 + hi * 8);
}
__device__ __forceinline__ void store_o(bf16_t* optr, const f32x16 (&o)[4], float inv, int hi) {
#pragma unroll
    for (int dt = 0; dt < 4; ++dt)
#pragma unroll
        for (int q = 0; q < 4; ++q) store_bf4(optr + 32 * dt + 8 * q + 4 * hi, o[dt][4 * q] * inv, o[dt][4 * q + 1] * inv, o[dt][4 * q + 2] * inv, o[dt][4 * q + 3] * inv);
}
__device__ __forceinline__ void zero_o(f32x16 (&o)[4]) {
#pragma unroll
    for (int dt = 0; dt < 4; ++dt)
#pragma unroll
        for (int r = 0; r < 16; ++r) o[dt][r] = 0.f;
}

__device__ __forceinline__ int claim(unsigned* ctr, LAS char* lds) {
    volatile LAS int* slot = (volatile LAS int*)(lds + LDS_CTL + 64);
    __syncthreads();
    if (otid() == 0) *slot = (int)atomicAdd(ctr, 1u);
    __syncthreads();
    return *slot;
}

__device__ __forceinline__ void conv_tile(LAS char* lds, const float* src, int N, int k0, int n0, bf16_t* dst, int ldd, int rowmap, const float* kscale) {
    LAS float* tile = (LAS float*)lds;
    const int tid = otid();
    __syncthreads();
    {
        const int kr = tid >> 6, nc = tid & 63; const bool inb = n0 + nc < N;
#pragma unroll
        for (int i = 0; i < 16; ++i) { const int k = kr + 4 * i; float v = inb ? gld<float>(src + (size_t)(k0 + k) * N + n0 + nc) : 0.f; if (kscale) v *= gld<float>(kscale + k0 + k); tile[k * 65 + nc] = v; }
    }
    __syncthreads();
    {
        const int n = tid >> 2, kq = (tid & 3) * 16; const int c = n0 + n;
        const int drow = rowmap == 0 ? c : (128 * (c >> 6) + 64 * ((c >> 5) & 1) + 32 * (rowmap - 1) + (c & 31));
        u32x4 w0, w1;
        w0.x = cvtpk(tile[(kq + 0) * 65 + n], tile[(kq + 1) * 65 + n]);   w0.y = cvtpk(tile[(kq + 2) * 65 + n], tile[(kq + 3) * 65 + n]);
        w0.z = cvtpk(tile[(kq + 4) * 65 + n], tile[(kq + 5) * 65 + n]);   w0.w = cvtpk(tile[(kq + 6) * 65 + n], tile[(kq + 7) * 65 + n]);
        w1.x = cvtpk(tile[(kq + 8) * 65 + n], tile[(kq + 9) * 65 + n]);   w1.y = cvtpk(tile[(kq + 10) * 65 + n], tile[(kq + 11) * 65 + n]);
        w1.z = cvtpk(tile[(kq + 12) * 65 + n], tile[(kq + 13) * 65 + n]); w1.w = cvtpk(tile[(kq + 14) * 65 + n], tile[(kq + 15) * 65 + n]);
        bf16_t* d = dst + (size_t)drow * ldd + k0 + kq;
        gst<u32x4>(d, w0); gst<u32x4>(d + 8, w1);
    }
}

__device__ __forceinline__ void phase_prep(const Params& p, int layer, LAS char* lds) {
    char* ws = ows(p.ws);
    const int tid = otid();
    constexpr int N_WIN = 32 * 72, N_WQ = 6 * 12, N_WKV = 2 * 16, N_W1 = 64 * 4, N_W2 = 4 * 2, N_WOUT = 32 * 32, N_EG = NEXP * 32 * 8, N_ED = NEXP * 8 * 32;
    constexpr int E0 = 0, E1 = E0 + N_WIN, E2 = E1 + N_WQ, E3 = E2 + N_WKV, E4 = E3 + N_W1, E5 = E4 + N_W1, E6 = E5 + N_W2, E7 = E6 + N_W2, E8 = E7 + N_WOUT,
                  E9 = E8 + N_EG, E10 = E9 + N_EG, E11 = E10 + N_ED, E12 = E11 + 32  , E13 = E12 + 64  , E14 = E13 + 4096  ;
    const int total = layer == 0 ? E14 : E12;
    for (int it = oblk(); it < total; it += gridDim.x) {
        if (it < E1) { const int u = it - E0, kt = u % 32, nt = u / 32;
            conv_tile(lds, p.in[I_WIN] + (size_t)layer * DM * INC, INC, kt * 64, nt * 64, (bf16_t*)(ws + OFF_WIN_T), DM, 0, nullptr);
        } else if (it < E2) { const int u = it - E1, kt = u % 6, nt = u / 6;
            conv_tile(lds, p.in[I_WQUP] + (size_t)layer * 384 * 768, 768, kt * 64, nt * 64, (bf16_t*)(ws + OFF_WQ_T), 384, 0, p.in[I_QLN] + layer * 384);
        } else if (it < E3) { const int u = it - E2, kt = u % 2, nt = u / 2;
            conv_tile(lds, p.in[I_WKVUP] + (size_t)layer * 128 * 1024, 1024, kt * 64, nt * 64, (bf16_t*)(ws + OFF_WKV_T), 128, 0, p.in[I_KVLN] + layer * 128);
        } else if (it < E5) { const int which = it >= E4, u = it - (which ? E4 : E3), kt = u % 64, nt = u / 64;
            conv_tile(lds, p.in[which ? I_W1V : I_W1K] + (size_t)layer * 4096 * 256, 256, kt * 64, nt * 64, (bf16_t*)(ws + (which ? OFF_W1V_T : OFF_W1K_T)), 4096, 0, nullptr);
        } else if (it < E7) { const int which = it >= E6, u = it - (which ? E6 : E5), kt = u % 4, nt = u / 4;
            conv_tile(lds, p.in[which ? I_W2V : I_W2K] + (size_t)layer * 256 * 128, 128, kt * 64, nt * 64, (bf16_t*)(ws + (which ? OFF_W2V_T : OFF_W2K_T)), 256, 0, nullptr);
        } else if (it < E8) { const int u = it - E7, kt = u % 32, nt = u / 32;
            conv_tile(lds, p.in[I_WOUT] + (size_t)layer * DM * DM, DM, kt * 64, nt * 64, (bf16_t*)(ws + OFF_WOUT_T), DM, 0, nullptr);
        } else if (it < E10) { const int isup = it >= E9, u = it - (isup ? E9 : E8), e = u / 256, r = u % 256, kt = r % 32, nt = r / 32;
            conv_tile(lds, p.in[isup ? I_WUP : I_WGATE] + ((size_t)layer * NEXP + e) * DM * EFF, EFF, kt * 64, nt * 64, (bf16_t*)(ws + OFF_WGU_T) + (size_t)e * 1024 * DM, DM, 1 + isup, nullptr);
        } else if (it < E11) { const int u = it - E10, e = u / 256, r = u % 256, kt = r % 8, nt = r / 8;
            conv_tile(lds, p.in[I_WDOWN] + ((size_t)layer * NEXP + e) * EFF * DM, DM, kt * 64, nt * 64, (bf16_t*)(ws + OFF_WD_T) + (size_t)e * DM * EFF, EFF, 0, nullptr);
        } else if (it < E12) { const int u = it - E11, which = u >> 4, kc = u & 15;
            const float* pe = p.in[which ? I_PEV : I_PEK] + (size_t)layer * 4096 + kc * 256;
            const float* w1 = p.in[which ? I_W1V : I_W1K] + (size_t)layer * 4096 * 256 + (size_t)kc * 256 * 256;
            float a0 = 0.f, a1 = 0.f, a2 = 0.f, a3 = 0.f;
            for (int k = 0; k < 256; k += 4) { a0 += pe[k] * w1[(size_t)k * 256 + tid]; a1 += pe[k + 1] * w1[(size_t)(k + 1) * 256 + tid]; a2 += pe[k + 2] * w1[(size_t)(k + 2) * 256 + tid]; a3 += pe[k + 3] * w1[(size_t)(k + 3) * 256 + tid]; }
            ((float*)(ws + OFF_B1P))[(which * 16 + kc) * 256 + tid] = (a0 + a1) + (a2 + a3);
        } else if (it < E13) { const int u = it - E12;
            f32x2* cs16 = (f32x2*)(ws + OFF_CS16); f32x2* cs32 = (f32x2*)(ws + OFF_CS32);
            for (int e = tid; e < 32 * 48; e += 256) { const int pos = u * 32 + e / 48, j = e % 48;
                const int half = j < 16 ? 16 : 32, i = j < 16 ? j : j - 16;
                const float invf = exp2f(-(float)i / (float)half * 18.931568569324174f);
                const float ang = (float)pos * invf;
                f32x2 cs; cs.x = cosf(ang); cs.y = sinf(ang);
                if (j < 16) cs16[pos * 16 + i] = cs; else cs32[pos * 32 + i] = cs; }
        } else { const int u = it - E13;
            const float* x = p.in[I_X] + (size_t)u * 4096; bf16_t* xb = (bf16_t*)(ws + OFF_XB) + (size_t)u * 4096;
            for (int e = tid * 4; e < 4096; e += 1024) { const f32x4 v = gld<f32x4>(x + e); store_bf4(xb + e, v[0], v[1], v[2], v[3]); }
        }
    }
    if (oblk() == 0 && tid < NEXP) ((unsigned*)(ws + OFF_ECNT))[tid] = 0u;
    { unsigned* imp = (unsigned*)(ws + OFF_IMP); for (size_t e = (size_t)oblk() * 256 + tid; e < (size_t)NT * 32; e += (size_t)gridDim.x * 256) gst<unsigned>(imp + e, 0u); }
}

#define AO4(ld) { (unsigned)(sr * (ld) + sc), (unsigned)((sr + 32) * (ld) + sc), (unsigned)((sr + 64) * (ld) + sc), (unsigned)((sr + 96) * (ld) + sc) }
__device__ __forceinline__ void phase_win(const Params& p, int layer, LAS char* lds) {
    char* ws = ows(p.ws); const int tid = otid(), sr = tid >> 3, sc = (tid & 7) * 8;
    const bf16_t* A = (const bf16_t*)(ws + OFF_XB); const bf16_t* Bt = (const bf16_t*)(ws + OFF_WIN_T);
    for (int u = oblk(); u < 64 * 18; u += gridDim.x) {
        const int mt = u & 63, nt = u >> 6;
        EpiWin e{(bf16_t*)(ws + OFF_H), (float*)(ws + OFF_GATES), (const f32x2*)(ws + OFF_CS16), (const f32x2*)(ws + OFF_CS32), mt * 128, nt * 256};
        const unsigned ao[4] = AO4(DM);
        gemm_unit(lds, A + (size_t)mt * 128 * DM, ao, 128, Bt + (size_t)nt * 256 * DM, (unsigned)(sr * DM + sc), (size_t)32 * DM, DM / 64, e);
    }
}
__device__ __forceinline__ void phase_up(const Params& p, int layer, LAS char* lds) {
    char* ws = ows(p.ws); const int tid = otid(), sr = tid >> 3, sc = (tid & 7) * 8;
    const bf16_t* H = (const bf16_t*)(ws + OFF_H);
    constexpr int U0 = 64, U1 = U0 + 64 * 3, U2 = U1 + 64 * 4;
    for (int u = oblk(); u < U2; u += gridDim.x) {
        if (u < U0) {
            const int which = u >> 5, mt = (u >> 3) & 3, ksp = u & 7;
            const int col = which ? C_NVC : C_NKC;
            unsigned ao[4];
#pragma unroll
            for (int i = 0; i < 4; ++i) { int c = sr + 32 * i; if (c > 126) c = 126; ao[i] = (unsigned)(16 * c * LDH + sc); }
            const bf16_t* ab = H + (size_t)(mt * SEQ + 4 * ksp) * LDH + col;
            const bf16_t* bb = (const bf16_t*)(ws + (which ? OFF_W1V_T : OFF_W1K_T)) + 512 * ksp;
            EpiCmp1 e{(float*)(ws + OFF_HCP) + ((size_t)ksp * 2 + which) * 512 * 256, mt * 128};
            gemm_unit(lds, ab, ao, LDH, bb, (unsigned)(sr * 4096 + sc), (size_t)32 * 4096, 512 / 64, e);
        } else if (u < U1) {
            const int v = u - U0, mt = v & 63, nt = v >> 6;
            const unsigned ao[4] = AO4(LDH);
            EpiQup e{(bf16_t*)(ws + OFF_QM), (const f32x2*)(ws + OFF_CS32), mt * 128, nt * 256};
            row_sumsq<384>(lds, H + (size_t)mt * 128 * LDH + C_QLAT, LDH);
            gemm_unit(lds, H + (size_t)mt * 128 * LDH + C_QLAT, ao, 128, (const bf16_t*)(ws + OFF_WQ_T) + (size_t)nt * 256 * 384, (unsigned)(sr * 384 + sc), (size_t)32 * 384, 384 / 64, e);
        } else {
            const int v = u - U1, mt = v & 63, nt = v >> 6;
            const unsigned ao[4] = AO4(LDH);
            EpiKVup e{(bf16_t*)(ws + OFF_KN), mt * 128, nt * 256};
            row_sumsq<128>(lds, H + (size_t)mt * 128 * LDH + C_KVLAT, LDH);
            gemm_unit(lds, H + (size_t)mt * 128 * LDH + C_KVLAT, ao, 128, (const bf16_t*)(ws + OFF_WKV_T) + (size_t)nt * 256 * 128, (unsigned)(sr * 128 + sc), (size_t)32 * 128, 128 / 64, e);
        }
    }
}
__device__ __forceinline__ void phase_cmp2(const Params& p, int layer, LAS char* lds) {
    char* ws = ows(p.ws); const int tid = otid(), sr = tid >> 3, sc = (tid & 7) * 8;
    for (int u = oblk(); u < 8; u += gridDim.x) {
        const int which = u >> 2, mt = u & 3;
        bf16_t* Hc = (bf16_t*)(ws + OFF_HC) + (size_t)which * 512 * 256 + (size_t)mt * 128 * 256;
        const float* P = (const float*)(ws + OFF_HCP) + (size_t)which * 512 * 256 + (size_t)mt * 128 * 256;
        const float* b1p = (const float*)(ws + OFF_B1P) + which * 16 * 256;
        for (int e = tid * 4; e < 128 * 256; e += 1024) {
            f32x4 a = {0.f, 0.f, 0.f, 0.f};
            for (int q = 0; q < 16; ++q) a += gld<f32x4>(b1p + q * 256 + (e & 255));
            for (int q = 0; q < 8; ++q) a += gld<f32x4>(P + (size_t)q * 2 * 512 * 256 + e);
            store_bf4(Hc + e, gelu_tanh(a[0]), gelu_tanh(a[1]), gelu_tanh(a[2]), gelu_tanh(a[3]));
        }
        asm volatile("s_waitcnt vmcnt(0)" ::: "memory");
        __syncthreads();
        const unsigned ao[4] = AO4(256);
        EpiCmp2 e{(bf16_t*)(ws + (which ? OFF_VC : OFF_KC)), (const f32x2*)(ws + OFF_CS16), which == 0, mt * 128};
        gemm_unit(lds, Hc, ao, 128, (const bf16_t*)(ws + (which ? OFF_W2V_T : OFF_W2K_T)), (unsigned)(sr * 256 + sc), (size_t)32 * 256, 256 / 64, e);
    }
}
__device__ __forceinline__ void phase_out(const Params& p, int layer, LAS char* lds) {
    char* ws = ows(p.ws); const int tid = otid(), sr = tid >> 3, sc = (tid & 7) * 8;
    const bf16_t* A = (const bf16_t*)(ws + OFF_MIX); const bf16_t* Bt = (const bf16_t*)(ws + OFF_WOUT_T);
    const float* X = layer == 0 ? p.in[I_X] : (const float*)(ws + OFF_XA);
    for (int u = oblk(); u < 64 * 8; u += gridDim.x) {
        const int mt = u & 63, nt = u >> 6;
        EpiOut e{(float*)(ws + OFF_YB), X, mt * 128, nt * 256};
        const unsigned ao[4] = AO4(DM);
        gemm_unit(lds, A + (size_t)mt * 128 * DM, ao, 128, Bt + (size_t)nt * 256 * DM, (unsigned)(sr * DM + sc), (size_t)32 * DM, DM / 64, e);
    }
}

__device__ __forceinline__ void item_mla(const Params& p, int it, LAS char* lds) {
    char* ws = ows(p.ws); const int tid = otid(), lane = tid & 63, w = tid >> 6, l32 = lane & 31, hi = lane >> 5;
    const int qb = 15 - (it >> 4), h = it & 3, b = (it >> 2) & 3;
    const int token = qb * 128 + 32 * w + l32; const size_t row = (size_t)b * SEQ + token;
    bf16x8 qf[12]; load_q<192>((const bf16_t*)(ws + OFF_QM) + row * 768 + h * 192, hi, qf);
    KeySrc ks; ks.k0 = (const bf16_t*)(ws + OFF_KN) + (size_t)b * SEQ * 512 + h * 128; ks.kstride = 512;
    ks.kr = (const bf16_t*)(ws + OFF_H) + (size_t)b * SEQ * LDH + C_KROPE; ks.krstride = LDH;
    ks.v0 = (const bf16_t*)(ws + OFF_VM) + (size_t)b * SEQ * 512 + h * 128; ks.vstride = 512;
    f32x16 o[4]; zero_o(o); float m = -1e30f, l = 0.f;
    attn_run<192, false>(lds, ks, 0, 2 * qb + 2, 0u, qf, token, 0x7fffffffu, 0u, 0.07216878364870322f * LOG2E, o, m, l, tid);
    store_o((bf16_t*)(ws + OFF_MIX) + row * DM + h * 128, o, 1.f / l, hi);
}
__device__ __forceinline__ void item_dil(const Params& p, int it, LAS char* lds) {
    char* ws = ows(p.ws); const int tid = otid(), lane = tid & 63, w = tid >> 6, l32 = lane & 31, hi = lane >> 5;
    const int rem = it % 48, bh = it / 48, h = bh % 6, b = bh / 6;
    const int n = rem >> 4, r2 = rem & 15;
    const int dil = n == 0 ? 1 : (n == 1 ? 4 : 16);
    const int rho = n == 0 ? 0 : (n == 1 ? (r2 >> 2) : r2), qb = n == 0 ? r2 : (n == 1 ? (r2 & 3) : 0);
    const int i = qb * 128 + 32 * w + l32, token = rho + i * dil; const size_t row = (size_t)b * SEQ + token;
    const bf16_t* H = (const bf16_t*)(ws + OFF_H);
    bf16x8 qf[8]; load_q<128>(H + row * LDH + C_DQ + h * 128, hi, qf);
    KeySrc ks; ks.k0 = H + ((size_t)b * SEQ + rho) * LDH + C_DK + h * 128; ks.kstride = (size_t)dil * LDH; ks.kr = ks.k0; ks.krstride = 0;
    ks.v0 = H + ((size_t)b * SEQ + rho) * LDH + C_DV + h * 128; ks.vstride = (size_t)dil * LDH;
    f32x16 o[4]; zero_o(o); float m = -1e30f, l = 0.f;
    const int jlo = 2 * qb - 2 < 0 ? 0 : 2 * qb - 2;
    attn_run<128, false>(lds, ks, jlo, 2 * qb + 2, 0u, qf, i, 128u, 0u, 0.08838834764831845f * LOG2E, o, m, l, tid);
    store_o((bf16_t*)(ws + OFF_ODIL) + ((size_t)n * NT + row) * 768 + h * 128, o, 1.f / l, hi);
    if (hi == 0) gst<float>((float*)(ws + OFF_LDIL) + ((size_t)n * NT + row) * 6 + h, m + __log2f(l));
}
__device__ __forceinline__ void item_win(const Params& p, int it, LAS char* lds) {
    char* ws = ows(p.ws); const int tid = otid(), lane = tid & 63, w = tid >> 6, l32 = lane & 31, hi = lane >> 5;
    const int hp = it % 3, b = (it / 3) & 3, tb = 31 - it / 12;
    const int head = 2 * hp + (w >> 1), token = 64 * tb + 32 * (w & 1) + l32; const size_t row = (size_t)b * SEQ + token;
    const bf16_t* H = (const bf16_t*)(ws + OFF_H);
    bf16x8 qf[8]; load_q<128>(H + row * LDH + C_NQ + head * 128, hi, qf);
    KeySrc ks; ks.k0 = H + (size_t)b * SEQ * LDH + C_NKW; ks.kstride = LDH; ks.kr = ks.k0; ks.krstride = 0; ks.v0 = H + (size_t)b * SEQ * LDH + C_NVW; ks.vstride = LDH;
    f32x16 o[4]; zero_o(o); float m = -1e30f, l = 0.f;
    attn_run<128, false>(lds, ks, tb - 8 < 0 ? 0 : tb - 8, tb + 1, 0u, qf, token, 511u, 0u, 0.08838834764831845f * LOG2E, o, m, l, tid);
    store_o((bf16_t*)(ws + OFF_PW) + row * 768 + head * 128, o, 1.f / l, hi);
}
__device__ __forceinline__ void item_cmp(const Params& p, int it, LAS char* lds) {
    char* ws = ows(p.ws); const int tid = otid(), lane = tid & 63, w = tid >> 6, l32 = lane & 31, hi = lane >> 5;
    const int hp = it % 3, tb = (it / 3) % 32, b = it / 96;
    const int head = 2 * hp + (w >> 1), token = 64 * tb + 32 * (w & 1) + l32; const size_t row = (size_t)b * SEQ + token;
    const bf16_t* H = (const bf16_t*)(ws + OFF_H);
    bf16x8 qf[8]; load_q<128>(H + row * LDH + C_NQ + head * 128, hi, qf);
    KeySrc ks; ks.k0 = (const bf16_t*)(ws + OFF_KC) + (size_t)b * 128 * 128; ks.kstride = 128; ks.kr = ks.k0; ks.krstride = 0; ks.v0 = (const bf16_t*)(ws + OFF_VC) + (size_t)b * 128 * 128; ks.vstride = 128;
    const int qi = (token - 31) >> 4;
    const int qimax = (64 * tb + 63 - 31) >> 4;
    const int jhi = qimax < 0 ? 0 : (qimax >> 6) + 1;
    const float c2 = 0.08838834764831845f * LOG2E;
    f32x16 o[4]; zero_o(o); float m = -1e30f, l = 0.f;
    attn_run<128, false>(lds, ks, 0, jhi, 0u, qf, qi, 0x7fffffffu, 0u, c2, o, m, l, tid);
    const float inv = l > 0.f ? 1.f / l : 0.f;
    store_o((bf16_t*)(ws + OFF_PC) + row * 768 + head * 128, o, inv, hi);
    unsigned* imp = (unsigned*)(ws + OFF_IMP) + row * 32;
    const AttnSrc<128> asrc = attn_src<128>(ks, tid);
    for (int jt = 0; jt < jhi; ++jt) {
        attn_stage<128>(lds, asrc, jt, false, tid);
        __syncthreads();
        f32x16 p0, p1; attn_scores<128>(lds, qf, p0, p1, l32, hi);
        const int dq = qi - jt * 64 - 8 * hi;
#pragma unroll
        for (int r = 0; r < 16; ++r) { const int ko = 16 * (r >> 3) + (r & 7);
            p0[r] = (dq - ko >= 0) ? __builtin_amdgcn_exp2f(p0[r] * c2 - m) * inv : 0.f;
            p1[r] = (dq - ko - 32 >= 0) ? __builtin_amdgcn_exp2f(p1[r] * c2 - m) * inv : 0.f; }
#pragma unroll
        for (int t = 0; t < 2; ++t)
#pragma unroll
            for (int u = 0; u < 2; ++u) {
                unsigned q[8];
#pragma unroll
                for (int j = 0; j < 8; ++j) q[j] = (unsigned)((t ? p1[8 * u + j] : p0[8 * u + j]) * 16777216.f + 0.5f);
                const int j0 = (64 * jt + 32 * t + 16 * u + 8 * hi) >> 2;
                const unsigned a0 = q[0] + q[1] + q[2] + q[3], a1 = q[4] + q[5] + q[6] + q[7] + q[3], a2 = q[7];
                if (a0) atomicAdd(imp + j0, a0);
                if (a1) atomicAdd(imp + j0 + 1, a1);
                if (a2 && j0 + 2 < 32) atomicAdd(imp + j0 + 2, a2);
            }
        __syncthreads();
    }
}
__device__ __forceinline__ void item_slc(const Params& p, int it, LAS char* lds) {
    char* ws = ows(p.ws); const int tid = otid(), lane = tid & 63, w = tid >> 6, l32 = lane & 31, hi = lane >> 5;
    const int hp = it % 3, b = (it / 3) & 3, tb = 31 - it / 12;
    LAS int* sc = (LAS int*)(lds + 47104); LAS unsigned* msk = (LAS unsigned*)(lds + 47104 + 8192);
    __syncthreads();
    if (tid < 65) msk[tid] = 0u;
    const unsigned* imp = (const unsigned*)(ws + OFF_IMP) + ((size_t)b * SEQ + 64 * tb) * 32;
#pragma unroll
    for (int i = 0; i < 8; ++i) { const int e = tid + i * 256, tk = e >> 5, j = e & 31, pos = 64 * tb + tk, qblk = pos >> 6;
        const bool valid = 64 * j <= pos, forced = (j == 0) || (j == qblk) || (j == qblk - 1);
        sc[e] = valid ? (forced ? 0x7fffffff : (int)gld<unsigned>(imp + e)) : -1; }
    __syncthreads();
#pragma unroll
    for (int i = 0; i < 8; ++i) { const int e = tid + i * 256, tk = e >> 5, j = e & 31; const int s = sc[e]; int rank = 0;
        for (int k = 0; k < 32; ++k) { const int sk = sc[tk * 32 + k]; rank += (sk > s || (sk == s && k < j)) ? 1 : 0; }
        if (rank < 16) { __hip_atomic_fetch_or(&msk[tk], 1u << j, __ATOMIC_RELAXED, __HIP_MEMORY_SCOPE_WORKGROUP); __hip_atomic_fetch_or(&msk[64], 1u << j, __ATOMIC_RELAXED, __HIP_MEMORY_SCOPE_WORKGROUP); } }
    __syncthreads();
    const int head = 2 * hp + (w >> 1), tk = 32 * (w & 1) + l32, token = 64 * tb + tk; const size_t row = (size_t)b * SEQ + token;
    const unsigned sel = msk[tk], uni = msk[64];
    const bf16_t* H = (const bf16_t*)(ws + OFF_H);
    bf16x8 qf[8]; load_q<128>(H + row * LDH + C_NQ + head * 128, hi, qf);
    KeySrc ks; ks.k0 = H + (size_t)b * SEQ * LDH + C_NKS; ks.kstride = LDH; ks.kr = ks.k0; ks.krstride = 0; ks.v0 = H + (size_t)b * SEQ * LDH + C_NVS; ks.vstride = LDH;
    f32x16 o[4]; zero_o(o); float m = -1e30f, l = 0.f;
    attn_run<128, true>(lds, ks, 0, tb + 1, uni, qf, token, 0x7fffffffu, sel, 0.08838834764831845f * LOG2E, o, m, l, tid);
    const float* gp = (const float*)(ws + OFF_GATES) + row * 18 + head * 3;
    const float g0 = gld<float>(gp), g1 = gld<float>(gp + 1) / l, g2 = gld<float>(gp + 2);
    const bf16_t* pc = (const bf16_t*)(ws + OFF_PC) + row * 768 + head * 128 + 4 * hi; const bf16_t* pw = (const bf16_t*)(ws + OFF_PW) + row * 768 + head * 128 + 4 * hi;
    bf16_t* mx = (bf16_t*)(ws + OFF_MIX) + row * DM + 1280 + head * 128 + 4 * hi;
#pragma unroll
    for (int dt = 0; dt < 4; ++dt)
#pragma unroll
        for (int q = 0; q < 4; ++q) { const u32x2 a = gld<u32x2>(pc + 32 * dt + 8 * q), b = gld<u32x2>(pw + 32 * dt + 8 * q);
            store_bf4(mx + 32 * dt + 8 * q, g0 * bf_lo(a.x) + g1 * o[dt][4 * q] + g2 * bf_lo(b.x), g0 * bf_hi(a.x) + g1 * o[dt][4 * q + 1] + g2 * bf_hi(b.x),
                                            g0 * bf_lo(a.y) + g1 * o[dt][4 * q + 2] + g2 * bf_lo(b.y), g0 * bf_hi(a.y) + g1 * o[dt][4 * q + 3] + g2 * bf_hi(b.y)); }
}
__device__ __forceinline__ void item_dilmix(const Params& p, int it, LAS char* lds) {
    char* ws = ows(p.ws); const int tid = otid();
    const bf16_t* OD = (const bf16_t*)(ws + OFF_ODIL); const float* LD = (const float*)(ws + OFF_LDIL); bf16_t* MIX = (bf16_t*)(ws + OFF_MIX);
    for (int e = tid; e < 64 * 96; e += 256) {
        const size_t row = (size_t)it * 64 + e / 96; const int cc = (e % 96) * 8, h = cc >> 7;
        const float L0 = gld<float>(LD + row * 6 + h), L1 = gld<float>(LD + ((size_t)NT + row) * 6 + h), L2 = gld<float>(LD + ((size_t)2 * NT + row) * 6 + h);
        const float M = fmaxf(L0, fmaxf(L1, L2)); float w0 = __builtin_amdgcn_exp2f(L0 - M), w1 = __builtin_amdgcn_exp2f(L1 - M), w2 = __builtin_amdgcn_exp2f(L2 - M);
        const float inv = 1.f / (w0 + w1 + w2); w0 *= inv; w1 *= inv; w2 *= inv;
        const u32x4 a = gld<u32x4>(OD + row * 768 + cc), bq = gld<u32x4>(OD + ((size_t)NT + row) * 768 + cc), cq = gld<u32x4>(OD + ((size_t)2 * NT + row) * 768 + cc); u32x4 r;
#pragma unroll
        for (int j = 0; j < 4; ++j) r[j] = cvtpk(w0 * bf_lo(a[j]) + w1 * bf_lo(bq[j]) + w2 * bf_lo(cq[j]), w0 * bf_hi(a[j]) + w1 * bf_hi(bq[j]) + w2 * bf_hi(cq[j]));
        gst<u32x4>(MIX + row * DM + 512 + cc, r);
    }
}
__device__ __forceinline__ void phase_attn_d(const Params& p, int ctr_idx, LAS char* lds) {
    unsigned* ctr = (unsigned*)(ows(p.ws) + OFF_CTR) + ctr_idx;
    constexpr int NWIN = 384, NDIL = NB * 6 * 48, NCMP = 384;
    for (;;) { const int it = claim(ctr, lds); if (it >= NWIN + NDIL + NCMP) break;
        if (it < NWIN) item_win(p, it, lds); else if (it < NWIN + NDIL) item_dil(p, it - NWIN, lds); else item_cmp(p, it - NWIN - NDIL, lds); }
}
__device__ __forceinline__ void phase_attn_e(const Params& p, int ctr_idx, LAS char* lds) {
    unsigned* ctr = (unsigned*)(ows(p.ws) + OFF_CTR) + ctr_idx;
    constexpr int NMLA = 256, NSLC = 384, NMIX = NT / 64;
    for (;;) { const int it = claim(ctr, lds); if (it >= NMLA + NSLC + NMIX) break;
        if (it < NMLA) item_mla(p, it, lds); else if (it < NMLA + NSLC) item_slc(p, it - NMLA, lds); else item_dilmix(p, it - NMLA - NSLC, lds); }
}
__device__ __forceinline__ void phase_combine(const Params& p) {
    char* ws = ows(p.ws);
    const bf16_t* OD = (const bf16_t*)(ws + OFF_ODIL); const float* LD = (const float*)(ws + OFF_LDIL);
    const bf16_t* PC = (const bf16_t*)(ws + OFF_PC); const bf16_t* PS = (const bf16_t*)(ws + OFF_PS); const bf16_t* PW = (const bf16_t*)(ws + OFF_PW);
    const float* G = (const float*)(ws + OFF_GATES); bf16_t* MIX = (bf16_t*)(ws + OFF_MIX);
    for (size_t e = (size_t)oblk() * 256 + otid(); e < (size_t)NT * 192; e += (size_t)gridDim.x * 256) {
        const size_t row = e / 192; const int c = (int)(e % 192), isn = c >= 96, cc = (isn ? c - 96 : c) * 8, h = cc >> 7;
        float w0, w1, w2; const bf16_t *s0, *s1, *s2;
        if (!isn) { const float L0 = gld<float>(LD + row * 6 + h), L1 = gld<float>(LD + ((size_t)NT + row) * 6 + h), L2 = gld<float>(LD + ((size_t)2 * NT + row) * 6 + h);
            const float M = fmaxf(L0, fmaxf(L1, L2)); w0 = __builtin_amdgcn_exp2f(L0 - M); w1 = __builtin_amdgcn_exp2f(L1 - M); w2 = __builtin_amdgcn_exp2f(L2 - M);
            const float inv = 1.f / (w0 + w1 + w2); w0 *= inv; w1 *= inv; w2 *= inv;
            s0 = OD + row * 768 + cc; s1 = OD + ((size_t)NT + row) * 768 + cc; s2 = OD + ((size_t)2 * NT + row) * 768 + cc;
        } else { w0 = gld<float>(G + row * 18 + h * 3); w1 = gld<float>(G + row * 18 + h * 3 + 1); w2 = gld<float>(G + row * 18 + h * 3 + 2); s0 = PC + row * 768 + cc; s1 = PS + row * 768 + cc; s2 = PW + row * 768 + cc; }
        const u32x4 a = gld<u32x4>(s0), bq = gld<u32x4>(s1), cq = gld<u32x4>(s2); u32x4 r;
#pragma unroll
        for (int j = 0; j < 4; ++j) r[j] = cvtpk(w0 * bf_lo(a[j]) + w1 * bf_lo(bq[j]) + w2 * bf_lo(cq[j]), w0 * bf_hi(a[j]) + w1 * bf_hi(bq[j]) + w2 * bf_hi(cq[j]));
        gst<u32x4>(MIX + row * DM + 512 + (isn ? 768 : 0) + cc, r);
    }
}

__device__ __forceinline__ void phase_ln(const Params& p, int layer, int mode) {
    char* ws = ows(p.ws); const int tid = otid(), lane = tid & 63, wv = (oblk() * 256 + tid) >> 6, nw = gridDim.x * 4;
    const float* g = p.in[mode ? I_LN2G : I_LN1G] + layer * DM; const float* bb = p.in[mode ? I_LN2B : I_LN1B] + layer * DM;
    for (int row = wv; row < NT; row += nw) {
        f32x4 v[8];
        if (mode == 0) { const float* y = (const float*)(ws + OFF_YB) + (size_t)row * DM;
#pragma unroll
            for (int i = 0; i < 8; ++i) v[i] = gld<f32x4>(y + (i * 64 + lane) * 4);
        } else { const float* x1 = (const float*)(ws + OFF_X1) + (size_t)row * DM; const bf16_t* y0 = (const bf16_t*)(ws + OFF_Y) + (size_t)(2 * row) * DM; const bf16_t* y1 = y0 + DM;
#pragma unroll
            for (int i = 0; i < 8; ++i) { const int c = (i * 64 + lane) * 4; const f32x4 xv = gld<f32x4>(x1 + c); const u32x2 a = gld<u32x2>(y0 + c), b2 = gld<u32x2>(y1 + c);
                v[i][0] = DN_ALPHA * xv[0] + bf_lo(a.x) + bf_lo(b2.x); v[i][1] = DN_ALPHA * xv[1] + bf_hi(a.x) + bf_hi(b2.x);
                v[i][2] = DN_ALPHA * xv[2] + bf_lo(a.y) + bf_lo(b2.y); v[i][3] = DN_ALPHA * xv[3] + bf_hi(a.y) + bf_hi(b2.y); }
        }
        float s = 0.f;
#pragma unroll
        for (int i = 0; i < 8; ++i) s += (v[i][0] + v[i][1]) + (v[i][2] + v[i][3]);
        const float mu = wave_sum(s) * (1.f / DM);
        float q = 0.f;
#pragma unroll
        for (int i = 0; i < 8; ++i) { const f32x4 d = v[i] - mu; q += (d[0] * d[0] + d[1] * d[1]) + (d[2] * d[2] + d[3] * d[3]); }
        const float rstd = 1.f / sqrtf(wave_sum(q) * (1.f / DM) + 1e-5f);
        float* of = mode == 0 ? (float*)(ws + OFF_X1) + (size_t)row * DM : (layer == DEPTH - 1 ? p.out + (size_t)row * DM : (float*)(ws + OFF_XA) + (size_t)row * DM);
        bf16_t* ob = mode == 0 ? (bf16_t*)(ws + OFF_X1B) + (size_t)row * DM : (bf16_t*)(ws + OFF_XB) + (size_t)row * DM;
#pragma unroll
        for (int i = 0; i < 8; ++i) { const int c = (i * 64 + lane) * 4; const f32x4 gv = gld<f32x4>(g + c), bv = gld<f32x4>(bb + c);
            f32x4 o = (v[i] - mu) * rstd * gv + bv; gst<f32x4>(of + c, o);
            if (mode == 0 || layer < DEPTH - 1) store_bf4(ob + c, o[0], o[1], o[2], o[3]); }
    }
}
__device__ __forceinline__ void phase_router(const Params& p, int layer, LAS char* lds) {
    char* ws = ows(p.ws); const int tid = otid(), lane = tid & 63, w = tid >> 6, l32 = lane & 31, hi = lane >> 5;
    const float* X1 = (const float*)(ws + OFF_X1); const float* We = p.in[I_WEXP] + (size_t)layer * DM * 32; const float* Wg = p.in[I_WGRP] + (size_t)layer * DM * 4;
    LAS float* red = (LAS float*)lds;
    unsigned* ecnt = (unsigned*)(ws + OFF_ECNT); int* list = (int*)(ws + OFF_LIST); float* gw = (float*)(ws + OFF_GW);
    for (int it = oblk(); it < NT / 32; it += gridDim.x) {
        const int t0 = it * 32;
        f32x16 ae, ag;
#pragma unroll
        for (int r = 0; r < 16; ++r) { ae[r] = 0.f; ag[r] = 0.f; }
        const float* xr = X1 + (size_t)(t0 + l32) * DM + w * 512 + 4 * hi;
        const float* wer = We + (size_t)(w * 512 + 4 * hi) * 32 + l32;
        const float* wgr = Wg + (size_t)(w * 512 + 4 * hi) * 4 + (l32 & 3);
        f32x4 xa[4], xb[4]; float wea[4][4], web[4][4], wga[4][4], wgb[4][4];
#define RT_LOAD(X, WE, WG, KC) do { _Pragma("unroll") for (int i_ = 0; i_ < 4; ++i_) { X[i_] = gld<f32x4>(xr + (KC) + 8 * i_); \
            _Pragma("unroll") for (int j_ = 0; j_ < 4; ++j_) { WE[i_][j_] = gld<float>(wer + (size_t)((KC) + 8 * i_ + j_) * 32); WG[i_][j_] = l32 < 4 ? gld<float>(wgr + (size_t)((KC) + 8 * i_ + j_) * 4) : 0.f; } } } while (0)
#define RT_MMA(X, WE, WG) do { _Pragma("unroll") for (int i_ = 0; i_ < 4; ++i_) _Pragma("unroll") for (int j_ = 0; j_ < 4; ++j_) { \
            ae = __builtin_amdgcn_mfma_f32_32x32x2f32(X[i_][j_], WE[i_][j_], ae, 0, 0, 0); ag = __builtin_amdgcn_mfma_f32_32x32x2f32(X[i_][j_], WG[i_][j_], ag, 0, 0, 0); } } while (0)
        RT_LOAD(xa, wea, wga, 0);
        for (int kc = 0; kc < 512; kc += 64) {
            RT_LOAD(xb, web, wgb, kc + 32);
            RT_MMA(xa, wea, wga);
            if (kc + 64 < 512) RT_LOAD(xa, wea, wga, kc + 64);
            RT_MMA(xb, web, wgb);
        }
#undef RT_LOAD
#undef RT_MMA
        __syncthreads();
#pragma unroll
        for (int r = 0; r < 16; ++r) { const int tk = crow(r, hi); red[(w * 32 + tk) * 36 + l32] = ae[r]; if (l32 < 4) red[(w * 32 + tk) * 36 + 32 + l32] = ag[r]; }
        __syncthreads();
        if (tid < 32) {
            const int tk = tid;
            float lg[4];
#pragma unroll
            for (int j = 0; j < 4; ++j) lg[j] = (red[(0 * 32 + tk) * 36 + 32 + j] + red[(1 * 32 + tk) * 36 + 32 + j]) + (red[(2 * 32 + tk) * 36 + 32 + j] + red[(3 * 32 + tk) * 36 + 32 + j]);
            int gi = 0; float gm = lg[0];
#pragma unroll
            for (int j = 1; j < 4; ++j) if (lg[j] > gm) { gm = lg[j]; gi = j; }
            float den = 0.f;
#pragma unroll
            for (int j = 0; j < 4; ++j) den += __expf(lg[j] - gm);
            const float pg = 1.f / den;
            float b0 = -__builtin_inff(), b1 = -__builtin_inff(); int i0 = 0, i1 = 0;
#pragma unroll
            for (int j = 0; j < 8; ++j) { const int n = gi * 8 + j;
                const float v = (red[(0 * 32 + tk) * 36 + n] + red[(1 * 32 + tk) * 36 + n]) + (red[(2 * 32 + tk) * 36 + n] + red[(3 * 32 + tk) * 36 + n]);
                if (v > b0) { b1 = b0; i1 = i0; b0 = v; i0 = j; } else if (v > b1) { b1 = v; i1 = j; } }
            const float w1 = __expf(b1 - b0), g0 = pg / (1.f + w1), g1 = pg * w1 / (1.f + w1);
            const int tok = t0 + tk, e0 = gi * 8 + i0, e1 = gi * 8 + i1;
            const unsigned p0 = atomicAdd(&ecnt[e0], 1u), p1 = atomicAdd(&ecnt[e1], 1u);
            list[(size_t)e0 * NT + p0] = 2 * tok; list[(size_t)e1 * NT + p1] = 2 * tok + 1;
            gw[2 * tok] = g0; gw[2 * tok + 1] = g1;
        }
        __syncthreads();
    }
}
__device__ __forceinline__ int moe_table(const Params& p, LAS char* lds) {
    LAS int* off = (LAS int*)(lds + LDS_CTL + 128); LAS int* toff = off + 33;
    __syncthreads();
    if (otid() == 0) { const unsigned* ecnt = (const unsigned*)(ows(p.ws) + OFF_ECNT); int a = 0, t = 0;
        for (int e = 0; e < NEXP; ++e) { off[e] = a; toff[e] = t; const int c = (int)ecnt[e]; a += c; t += (c + 127) >> 7; } off[NEXP] = a; toff[NEXP] = t; }
    __syncthreads();
    return toff[NEXP];
}
__device__ __forceinline__ void phase_moe1(const Params& p, LAS char* lds) {
    char* ws = ows(p.ws); const int tid = otid(), sr = tid >> 3, sc = (tid & 7) * 8;
    const int ntile = moe_table(p, lds); const LAS int* off = (const LAS int*)(lds + LDS_CTL + 128); const LAS int* toff = off + 33;
    const unsigned* ecnt = (const unsigned*)(ws + OFF_ECNT); const int* list = (const int*)(ws + OFF_LIST);
    const bf16_t* X1B = (const bf16_t*)(ws + OFF_X1B);
    for (int u = oblk(); u < ntile * 4; u += gridDim.x) {
        int e = 0; for (int k = 1; k < NEXP; ++k) if (u >= toff[k] * 4) e = k;
        const int mte = toff[e + 1] - toff[e], v = u - toff[e] * 4, nt = v / mte, mt = v - nt * mte;
        const int cnt = (int)ecnt[e], nvalid = cnt - mt * 128 < 128 ? cnt - mt * 128 : 128;
        const int* le = list + (size_t)e * NT + mt * 128;
        unsigned ao[4];
#pragma unroll
        for (int i = 0; i < 4; ++i) { const int r = sr + 32 * i; ao[i] = (unsigned)((gld<int>(le + (r < nvalid ? r : 0)) >> 1) * DM + sc); }
        EpiMoe1 ep{(bf16_t*)(ws + OFF_HM), off[e] + mt * 128, nvalid, nt * 256};
        gemm_unit(lds, X1B, ao, 128, (const bf16_t*)(ws + OFF_WGU_T) + ((size_t)e * 1024 + nt * 256) * DM, (unsigned)(sr * DM + sc), (size_t)32 * DM, DM / 64, ep);
    }
}
__device__ __forceinline__ void phase_moe2(const Params& p, LAS char* lds) {
    char* ws = ows(p.ws); const int tid = otid(), sr = tid >> 3, sc = (tid & 7) * 8;
    const int ntile = moe_table(p, lds); const LAS int* off = (const LAS int*)(lds + LDS_CTL + 128); const LAS int* toff = off + 33;
    const unsigned* ecnt = (const unsigned*)(ws + OFF_ECNT); const int* list = (const int*)(ws + OFF_LIST);
    const bf16_t* HM = (const bf16_t*)(ws + OFF_HM);
    for (int u = oblk(); u < ntile * 8; u += gridDim.x) {
        int e = 0; for (int k = 1; k < NEXP; ++k) if (u >= toff[k] * 8) e = k;
        const int mte = toff[e + 1] - toff[e], v = u - toff[e] * 8, nt = v / mte, mt = v - nt * mte;
        const int cnt = (int)ecnt[e], nvalid = cnt - mt * 128 < 128 ? cnt - mt * 128 : 128;
        const unsigned ao[4] = AO4(EFF);
        EpiMoe2 ep{(bf16_t*)(ws + OFF_Y), list + (size_t)e * NT + mt * 128, (const float*)(ws + OFF_GW), nvalid, nt * 256};
        gemm_unit(lds, HM + (size_t)(off[e] + mt * 128) * EFF, ao, 128, (const bf16_t*)(ws + OFF_WD_T) + ((size_t)e * DM + nt * 256) * EFF, (unsigned)(sr * EFF + sc), (size_t)32 * EFF, EFF / 64, ep);
    }
}

__device__ __forceinline__ Params load_params() {
    Params q;
#if defined(__HIP_DEVICE_COMPILE__)
    const CAS Params* pp = (const CAS Params*)__builtin_amdgcn_kernarg_segment_ptr(); asm volatile("" : "+s"(pp));
#pragma unroll
    for (int i = 0; i < 22; ++i) q.in[i] = pp->in[i];
    q.out = pp->out; q.ws = pp->ws;
#endif
    return q;
}
constexpr int REP_PREP = 1, REP_GEMM = 1, REP_ATTN = 1;
__global__ void __launch_bounds__(256, 2) fwd_kernel(Params p) {
    extern __shared__ __attribute__((aligned(16))) char lds_raw[];
    LAS char* lds = (LAS char*)lds_raw;
    if (threadIdx.x == 0) { *(LAS u32x4*)(lds + LDS_CTL) = (u32x4){0u, 0u, 0u, 0u}; }
    __syncthreads();
    XcdBarrier bar = xcd_barrier_post((unsigned*)(p.ws + OFF_BAR), (volatile LAS unsigned*)(lds + LDS_CTL));
    for (int layer = 0; layer < DEPTH; ++layer) {
        for (int r = 0; r < REP_PREP; ++r) { phase_prep(load_params(), layer, lds);              xcd_barrier(bar); }
        for (int r = 0; r < REP_GEMM; ++r) { phase_win(load_params(), layer, lds);               xcd_barrier(bar); }
        phase_up(load_params(), layer, lds);                xcd_barrier(bar);
        phase_cmp2(load_params(), layer, lds);              xcd_barrier(bar);
        for (int r = 0; r < REP_ATTN; ++r) { phase_attn_d(load_params(), 64 * (2 * layer) + 16 * r, lds);       xcd_barrier(bar); }
        for (int r = 0; r < REP_ATTN; ++r) { phase_attn_e(load_params(), 64 * (2 * layer + 1) + 16 * r, lds);   xcd_barrier(bar); }
        for (int r = 0; r < REP_GEMM; ++r) { phase_out(load_params(), layer, lds);               xcd_barrier(bar); }
        phase_ln(load_params(), layer, 0);                  xcd_barrier(bar);
        phase_router(load_params(), layer, lds);            xcd_barrier(bar);
        for (int r = 0; r < REP_GEMM; ++r) { phase_moe1(load_params(), lds);                     xcd_barrier(bar); }
        for (int r = 0; r < REP_GEMM; ++r) { phase_moe2(load_params(), lds);                     xcd_barrier(bar); }
        phase_ln(load_params(), layer, 1);                  xcd_barrier(bar);
    }
}

extern "C" void kernel_launch(void* const* d_in, const int* in_sizes, int n_in, void* d_out, int out_size, void* d_ws, size_t ws_size, hipStream_t stream) {
    (void)in_sizes; (void)out_size;
    static int grid = 0;
    if (!grid) {
        int dev = 0, cus = 0, per_cu = 0;
        (void)hipGetDevice(&dev);
        (void)hipDeviceGetAttribute(&cus, hipDeviceAttributeMultiprocessorCount, dev);
        (void)hipFuncSetAttribute((const void*)fwd_kernel, hipFuncAttributeMaxDynamicSharedMemorySize, LDS_BYTES);
        (void)hipOccupancyMaxActiveBlocksPerMultiprocessor(&per_cu, (const void*)fwd_kernel, 256, LDS_BYTES);
        if (cus <= 0) cus = 256;
        if (per_cu < 1) per_cu = 1;
        grid = cus * (per_cu < 2 ? per_cu : 2);
    }
    if (n_in < 22 || ws_size < WS_TOTAL) { fprintf(stderr, "kernel_launch: bad arguments (n_in %d, ws %zu < %zu)\n", n_in, ws_size, (size_t)WS_TOTAL); return; }
    Params p;
    for (int i = 0; i < 22; ++i) p.in[i] = (const float*)d_in[i];
    p.out = (float*)d_out; p.ws = (char*)d_ws;
    (void)hipMemsetAsync(d_ws, 0, ZERO_BYTES, stream);
    fwd_kernel<<<dim3(grid), dim3(256), LDS_BYTES, stream>>>(p);
}
```

```cpp
#include <hip/hip_runtime.h>
#include <stdint.h>
#include <stdio.h>

#define LAS __attribute__((address_space(3)))
#define GAS __attribute__((address_space(1)))
#define CAS __attribute__((address_space(4)))
typedef unsigned short bf16_t;
typedef short bf16x8 __attribute__((ext_vector_type(8)));
typedef short s16x4 __attribute__((ext_vector_type(4)));
typedef float f32x16 __attribute__((ext_vector_type(16)));
typedef float f32x4 __attribute__((ext_vector_type(4)));
typedef float f32x2 __attribute__((ext_vector_type(2)));
typedef unsigned u32x4 __attribute__((ext_vector_type(4)));
typedef unsigned u32x2 __attribute__((ext_vector_type(2)));

constexpr int NB = 4, SEQ = 2048, NT = NB * SEQ, DM = 2048, DEPTH = 2;
constexpr int INC = 4434, LDH = 4608;
constexpr int C_QLAT = 0, C_KVLAT = 384, C_KROPE = 512, C_DQ = 576, C_DK = 1344, C_DV = 2112, C_NQ = 2880, C_NKC = 3648, C_NVC = 3776,
              C_NKS = 3904, C_NVS = 4032, C_NKW = 4160, C_NVW = 4288, C_GATE = 4416;
constexpr int NEXP = 32, EFF = 512;
constexpr float DN_ALPHA = 1.41421356237309515f;
constexpr float LOG2E = 1.4426950408889634f;

constexpr size_t al256(size_t x) { return (x + 255) & ~(size_t)255; }
constexpr size_t OFF_BAR = 0;
constexpr size_t OFF_CTR = 16384;
constexpr size_t ZERO_BYTES = 20480;
constexpr size_t OFF_ECNT = ZERO_BYTES;
constexpr size_t OFF_CS16 = OFF_ECNT + 256;
constexpr size_t OFF_CS32 = OFF_CS16 + (size_t)SEQ * 16 * 8;
constexpr size_t OFF_WIN_T = OFF_CS32 + (size_t)SEQ * 32 * 8;
constexpr size_t OFF_WQ_T = OFF_WIN_T + (size_t)LDH * DM * 2;
constexpr size_t OFF_WKV_T = OFF_WQ_T + (size_t)768 * 384 * 2;
constexpr size_t OFF_W1K_T = OFF_WKV_T + (size_t)1024 * 128 * 2;
constexpr size_t OFF_W1V_T = OFF_W1K_T + (size_t)256 * 4096 * 2;
constexpr size_t OFF_W2K_T = OFF_W1V_T + (size_t)256 * 4096 * 2;
constexpr size_t OFF_W2V_T = OFF_W2K_T + (size_t)256 * 256 * 2;
constexpr size_t OFF_WOUT_T = OFF_W2V_T + (size_t)256 * 256 * 2;
constexpr size_t OFF_WGU_T = OFF_WOUT_T + (size_t)DM * DM * 2;
constexpr size_t OFF_WD_T = OFF_WGU_T + (size_t)NEXP * 1024 * DM * 2;
constexpr size_t OFF_B1P = OFF_WD_T + (size_t)NEXP * DM * EFF * 2;
constexpr size_t OFF_XB = OFF_B1P + (size_t)2 * 16 * 256 * 4;
constexpr size_t OFF_H = OFF_XB + (size_t)NT * DM * 2;
constexpr size_t OFF_GATES = OFF_H + (size_t)NT * LDH * 2;
constexpr size_t OFF_QM = OFF_GATES + al256((size_t)NT * 18 * 4);
constexpr size_t OFF_KN = OFF_QM + (size_t)NT * 768 * 2;
constexpr size_t OFF_VM = OFF_KN + (size_t)NT * 512 * 2;
static_assert(OFF_VM == OFF_KN + (size_t)NT * 512 * 2, "Vm must follow Kn");
constexpr size_t OFF_HC = OFF_VM + (size_t)NT * 512 * 2;
constexpr size_t OFF_HCP = OFF_HC + (size_t)2 * 512 * 256 * 2;
constexpr size_t OFF_KC = OFF_HCP + (size_t)8 * 2 * 512 * 256 * 4;
constexpr size_t OFF_VC = OFF_KC + (size_t)512 * 128 * 2;
constexpr size_t OFF_IMP = OFF_VC + (size_t)512 * 128 * 2;
constexpr size_t OFF_ODIL = OFF_IMP + (size_t)NT * 32 * 4;
constexpr size_t OFF_LDIL = OFF_ODIL + (size_t)3 * NT * 768 * 2;
constexpr size_t OFF_PC = OFF_LDIL + (size_t)3 * NT * 6 * 4;
constexpr size_t OFF_PS = OFF_PC + (size_t)NT * 768 * 2;
constexpr size_t OFF_PW = OFF_PS + (size_t)NT * 768 * 2;
constexpr size_t OFF_MIX = OFF_PW + (size_t)NT * 768 * 2;
constexpr size_t OFF_YB = OFF_MIX + (size_t)NT * DM * 2;
constexpr size_t OFF_XA = OFF_YB + (size_t)NT * DM * 4;
constexpr size_t OFF_X1 = OFF_XA + (size_t)NT * DM * 4;
constexpr size_t OFF_X1B = OFF_X1 + (size_t)NT * DM * 4;
constexpr size_t OFF_HM = OFF_X1B + (size_t)NT * DM * 2;
constexpr size_t OFF_Y = OFF_HM + (size_t)(2 * NT + 128) * EFF * 2;
constexpr size_t OFF_LIST = OFF_Y + (size_t)2 * NT * DM * 2;
constexpr size_t OFF_GW = OFF_LIST + (size_t)NEXP * NT * 4;
constexpr size_t WS_TOTAL = OFF_GW + (size_t)2 * NT * 4;

struct Params { const float* in[22]; float* out; char* ws; };
enum { I_X = 0, I_WIN, I_QLN, I_WQUP, I_KVLN, I_WKVUP, I_PEK, I_W1K, I_W2K, I_PEV, I_W1V, I_W2V, I_WOUT, I_LN1G, I_LN1B, I_WGRP, I_WEXP, I_WGATE, I_WUP, I_WDOWN, I_LN2G, I_LN2B };

#define XB_TMO      128
#define XB_XCNT(j)  (256  + 64 * (j))
#define XB_XSUB(j)  (1280 + 64 * (j))
#define XB_XGEN(j)  (2304 + 64 * (j))
#define XB_TOP      3328
#define XB_TOPGEN   3392
#define XCD_BAR_WORDS 3456
#define XB_SPIN_CAP (1u << 18)

__device__ __forceinline__ unsigned xb_ld(unsigned* p)              { return __hip_atomic_load(p, __ATOMIC_RELAXED, __HIP_MEMORY_SCOPE_AGENT); }
__device__ __forceinline__ unsigned xb_add(unsigned* p, unsigned v) { return __hip_atomic_fetch_add(p, v, __ATOMIC_RELAXED, __HIP_MEMORY_SCOPE_AGENT); }
__device__ __forceinline__ unsigned xb_xcc_id() { return (unsigned)__builtin_amdgcn_s_getreg((3 << 11) | 20) & 0xFu; }
#define XB_SPIN(cond, bar) do { unsigned _sp = 0; while (cond) { __builtin_amdgcn_s_sleep(1); \
    if ((++_sp & 255u) == 0u) { if (xb_ld(&(bar)[XB_TMO])) break; if (_sp > XB_SPIN_CAP) { atomicAdd(&(bar)[XB_TMO], 1u); break; } } } } while (0)

struct XcdBarrier { unsigned* bar; unsigned x; volatile LAS unsigned* st; };

__device__ __forceinline__ XcdBarrier xcd_barrier_post(unsigned* bar, volatile LAS unsigned* st) {
    XcdBarrier b; b.bar = bar; b.x = xb_xcc_id(); b.st = st;
    if (threadIdx.x == 0) (void)xb_add(&bar[XB_XCNT(b.x)], 1u);
    return b;
}
__device__ __forceinline__ void xcd_barrier_complete(unsigned* bar, unsigned x, unsigned& nloc, unsigned& nx) {
    const unsigned G = gridDim.x * gridDim.y * gridDim.z;
    unsigned sum, cnt, mine, sp = 0u;
    for (;;) {
        sum = 0u; cnt = 0u; mine = 0u;
#pragma unroll
        for (unsigned j = 0; j < 16; ++j) { const unsigned c = xb_ld(&bar[XB_XCNT(j)]); sum += c; cnt += (c > 0u) ? 1u : 0u; mine = (j == x) ? c : mine; }
        if (sum == G) break;
        __builtin_amdgcn_s_sleep(1);
        if ((++sp & 255u) == 0u) { if (xb_ld(&bar[XB_TMO])) break; if (sp > XB_SPIN_CAP) { atomicAdd(&bar[XB_TMO], 1u); break; } }
    }
    nloc = mine > 0u ? mine : 1u; nx = cnt > 0u ? cnt : 1u;
}
__device__ __forceinline__ void xcd_barrier(const XcdBarrier& b) {
    asm volatile("s_waitcnt vmcnt(0)" ::: "memory");
    __syncthreads();
    if (threadIdx.x == 0) {
        unsigned* bar = b.bar;
        __builtin_amdgcn_s_waitcnt(0);
        unsigned nloc = b.st[0], nx = b.st[1];
        if (nloc == 0u) { xcd_barrier_complete(bar, b.x, nloc, nx); b.st[0] = nloc; b.st[1] = nx; }
        const unsigned old = xb_add(&bar[XB_XSUB(b.x)], 1u);
        const unsigned gen = old / nloc;
        if (old + 1u == (gen + 1u) * nloc) {
            __builtin_amdgcn_fence(__ATOMIC_RELEASE, "agent");
            asm volatile("s_waitcnt vmcnt(0)" ::: "memory");
            const unsigned og = xb_add(&bar[XB_TOP], 1u);
            const unsigned tg = og / nx;
            if (og + 1u == (tg + 1u) * nx) xb_add(&bar[XB_TOPGEN], 1u);
            else XB_SPIN(xb_ld(&bar[XB_TOPGEN]) == tg, bar);
            __builtin_amdgcn_fence(__ATOMIC_ACQUIRE, "agent");
            xb_add(&bar[XB_XGEN(b.x)], 1u);
            asm volatile("s_waitcnt vmcnt(0)" ::: "memory");
        } else {
            XB_SPIN(xb_ld(&bar[XB_XGEN(b.x)]) == gen, bar);
            __builtin_amdgcn_fence(__ATOMIC_ACQUIRE, "agent");
            asm volatile("s_waitcnt vmcnt(0)" ::: "memory");
        }
    }
    __syncthreads();
}

template <class T> __device__ __forceinline__ T gld(const void* p) { return *(const GAS T*)p; }
template <class T> __device__ __forceinline__ void gst(void* p, const T& v) { *(GAS T*)p = v; }
__device__ __forceinline__ __amdgpu_buffer_rsrc_t mk_rsrc(const void* p) {
    const unsigned long long v = (unsigned long long)p;
    const unsigned lo = __builtin_amdgcn_readfirstlane((unsigned)v), hi = __builtin_amdgcn_readfirstlane((unsigned)(v >> 32));
    return __builtin_amdgcn_make_buffer_rsrc((void*)(((unsigned long long)hi << 32) | lo), 0, 0xFFFFFFF0u, 0x00020000);
}
__device__ __forceinline__ bf16x8 bld8(__amdgpu_buffer_rsrc_t r, unsigned voff, int soff) { const u32x4 v = __builtin_amdgcn_raw_buffer_load_b128(r, (int)voff, soff, 0); return __builtin_bit_cast(bf16x8, v); }
__device__ __forceinline__ unsigned cvtpk(float lo, float hi) { unsigned r; asm volatile("v_cvt_pk_bf16_f32 %0, %1, %2" : "=v"(r) : "v"(lo), "v"(hi)); return r; }
__device__ __forceinline__ float bf_lo(unsigned u) { return __uint_as_float(u << 16); }
__device__ __forceinline__ float bf_hi(unsigned u) { return __uint_as_float(u & 0xffff0000u); }
__device__ __forceinline__ float bf2f(bf16_t b) { return __uint_as_float((unsigned)b << 16); }
__device__ __forceinline__ float wave_sum(float v) {
#pragma unroll
    for (int o = 32; o >= 1; o >>= 1) v += __shfl_xor(v, o);
    return v;
}
__device__ __forceinline__ int otid() { int t = threadIdx.x; asm volatile("" : "+v"(t)); return t; }
__device__ __forceinline__ int oblk() { int b = blockIdx.x; asm volatile("" : "+s"(b)); return b; }
__device__ __forceinline__ char* ows(const char* w) { char* q = const_cast<char*>(w); asm volatile("" : "+s"(q)); return q; }
__device__ __forceinline__ int crow(int r, int hi) { return (r & 3) + 8 * (r >> 2) + 4 * hi; }

constexpr int LDS_BYTES = 65536;
constexpr int LDS_CTL = 65024;

constexpr int GS = 72;
constexpr int G_BOFF = 128 * GS * 2;
constexpr int G_ROWSS = 384 * GS * 2;

template <class EPI>
__device__ __forceinline__ void gemm_unit(LAS char* lds, const bf16_t* abase, const unsigned (&aoff)[4], int ajump, const bf16_t* bbase, unsigned boff, size_t ldb32, int nkt, const EPI& epi) {
    const int tid = otid(), lane = tid & 63, w = tid >> 6, l32 = lane & 31, hi = lane >> 5;
    const int wm = w >> 1, wn = w & 1;
    const int sr = tid >> 3, sc = (tid & 7) * 8;
    const int st_off = (sr * GS + sc) * 2;
    const int a_rd = ((wm * 64 + l32) * GS + hi * 8) * 2;
    const int b_rd = G_BOFF + ((wn * 128 + l32) * GS + hi * 8) * 2;
    f32x16 acc[2][4];
#pragma unroll
    for (int i = 0; i < 2; ++i)
#pragma unroll
        for (int j = 0; j < 4; ++j)
#pragma unroll
            for (int r = 0; r < 16; ++r) acc[i][j][r] = 0.f;
    bf16x8 ra[4], rb[8];
    const __amdgpu_buffer_rsrc_t rsa = mk_rsrc(abase), rsb = mk_rsrc(bbase);
    const int lb2 = (int)(ldb32 * 2);
#pragma unroll
    for (int i = 0; i < 4; ++i) ra[i] = bld8(rsa, 2u * aoff[i], 0);
#pragma unroll
    for (int i = 0; i < 8; ++i) rb[i] = bld8(rsb, 2u * boff, i * lb2);
    for (int kt = 0; kt < nkt; ++kt) {
#pragma unroll
        for (int i = 0; i < 4; ++i) *(LAS bf16x8*)(lds + st_off + i * 32 * GS * 2) = ra[i];
#pragma unroll
        for (int i = 0; i < 8; ++i) *(LAS bf16x8*)(lds + G_BOFF + st_off + i * 32 * GS * 2) = rb[i];
        __syncthreads();
        if (kt + 1 < nkt) {
            const int k = (kt + 1) * 64;
            const int ao = (k >> 7) * ajump + (k & 127);
#pragma unroll
            for (int i = 0; i < 4; ++i) ra[i] = bld8(rsa, 2u * aoff[i], 2 * ao);
#pragma unroll
            for (int i = 0; i < 8; ++i) rb[i] = bld8(rsb, 2u * boff, i * lb2 + 2 * k);
        }
#pragma unroll
        for (int ks = 0; ks < 4; ++ks) {
            bf16x8 af[2], bfr[4];
#pragma unroll
            for (int i = 0; i < 2; ++i) af[i] = *(const LAS bf16x8*)(lds + a_rd + i * 32 * GS * 2 + ks * 32);
#pragma unroll
            for (int j = 0; j < 4; ++j) bfr[j] = *(const LAS bf16x8*)(lds + b_rd + j * 32 * GS * 2 + ks * 32);
#pragma unroll
            for (int i = 0; i < 2; ++i)
#pragma unroll
                for (int j = 0; j < 4; ++j) acc[i][j] = __builtin_amdgcn_mfma_f32_32x32x16_bf16(bfr[j], af[i], acc[i][j], 0, 0, 0);
            if (ks & 1) asm volatile("" ::: "memory");
        }
        __syncthreads();
    }
    epi(acc, wm, wn, l32, hi, lds);
}
template <int K> __device__ __forceinline__ void row_sumsq(LAS char* lds, const bf16_t* A, int ld) {
    const int tid = otid(), row = tid >> 1, half = tid & 1;
    const bf16_t* ptr = A + (size_t)row * ld + half * (K / 2);
    float ss = 0.f;
#pragma unroll
    for (int c = 0; c < K / 16; ++c) { const u32x4 v = gld<u32x4>(ptr + c * 8);
#pragma unroll
        for (int j = 0; j < 4; ++j) { const float a = bf_lo(v[j]), b = bf_hi(v[j]); ss += a * a + b * b; } }
    ss += __shfl_xor(ss, 1);
    __syncthreads();
    if (half == 0) ((LAS float*)(lds + G_ROWSS))[row] = ss;
}

__device__ __forceinline__ void store_bf4(bf16_t* p, float a, float b, float c, float d) { u32x2 w; w.x = cvtpk(a, b); w.y = cvtpk(c, d); gst<u32x2>(p, w); }

__device__ __forceinline__ void store_tiles4(bf16_t* p, const f32x16 (&a)[4], float sc) {
#pragma unroll
    for (int ni = 0; ni < 4; ++ni)
#pragma unroll
        for (int q = 0; q < 4; ++q) store_bf4(p + 32 * ni + 8 * q, a[ni][4 * q] * sc, a[ni][4 * q + 1] * sc, a[ni][4 * q + 2] * sc, a[ni][4 * q + 3] * sc);
}
__device__ __forceinline__ void rope_pair32(f32x16& lo, f32x16& hi16, const f32x2* cs32, int pos, int hi, bool on = true) {
#pragma unroll
    for (int r = 0; r < 16; ++r) { f32x2 cs = {1.f, 0.f}; if (on) cs = gld<f32x2>(cs32 + pos * 32 + crow(r, hi)); const float x1 = lo[r], x2 = hi16[r]; lo[r] = x1 * cs.x - x2 * cs.y; hi16[r] = x2 * cs.x + x1 * cs.y; }
}
__device__ __forceinline__ void rope_first32(f32x16& t, const f32x2* cs16, int pos, int hi) {
#pragma unroll
    for (int r = 0; r < 8; ++r) { const f32x2 cs = gld<f32x2>(cs16 + pos * 16 + crow(r, hi)); const float x1 = t[r], x2 = t[r + 8]; t[r] = x1 * cs.x - x2 * cs.y; t[r + 8] = x2 * cs.x + x1 * cs.y; }
}
__device__ __forceinline__ bool is_rope16(int c0) {
    return (((c0 - C_DQ) & 127) == 0) && ((c0 >= C_DQ && c0 < C_DV) || (c0 >= C_NQ && c0 < C_NKC) || c0 == C_NKS || c0 == C_NKW);
}
struct EpiWin {
    bf16_t* H; float* gates; const f32x2* cs16; const f32x2* cs32; int m0, n0;
    __device__ __forceinline__ void operator()(f32x16 (&acc)[2][4], int wm, int wn, int l32, int hi, LAS char*) const {
        const int nw = n0 + 128 * wn;
#pragma unroll
        for (int mi = 0; mi < 2; ++mi) {
            const int row = m0 + 64 * wm + 32 * mi + l32, pos = row & (SEQ - 1);
            if (nw == C_KROPE) rope_pair32(acc[mi][0], acc[mi][1], cs32, pos, hi);
#pragma unroll
            for (int ni = 0; ni < 4; ++ni) if (is_rope16(nw + 32 * ni)) rope_first32(acc[mi][ni], cs16, pos, hi);
            if (nw == C_GATE - 64) {
#pragma unroll
                for (int r = 0; r < 16; ++r) { const int c = crow(r, hi); if (c < 18) gst<float>(gates + (size_t)row * 18 + c, 1.f / (1.f + __expf(-acc[mi][2][r]))); }
            }
            store_tiles4(H + (size_t)row * LDH + nw + 4 * hi, acc[mi], 1.f);
        }
    }
};
struct EpiQup {
    bf16_t* Q; const f32x2* cs32; int m0, n0;
    __device__ __forceinline__ void operator()(f32x16 (&acc)[2][4], int wm, int wn, int l32, int hi, LAS char* lds) const {
        const int nw = n0 + 128 * wn; const LAS float* rs = (const LAS float*)(lds + G_ROWSS);
#pragma unroll
        for (int mi = 0; mi < 2; ++mi) {
            const int rl = 64 * wm + 32 * mi + l32, row = m0 + rl, pos = row & (SEQ - 1);
            const float sc = __builtin_amdgcn_rsqf(rs[rl] * (1.f / 384.f) + 1e-6f);
#pragma unroll
            for (int ni = 0; ni < 4; ++ni)
#pragma unroll
                for (int r = 0; r < 16; ++r) acc[mi][ni][r] *= sc;
            rope_pair32(acc[mi][0], acc[mi][1], cs32, pos, hi, (nw % 192) == 128);
            rope_pair32(acc[mi][2], acc[mi][3], cs32, pos, hi, ((nw + 64) % 192) == 128);
            store_tiles4(Q + (size_t)row * 768 + nw + 4 * hi, acc[mi], 1.f);
        }
    }
};
struct EpiKVup {
    bf16_t* Kn; int m0, n0;
    __device__ __forceinline__ void operator()(f32x16 (&acc)[2][4], int wm, int wn, int l32, int hi, LAS char* lds) const {
        const int nw = n0 + 128 * wn; const LAS float* rs = (const LAS float*)(lds + G_ROWSS);
        const int head = nw >> 8, within = nw & 255;
        bf16_t* base = Kn + (within < 128 ? (size_t)0 : (size_t)NT * 512) + head * 128 + 4 * hi;
#pragma unroll
        for (int mi = 0; mi < 2; ++mi) {
            const int rl = 64 * wm + 32 * mi + l32, row = m0 + rl;
            const float sc = __builtin_amdgcn_rsqf(rs[rl] * (1.f / 128.f) + 1e-6f);
            store_tiles4(base + (size_t)row * 512, acc[mi], sc);
        }
    }
};
__device__ __forceinline__ float gelu_tanh(float x) {
    const float u = 0.7978845608028654f * (x + 0.044715f * x * x * x);
    const float e = __expf(-2.f * fabsf(u)); const float t = (1.f - e) / (1.f + e);
    return 0.5f * x * (1.f + (u < 0.f ? -t : t));
}
struct EpiCmp1 {
    float* P; int m0;
    __device__ __forceinline__ void operator()(f32x16 (&acc)[2][4], int wm, int wn, int l32, int hi, LAS char*) const {
#pragma unroll
        for (int mi = 0; mi < 2; ++mi) {
            float* p = P + (size_t)(m0 + 64 * wm + 32 * mi + l32) * 256 + 128 * wn + 4 * hi;
#pragma unroll
            for (int ni = 0; ni < 4; ++ni)
#pragma unroll
                for (int q = 0; q < 4; ++q) { f32x4 v = {acc[mi][ni][4 * q], acc[mi][ni][4 * q + 1], acc[mi][ni][4 * q + 2], acc[mi][ni][4 * q + 3]}; gst<f32x4>(p + 32 * ni + 8 * q, v); }
        }
    }
};
struct EpiCmp2 {
    bf16_t* O; const f32x2* cs16; int dorope; int m0;
    __device__ __forceinline__ void operator()(f32x16 (&acc)[2][4], int wm, int wn, int l32, int hi, LAS char*) const {
        if (wn != 0) return;
#pragma unroll
        for (int mi = 0; mi < 2; ++mi) {
            const int row = m0 + 64 * wm + 32 * mi + l32, c = row & 127, pos = 16 * c + 31;
            if (dorope && c < 127) rope_first32(acc[mi][0], cs16, pos, hi);
            store_tiles4(O + (size_t)row * 128 + 4 * hi, acc[mi], c < 127 ? 1.f : 0.f);
        }
    }
};
struct EpiOut {
    float* Y; const float* X; int m0, n0;
    __device__ __forceinline__ void operator()(f32x16 (&acc)[2][4], int wm, int wn, int l32, int hi, LAS char*) const {
        const int nw = n0 + 128 * wn;
#pragma unroll
        for (int mi = 0; mi < 2; ++mi) {
            const size_t off = (size_t)(m0 + 64 * wm + 32 * mi + l32) * DM + nw + 4 * hi;
#pragma unroll
            for (int ni = 0; ni < 4; ++ni)
#pragma unroll
                for (int q = 0; q < 4; ++q) { const f32x4 xv = gld<f32x4>(X + off + 32 * ni + 8 * q);
                    f32x4 o; o[0] = DN_ALPHA * xv[0] + acc[mi][ni][4 * q]; o[1] = DN_ALPHA * xv[1] + acc[mi][ni][4 * q + 1]; o[2] = DN_ALPHA * xv[2] + acc[mi][ni][4 * q + 2]; o[3] = DN_ALPHA * xv[3] + acc[mi][ni][4 * q + 3];
                    gst<f32x4>(Y + off + 32 * ni + 8 * q, o);
                    if (q == 3) asm volatile("" ::: "memory"); }
        }
    }
};
struct EpiMoe1 {
    bf16_t* Hm; int rowbase, nvalid, n0;
    __device__ __forceinline__ void operator()(f32x16 (&acc)[2][4], int wm, int wn, int l32, int hi, LAS char*) const {
        const int ff0 = (n0 + 128 * wn) >> 1;
#pragma unroll
        for (int mi = 0; mi < 2; ++mi) {
            const int rl = 64 * wm + 32 * mi + l32;
            if (rl < nvalid) {
                bf16_t* p = Hm + (size_t)(rowbase + rl) * EFF + ff0 + 4 * hi;
#pragma unroll
                for (int h2 = 0; h2 < 2; ++h2)
#pragma unroll
                    for (int q = 0; q < 4; ++q) { float v[4];
#pragma unroll
                        for (int j = 0; j < 4; ++j) { const float g = acc[mi][2 * h2][4 * q + j], u = acc[mi][2 * h2 + 1][4 * q + j]; v[j] = g / (1.f + __expf(-g)) * u; }
                        store_bf4(p + 32 * h2 + 8 * q, v[0], v[1], v[2], v[3]); }
            }
        }
    }
};
struct EpiMoe2 {
    bf16_t* Y; const int* list; const float* gw; int nvalid, n0;
    __device__ __forceinline__ void operator()(f32x16 (&acc)[2][4], int wm, int wn, int l32, int hi, LAS char*) const {
        const int nw = n0 + 128 * wn;
#pragma unroll
        for (int mi = 0; mi < 2; ++mi) {
            const int rl = 64 * wm + 32 * mi + l32;
            if (rl < nvalid) { const int slot = gld<int>(list + rl); store_tiles4(Y + (size_t)slot * DM + nw + 4 * hi, acc[mi], gld<float>(gw + slot)); }
        }
    }
};

constexpr int VS = 160;
struct KeySrc { const bf16_t* k0; size_t kstride; const bf16_t* kr; size_t krstride; const bf16_t* v0; size_t vstride; };

template <int DQK> struct AttnRegs { bf16x8 k[DQK / 8 * 64 / 256]; bf16x8 v[4]; };
template <int DQK> struct AttnSrc { __amdgpu_buffer_rsrc_t rk, rr, rv; unsigned ko[DQK / 8 * 64 / 256]; unsigned vo[4]; unsigned ktile, rtile, vtile; };
template <int DQK> __device__ __forceinline__ AttnSrc<DQK> attn_src(const KeySrc& ks, int tid) {
    constexpr int KCH = DQK / 8, NKL = KCH * 64 / 256;
    AttnSrc<DQK> a; a.rk = mk_rsrc(ks.k0); a.rr = mk_rsrc(ks.kr); a.rv = mk_rsrc(ks.v0);
#pragma unroll
    for (int i = 0; i < NKL; ++i) { const int idx = tid + i * 256, key = idx / KCH, ch = idx - key * KCH;
        a.ko[i] = (DQK == 128 || ch < 16) ? (unsigned)(key * (unsigned)ks.kstride + ch * 8) * 2u : (unsigned)(key * (unsigned)ks.krstride + (ch - 16) * 8) * 2u; }
#pragma unroll
    for (int i = 0; i < 4; ++i) { const int idx = tid + i * 256, key = idx >> 4, ch = idx & 15; a.vo[i] = (unsigned)(key * (unsigned)ks.vstride + ch * 8) * 2u; }
    a.ktile = 128u * (unsigned)ks.kstride; a.rtile = 128u * (unsigned)ks.krstride; a.vtile = 128u * (unsigned)ks.vstride;
    return a;
}
template <int DQK> __device__ __forceinline__ void attn_gload(const AttnSrc<DQK>& a, int jt, AttnRegs<DQK>& R, bool withv, int tid) {
    constexpr int KCH = DQK / 8, NKL = KCH * 64 / 256;
#pragma unroll
    for (int i = 0; i < NKL; ++i) { const int idx = tid + i * 256, key = idx / KCH, ch = idx - key * KCH;
        R.k[i] = (DQK == 128 || ch < 16) ? bld8(a.rk, a.ko[i], (int)(jt * a.ktile)) : bld8(a.rr, a.ko[i], (int)(jt * a.rtile)); }
    if (withv) {
#pragma unroll
        for (int i = 0; i < 4; ++i) R.v[i] = bld8(a.rv, a.vo[i], (int)(jt * a.vtile));
    }
}
template <int DQK> __device__ __forceinline__ void attn_lwrite(LAS char* lds, const AttnRegs<DQK>& R, bool withv, int tid) {
    constexpr int KS = DQK + 8, KCH = DQK / 8, NKL = KCH * 64 / 256;
#pragma unroll
    for (int i = 0; i < NKL; ++i) { const int idx = tid + i * 256, key = idx / KCH, ch = idx - key * KCH; *(LAS bf16x8*)(lds + (key * KS + ch * 8) * 2) = R.k[i]; }
    if (withv) {
#pragma unroll
        for (int i = 0; i < 4; ++i) { const int idx = tid + i * 256, key = idx >> 4, ch = idx & 15; *(LAS bf16x8*)(lds + 64 * KS * 2 + (key * VS + ch * 8) * 2) = R.v[i]; }
    }
}
template <int DQK> __device__ __forceinline__ void attn_stage(LAS char* lds, const AttnSrc<DQK>& a, int jt, bool withv, int tid) { AttnRegs<DQK> R; attn_gload<DQK>(a, jt, R, withv, tid); attn_lwrite<DQK>(lds, R, withv, tid); }
template <int DQK> __device__ __forceinline__ void attn_scores(const LAS char* lds, const bf16x8 (&qf)[DQK / 16], f32x16& p0, f32x16& p1, int l32, int hi) {
    constexpr int KS = DQK + 8;
    const int sg = (l32 & ~12) | ((l32 & 4) << 1) | ((l32 & 8) >> 1);
    const LAS char* kb = lds + (sg * KS + hi * 8) * 2;
#pragma unroll
    for (int r = 0; r < 16; ++r) { p0[r] = 0.f; p1[r] = 0.f; }
#pragma unroll
    for (int ds = 0; ds < DQK / 16; ++ds) {
        const bf16x8 a0 = *(const LAS bf16x8*)(kb + ds * 32), a1 = *(const LAS bf16x8*)(kb + 32 * KS * 2 + ds * 32);
        p0 = __builtin_amdgcn_mfma_f32_32x32x16_bf16(a0, qf[ds], p0, 0, 0, 0);
        p1 = __builtin_amdgcn_mfma_f32_32x32x16_bf16(a1, qf[ds], p1, 0, 0, 0);
    }
}
template <int DQK, bool SEL>
__device__ __forceinline__ void attn_run(LAS char* lds, const KeySrc& ks, int jt_lo, int jt_hi, unsigned tile_union, const bf16x8 (&qf)[DQK / 16],
                                         int qi, unsigned maxd, unsigned sel, float c2, f32x16 (&o)[4], float& m_run, float& l_run, int tid) {
    constexpr int KS = DQK + 8;
    const int lane = tid & 63, l32 = lane & 31, hi = lane >> 5;
    const int g = lane >> 4, i16 = lane & 15;
    const LAS char* vb = (lds + 64 * KS * 2 + ((8 * hi + (i16 >> 2)) * VS + 16 * (g & 1) + 4 * (i16 & 3)) * 2);
    const float NEG = -__builtin_inff();
    int qmin = qi, qmax = qi;
#pragma unroll
    for (int sft = 32; sft >= 1; sft >>= 1) { qmin = min(qmin, __shfl_xor(qmin, sft)); qmax = max(qmax, __shfl_xor(qmax, sft)); }
    int jt = jt_lo;
    if (SEL) { while (jt < jt_hi && !((tile_union >> jt) & 1u)) ++jt; }
    if (jt >= jt_hi) return;
    AttnRegs<DQK> R;
    const AttnSrc<DQK> asrc = attn_src<DQK>(ks, tid);
    constexpr bool PF = DQK == 128;
    if (PF) attn_gload<DQK>(asrc, jt, R, true, tid);
    for (;;) {
        if (!PF) attn_gload<DQK>(asrc, jt, R, true, tid);
        attn_lwrite<DQK>(lds, R, true, tid);
        __syncthreads();
        int jn = jt + 1;
        if (SEL) { while (jn < jt_hi && !((tile_union >> jn) & 1u)) ++jn; }
        if (PF && jn < jt_hi) attn_gload<DQK>(asrc, jn, R, true, tid);
        f32x16 p0, p1;
        attn_scores<DQK>(lds, qf, p0, p1, l32, hi);
        const bool ok = SEL ? (((sel >> jt) & 1u) != 0u) : true;
        const bool interior = (qmin - (jt * 64 + 63) >= 0) && ((unsigned)(qmax - jt * 64) <= maxd) && (SEL ? __all(ok) : true);
        float mx = NEG;
        if (interior) {
#pragma unroll
            for (int r = 0; r < 16; ++r) mx = fmaxf(mx, fmaxf(p0[r], p1[r]));
        } else {
            const int dq = qi - jt * 64 - 8 * hi;
#pragma unroll
            for (int r = 0; r < 16; ++r) {
                const int ko = 16 * (r >> 3) + (r & 7);
                const float s0 = (ok && (unsigned)(dq - ko) <= maxd) ? p0[r] : NEG;
                const float s1 = (ok && (unsigned)(dq - ko - 32) <= maxd) ? p1[r] : NEG;
                p0[r] = s0; p1[r] = s1; mx = fmaxf(mx, fmaxf(s0, s1));
            }
        }
        mx = fmaxf(mx, __shfl_xor(mx, 32));
        const float mn = fmaxf(m_run, mx * c2);
        const float alpha = __builtin_amdgcn_exp2f(m_run - mn);
        const float nmn = -mn;
        float rs = 0.f;
#pragma unroll
        for (int r = 0; r < 16; ++r) { p0[r] = __builtin_amdgcn_exp2f(fmaf(p0[r], c2, nmn)); p1[r] = __builtin_amdgcn_exp2f(fmaf(p1[r], c2, nmn)); rs += p0[r] + p1[r]; }
        rs += __shfl_xor(rs, 32);
        l_run = l_run * alpha + rs; m_run = mn;
        if (!__all(alpha == 1.f)) {
#pragma unroll
            for (int dt = 0; dt < 4; ++dt)
#pragma unroll
                for (int r = 0; r < 16; ++r) o[dt][r] *= alpha;
        }
#pragma unroll
        for (int s4 = 0; s4 < 4; ++s4) {
            u32x4 pw;
            if (s4 == 0)      { pw.x = cvtpk(p0[0], p0[1]);  pw.y = cvtpk(p0[2], p0[3]);   pw.z = cvtpk(p0[4], p0[5]);   pw.w = cvtpk(p0[6], p0[7]); }
            else if (s4 == 1) { pw.x = cvtpk(p0[8], p0[9]);  pw.y = cvtpk(p0[10], p0[11]); pw.z = cvtpk(p0[12], p0[13]); pw.w = cvtpk(p0[14], p0[15]); }
            else if (s4 == 2) { pw.x = cvtpk(p1[0], p1[1]);  pw.y = cvtpk(p1[2], p1[3]);   pw.z = cvtpk(p1[4], p1[5]);   pw.w = cvtpk(p1[6], p1[7]); }
            else              { pw.x = cvtpk(p1[8], p1[9]);  pw.y = cvtpk(p1[10], p1[11]); pw.z = cvtpk(p1[12], p1[13]); pw.w = cvtpk(p1[14], p1[15]); }
            const bf16x8 pb = *reinterpret_cast<bf16x8*>(&pw);
#pragma unroll
            for (int dt = 0; dt < 4; ++dt) {
                const s16x4 v0 = __builtin_amdgcn_ds_read_tr16_b64_v4i16((LAS s16x4*)(vb + (s4 * 16 * VS + dt * 32) * 2));
                const s16x4 v1 = __builtin_amdgcn_ds_read_tr16_b64_v4i16((LAS s16x4*)(vb + (s4 * 16 * VS + 4 * VS + dt * 32) * 2));
                const bf16x8 va = {v0[0], v0[1], v0[2], v0[3], v1[0], v1[1], v1[2], v1[3]};
                o[dt] = __builtin_amdgcn_mfma_f32_32x32x16_bf16(va, pb, o[dt], 0, 0, 0);
            }
        }
        __syncthreads();
        if (jn >= jt_hi) break;
        jt = jn;
    }
}
template <int DQK> __device__ __forceinline__ void load_q(const bf16_t* qptr, int hi, bf16x8 (&qf)[DQK / 16]) {
#pragma unroll
    for (int ds = 0; ds < DQK / 16; ++ds) qf[ds] = gld<bf16x8>(qptr + ds * 16 + hi * 8);
}
__device__ __forceinline__ void store_o(bf16_t* optr, const f32x16 (&o)[4], float inv, int hi) {
#pragma unroll
    for (int dt = 0; dt < 4; ++dt)
#pragma unroll
        for (int q = 0; q < 4; ++q) store_bf4(optr + 32 * dt + 8 * q + 4 * hi, o[dt][4 * q] * inv, o[dt][4 * q + 1] * inv, o[dt][4 * q + 2] * inv, o[dt][4 * q + 3] * inv);
}
__device__ __forceinline__ void zero_o(f32x16 (&o)[4]) {
#pragma unroll
    for (int dt = 0; dt < 4; ++dt)
#pragma unroll
        for (int r = 0; r < 16; ++r) o[dt][r] = 0.f;
}

__device__ __forceinline__ int claim(unsigned* ctr, LAS char* lds) {
    volatile LAS int* slot = (volatile LAS int*)(lds + LDS_CTL + 64);
    __syncthreads();
    if (otid() == 0) *slot = (int)atomicAdd(ctr, 1u);
    __syncthreads();
    return *slot;
}

__device__ __forceinline__ void conv_tile(LAS char* lds, const float* src, int N, int k0, int n0, bf16_t* dst, int ldd, int rowmap, const float* kscale) {
    LAS float* tile = (LAS float*)lds;
    const int tid = otid();
    __syncthreads();
    {
        const int kr = tid >> 6, nc = tid & 63; const bool inb = n0 + nc < N;
#pragma unroll
        for (int i = 0; i < 16; ++i) { const int k = kr + 4 * i; float v = inb ? gld<float>(src + (size_t)(k0 + k) * N + n0 + nc) : 0.f; if (kscale) v *= gld<float>(kscale + k0 + k); tile[k * 65 + nc] = v; }
    }
    __syncthreads();
    {
        const int n = tid >> 2, kq = (tid & 3) * 16; const int c = n0 + n;
        const int drow = rowmap == 0 ? c : (128 * (c >> 6) + 64 * ((c >> 5) & 1) + 32 * (rowmap - 1) + (c & 31));
        u32x4 w0, w1;
        w0.x = cvtpk(tile[(kq + 0) * 65 + n], tile[(kq + 1) * 65 + n]);   w0.y = cvtpk(tile[(kq + 2) * 65 + n], tile[(kq + 3) * 65 + n]);
        w0.z = cvtpk(tile[(kq + 4) * 65 + n], tile[(kq + 5) * 65 + n]);   w0.w = cvtpk(tile[(kq + 6) * 65 + n], tile[(kq + 7) * 65 + n]);
        w1.x = cvtpk(tile[(kq + 8) * 65 + n], tile[(kq + 9) * 65 + n]);   w1.y = cvtpk(tile[(kq + 10) * 65 + n], tile[(kq + 11) * 65 + n]);
        w1.z = cvtpk(tile[(kq + 12) * 65 + n], tile[(kq + 13) * 65 + n]); w1.w = cvtpk(tile[(kq + 14) * 65 + n], tile[(kq + 15) * 65 + n]);
        bf16_t* d = dst + (size_t)drow * ldd + k0 + kq;
        gst<u32x4>(d, w0); gst<u32x4>(d + 8, w1);
    }
}

__device__ __forceinline__ void phase_prep(const Params& p, int layer, LAS char* lds) {
    char* ws = ows(p.ws);
    const int tid = otid();
    constexpr int N_WIN = 32 * 72, N_WQ = 6 * 12, N_WKV = 2 * 16, N_W1 = 64 * 4, N_W2 = 4 * 2, N_WOUT = 32 * 32, N_EG = NEXP * 32 * 8, N_ED = NEXP * 8 * 32;
    constexpr int E0 = 0, E1 = E0 + N_WIN, E2 = E1 + N_WQ, E3 = E2 + N_WKV, E4 = E3 + N_W1, E5 = E4 + N_W1, E6 = E5 + N_W2, E7 = E6 + N_W2, E8 = E7 + N_WOUT,
                  E9 = E8 + N_EG, E10 = E9 + N_EG, E11 = E10 + N_ED, E12 = E11 + 32  , E13 = E12 + 64  , E14 = E13 + 4096  ;
    const int total = layer == 0 ? E14 : E12;
    for (int it = oblk(); it < total; it += gridDim.x) {
        if (it < E1) { const int u = it - E0, kt = u % 32, nt = u / 32;
            conv_tile(lds, p.in[I_WIN] + (size_t)layer * DM * INC, INC, kt * 64, nt * 64, (bf16_t*)(ws + OFF_WIN_T), DM, 0, nullptr);
        } else if (it < E2) { const int u = it - E1, kt = u % 6, nt = u / 6;
            conv_tile(lds, p.in[I_WQUP] + (size_t)layer * 384 * 768, 768, kt * 64, nt * 64, (bf16_t*)(ws + OFF_WQ_T), 384, 0, p.in[I_QLN] + layer * 384);
        } else if (it < E3) { const int u = it - E2, kt = u % 2, nt = u / 2;
            conv_tile(lds, p.in[I_WKVUP] + (size_t)layer * 128 * 1024, 1024, kt * 64, nt * 64, (bf16_t*)(ws + OFF_WKV_T), 128, 0, p.in[I_KVLN] + layer * 128);
        } else if (it < E5) { const int which = it >= E4, u = it - (which ? E4 : E3), kt = u % 64, nt = u / 64;
            conv_tile(lds, p.in[which ? I_W1V : I_W1K] + (size_t)layer * 4096 * 256, 256, kt * 64, nt * 64, (bf16_t*)(ws + (which ? OFF_W1V_T : OFF_W1K_T)), 4096, 0, nullptr);
        } else if (it < E7) { const int which = it >= E6, u = it - (which ? E6 : E5), kt = u % 4, nt = u / 4;
            conv_tile(lds, p.in[which ? I_W2V : I_W2K] + (size_t)layer * 256 * 128, 128, kt * 64, nt * 64, (bf16_t*)(ws + (which ? OFF_W2V_T : OFF_W2K_T)), 256, 0, nullptr);
        } else if (it < E8) { const int u = it - E7, kt = u % 32, nt = u / 32;
            conv_tile(lds, p.in[I_WOUT] + (size_t)layer * DM * DM, DM, kt * 64, nt * 64, (bf16_t*)(ws + OFF_WOUT_T), DM, 0, nullptr);
        } else if (it < E10) { const int isup = it >= E9, u = it - (isup ? E9 : E8), e = u / 256, r = u % 256, kt = r % 32, nt = r / 32;
            conv_tile(lds, p.in[isup ? I_WUP : I_WGATE] + ((size_t)layer * NEXP + e) * DM * EFF, EFF, kt * 64, nt * 64, (bf16_t*)(ws + OFF_WGU_T) + (size_t)e * 1024 * DM, DM, 1 + isup, nullptr);
        } else if (it < E11) { const int u = it - E10, e = u / 256, r = u % 256, kt = r % 8, nt = r / 8;
            conv_tile(lds, p.in[I_WDOWN] + ((size_t)layer * NEXP + e) * EFF * DM, DM, kt * 64, nt * 64, (bf16_t*)(ws + OFF_WD_T) + (size_t)e * DM * EFF, EFF, 0, nullptr);
        } else if (it < E12) { const int u = it - E11, which = u >> 4, kc = u & 15;
            const float* pe = p.in[which ? I_PEV : I_PEK] + (size_t)layer * 4096 + kc * 256;
            const float* w1 = p.in[which ? I_W1V : I_W1K] + (size_t)layer * 4096 * 256 + (size_t)kc * 256 * 256;
            float a0 = 0.f, a1 = 0.f, a2 = 0.f, a3 = 0.f;
            for (int k = 0; k < 256; k += 4) { a0 += pe[k] * w1[(size_t)k * 256 + tid]; a1 += pe[k + 1] * w1[(size_t)(k + 1) * 256 + tid]; a2 += pe[k + 2] * w1[(size_t)(k + 2) * 256 + tid]; a3 += pe[k + 3] * w1[(size_t)(k + 3) * 256 + tid]; }
            ((float*)(ws + OFF_B1P))[(which * 16 + kc) * 256 + tid] = (a0 + a1) + (a2 + a3);
        } else if (it < E13) { const int u = it - E12;
            f32x2* cs16 = (f32x2*)(ws + OFF_CS16); f32x2* cs32 = (f32x2*)(ws + OFF_CS32);
            for (int e = tid; e < 32 * 48; e += 256) { const int pos = u * 32 + e / 48, j = e % 48;
                const int half = j < 16 ? 16 : 32, i = j < 16 ? j : j - 16;
                const float invf = exp2f(-(float)i / (float)half * 18.931568569324174f);
                const float ang = (float)pos * invf;
                f32x2 cs; cs.x = cosf(ang); cs.y = sinf(ang);
                if (j < 16) cs16[pos * 16 + i] = cs; else cs32[pos * 32 + i] = cs; }
        } else { const int u = it - E13;
            const float* x = p.in[I_X] + (size_t)u * 4096; bf16_t* xb = (bf16_t*)(ws + OFF_XB) + (size_t)u * 4096;
            for (int e = tid * 4; e < 4096; e += 1024) { const f32x4 v = gld<f32x4>(x + e); store_bf4(xb + e, v[0], v[1], v[2], v[3]); }
        }
    }
    if (oblk() == 0 && tid < NEXP) ((unsigned*)(ws + OFF_ECNT))[tid] = 0u;
    { unsigned* imp = (unsigned*)(ws + OFF_IMP); for (size_t e = (size_t)oblk() * 256 + tid; e < (size_t)NT * 32; e += (size_t)gridDim.x * 256) gst<unsigned>(imp + e, 0u); }
}

#define AO4(ld) { (unsigned)(sr * (ld) + sc), (unsigned)((sr + 32) * (ld) + sc), (unsigned)((sr + 64) * (ld) + sc), (unsigned)((sr + 96) * (ld) + sc) }
__device__ __forceinline__ void phase_win(const Params& p, int layer, LAS char* lds) {
    char* ws = ows(p.ws); const int tid = otid(), sr = tid >> 3, sc = (tid & 7) * 8;
    const bf16_t* A = (const bf16_t*)(ws + OFF_XB); const bf16_t* Bt = (const bf16_t*)(ws + OFF_WIN_T);
    for (int u = oblk(); u < 64 * 18; u += gridDim.x) {
        const int mt = u & 63, nt = u >> 6;
        EpiWin e{(bf16_t*)(ws + OFF_H), (float*)(ws + OFF_GATES), (const f32x2*)(ws + OFF_CS16), (const f32x2*)(ws + OFF_CS32), mt * 128, nt * 256};
        const unsigned ao[4] = AO4(DM);
        gemm_unit(lds, A + (size_t)mt * 128 * DM, ao, 128, Bt + (size_t)nt * 256 * DM, (unsigned)(sr * DM + sc), (size_t)32 * DM, DM / 64, e);
    }
}
__device__ __forceinline__ void phase_up(const Params& p, int layer, LAS char* lds) {
    char* ws = ows(p.ws); const int tid = otid(), sr = tid >> 3, sc = (tid & 7) * 8;
    const bf16_t* H = (const bf16_t*)(ws + OFF_H);
    constexpr int U0 = 64, U1 = U0 + 64 * 3, U2 = U1 + 64 * 4;
    for (int u = oblk(); u < U2; u += gridDim.x) {
        if (u < U0) {
            const int which = u >> 5, mt = (u >> 3) & 3, ksp = u & 7;
            const int col = which ? C_NVC : C_NKC;
            unsigned ao[4];
#pragma unroll
            for (int i = 0; i < 4; ++i) { int c = sr + 32 * i; if (c > 126) c = 126; ao[i] = (unsigned)(16 * c * LDH + sc); }
            const bf16_t* ab = H + (size_t)(mt * SEQ + 4 * ksp) * LDH + col;
            const bf16_t* bb = (const bf16_t*)(ws + (which ? OFF_W1V_T : OFF_W1K_T)) + 512 * ksp;
            EpiCmp1 e{(float*)(ws + OFF_HCP) + ((size_t)ksp * 2 + which) * 512 * 256, mt * 128};
            gemm_unit(lds, ab, ao, LDH, bb, (unsigned)(sr * 4096 + sc), (size_t)32 * 4096, 512 / 64, e);
        } else if (u < U1) {
            const int v = u - U0, mt = v & 63, nt = v >> 6;
            const unsigned ao[4] = AO4(LDH);
            EpiQup e{(bf16_t*)(ws + OFF_QM), (const f32x2*)(ws + OFF_CS32), mt * 128, nt * 256};
            row_sumsq<384>(lds, H + (size_t)mt * 128 * LDH + C_QLAT, LDH);
            gemm_unit(lds, H + (size_t)mt * 128 * LDH + C_QLAT, ao, 128, (const bf16_t*)(ws + OFF_WQ_T) + (size_t)nt * 256 * 384, (unsigned)(sr * 384 + sc), (size_t)32 * 384, 384 / 64, e);
        } else {
            const int v = u - U1, mt = v & 63, nt = v >> 6;
            const unsigned ao[4] = AO4(LDH);
            EpiKVup e{(bf16_t*)(ws + OFF_KN), mt * 128, nt * 256};
            row_sumsq<128>(lds, H + (size_t)mt * 128 * LDH + C_KVLAT, LDH);
            gemm_unit(lds, H + (size_t)mt * 128 * LDH + C_KVLAT, ao, 128, (const bf16_t*)(ws + OFF_WKV_T) + (size_t)nt * 256 * 128, (unsigned)(sr * 128 + sc), (size_t)32 * 128, 128 / 64, e);
        }
    }
}
__device__ __forceinline__ void phase_cmp2(const Params& p, int layer, LAS char* lds) {
    char* ws = ows(p.ws); const int tid = otid(), sr = tid >> 3, sc = (tid & 7) * 8;
    for (int u = oblk(); u < 8; u += gridDim.x) {
        const int which = u >> 2, mt = u & 3;
        bf16_t* Hc = (bf16_t*)(ws + OFF_HC) + (size_t)which * 512 * 256 + (size_t)mt * 128 * 256;
        const float* P = (const float*)(ws + OFF_HCP) + (size_t)which * 512 * 256 + (size_t)mt * 128 * 256;
        const float* b1p = (const float*)(ws + OFF_B1P) + which * 16 * 256;
        for (int e = tid * 4; e < 128 * 256; e += 1024) {
            f32x4 a = {0.f, 0.f, 0.f, 0.f};
            for (int q = 0; q < 16; ++q) a += gld<f32x4>(b1p + q * 256 + (e & 255));
            for (int q = 0; q < 8; ++q) a += gld<f32x4>(P + (size_t)q * 2 * 512 * 256 + e);
            store_bf4(Hc + e, gelu_tanh(a[0]), gelu_tanh(a[1]), gelu_tanh(a[2]), gelu_tanh(a[3]));
        }
        asm volatile("s_waitcnt vmcnt(0)" ::: "memory");
        __syncthreads();
        const unsigned ao[4] = AO4(256);
        EpiCmp2 e{(bf16_t*)(ws + (which ? OFF_VC : OFF_KC)), (const f32x2*)(ws + OFF_CS16), which == 0, mt * 128};
        gemm_unit(lds, Hc, ao, 128, (const bf16_t*)(ws + (which ? OFF_W2V_T : OFF_W2K_T)), (unsigned)(sr * 256 + sc), (size_t)32 * 256, 256 / 64, e);
    }
}
__device__ __forceinline__ void phase_out(const Params& p, int layer, LAS char* lds) {
    char* ws = ows(p.ws); const int tid = otid(), sr = tid >> 3, sc = (tid & 7) * 8;
    const bf16_t* A = (const bf16_t*)(ws + OFF_MIX); const bf16_t* Bt = (const bf16_t*)(ws + OFF_WOUT_T);
    const float* X = layer == 0 ? p.in[I_X] : (const float*)(ws + OFF_XA);
    for (int u = oblk(); u < 64 * 8; u += gridDim.x) {
        const int mt = u & 63, nt = u >> 6;
        EpiOut e{(float*)(ws + OFF_YB), X, mt * 128, nt * 256};
        const unsigned ao[4] = AO4(DM);
        gemm_unit(lds, A + (size_t)mt * 128 * DM, ao, 128, Bt + (size_t)nt * 256 * DM, (unsigned)(sr * DM + sc), (size_t)32 * DM, DM / 64, e);
    }
}

__device__ __forceinline__ void item_mla(const Params& p, int it, LAS char* lds) {
    char* ws = ows(p.ws); const int tid = otid(), lane = tid & 63, w = tid >> 6, l32 = lane & 31, hi = lane >> 5;
    const int qb = 15 - (it >> 4), h = it & 3, b = (it >> 2) & 3;
    const int token = qb * 128 + 32 * w + l32; const size_t row = (size_t)b * SEQ + token;
    bf16x8 qf[12]; load_q<192>((const bf16_t*)(ws + OFF_QM) + row * 768 + h * 192, hi, qf);
    KeySrc ks; ks.k0 = (const bf16_t*)(ws + OFF_KN) + (size_t)b * SEQ * 512 + h * 128; ks.kstride = 512;
    ks.kr = (const bf16_t*)(ws + OFF_H) + (size_t)b * SEQ * LDH + C_KROPE; ks.krstride = LDH;
    ks.v0 = (const bf16_t*)(ws + OFF_VM) + (size_t)b * SEQ * 512 + h * 128; ks.vstride = 512;
    f32x16 o[4]; zero_o(o); float m = -1e30f, l = 0.f;
    attn_run<192, false>(lds, ks, 0, 2 * qb + 2, 0u, qf, token, 0x7fffffffu, 0u, 0.07216878364870322f * LOG2E, o, m, l, tid);
    store_o((bf16_t*)(ws + OFF_MIX) + row * DM + h * 128, o, 1.f / l, hi);
}
__device__ __forceinline__ void item_dil(const Params& p, int it, LAS char* lds) {
    char* ws = ows(p.ws); const int tid = otid(), lane = tid & 63, w = tid >> 6, l32 = lane & 31, hi = lane >> 5;
    const int rem = it % 48, bh = it / 48, h = bh % 6, b = bh / 6;
    const int n = rem >> 4, r2 = rem & 15;
    const int dil = n == 0 ? 1 : (n == 1 ? 4 : 16);
    const int rho = n == 0 ? 0 : (n == 1 ? (r2 >> 2) : r2), qb = n == 0 ? r2 : (n == 1 ? (r2 & 3) : 0);
    const int i = qb * 128 + 32 * w + l32, token = rho + i * dil; const size_t row = (size_t)b * SEQ + token;
    const bf16_t* H = (const bf16_t*)(ws + OFF_H);
    bf16x8 qf[8]; load_q<128>(H + row * LDH + C_DQ + h * 128, hi, qf);
    KeySrc ks; ks.k0 = H + ((size_t)b * SEQ + rho) * LDH + C_DK + h * 128; ks.kstride = (size_t)dil * LDH; ks.kr = ks.k0; ks.krstride = 0;
    ks.v0 = H + ((size_t)b * SEQ + rho) * LDH + C_DV + h * 128; ks.vstride = (size_t)dil * LDH;
    f32x16 o[4]; zero_o(o); float m = -1e30f, l = 0.f;
    const int jlo = 2 * qb - 2 < 0 ? 0 : 2 * qb - 2;
    attn_run<128, false>(lds, ks, jlo, 2 * qb + 2, 0u, qf, i, 128u, 0u, 0.08838834764831845f * LOG2E, o, m, l, tid);
    store_o((bf16_t*)(ws + OFF_ODIL) + ((size_t)n * NT + row) * 768 + h * 128, o, 1.f / l, hi);
    if (hi == 0) gst<float>((float*)(ws + OFF_LDIL) + ((size_t)n * NT + row) * 6 + h, m + __log2f(l));
}
__device__ __forceinline__ void item_win(const Params& p, int it, LAS char* lds) {
    char* ws = ows(p.ws); const int tid = otid(), lane = tid & 63, w = tid >> 6, l32 = lane & 31, hi = lane >> 5;
    const int hp = it % 3, b = (it / 3) & 3, tb = 31 - it / 12;
    const int head = 2 * hp + (w >> 1), token = 64 * tb + 32 * (w & 1) + l32; const size_t row = (size_t)b * SEQ + token;
    const bf16_t* H = (const bf16_t*)(ws + OFF_H);
    bf16x8 qf[8]; load_q<128>(H + row * LDH + C_NQ + head * 128, hi, qf);
    KeySrc ks; ks.k0 = H + (size_t)b * SEQ * LDH + C_NKW; ks.kstride = LDH; ks.kr = ks.k0; ks.krstride = 0; ks.v0 = H + (size_t)b * SEQ * LDH + C_NVW; ks.vstride = LDH;
    f32x16 o[4]; zero_o(o); float m = -1e30f, l = 0.f;
    attn_run<128, false>(lds, ks, tb - 8 < 0 ? 0 : tb - 8, tb + 1, 0u, qf, token, 511u, 0u, 0.08838834764831845f * LOG2E, o, m, l, tid);
    store_o((bf16_t*)(ws + OFF_PW) + row * 768 + head * 128, o, 1.f / l, hi);
}
__device__ __forceinline__ void item_cmp(const Params& p, int it, LAS char* lds) {
    char* ws = ows(p.ws); const int tid = otid(), lane = tid & 63, w = tid >> 6, l32 = lane & 31, hi = lane >> 5;
    const int hp = it % 3, tb = (it / 3) % 32, b = it / 96;
    const int head = 2 * hp + (w >> 1), token = 64 * tb + 32 * (w & 1) + l32; const size_t row = (size_t)b * SEQ + token;
    const bf16_t* H = (const bf16_t*)(ws + OFF_H);
    bf16x8 qf[8]; load_q<128>(H + row * LDH + C_NQ + head * 128, hi, qf);
    KeySrc ks; ks.k0 = (const bf16_t*)(ws + OFF_KC) + (size_t)b * 128 * 128; ks.kstride = 128; ks.kr = ks.k0; ks.krstride = 0; ks.v0 = (const bf16_t*)(ws + OFF_VC) + (size_t)b * 128 * 128; ks.vstride = 128;
    const int qi = (token - 31) >> 4;
    const int qimax = (64 * tb + 63 - 31) >> 4;
    const int jhi = qimax < 0 ? 0 : (qimax >> 6) + 1;
    const float c2 = 0.08838834764831845f * LOG2E;
    f32x16 o[4]; zero_o(o); float m = -1e30f, l = 0.f;
    attn_run<128, false>(lds, ks, 0, jhi, 0u, qf, qi, 0x7fffffffu, 0u, c2, o, m, l, tid);
    const float inv = l > 0.f ? 1.f / l : 0.f;
    store_o((bf16_t*)(ws + OFF_PC) + row * 768 + head * 128, o, inv, hi);
    unsigned* imp = (unsigned*)(ws + OFF_IMP) + row * 32;
    const AttnSrc<128> asrc = attn_src<128>(ks, tid);
    for (int jt = 0; jt < jhi; ++jt) {
        attn_stage<128>(lds, asrc, jt, false, tid);
        __syncthreads();
        f32x16 p0, p1; attn_scores<128>(lds, qf, p0, p1, l32, hi);
        const int dq = qi - jt * 64 - 8 * hi;
#pragma unroll
        for (int r = 0; r < 16; ++r) { const int ko = 16 * (r >> 3) + (r & 7);
            p0[r] = (dq - ko >= 0) ? __builtin_amdgcn_exp2f(p0[r] * c2 - m) * inv : 0.f;
            p1[r] = (dq - ko - 32 >= 0) ? __builtin_amdgcn_exp2f(p1[r] * c2 - m) * inv : 0.f; }
#pragma unroll
        for (int t = 0; t < 2; ++t)
#pragma unroll
            for (int u = 0; u < 2; ++u) {
                unsigned q[8];
#pragma unroll
                for (int j = 0; j < 8; ++j) q[j] = (unsigned)((t ? p1[8 * u + j] : p0[8 * u + j]) * 16777216.f + 0.5f);
                const int j0 = (64 * jt + 32 * t + 16 * u + 8 * hi) >> 2;
                const unsigned a0 = q[0] + q[1] + q[2] + q[3], a1 = q[4] + q[5] + q[6] + q[7] + q[3], a2 = q[7];
                if (a0) atomicAdd(imp + j0, a0);
                if (a1) atomicAdd(imp + j0 + 1, a1);
                if (a2 && j0 + 2 < 32) atomicAdd(imp + j0 + 2, a2);
            }
        __syncthreads();
    }
}
__device__ __forceinline__ void item_slc(const Params& p, int it, LAS char* lds) {
    char* ws = ows(p.ws); const int tid = otid(), lane = tid & 63, w = tid >> 6, l32 = lane & 31, hi = lane >> 5;
    const int hp = it % 3, b = (it / 3) & 3, tb = 31 - it / 12;
    LAS int* sc = (LAS int*)(lds + 47104); LAS unsigned* msk = (LAS unsigned*)(lds + 47104 + 8192);
    __syncthreads();
    if (tid < 65) msk[tid] = 0u;
    const unsigned* imp = (const unsigned*)(ws + OFF_IMP) + ((size_t)b * SEQ + 64 * tb) * 32;
#pragma unroll
    for (int i = 0; i < 8; ++i) { const int e = tid + i * 256, tk = e >> 5, j = e & 31, pos = 64 * tb + tk, qblk = pos >> 6;
        const bool valid = 64 * j <= pos, forced = (j == 0) || (j == qblk) || (j == qblk - 1);
        sc[e] = valid ? (forced ? 0x7fffffff : (int)gld<unsigned>(imp + e)) : -1; }
    __syncthreads();
#pragma unroll
    for (int i = 0; i < 8; ++i) { const int e = tid + i * 256, tk = e >> 5, j = e & 31; const int s = sc[e]; int rank = 0;
        for (int k = 0; k < 32; ++k) { const int sk = sc[tk * 32 + k]; rank += (sk > s || (sk == s && k < j)) ? 1 : 0; }
        if (rank < 16) { __hip_atomic_fetch_or(&msk[tk], 1u << j, __ATOMIC_RELAXED, __HIP_MEMORY_SCOPE_WORKGROUP); __hip_atomic_fetch_or(&msk[64], 1u << j, __ATOMIC_RELAXED, __HIP_MEMORY_SCOPE_WORKGROUP); } }
    __syncthreads();
    const int head = 2 * hp + (w >> 1), tk = 32 * (w & 1) + l32, token = 64 * tb + tk; const size_t row = (size_t)b * SEQ + token;
    const unsigned sel = msk[tk], uni = msk[64];
    const bf16_t* H = (const bf16_t*)(ws + OFF_H);
    bf16x8 qf[8]; load_q<128>(H + row * LDH + C_NQ + head * 128, hi, qf);
    KeySrc ks; ks.k0 = H + (size_t)b * SEQ * LDH + C_NKS; ks.kstride = LDH; ks.kr = ks.k0; ks.krstride = 0; ks.v0 = H + (size_t)b * SEQ * LDH + C_NVS; ks.vstride = LDH;
    f32x16 o[4]; zero_o(o); float m = -1e30f, l = 0.f;
    attn_run<128, true>(lds, ks, 0, tb + 1, uni, qf, token, 0x7fffffffu, sel, 0.08838834764831845f * LOG2E, o, m, l, tid);
    const float* gp = (const float*)(ws + OFF_GATES) + row * 18 + head * 3;
    const float g0 = gld<float>(gp), g1 = gld<float>(gp + 1) / l, g2 = gld<float>(gp + 2);
    const bf16_t* pc = (const bf16_t*)(ws + OFF_PC) + row * 768 + head * 128 + 4 * hi; const bf16_t* pw = (const bf16_t*)(ws + OFF_PW) + row * 768 + head * 128 + 4 * hi;
    bf16_t* mx = (bf16_t*)(ws + OFF_MIX) + row * DM + 1280 + head * 128 + 4 * hi;
#pragma unroll
    for (int dt = 0; dt < 4; ++dt)
#pragma unroll
        for (int q = 0; q < 4; ++q) { const u32x2 a = gld<u32x2>(pc + 32 * dt + 8 * q), b = gld<u32x2>(pw + 32 * dt + 8 * q);
            store_bf4(mx + 32 * dt + 8 * q, g0 * bf_lo(a.x) + g1 * o[dt][4 * q] + g2 * bf_lo(b.x), g0 * bf_hi(a.x) + g1 * o[dt][4 * q + 1] + g2 * bf_hi(b.x),
                                            g0 * bf_lo(a.y) + g1 * o[dt][4 * q + 2] + g2 * bf_lo(b.y), g0 * bf_hi(a.y) + g1 * o[dt][4 * q + 3] + g2 * bf_hi(b.y)); }
}
__device__ __forceinline__ void item_dilmix(const Params& p, int it, LAS char* lds) {
    char* ws = ows(p.ws); const int tid = otid();
    const bf16_t* OD = (const bf16_t*)(ws + OFF_ODIL); const float* LD = (const float*)(ws + OFF_LDIL); bf16_t* MIX = (bf16_t*)(ws + OFF_MIX);
    for (int e = tid; e < 64 * 96; e += 256) {
        const size_t row = (size_t)it * 64 + e / 96; const int cc = (e % 96) * 8, h = cc >> 7;
        const float L0 = gld<float>(LD + row * 6 + h), L1 = gld<float>(LD + ((size_t)NT + row) * 6 + h), L2 = gld<float>(LD + ((size_t)2 * NT + row) * 6 + h);
        const float M = fmaxf(L0, fmaxf(L1, L2)); float w0 = __builtin_amdgcn_exp2f(L0 - M), w1 = __builtin_amdgcn_exp2f(L1 - M), w2 = __builtin_amdgcn_exp2f(L2 - M);
        const float inv = 1.f / (w0 + w1 + w2); w0 *= inv; w1 *= inv; w2 *= inv;
        const u32x4 a = gld<u32x4>(OD + row * 768 + cc), bq = gld<u32x4>(OD + ((size_t)NT + row) * 768 + cc), cq = gld<u32x4>(OD + ((size_t)2 * NT + row) * 768 + cc); u32x4 r;
#pragma unroll
        for (int j = 0; j < 4; ++j) r[j] = cvtpk(w0 * bf_lo(a[j]) + w1 * bf_lo(bq[j]) + w2 * bf_lo(cq[j]), w0 * bf_hi(a[j]) + w1 * bf_hi(bq[j]) + w2 * bf_hi(cq[j]));
        gst<u32x4>(MIX + row * DM + 512 + cc, r);
    }
}
__device__ __forceinline__ void phase_attn_d(const Params& p, int ctr_idx, LAS char* lds) {
    unsigned* ctr = (unsigned*)(ows(p.ws) + OFF_CTR) + ctr_idx;
    constexpr int NWIN = 384, NDIL = NB * 6 * 48, NCMP = 384;
    for (;;) { const int it = claim(ctr, lds); if (it >= NWIN + NDIL + NCMP) break;
        if (it < NWIN) item_win(p, it, lds); else if (it < NWIN + NDIL) item_dil(p, it - NWIN, lds); else item_cmp(p, it - NWIN - NDIL, lds); }
}
__device__ __forceinline__ void phase_attn_e(const Params& p, int ctr_idx, LAS char* lds) {
    unsigned* ctr = (unsigned*)(ows(p.ws) + OFF_CTR) + ctr_idx;
    constexpr int NMLA = 256, NSLC = 384, NMIX = NT / 64;
    for (;;) { const int it = claim(ctr, lds); if (it >= NMLA + NSLC + NMIX) break;
        if (it < NMLA) item_mla(p, it, lds); else if (it < NMLA + NSLC) item_slc(p, it - NMLA, lds); else item_dilmix(p, it - NMLA - NSLC, lds); }
}
__device__ __forceinline__ void phase_combine(const Params& p) {
    char* ws = ows(p.ws);
    const bf16_t* OD = (const bf16_t*)(ws + OFF_ODIL); const float* LD = (const float*)(ws + OFF_LDIL);
    const bf16_t* PC = (const bf16_t*)(ws + OFF_PC); const bf16_t* PS = (const bf16_t*)(ws + OFF_PS); const bf16_t* PW = (const bf16_t*)(ws + OFF_PW);
    const float* G = (const float*)(ws + OFF_GATES); bf16_t* MIX = (bf16_t*)(ws + OFF_MIX);
    for (size_t e = (size_t)oblk() * 256 + otid(); e < (size_t)NT * 192; e += (size_t)gridDim.x * 256) {
        const size_t row = e / 192; const int c = (int)(e % 192), isn = c >= 96, cc = (isn ? c - 96 : c) * 8, h = cc >> 7;
        float w0, w1, w2; const bf16_t *s0, *s1, *s2;
        if (!isn) { const float L0 = gld<float>(LD + row * 6 + h), L1 = gld<float>(LD + ((size_t)NT + row) * 6 + h), L2 = gld<float>(LD + ((size_t)2 * NT + row) * 6 + h);
            const float M = fmaxf(L0, fmaxf(L1, L2)); w0 = __builtin_amdgcn_exp2f(L0 - M); w1 = __builtin_amdgcn_exp2f(L1 - M); w2 = __builtin_amdgcn_exp2f(L2 - M);
            const float inv = 1.f / (w0 + w1 + w2); w0 *= inv; w1 *= inv; w2 *= inv;
            s0 = OD + row * 768 + cc; s1 = OD + ((size_t)NT + row) * 768 + cc; s2 = OD + ((size_t)2 * NT + row) * 768 + cc;
        } else { w0 = gld<float>(G + row * 18 + h * 3); w1 = gld<float>(G + row * 18 + h * 3 + 1); w2 = gld<float>(G + row * 18 + h * 3 + 2); s0 = PC + row * 768 + cc; s1 = PS + row * 768 + cc; s2 = PW + row * 768 + cc; }
        const u32x4 a = gld<u32x4>(s0), bq = gld<u32x4>(s1), cq = gld<u32x4>(s2); u32x4 r;
#pragma unroll
        for (int j = 0; j < 4; ++j) r[j] = cvtpk(w0 * bf_lo(a[j]) + w1 * bf_lo(bq[j]) + w2 * bf_lo(cq[j]), w0 * bf_hi(a[j]) + w1 * bf_hi(bq[j]) + w2 * bf_hi(cq[j]));
        gst<u32x4>(MIX + row * DM + 512 + (isn ? 768 : 0) + cc, r);
    }
}

__device__ __forceinline__ void phase_ln(const Params& p, int layer, int mode) {
    char* ws = ows(p.ws); const int tid = otid(), lane = tid & 63, wv = (oblk() * 256 + tid) >> 6, nw = gridDim.x * 4;
    const float* g = p.in[mode ? I_LN2G : I_LN1G] + layer * DM; const float* bb = p.in[mode ? I_LN2B : I_LN1B] + layer * DM;
    for (int row = wv; row < NT; row += nw) {
        f32x4 v[8];
        if (mode == 0) { const float* y = (const float*)(ws + OFF_YB) + (size_t)row * DM;
#pragma unroll
            for (int i = 0; i < 8; ++i) v[i] = gld<f32x4>(y + (i * 64 + lane) * 4);
        } else { const float* x1 = (const float*)(ws + OFF_X1) + (size_t)row * DM; const bf16_t* y0 = (const bf16_t*)(ws + OFF_Y) + (size_t)(2 * row) * DM; const bf16_t* y1 = y0 + DM;
#pragma unroll
            for (int i = 0; i < 8; ++i) { const int c = (i * 64 + lane) * 4; const f32x4 xv = gld<f32x4>(x1 + c); const u32x2 a = gld<u32x2>(y0 + c), b2 = gld<u32x2>(y1 + c);
                v[i][0] = DN_ALPHA * xv[0] + bf_lo(a.x) + bf_lo(b2.x); v[i][1] = DN_ALPHA * xv[1] + bf_hi(a.x) + bf_hi(b2.x);
                v[i][2] = DN_ALPHA * xv[2] + bf_lo(a.y) + bf_lo(b2.y); v[i][3] = DN_ALPHA * xv[3] + bf_hi(a.y) + bf_hi(b2.y); }
        }
        float s = 0.f;
#pragma unroll
        for (int i = 0; i < 8; ++i) s += (v[i][0] + v[i][1]) + (v[i][2] + v[i][3]);
        const float mu = wave_sum(s) * (1.f / DM);
        float q = 0.f;
#pragma unroll
        for (int i = 0; i < 8; ++i) { const f32x4 d = v[i] - mu; q += (d[0] * d[0] + d[1] * d[1]) + (d[2] * d[2] + d[3] * d[3]); }
        const float rstd = 1.f / sqrtf(wave_sum(q) * (1.f / DM) + 1e-5f);
        float* of = mode == 0 ? (float*)(ws + OFF_X1) + (size_t)row * DM : (layer == DEPTH - 1 ? p.out + (size_t)row * DM : (float*)(ws + OFF_XA) + (size_t)row * DM);
        bf16_t* ob = mode == 0 ? (bf16_t*)(ws + OFF_X1B) + (size_t)row * DM : (bf16_t*)(ws + OFF_XB) + (size_t)row * DM;
#pragma unroll
        for (int i = 0; i < 8; ++i) { const int c = (i * 64 + lane) * 4; const f32x4 gv = gld<f32x4>(g + c), bv = gld<f32x4>(bb + c);
            f32x4 o = (v[i] - mu) * rstd * gv + bv; gst<f32x4>(of + c, o);
            if (mode == 0 || layer < DEPTH - 1) store_bf4(ob + c, o[0], o[1], o[2], o[3]); }
    }
}
__device__ __forceinline__ void ln1_row(char* ws, const float* g, const float* bb, int row, int lane) {
    const float* y = (const float*)(ws + OFF_YB) + (size_t)row * DM;
    f32x4 v[8];
#pragma unroll
    for (int i = 0; i < 8; ++i) v[i] = gld<f32x4>(y + (i * 64 + lane) * 4);
    float s = 0.f;
#pragma unroll
    for (int i = 0; i < 8; ++i) s += (v[i][0] + v[i][1]) + (v[i][2] + v[i][3]);
    const float mu = wave_sum(s) * (1.f / DM);
    float q = 0.f;
#pragma unroll
    for (int i = 0; i < 8; ++i) { const f32x4 d = v[i] - mu; q += (d[0] * d[0] + d[1] * d[1]) + (d[2] * d[2] + d[3] * d[3]); }
    const float rstd = 1.f / sqrtf(wave_sum(q) * (1.f / DM) + 1e-5f);
    float* of = (float*)(ws + OFF_X1) + (size_t)row * DM; bf16_t* ob = (bf16_t*)(ws + OFF_X1B) + (size_t)row * DM;
#pragma unroll
    for (int i = 0; i < 8; ++i) { const int c = (i * 64 + lane) * 4; const f32x4 gv = gld<f32x4>(g + c), bv = gld<f32x4>(bb + c);
        const f32x4 o = (v[i] - mu) * rstd * gv + bv; gst<f32x4>(of + c, o); store_bf4(ob + c, o[0], o[1], o[2], o[3]); }
}
__device__ __forceinline__ void phase_router(const Params& p, int layer, LAS char* lds) {
    char* ws = ows(p.ws); const int tid = otid(), lane = tid & 63, w = tid >> 6, l32 = lane & 31, hi = lane >> 5;
    const float* X1 = (const float*)(ws + OFF_X1); const float* We = p.in[I_WEXP] + (size_t)layer * DM * 32; const float* Wg = p.in[I_WGRP] + (size_t)layer * DM * 4;
    const float* lng = p.in[I_LN1G] + layer * DM; const float* lnb = p.in[I_LN1B] + layer * DM;
    LAS float* red = (LAS float*)lds;
    unsigned* ecnt = (unsigned*)(ws + OFF_ECNT); int* list = (int*)(ws + OFF_LIST); float* gw = (float*)(ws + OFF_GW);
    for (int it = oblk(); it < NT / 32; it += gridDim.x) {
        const int t0 = it * 32;
        for (int r = 0; r < 8; ++r) ln1_row(ws, lng, lnb, t0 + 8 * w + r, lane);
        asm volatile("s_waitcnt vmcnt(0)" ::: "memory");
        __syncthreads();
        f32x16 ae, ag;
#pragma unroll
        for (int r = 0; r < 16; ++r) { ae[r] = 0.f; ag[r] = 0.f; }
        const float* xr = X1 + (size_t)(t0 + l32) * DM + w * 512 + 4 * hi;
        const float* wer = We + (size_t)(w * 512 + 4 * hi) * 32 + l32;
        const float* wgr = Wg + (size_t)(w * 512 + 4 * hi) * 4 + (l32 & 3);
        f32x4 xa[4], xb[4]; float wea[4][4], web[4][4], wga[4][4], wgb[4][4];
#define RT_LOAD(X, WE, WG, KC) do { _Pragma("unroll") for (int i_ = 0; i_ < 4; ++i_) { X[i_] = gld<f32x4>(xr + (KC) + 8 * i_); \
            _Pragma("unroll") for (int j_ = 0; j_ < 4; ++j_) { WE[i_][j_] = gld<float>(wer + (size_t)((KC) + 8 * i_ + j_) * 32); WG[i_][j_] = l32 < 4 ? gld<float>(wgr + (size_t)((KC) + 8 * i_ + j_) * 4) : 0.f; } } } while (0)
#define RT_MMA(X, WE, WG) do { _Pragma("unroll") for (int i_ = 0; i_ < 4; ++i_) _Pragma("unroll") for (int j_ = 0; j_ < 4; ++j_) { \
            ae = __builtin_amdgcn_mfma_f32_32x32x2f32(X[i_][j_], WE[i_][j_], ae, 0, 0, 0); ag = __builtin_amdgcn_mfma_f32_32x32x2f32(X[i_][j_], WG[i_][j_], ag, 0, 0, 0); } } while (0)
        RT_LOAD(xa, wea, wga, 0);
        for (int kc = 0; kc < 512; kc += 64) {
            RT_LOAD(xb, web, wgb, kc + 32);
            RT_MMA(xa, wea, wga);
            if (kc + 64 < 512) RT_LOAD(xa, wea, wga, kc + 64);
            RT_MMA(xb, web, wgb);
        }
#undef RT_LOAD
#undef RT_MMA
        __syncthreads();
#pragma unroll
        for (int r = 0; r < 16; ++r) { const int tk = crow(r, hi); red[(w * 32 + tk) * 36 + l32] = ae[r]; if (l32 < 4) red[(w * 32 + tk) * 36 + 32 + l32] = ag[r]; }
        __syncthreads();
        if (tid < 32) {
            const int tk = tid;
            float lg[4];
#pragma unroll
            for (int j = 0; j < 4; ++j) lg[j] = (red[(0 * 32 + tk) * 36 + 32 + j] + red[(1 * 32 + tk) * 36 + 32 + j]) + (red[(2 * 32 + tk) * 36 + 32 + j] + red[(3 * 32 + tk) * 36 + 32 + j]);
            int gi = 0; float gm = lg[0];
#pragma unroll
            for (int j = 1; j < 4; ++j) if (lg[j] > gm) { gm = lg[j]; gi = j; }
            float den = 0.f;
#pragma unroll
            for (int j = 0; j < 4; ++j) den += __expf(lg[j] - gm);
            const float pg = 1.f / den;
            float b0 = -__builtin_inff(), b1 = -__builtin_inff(); int i0 = 0, i1 = 0;
#pragma unroll
            for (int j = 0; j < 8; ++j) { const int n = gi * 8 + j;
                const float v = (red[(0 * 32 + tk) * 36 + n] + red[(1 * 32 + tk) * 36 + n]) + (red[(2 * 32 + tk) * 36 + n] + red[(3 * 32 + tk) * 36 + n]);
                if (v > b0) { b1 = b0; i1 = i0; b0 = v; i0 = j; } else if (v > b1) { b1 = v; i1 = j; } }
            const float w1 = __expf(b1 - b0), g0 = pg / (1.f + w1), g1 = pg * w1 / (1.f + w1);
            const int tok = t0 + tk, e0 = gi * 8 + i0, e1 = gi * 8 + i1;
            const unsigned p0 = atomicAdd(&ecnt[e0], 1u), p1 = atomicAdd(&ecnt[e1], 1u);
            list[(size_t)e0 * NT + p0] = 2 * tok; list[(size_t)e1 * NT + p1] = 2 * tok + 1;
            gw[2 * tok] = g0; gw[2 * tok + 1] = g1;
        }
        __syncthreads();
    }
}
__device__ __forceinline__ int moe_table(const Params& p, LAS char* lds) {
    LAS int* off = (LAS int*)(lds + LDS_CTL + 128); LAS int* toff = off + 33;
    __syncthreads();
    if (otid() == 0) { const unsigned* ecnt = (const unsigned*)(ows(p.ws) + OFF_ECNT); int a = 0, t = 0;
        for (int e = 0; e < NEXP; ++e) { off[e] = a; toff[e] = t; const int c = (int)ecnt[e]; a += c; t += (c + 127) >> 7; } off[NEXP] = a; toff[NEXP] = t; }
    __syncthreads();
    return toff[NEXP];
}
__device__ __forceinline__ void phase_moe1(const Params& p, LAS char* lds) {
    char* ws = ows(p.ws); const int tid = otid(), sr = tid >> 3, sc = (tid & 7) * 8;
    const int ntile = moe_table(p, lds); const LAS int* off = (const LAS int*)(lds + LDS_CTL + 128); const LAS int* toff = off + 33;
    const unsigned* ecnt = (const unsigned*)(ws + OFF_ECNT); const int* list = (const int*)(ws + OFF_LIST);
    const bf16_t* X1B = (const bf16_t*)(ws + OFF_X1B);
    for (int u = oblk(); u < ntile * 4; u += gridDim.x) {
        int e = 0; for (int k = 1; k < NEXP; ++k) if (u >= toff[k] * 4) e = k;
        const int mte = toff[e + 1] - toff[e], v = u - toff[e] * 4, nt = v / mte, mt = v - nt * mte;
        const int cnt = (int)ecnt[e], nvalid = cnt - mt * 128 < 128 ? cnt - mt * 128 : 128;
        const int* le = list + (size_t)e * NT + mt * 128;
        unsigned ao[4];
#pragma unroll
        for (int i = 0; i < 4; ++i) { const int r = sr + 32 * i; ao[i] = (unsigned)((gld<int>(le + (r < nvalid ? r : 0)) >> 1) * DM + sc); }
        EpiMoe1 ep{(bf16_t*)(ws + OFF_HM), off[e] + mt * 128, nvalid, nt * 256};
        gemm_unit(lds, X1B, ao, 128, (const bf16_t*)(ws + OFF_WGU_T) + ((size_t)e * 1024 + nt * 256) * DM, (unsigned)(sr * DM + sc), (size_t)32 * DM, DM / 64, ep);
    }
}
__device__ __forceinline__ void phase_moe2(const Params& p, LAS char* lds) {
    char* ws = ows(p.ws); const int tid = otid(), sr = tid >> 3, sc = (tid & 7) * 8;
    const int ntile = moe_table(p, lds); const LAS int* off = (const LAS int*)(lds + LDS_CTL + 128); const LAS int* toff = off + 33;
    const unsigned* ecnt = (const unsigned*)(ws + OFF_ECNT); const int* list = (const int*)(ws + OFF_LIST);
    const bf16_t* HM = (const bf16_t*)(ws + OFF_HM);
    for (int u = oblk(); u < ntile * 8; u += gridDim.x) {
        int e = 0; for (int k = 1; k < NEXP; ++k) if (u >= toff[k] * 8) e = k;
        const int mte = toff[e + 1] - toff[e], v = u - toff[e] * 8, nt = v / mte, mt = v - nt * mte;
        const int cnt = (int)ecnt[e], nvalid = cnt - mt * 128 < 128 ? cnt - mt * 128 : 128;
        const unsigned ao[4] = AO4(EFF);
        EpiMoe2 ep{(bf16_t*)(ws + OFF_Y), list + (size_t)e * NT + mt * 128, (const float*)(ws + OFF_GW), nvalid, nt * 256};
        gemm_unit(lds, HM + (size_t)(off[e] + mt * 128) * EFF, ao, 128, (const bf16_t*)(ws + OFF_WD_T) + ((size_t)e * DM + nt * 256) * EFF, (unsigned)(sr * EFF + sc), (size_t)32 * EFF, EFF / 64, ep);
    }
}

__device__ __forceinline__ Params load_params() {
    Params q;
#if defined(__HIP_DEVICE_COMPILE__)
    const CAS Params* pp = (const CAS Params*)__builtin_amdgcn_kernarg_segment_ptr(); asm volatile("" : "+s"(pp));
#pragma unroll
    for (int i = 0; i < 22; ++i) q.in[i] = pp->in[i];
    q.out = pp->out; q.ws = pp->ws;
#endif
    return q;
}
constexpr int REP_PREP = 1, REP_GEMM = 1, REP_ATTN = 1;
__global__ void __launch_bounds__(256, 2) fwd_kernel(Params p) {
    extern __shared__ __attribute__((aligned(16))) char lds_raw[];
    LAS char* lds = (LAS char*)lds_raw;
    if (threadIdx.x == 0) { *(LAS u32x4*)(lds + LDS_CTL) = (u32x4){0u, 0u, 0u, 0u}; }
    __syncthreads();
    XcdBarrier bar = xcd_barrier_post((unsigned*)(p.ws + OFF_BAR), (volatile LAS unsigned*)(lds + LDS_CTL));
    for (int layer = 0; layer < DEPTH; ++layer) {
        for (int r = 0; r < REP_PREP; ++r) { phase_prep(load_params(), layer, lds);              xcd_barrier(bar); }
        for (int r = 0; r < REP_GEMM; ++r) { phase_win(load_params(), layer, lds);               xcd_barrier(bar); }
        phase_up(load_params(), layer, lds);                xcd_barrier(bar);
        phase_cmp2(load_params(), layer, lds);              xcd_barrier(bar);
        for (int r = 0; r < REP_ATTN; ++r) { phase_attn_d(load_params(), 64 * (2 * layer) + 16 * r, lds);       xcd_barrier(bar); }
        for (int r = 0; r < REP_ATTN; ++r) { phase_attn_e(load_params(), 64 * (2 * layer + 1) + 16 * r, lds);   xcd_barrier(bar); }
        for (int r = 0; r < REP_GEMM; ++r) { phase_out(load_params(), layer, lds);               xcd_barrier(bar); }
        phase_router(load_params(), layer, lds);            xcd_barrier(bar);
        for (int r = 0; r < REP_GEMM; ++r) { phase_moe1(load_params(), lds);                     xcd_barrier(bar); }
        for (int r = 0; r < REP_GEMM; ++r) { phase_moe2(load_params(), lds);                     xcd_barrier(bar); }
        phase_ln(load_params(), layer, 1);                  xcd_barrier(bar);
    }
}

extern "C" void kernel_launch(void* const* d_in, const int* in_sizes, int n_in, void* d_out, int out_size, void* d_ws, size_t ws_size, hipStream_t stream) {
    (void)in_sizes; (void)out_size;
    static int grid = 0;
    if (!grid) {
        int dev = 0, cus = 0, per_cu = 0;
        (void)hipGetDevice(&dev);
        (void)hipDeviceGetAttribute(&cus, hipDeviceAttributeMultiprocessorCount, dev);
        (void)hipFuncSetAttribute((const void*)fwd_kernel, hipFuncAttributeMaxDynamicSharedMemorySize, LDS_BYTES);
        (void)hipOccupancyMaxActiveBlocksPerMultiprocessor(&per_cu, (const void*)fwd_kernel, 256, LDS_BYTES);
        if (cus <= 0) cus = 256;
        if (per_cu < 1) per_cu = 1;
        grid = cus * (per_cu < 2 ? per_cu : 2);
    }
    if (n_in < 22 || ws_size < WS_TOTAL) { fprintf(stderr, "kernel_launch: bad arguments (n_in %d, ws %zu < %zu)\n", n_in, ws_size, (size_t)WS_TOTAL); return; }
    Params p;
    for (int i = 0; i < 22; ++i) p.in[i] = (const float*)d_in[i];
    p.out = (float*)d_out; p.ws = (char*)d_ws;
    (void)hipMemsetAsync(d_ws, 0, ZERO_BYTES, stream);
    fwd_kernel<<<dim3(grid), dim3(256), LDS_BYTES, stream>>>(p);
}
```

```cpp
#include <hip/hip_runtime.h>
#include <stdint.h>
#include <stdio.h>

#define LAS __attribute__((address_space(3)))
#define GAS __attribute__((address_space(1)))
#define CAS __attribute__((address_space(4)))
typedef unsigned short bf16_t;
typedef short bf16x8 __attribute__((ext_vector_type(8)));
typedef short s16x4 __attribute__((ext_vector_type(4)));
typedef float f32x16 __attribute__((ext_vector_type(16)));
typedef float f32x4 __attribute__((ext_vector_type(4)));
typedef float f32x2 __attribute__((ext_vector_type(2)));
typedef unsigned u32x4 __attribute__((ext_vector_type(4)));
typedef unsigned u32x2 __attribute__((ext_vector_type(2)));

constexpr int NB = 4, SEQ = 2048, NT = NB * SEQ, DM = 2048, DEPTH = 2;
constexpr int INC = 4434, LDH = 4608;
constexpr int C_QLAT = 0, C_KVLAT = 384, C_KROPE = 512, C_DQ = 576, C_DK = 1344, C_DV = 2112, C_NQ = 2880, C_NKC = 3648, C_NVC = 3776,
              C_NKS = 3904, C_NVS = 4032, C_NKW = 4160, C_NVW = 4288, C_GATE = 4416;
constexpr int NEXP = 32, EFF = 512;
constexpr float DN_ALPHA = 1.41421356237309515f;
constexpr float LOG2E = 1.4426950408889634f;

constexpr size_t al256(size_t x) { return (x + 255) & ~(size_t)255; }
constexpr size_t OFF_BAR = 0;
constexpr size_t OFF_CTR = 16384;
constexpr size_t ZERO_BYTES = 20480;
constexpr size_t OFF_ECNT = ZERO_BYTES;
constexpr size_t OFF_CS16 = OFF_ECNT + 256;
constexpr size_t OFF_CS32 = OFF_CS16 + (size_t)SEQ * 16 * 8;
constexpr size_t OFF_WIN_T = OFF_CS32 + (size_t)SEQ * 32 * 8;
constexpr size_t OFF_WQ_T = OFF_WIN_T + (size_t)LDH * DM * 2;
constexpr size_t OFF_WKV_T = OFF_WQ_T + (size_t)768 * 384 * 2;
constexpr size_t OFF_W1K_T = OFF_WKV_T + (size_t)1024 * 128 * 2;
constexpr size_t OFF_W1V_T = OFF_W1K_T + (size_t)256 * 4096 * 2;
constexpr size_t OFF_W2K_T = OFF_W1V_T + (size_t)256 * 4096 * 2;
constexpr size_t OFF_W2V_T = OFF_W2K_T + (size_t)256 * 256 * 2;
constexpr size_t OFF_WOUT_T = OFF_W2V_T + (size_t)256 * 256 * 2;
constexpr size_t OFF_WGU_T = OFF_WOUT_T + (size_t)DM * DM * 2;
constexpr size_t OFF_WD_T = OFF_WGU_T + (size_t)NEXP * 1024 * DM * 2;
constexpr size_t OFF_B1P = OFF_WD_T + (size_t)NEXP * DM * EFF * 2;
constexpr size_t OFF_XB = OFF_B1P + (size_t)2 * 16 * 256 * 4;
constexpr size_t OFF_H = OFF_XB + (size_t)NT * DM * 2;
constexpr size_t OFF_GATES = OFF_H + (size_t)NT * LDH * 2;
constexpr size_t OFF_QM = OFF_GATES + al256((size_t)NT * 18 * 4);
constexpr size_t OFF_KN = OFF_QM + (size_t)NT * 768 * 2;
constexpr size_t OFF_VM = OFF_KN + (size_t)NT * 512 * 2;
static_assert(OFF_VM == OFF_KN + (size_t)NT * 512 * 2, "Vm must follow Kn");
constexpr size_t OFF_HC = OFF_VM + (size_t)NT * 512 * 2;
constexpr size_t OFF_HCP = OFF_HC + (size_t)2 * 512 * 256 * 2;
constexpr size_t OFF_KC = OFF_HCP + (size_t)8 * 2 * 512 * 256 * 4;
constexpr size_t OFF_VC = OFF_KC + (size_t)512 * 128 * 2;
constexpr size_t OFF_IMP = OFF_VC + (size_t)512 * 128 * 2;
constexpr size_t OFF_ODIL = OFF_IMP + (size_t)NT * 32 * 4;
constexpr size_t OFF_LDIL = OFF_ODIL + (size_t)3 * NT * 768 * 2;
constexpr size_t OFF_PC = OFF_LDIL + (size_t)3 * NT * 6 * 4;
constexpr size_t OFF_PS = OFF_PC + (size_t)NT * 768 * 2;
constexpr size_t OFF_PW = OFF_PS + (size_t)NT * 768 * 2;
constexpr size_t OFF_MIX = OFF_PW + (size_t)NT * 768 * 2;
constexpr size_t OFF_YB = OFF_MIX + (size_t)NT * DM * 2;
constexpr size_t OFF_XA = OFF_YB + (size_t)NT * DM * 4;
constexpr size_t OFF_X1 = OFF_XA + (size_t)NT * DM * 4;
constexpr size_t OFF_X1B = OFF_X1 + (size_t)NT * DM * 4;
constexpr size_t OFF_HM = OFF_X1B + (size_t)NT * DM * 2;
constexpr size_t OFF_Y = OFF_HM + (size_t)(2 * NT + 128) * EFF * 2;
constexpr size_t OFF_LIST = OFF_Y + (size_t)2 * NT * DM * 2;
constexpr size_t OFF_GW = OFF_LIST + (size_t)NEXP * NT * 4;
constexpr size_t WS_TOTAL = OFF_GW + (size_t)2 * NT * 4;

struct Params { const float* in[22]; float* out; char* ws; };
enum { I_X = 0, I_WIN, I_QLN, I_WQUP, I_KVLN, I_WKVUP, I_PEK, I_W1K, I_W2K, I_PEV, I_W1V, I_W2V, I_WOUT, I_LN1G, I_LN1B, I_WGRP, I_WEXP, I_WGATE, I_WUP, I_WDOWN, I_LN2G, I_LN2B };

#define XB_TMO      128
#define XB_XCNT(j)  (256  + 64 * (j))
#define XB_XSUB(j)  (1280 + 64 * (j))
#define XB_XGEN(j)  (2304 + 64 * (j))
#define XB_TOP      3328
#define XB_TOPGEN   3392
#define XCD_BAR_WORDS 3456
#define XB_SPIN_CAP (1u << 18)

__device__ __forceinline__ unsigned xb_ld(unsigned* p)              { return __hip_atomic_load(p, __ATOMIC_RELAXED, __HIP_MEMORY_SCOPE_AGENT); }
__device__ __forceinline__ unsigned xb_add(unsigned* p, unsigned v) { return __hip_atomic_fetch_add(p, v, __ATOMIC_RELAXED, __HIP_MEMORY_SCOPE_AGENT); }
__device__ __forceinline__ unsigned xb_xcc_id() { return (unsigned)__builtin_amdgcn_s_getreg((3 << 11) | 20) & 0xFu; }
#define XB_SPIN(cond, bar) do { unsigned _sp = 0; while (cond) { __builtin_amdgcn_s_sleep(1); \
    if ((++_sp & 255u) == 0u) { if (xb_ld(&(bar)[XB_TMO])) break; if (_sp > XB_SPIN_CAP) { atomicAdd(&(bar)[XB_TMO], 1u); break; } } } } while (0)

struct XcdBarrier { unsigned* bar; unsigned x; volatile LAS unsigned* st; };

__device__ __forceinline__ XcdBarrier xcd_barrier_post(unsigned* bar, volatile LAS unsigned* st) {
    XcdBarrier b; b.bar = bar; b.x = xb_xcc_id(); b.st = st;
    if (threadIdx.x == 0) (void)xb_add(&bar[XB_XCNT(b.x)], 1u);
    return b;
}
__device__ __forceinline__ void xcd_barrier_complete(unsigned* bar, unsigned x, unsigned& nloc, unsigned& nx) {
    const unsigned G = gridDim.x * gridDim.y * gridDim.z;
    unsigned sum, cnt, mine, sp = 0u;
    for (;;) {
        sum = 0u; cnt = 0u; mine = 0u;
#pragma unroll
        for (unsigned j = 0; j < 16; ++j) { const unsigned c = xb_ld(&bar[XB_XCNT(j)]); sum += c; cnt += (c > 0u) ? 1u : 0u; mine = (j == x) ? c : mine; }
        if (sum == G) break;
        __builtin_amdgcn_s_sleep(1);
        if ((++sp & 255u) == 0u) { if (xb_ld(&bar[XB_TMO])) break; if (sp > XB_SPIN_CAP) { atomicAdd(&bar[XB_TMO], 1u); break; } }
    }
    nloc = mine > 0u ? mine : 1u; nx = cnt > 0u ? cnt : 1u;
}
__device__ __forceinline__ void xcd_barrier(const XcdBarrier& b) {
    asm volatile("s_waitcnt vmcnt(0)" ::: "memory");
    __syncthreads();
    if (threadIdx.x == 0) {
        unsigned* bar = b.bar;
        __builtin_amdgcn_s_waitcnt(0);
        unsigned nloc = b.st[0], nx = b.st[1];
        if (nloc == 0u) { xcd_barrier_complete(bar, b.x, nloc, nx); b.st[0] = nloc; b.st[1] = nx; }
        const unsigned old = xb_add(&bar[XB_XSUB(b.x)], 1u);
        const unsigned gen = old / nloc;
        if (old + 1u == (gen + 1u) * nloc) {
            __builtin_amdgcn_fence(__ATOMIC_RELEASE, "agent");
            asm volatile("s_waitcnt vmcnt(0)" ::: "memory");
            const unsigned og = xb_add(&bar[XB_TOP], 1u);
            const unsigned tg = og / nx;
            if (og + 1u == (tg + 1u) * nx) xb_add(&bar[XB_TOPGEN], 1u);
            else XB_SPIN(xb_ld(&bar[XB_TOPGEN]) == tg, bar);
            __builtin_amdgcn_fence(__ATOMIC_ACQUIRE, "agent");
            xb_add(&bar[XB_XGEN(b.x)], 1u);
            asm volatile("s_waitcnt vmcnt(0)" ::: "memory");
        } else {
            XB_SPIN(xb_ld(&bar[XB_XGEN(b.x)]) == gen, bar);
            __builtin_amdgcn_fence(__ATOMIC_ACQUIRE, "agent");
            asm volatile("s_waitcnt vmcnt(0)" ::: "memory");
        }
    }
    __syncthreads();
}

template <class T> __device__ __forceinline__ T gld(const void* p) { return *(const GAS T*)p; }
template <class T> __device__ __forceinline__ void gst(void* p, const T& v) { *(GAS T*)p = v; }
__device__ __forceinline__ __amdgpu_buffer_rsrc_t mk_rsrc(const void* p) {
    const unsigned long long v = (unsigned long long)p;
    const unsigned lo = __builtin_amdgcn_readfirstlane((unsigned)v), hi = __builtin_amdgcn_readfirstlane((unsigned)(v >> 32));
    return __builtin_amdgcn_make_buffer_rsrc((void*)(((unsigned long long)hi << 32) | lo), 0, 0xFFFFFFF0u, 0x00020000);
}
__device__ __forceinline__ bf16x8 bld8(__amdgpu_buffer_rsrc_t r, unsigned voff, int soff) { const u32x4 v = __builtin_amdgcn_raw_buffer_load_b128(r, (int)voff, soff, 0); return __builtin_bit_cast(bf16x8, v); }
__device__ __forceinline__ unsigned cvtpk(float lo, float hi) { unsigned r; asm volatile("v_cvt_pk_bf16_f32 %0, %1, %2" : "=v"(r) : "v"(lo), "v"(hi)); return r; }
__device__ __forceinline__ float bf_lo(unsigned u) { return __uint_as_float(u << 16); }
__device__ __forceinline__ float bf_hi(unsigned u) { return __uint_as_float(u & 0xffff0000u); }
__device__ __forceinline__ float bf2f(bf16_t b) { return __uint_as_float((unsigned)b << 16); }
__device__ __forceinline__ float wave_sum(float v) {
#pragma unroll
    for (int o = 32; o >= 1; o >>= 1) v += __shfl_xor(v, o);
    return v;
}
__device__ __forceinline__ int otid() { int t = threadIdx.x; asm volatile("" : "+v"(t)); return t; }
__device__ __forceinline__ int oblk() { int b = blockIdx.x; asm volatile("" : "+s"(b)); return b; }
__device__ __forceinline__ char* ows(const char* w) { char* q = const_cast<char*>(w); asm volatile("" : "+s"(q)); return q; }
__device__ __forceinline__ int crow(int r, int hi) { return (r & 3) + 8 * (r >> 2) + 4 * hi; }

constexpr int LDS_BYTES = 65536;
constexpr int LDS_CTL = 65024;

constexpr int GS = 72;
constexpr int G_BOFF = 128 * GS * 2;
constexpr int G_ROWSS = 384 * GS * 2;

template <class EPI>
__device__ __forceinline__ void gemm_unit(LAS char* lds, const bf16_t* abase, const unsigned (&aoff)[4], int ajump, const bf16_t* bbase, unsigned boff, size_t ldb32, int nkt, const EPI& epi) {
    const int tid = otid(), lane = tid & 63, w = tid >> 6, l32 = lane & 31, hi = lane >> 5;
    const int wm = w >> 1, wn = w & 1;
    const int sr = tid >> 3, sc = (tid & 7) * 8;
    const int st_off = (sr * GS + sc) * 2;
    const int a_rd = ((wm * 64 + l32) * GS + hi * 8) * 2;
    const int b_rd = G_BOFF + ((wn * 128 + l32) * GS + hi * 8) * 2;
    f32x16 acc[2][4];
#pragma unroll
    for (int i = 0; i < 2; ++i)
#pragma unroll
        for (int j = 0; j < 4; ++j)
#pragma unroll
            for (int r = 0; r < 16; ++r) acc[i][j][r] = 0.f;
    bf16x8 ra[4], rb[8];
    const __amdgpu_buffer_rsrc_t rsa = mk_rsrc(abase), rsb = mk_rsrc(bbase);
    const int lb2 = (int)(ldb32 * 2);
#pragma unroll
    for (int i = 0; i < 4; ++i) ra[i] = bld8(rsa, 2u * aoff[i], 0);
#pragma unroll
    for (int i = 0; i < 8; ++i) rb[i] = bld8(rsb, 2u * boff, i * lb2);
    for (int kt = 0; kt < nkt; ++kt) {
#pragma unroll
        for (int i = 0; i < 4; ++i) *(LAS bf16x8*)(lds + st_off + i * 32 * GS * 2) = ra[i];
#pragma unroll
        for (int i = 0; i < 8; ++i) *(LAS bf16x8*)(lds + G_BOFF + st_off + i * 32 * GS * 2) = rb[i];
        __syncthreads();
        if (kt + 1 < nkt) {
            const int k = (kt + 1) * 64;
            const int ao = (k >> 7) * ajump + (k & 127);
#pragma unroll
            for (int i = 0; i < 4; ++i) ra[i] = bld8(rsa, 2u * aoff[i], 2 * ao);
#pragma unroll
            for (int i = 0; i < 8; ++i) rb[i] = bld8(rsb, 2u * boff, i * lb2 + 2 * k);
        }
#pragma unroll
        for (int ks = 0; ks < 4; ++ks) {
            bf16x8 af[2], bfr[4];
#pragma unroll
            for (int i = 0; i < 2; ++i) af[i] = *(const LAS bf16x8*)(lds + a_rd + i * 32 * GS * 2 + ks * 32);
#pragma unroll
            for (int j = 0; j < 4; ++j) bfr[j] = *(const LAS bf16x8*)(lds + b_rd + j * 32 * GS * 2 + ks * 32);
#pragma unroll
            for (int i = 0; i < 2; ++i)
#pragma unroll
                for (int j = 0; j < 4; ++j) acc[i][j] = __builtin_amdgcn_mfma_f32_32x32x16_bf16(bfr[j], af[i], acc[i][j], 0, 0, 0);
            if (ks & 1) asm volatile("" ::: "memory");
        }
        __syncthreads();
    }
    epi(acc, wm, wn, l32, hi, lds);
}
template <int K> __device__ __forceinline__ void row_sumsq(LAS char* lds, const bf16_t* A, int ld) {
    const int tid = otid(), row = tid >> 1, half = tid & 1;
    const bf16_t* ptr = A + (size_t)row * ld + half * (K / 2);
    float ss = 0.f;
#pragma unroll
    for (int c = 0; c < K / 16; ++c) { const u32x4 v = gld<u32x4>(ptr + c * 8);
#pragma unroll
        for (int j = 0; j < 4; ++j) { const float a = bf_lo(v[j]), b = bf_hi(v[j]); ss += a * a + b * b; } }
    ss += __shfl_xor(ss, 1);
    __syncthreads();
    if (half == 0) ((LAS float*)(lds + G_ROWSS))[row] = ss;
}

__device__ __forceinline__ void store_bf4(bf16_t* p, float a, float b, float c, float d) { u32x2 w; w.x = cvtpk(a, b); w.y = cvtpk(c, d); gst<u32x2>(p, w); }

__device__ __forceinline__ void store_tiles4(bf16_t* p, const f32x16 (&a)[4], float sc) {
#pragma unroll
    for (int ni = 0; ni < 4; ++ni)
#pragma unroll
        for (int q = 0; q < 4; ++q) store_bf4(p + 32 * ni + 8 * q, a[ni][4 * q] * sc, a[ni][4 * q + 1] * sc, a[ni][4 * q + 2] * sc, a[ni][4 * q + 3] * sc);
}
__device__ __forceinline__ void rope_pair32(f32x16& lo, f32x16& hi16, const f32x2* cs32, int pos, int hi, bool on = true) {
#pragma unroll
    for (int r = 0; r < 16; ++r) { f32x2 cs = {1.f, 0.f}; if (on) cs = gld<f32x2>(cs32 + pos * 32 + crow(r, hi)); const float x1 = lo[r], x2 = hi16[r]; lo[r] = x1 * cs.x - x2 * cs.y; hi16[r] = x2 * cs.x + x1 * cs.y; }
}
__device__ __forceinline__ void rope_first32(f32x16& t, const f32x2* cs16, int pos, int hi) {
#pragma unroll
    for (int r = 0; r < 8; ++r) { const f32x2 cs = gld<f32x2>(cs16 + pos * 16 + crow(r, hi)); const float x1 = t[r], x2 = t[r + 8]; t[r] = x1 * cs.x - x2 * cs.y; t[r + 8] = x2 * cs.x + x1 * cs.y; }
}
__device__ __forceinline__ bool is_rope16(int c0) {
    return (((c0 - C_DQ) & 127) == 0) && ((c0 >= C_DQ && c0 < C_DV) || (c0 >= C_NQ && c0 < C_NKC) || c0 == C_NKS || c0 == C_NKW);
}
struct EpiWin {
    bf16_t* H; float* gates; const f32x2* cs16; const f32x2* cs32; int m0, n0;
    __device__ __forceinline__ void operator()(f32x16 (&acc)[2][4], int wm, int wn, int l32, int hi, LAS char*) const {
        const int nw = n0 + 128 * wn;
#pragma unroll
        for (int mi = 0; mi < 2; ++mi) {
            const int row = m0 + 64 * wm + 32 * mi + l32, pos = row & (SEQ - 1);
            if (nw == C_KROPE) rope_pair32(acc[mi][0], acc[mi][1], cs32, pos, hi);
#pragma unroll
            for (int ni = 0; ni < 4; ++ni) if (is_rope16(nw + 32 * ni)) rope_first32(acc[mi][ni], cs16, pos, hi);
            if (nw == C_GATE - 64) {
#pragma unroll
                for (int r = 0; r < 16; ++r) { const int c = crow(r, hi); if (c < 18) gst<float>(gates + (size_t)row * 18 + c, 1.f / (1.f + __expf(-acc[mi][2][r]))); }
            }
            store_tiles4(H + (size_t)row * LDH + nw + 4 * hi, acc[mi], 1.f);
        }
    }
};
struct EpiQup {
    bf16_t* Q; const f32x2* cs32; int m0, n0;
    __device__ __forceinline__ void operator()(f32x16 (&acc)[2][4], int wm, int wn, int l32, int hi, LAS char* lds) const {
        const int nw = n0 + 128 * wn; const LAS float* rs = (const LAS float*)(lds + G_ROWSS);
#pragma unroll
        for (int mi = 0; mi < 2; ++mi) {
            const int rl = 64 * wm + 32 * mi + l32, row = m0 + rl, pos = row & (SEQ - 1);
            const float sc = __builtin_amdgcn_rsqf(rs[rl] * (1.f / 384.f) + 1e-6f);
#pragma unroll
            for (int ni = 0; ni < 4; ++ni)
#pragma unroll
                for (int r = 0; r < 16; ++r) acc[mi][ni][r] *= sc;
            rope_pair32(acc[mi][0], acc[mi][1], cs32, pos, hi, (nw % 192) == 128);
            rope_pair32(acc[mi][2], acc[mi][3], cs32, pos, hi, ((nw + 64) % 192) == 128);
            store_tiles4(Q + (size_t)row * 768 + nw + 4 * hi, acc[mi], 1.f);
        }
    }
};
struct EpiKVup {
    bf16_t* Kn; int m0, n0;
    __device__ __forceinline__ void operator()(f32x16 (&acc)[2][4], int wm, int wn, int l32, int hi, LAS char* lds) const {
        const int nw = n0 + 128 * wn; const LAS float* rs = (const LAS float*)(lds + G_ROWSS);
        const int head = nw >> 8, within = nw & 255;
        bf16_t* base = Kn + (within < 128 ? (size_t)0 : (size_t)NT * 512) + head * 128 + 4 * hi;
#pragma unroll
        for (int mi = 0; mi < 2; ++mi) {
            const int rl = 64 * wm + 32 * mi + l32, row = m0 + rl;
            const float sc = __builtin_amdgcn_rsqf(rs[rl] * (1.f / 128.f) + 1e-6f);
            store_tiles4(base + (size_t)row * 512, acc[mi], sc);
        }
    }
};
__device__ __forceinline__ float gelu_tanh(float x) {
    const float u = 0.7978845608028654f * (x + 0.044715f * x * x * x);
    const float e = __expf(-2.f * fabsf(u)); const float t = (1.f - e) / (1.f + e);
    return 0.5f * x * (1.f + (u < 0.f ? -t : t));
}
struct EpiCmp1 {
    float* P; int m0;
    __device__ __forceinline__ void operator()(f32x16 (&acc)[2][4], int wm, int wn, int l32, int hi, LAS char*) const {
#pragma unroll
        for (int mi = 0; mi < 2; ++mi) {
            float* p = P + (size_t)(m0 + 64 * wm + 32 * mi + l32) * 256 + 128 * wn + 4 * hi;
#pragma unroll
            for (int ni = 0; ni < 4; ++ni)
#pragma unroll
                for (int q = 0; q < 4; ++q) { f32x4 v = {acc[mi][ni][4 * q], acc[mi][ni][4 * q + 1], acc[mi][ni][4 * q + 2], acc[mi][ni][4 * q + 3]}; gst<f32x4>(p + 32 * ni + 8 * q, v); }
        }
    }
};
struct EpiCmp2 {
    bf16_t* O; const f32x2* cs16; int dorope; int m0;
    __device__ __forceinline__ void operator()(f32x16 (&acc)[2][4], int wm, int wn, int l32, int hi, LAS char*) const {
        if (wn != 0) return;
#pragma unroll
        for (int mi = 0; mi < 2; ++mi) {
            const int row = m0 + 64 * wm + 32 * mi + l32, c = row & 127, pos = 16 * c + 31;
            if (dorope && c < 127) rope_first32(acc[mi][0], cs16, pos, hi);
            store_tiles4(O + (size_t)row * 128 + 4 * hi, acc[mi], c < 127 ? 1.f : 0.f);
        }
    }
};
struct EpiOut {
    float* Y; const float* X; int m0, n0;
    __device__ __forceinline__ void operator()(f32x16 (&acc)[2][4], int wm, int wn, int l32, int hi, LAS char*) const {
        const int nw = n0 + 128 * wn;
#pragma unroll
        for (int mi = 0; mi < 2; ++mi) {
            const size_t off = (size_t)(m0 + 64 * wm + 32 * mi + l32) * DM + nw + 4 * hi;
#pragma unroll
            for (int ni = 0; ni < 4; ++ni)
#pragma unroll
                for (int q = 0; q < 4; ++q) { const f32x4 xv = gld<f32x4>(X + off + 32 * ni + 8 * q);
                    f32x4 o; o[0] = DN_ALPHA * xv[0] + acc[mi][ni][4 * q]; o[1] = DN_ALPHA * xv[1] + acc[mi][ni][4 * q + 1]; o[2] = DN_ALPHA * xv[2] + acc[mi][ni][4 * q + 2]; o[3] = DN_ALPHA * xv[3] + acc[mi][ni][4 * q + 3];
                    gst<f32x4>(Y + off + 32 * ni + 8 * q, o);
                    if (q == 3) asm volatile("" ::: "memory"); }
        }
    }
};
struct EpiMoe1 {
    bf16_t* Hm; int rowbase, nvalid, n0;
    __device__ __forceinline__ void operator()(f32x16 (&acc)[2][4], int wm, int wn, int l32, int hi, LAS char*) const {
        const int ff0 = (n0 + 128 * wn) >> 1;
#pragma unroll
        for (int mi = 0; mi < 2; ++mi) {
            const int rl = 64 * wm + 32 * mi + l32;
            if (rl < nvalid) {
                bf16_t* p = Hm + (size_t)(rowbase + rl) * EFF + ff0 + 4 * hi;
#pragma unroll
                for (int h2 = 0; h2 < 2; ++h2)
#pragma unroll
                    for (int q = 0; q < 4; ++q) { float v[4];
#pragma unroll
                        for (int j = 0; j < 4; ++j) { const float g = acc[mi][2 * h2][4 * q + j], u = acc[mi][2 * h2 + 1][4 * q + j]; v[j] = g / (1.f + __expf(-g)) * u; }
                        store_bf4(p + 32 * h2 + 8 * q, v[0], v[1], v[2], v[3]); }
            }
        }
    }
};
struct EpiMoe2 {
    bf16_t* Y; const int* list; const float* gw; int nvalid, n0;
    __device__ __forceinline__ void operator()(f32x16 (&acc)[2][4], int wm, int wn, int l32, int hi, LAS char*) const {
        const int nw = n0 + 128 * wn;
#pragma unroll
        for (int mi = 0; mi < 2; ++mi) {
            const int rl = 64 * wm + 32 * mi + l32;
            if (rl < nvalid) { const int slot = gld<int>(list + rl); store_tiles4(Y + (size_t)slot * DM + nw + 4 * hi, acc[mi], gld<float>(gw + slot)); }
        }
    }
};

constexpr int VS = 160;
struct KeySrc { const bf16_t* k0; size_t kstride; const bf16_t* kr; size_t krstride; const bf16_t* v0; size_t vstride; };

template <int DQK> struct AttnRegs { bf16x8 k[DQK / 8 * 64 / 256]; bf16x8 v[4]; };
template <int DQK> struct AttnSrc { __amdgpu_buffer_rsrc_t rk, rr, rv; unsigned ko[DQK / 8 * 64 / 256]; unsigned vo[4]; unsigned ktile, rtile, vtile; };
template <int DQK> __device__ __forceinline__ AttnSrc<DQK> attn_src(const KeySrc& ks, int tid) {
    constexpr int KCH = DQK / 8, NKL = KCH * 64 / 256;
    AttnSrc<DQK> a; a.rk = mk_rsrc(ks.k0); a.rr = mk_rsrc(ks.kr); a.rv = mk_rsrc(ks.v0);
#pragma unroll
    for (int i = 0; i < NKL; ++i) { const int idx = tid + i * 256, key = idx / KCH, ch = idx - key * KCH;
        a.ko[i] = (DQK == 128 || ch < 16) ? (unsigned)(key * (unsigned)ks.kstride + ch * 8) * 2u : (unsigned)(key * (unsigned)ks.krstride + (ch - 16) * 8) * 2u; }
#pragma unroll
    for (int i = 0; i < 4; ++i) { const int idx = tid + i * 256, key = idx >> 4, ch = idx & 15; a.vo[i] = (unsigned)(key * (unsigned)ks.vstride + ch * 8) * 2u; }
    a.ktile = 128u * (unsigned)ks.kstride; a.rtile = 128u * (unsigned)ks.krstride; a.vtile = 128u * (unsigned)ks.vstride;
    return a;
}
template <int DQK> __device__ __forceinline__ void attn_gload(const AttnSrc<DQK>& a, int jt, AttnRegs<DQK>& R, bool withv, int tid) {
    constexpr int KCH = DQK / 8, NKL = KCH * 64 / 256;
#pragma unroll
    for (int i = 0; i < NKL; ++i) { const int idx = tid + i * 256, key = idx / KCH, ch = idx - key * KCH;
        R.k[i] = (DQK == 128 || ch < 16) ? bld8(a.rk, a.ko[i], (int)(jt * a.ktile)) : bld8(a.rr, a.ko[i], (int)(jt * a.rtile)); }
    if (withv) {
#pragma unroll
        for (int i = 0; i < 4; ++i) R.v[i] = bld8(a.rv, a.vo[i], (int)(jt * a.vtile));
    }
}
template <int DQK> __device__ __forceinline__ void attn_lwrite(LAS char* lds, const AttnRegs<DQK>& R, bool withv, int tid) {
    constexpr int KS = DQK + 8, KCH = DQK / 8, NKL = KCH * 64 / 256;
#pragma unroll
    for (int i = 0; i < NKL; ++i) { const int idx = tid + i * 256, key = idx / KCH, ch = idx - key * KCH; *(LAS bf16x8*)(lds + (key * KS + ch * 8) * 2) = R.k[i]; }
    if (withv) {
#pragma unroll
        for (int i = 0; i < 4; ++i) { const int idx = tid + i * 256, key = idx >> 4, ch = idx & 15; *(LAS bf16x8*)(lds + 64 * KS * 2 + (key * VS + ch * 8) * 2) = R.v[i]; }
    }
}
template <int DQK> __device__ __forceinline__ void attn_stage(LAS char* lds, const AttnSrc<DQK>& a, int jt, bool withv, int tid) { AttnRegs<DQK> R; attn_gload<DQK>(a, jt, R, withv, tid); attn_lwrite<DQK>(lds, R, withv, tid); }
template <int DQK> __device__ __forceinline__ void attn_scores(const LAS char* lds, const bf16x8 (&qf)[DQK / 16], f32x16& p0, f32x16& p1, int l32, int hi) {
    constexpr int KS = DQK + 8;
    const int sg = (l32 & ~12) | ((l32 & 4) << 1) | ((l32 & 8) >> 1);
    const LAS char* kb = lds + (sg * KS + hi * 8) * 2;
#pragma unroll
    for (int r = 0; r < 16; ++r) { p0[r] = 0.f; p1[r] = 0.f; }
#pragma unroll
    for (int ds = 0; ds < DQK / 16; ++ds) {
        const bf16x8 a0 = *(const LAS bf16x8*)(kb + ds * 32), a1 = *(const LAS bf16x8*)(kb + 32 * KS * 2 + ds * 32);
        p0 = __builtin_amdgcn_mfma_f32_32x32x16_bf16(a0, qf[ds], p0, 0, 0, 0);
        p1 = __builtin_amdgcn_mfma_f32_32x32x16_bf16(a1, qf[ds], p1, 0, 0, 0);
    }
}
template <int DQK, bool SEL>
__device__ __forceinline__ void attn_run(LAS char* lds, const KeySrc& ks, int jt_lo, int jt_hi, unsigned tile_union, const bf16x8 (&qf)[DQK / 16],
                                         int qi, unsigned maxd, unsigned sel, float c2, f32x16 (&o)[4], float& m_run, float& l_run, int tid) {
    constexpr int KS = DQK + 8;
    const int lane = tid & 63, l32 = lane & 31, hi = lane >> 5;
    const int g = lane >> 4, i16 = lane & 15;
    const LAS char* vb = (lds + 64 * KS * 2 + ((8 * hi + (i16 >> 2)) * VS + 16 * (g & 1) + 4 * (i16 & 3)) * 2);
    const float NEG = -__builtin_inff();
    int qmin = qi, qmax = qi;
#pragma unroll
    for (int sft = 32; sft >= 1; sft >>= 1) { qmin = min(qmin, __shfl_xor(qmin, sft)); qmax = max(qmax, __shfl_xor(qmax, sft)); }
    int jt = jt_lo;
    if (SEL) { while (jt < jt_hi && !((tile_union >> jt) & 1u)) ++jt; }
    if (jt >= jt_hi) return;
    AttnRegs<DQK> R;
    const AttnSrc<DQK> asrc = attn_src<DQK>(ks, tid);
    constexpr bool PF = DQK == 128;
    if (PF) attn_gload<DQK>(asrc, jt, R, true, tid);
    for (;;) {
        if (!PF) attn_gload<DQK>(asrc, jt, R, true, tid);
        attn_lwrite<DQK>(lds, R, true, tid);
        __syncthreads();
        int jn = jt + 1;
        if (SEL) { while (jn < jt_hi && !((tile_union >> jn) & 1u)) ++jn; }
        if (PF && jn < jt_hi) attn_gload<DQK>(asrc, jn, R, true, tid);
        f32x16 p0, p1;
        attn_scores<DQK>(lds, qf, p0, p1, l32, hi);
        const bool ok = SEL ? (((sel >> jt) & 1u) != 0u) : true;
        const bool interior = (qmin - (jt * 64 + 63) >= 0) && ((unsigned)(qmax - jt * 64) <= maxd) && (SEL ? __all(ok) : true);
        float mx = NEG;
        if (interior) {
#pragma unroll
            for (int r = 0; r < 16; ++r) mx = fmaxf(mx, fmaxf(p0[r], p1[r]));
        } else {
            const int dq = qi - jt * 64 - 8 * hi;
#pragma unroll
            for (int r = 0; r < 16; ++r) {
                const int ko = 16 * (r >> 3) + (r & 7);
                const float s0 = (ok && (unsigned)(dq - ko) <= maxd) ? p0[r] : NEG;
                const float s1 = (ok && (unsigned)(dq - ko - 32) <= maxd) ? p1[r] : NEG;
                p0[r] = s0; p1[r] = s1; mx = fmaxf(mx, fmaxf(s0, s1));
            }
        }
        mx = fmaxf(mx, __shfl_xor(mx, 32));
        const float mn = fmaxf(m_run, mx * c2);
        const float alpha = __builtin_amdgcn_exp2f(m_run - mn);
        const float nmn = -mn;
        float rs = 0.f;
#pragma unroll
        for (int r = 0; r < 16; ++r) { p0[r] = __builtin_amdgcn_exp2f(fmaf(p0[r], c2, nmn)); p1[r] = __builtin_amdgcn_exp2f(fmaf(p1[r], c2, nmn)); rs += p0[r] + p1[r]; }
        rs += __shfl_xor(rs, 32);
        l_run = l_run * alpha + rs; m_run = mn;
        if (!__all(alpha == 1.f)) {
#pragma unroll
            for (int dt = 0; dt < 4; ++dt)
#pragma unroll
                for (int r = 0; r < 16; ++r) o[dt][r] *= alpha;
        }
#pragma unroll
        for (int s4 = 0; s4 < 4; ++s4) {
            u32x4 pw;
            if (s4 == 0)      { pw.x = cvtpk(p0[0], p0[1]);  pw.y = cvtpk(p0[2], p0[3]);   pw.z = cvtpk(p0[4], p0[5]);   pw.w = cvtpk(p0[6], p0[7]); }
            else if (s4 == 1) { pw.x = cvtpk(p0[8], p0[9]);  pw.y = cvtpk(p0[10], p0[11]); pw.z = cvtpk(p0[12], p0[13]); pw.w = cvtpk(p0[14], p0[15]); }
            else if (s4 == 2) { pw.x = cvtpk(p1[0], p1[1]);  pw.y = cvtpk(p1[2], p1[3]);   pw.z = cvtpk(p1[4], p1[5]);   pw.w = cvtpk(p1[6], p1[7]); }
            else              { pw.x = cvtpk(p1[8], p1[9]);  pw.y = cvtpk(p1[10], p1[11]); pw.z = cvtpk(p1[12], p1[13]); pw.w = cvtpk(p1[14], p1[15]); }
            const bf16x8 pb = *reinterpret_cast<bf16x8*>(&pw);
#pragma unroll
            for (int dt = 0; dt < 4; ++dt) {
                const s16x4 v0 = __builtin_amdgcn_ds_read_tr16_b64_v4i16((LAS s16x4*)(vb + (s4 * 16 * VS + dt * 32) * 2));
                const s16x4 v1 = __builtin_amdgcn_ds_read_tr16_b64_v4i16((LAS s16x4*)(vb + (s4 * 16 * VS + 4 * VS + dt * 32) * 2));
                const bf16x8 va = {v0[0], v0[1], v0[2], v0[3], v1[0], v1[1], v1[2], v1[3]};
                o[dt] = __builtin_amdgcn_mfma_f32_32x32x16_bf16(va, pb, o[dt], 0, 0, 0);
            }
        }
        __syncthreads();
        if (jn >= jt_hi) break;
        jt = jn;
    }
}
template <int DQK> __device__ __forceinline__ void load_q(const bf16_t* qptr, int hi, bf16x8 (&qf)[DQK / 16]) {
#pragma unroll
    for (int ds = 0; ds < DQK / 16; ++ds) qf[ds] = gld<bf16x8>(qptr + ds * 16 + hi * 8);
}
__device__ __forceinline__ void store_o(bf16_t* optr, const f32x16 (&o)[4], float inv, int hi) {
#pragma unroll
    for (int dt = 0; dt < 4; ++dt)
#pragma unroll
        for (int q = 0; q < 4; ++q) store_bf4(optr + 32 * dt + 8 * q + 4 * hi, o[dt][4 * q] * inv, o[dt][4 * q + 1] * inv, o[dt][4 * q + 2] * inv, o[dt][4 * q + 3] * inv);
}
__device__ __forceinline__ void zero_o(f32x16 (&o)[4]) {
#pragma unroll
    for (int dt = 0; dt < 4; ++dt)
#pragma unroll
        for (int r = 0; r < 16; ++r) o[dt][r] = 0.f;
}

__device__ __forceinline__ int claim(unsigned* ctr, LAS char* lds) {
    volatile LAS int* slot = (volatile LAS int*)(lds + LDS_CTL + 64);
    __syncthreads();
    if (otid() == 0) *slot = (int)atomicAdd(ctr, 1u);
    __syncthreads();
    return *slot;
}

__device__ __forceinline__ void conv_tile(LAS char* lds, const float* src, int N, int k0, int n0, bf16_t* dst, int ldd, int rowmap, const float* kscale) {
    LAS float* tile = (LAS float*)lds;
    const int tid = otid();
    __syncthreads();
    {
        const int kr = tid >> 6, nc = tid & 63; const bool inb = n0 + nc < N;
#pragma unroll
        for (int i = 0; i < 16; ++i) { const int k = kr + 4 * i; float v = inb ? gld<float>(src + (size_t)(k0 + k) * N + n0 + nc) : 0.f; if (kscale) v *= gld<float>(kscale + k0 + k); tile[k * 65 + nc] = v; }
    }
    __syncthreads();
    {
        const int n = tid >> 2, kq = (tid & 3) * 16; const int c = n0 + n;
        const int drow = rowmap == 0 ? c : (128 * (c >> 6) + 64 * ((c >> 5) & 1) + 32 * (rowmap - 1) + (c & 31));
        u32x4 w0, w1;
        w0.x = cvtpk(tile[(kq + 0) * 65 + n], tile[(kq + 1) * 65 + n]);   w0.y = cvtpk(tile[(kq + 2) * 65 + n], tile[(kq + 3) * 65 + n]);
        w0.z = cvtpk(tile[(kq + 4) * 65 + n], tile[(kq + 5) * 65 + n]);   w0.w = cvtpk(tile[(kq + 6) * 65 + n], tile[(kq + 7) * 65 + n]);
        w1.x = cvtpk(tile[(kq + 8) * 65 + n], tile[(kq + 9) * 65 + n]);   w1.y = cvtpk(tile[(kq + 10) * 65 + n], tile[(kq + 11) * 65 + n]);
        w1.z = cvtpk(tile[(kq + 12) * 65 + n], tile[(kq + 13) * 65 + n]); w1.w = cvtpk(tile[(kq + 14) * 65 + n], tile[(kq + 15) * 65 + n]);
        bf16_t* d = dst + (size_t)drow * ldd + k0 + kq;
        gst<u32x4>(d, w0); gst<u32x4>(d + 8, w1);
    }
}

__device__ __forceinline__ void phase_prep(const Params& p, int layer, LAS char* lds) {
    char* ws = ows(p.ws);
    const int tid = otid();
    constexpr int N_WIN = 32 * 72, N_WQ = 6 * 12, N_WKV = 2 * 16, N_W1 = 64 * 4, N_W2 = 4 * 2, N_WOUT = 32 * 32, N_EG = NEXP * 32 * 8, N_ED = NEXP * 8 * 32;
    constexpr int E0 = 0, E1 = E0 + N_WIN, E2 = E1 + N_WQ, E3 = E2 + N_WKV, E4 = E3 + N_W1, E5 = E4 + N_W1, E6 = E5 + N_W2, E7 = E6 + N_W2, E8 = E7 + N_WOUT,
                  E9 = E8 + N_EG, E10 = E9 + N_EG, E11 = E10 + N_ED, E12 = E11 + 32  , E13 = E12 + 64  , E14 = E13 + 4096  ;
    const int total = layer == 0 ? E14 : E12;
    for (int it = oblk(); it < total; it += gridDim.x) {
        if (it < E1) { const int u = it - E0, kt = u % 32, nt = u / 32;
            conv_tile(lds, p.in[I_WIN] + (size_t)layer * DM * INC, INC, kt * 64, nt * 64, (bf16_t*)(ws + OFF_WIN_T), DM, 0, nullptr);
        } else if (it < E2) { const int u = it - E1, kt = u % 6, nt = u / 6;
            conv_tile(lds, p.in[I_WQUP] + (size_t)layer * 384 * 768, 768, kt * 64, nt * 64, (bf16_t*)(ws + OFF_WQ_T), 384, 0, p.in[I_QLN] + layer * 384);
        } else if (it < E3) { const int u = it - E2, kt = u % 2, nt = u / 2;
            conv_tile(lds, p.in[I_WKVUP] + (size_t)layer * 128 * 1024, 1024, kt * 64, nt * 64, (bf16_t*)(ws + OFF_WKV_T), 128, 0, p.in[I_KVLN] + layer * 128);
        } else if (it < E5) { const int which = it >= E4, u = it - (which ? E4 : E3), kt = u % 64, nt = u / 64;
            conv_tile(lds, p.in[which ? I_W1V : I_W1K] + (size_t)layer * 4096 * 256, 256, kt * 64, nt * 64, (bf16_t*)(ws + (which ? OFF_W1V_T : OFF_W1K_T)), 4096, 0, nullptr);
        } else if (it < E7) { const int which = it >= E6, u = it - (which ? E6 : E5), kt = u % 4, nt = u / 4;
            conv_tile(lds, p.in[which ? I_W2V : I_W2K] + (size_t)layer * 256 * 128, 128, kt * 64, nt * 64, (bf16_t*)(ws + (which ? OFF_W2V_T : OFF_W2K_T)), 256, 0, nullptr);
        } else if (it < E8) { const int u = it - E7, kt = u % 32, nt = u / 32;
            conv_tile(lds, p.in[I_WOUT] + (size_t)layer * DM * DM, DM, kt * 64, nt * 64, (bf16_t*)(ws + OFF_WOUT_T), DM, 0, nullptr);
        } else if (it < E10) { const int isup = it >= E9, u = it - (isup ? E9 : E8), e = u / 256, r = u % 256, kt = r % 32, nt = r / 32;
            conv_tile(lds, p.in[isup ? I_WUP : I_WGATE] + ((size_t)layer * NEXP + e) * DM * EFF, EFF, kt * 64, nt * 64, (bf16_t*)(ws + OFF_WGU_T) + (size_t)e * 1024 * DM, DM, 1 + isup, nullptr);
        } else if (it < E11) { const int u = it - E10, e = u / 256, r = u % 256, kt = r % 8, nt = r / 8;
            conv_tile(lds, p.in[I_WDOWN] + ((size_t)layer * NEXP + e) * EFF * DM, DM, kt * 64, nt * 64, (bf16_t*)(ws + OFF_WD_T) + (size_t)e * DM * EFF, EFF, 0, nullptr);
        } else if (it < E12) { const int u = it - E11, which = u >> 4, kc = u & 15;
            const float* pe = p.in[which ? I_PEV : I_PEK] + (size_t)layer * 4096 + kc * 256;
            const float* w1 = p.in[which ? I_W1V : I_W1K] + (size_t)layer * 4096 * 256 + (size_t)kc * 256 * 256;
            float a0 = 0.f, a1 = 0.f, a2 = 0.f, a3 = 0.f;
            for (int k = 0; k < 256; k += 4) { a0 += pe[k] * w1[(size_t)k * 256 + tid]; a1 += pe[k + 1] * w1[(size_t)(k + 1) * 256 + tid]; a2 += pe[k + 2] * w1[(size_t)(k + 2) * 256 + tid]; a3 += pe[k + 3] * w1[(size_t)(k + 3) * 256 + tid]; }
            ((float*)(ws + OFF_B1P))[(which * 16 + kc) * 256 + tid] = (a0 + a1) + (a2 + a3);
        } else if (it < E13) { const int u = it - E12;
            f32x2* cs16 = (f32x2*)(ws + OFF_CS16); f32x2* cs32 = (f32x2*)(ws + OFF_CS32);
            for (int e = tid; e < 32 * 48; e += 256) { const int pos = u * 32 + e / 48, j = e % 48;
                const int half = j < 16 ? 16 : 32, i = j < 16 ? j : j - 16;
                const float invf = exp2f(-(float)i / (float)half * 18.931568569324174f);
                const float ang = (float)pos * invf;
                f32x2 cs; cs.x = cosf(ang); cs.y = sinf(ang);
                if (j < 16) cs16[pos * 16 + i] = cs; else cs32[pos * 32 + i] = cs; }
        } else { const int u = it - E13;
            const float* x = p.in[I_X] + (size_t)u * 4096; bf16_t* xb = (bf16_t*)(ws + OFF_XB) + (size_t)u * 4096;
            for (int e = tid * 4; e < 4096; e += 1024) { const f32x4 v = gld<f32x4>(x + e); store_bf4(xb + e, v[0], v[1], v[2], v[3]); }
        }
    }
    if (oblk() == 0 && tid < NEXP) ((unsigned*)(ws + OFF_ECNT))[tid] = 0u;
    { unsigned* imp = (unsigned*)(ws + OFF_IMP); for (size_t e = (size_t)oblk() * 256 + tid; e < (size_t)NT * 32; e += (size_t)gridDim.x * 256) gst<unsigned>(imp + e, 0u); }
}

#define AO4(ld) { (unsigned)(sr * (ld) + sc), (unsigned)((sr + 32) * (ld) + sc), (unsigned)((sr + 64) * (ld) + sc), (unsigned)((sr + 96) * (ld) + sc) }
__device__ __forceinline__ void phase_win(const Params& p, int layer, LAS char* lds) {
    char* ws = ows(p.ws); const int tid = otid(), sr = tid >> 3, sc = (tid & 7) * 8;
    const bf16_t* A = (const bf16_t*)(ws + OFF_XB); const bf16_t* Bt = (const bf16_t*)(ws + OFF_WIN_T);
    for (int u = oblk(); u < 64 * 18; u += gridDim.x) {
        const int mt = u & 63, nt = u >> 6;
        EpiWin e{(bf16_t*)(ws + OFF_H), (float*)(ws + OFF_GATES), (const f32x2*)(ws + OFF_CS16), (const f32x2*)(ws + OFF_CS32), mt * 128, nt * 256};
        const unsigned ao[4] = AO4(DM);
        gemm_unit(lds, A + (size_t)mt * 128 * DM, ao, 128, Bt + (size_t)nt * 256 * DM, (unsigned)(sr * DM + sc), (size_t)32 * DM, DM / 64, e);
    }
}
__device__ __forceinline__ void phase_up(const Params& p, int layer, LAS char* lds) {
    char* ws = ows(p.ws); const int tid = otid(), sr = tid >> 3, sc = (tid & 7) * 8;
    const bf16_t* H = (const bf16_t*)(ws + OFF_H);
    constexpr int U0 = 64, U1 = U0 + 64 * 3, U2 = U1 + 64 * 4;
    for (int u = oblk(); u < U2; u += gridDim.x) {
        if (u < U0) {
            const int which = u >> 5, mt = (u >> 3) & 3, ksp = u & 7;
            const int col = which ? C_NVC : C_NKC;
            unsigned ao[4];
#pragma unroll
            for (int i = 0; i < 4; ++i) { int c = sr + 32 * i; if (c > 126) c = 126; ao[i] = (unsigned)(16 * c * LDH + sc); }
            const bf16_t* ab = H + (size_t)(mt * SEQ + 4 * ksp) * LDH + col;
            const bf16_t* bb = (const bf16_t*)(ws + (which ? OFF_W1V_T : OFF_W1K_T)) + 512 * ksp;
            EpiCmp1 e{(float*)(ws + OFF_HCP) + ((size_t)ksp * 2 + which) * 512 * 256, mt * 128};
            gemm_unit(lds, ab, ao, LDH, bb, (unsigned)(sr * 4096 + sc), (size_t)32 * 4096, 512 / 64, e);
        } else if (u < U1) {
            const int v = u - U0, mt = v & 63, nt = v >> 6;
            const unsigned ao[4] = AO4(LDH);
            EpiQup e{(bf16_t*)(ws + OFF_QM), (const f32x2*)(ws + OFF_CS32), mt * 128, nt * 256};
            row_sumsq<384>(lds, H + (size_t)mt * 128 * LDH + C_QLAT, LDH);
            gemm_unit(lds, H + (size_t)mt * 128 * LDH + C_QLAT, ao, 128, (const bf16_t*)(ws + OFF_WQ_T) + (size_t)nt * 256 * 384, (unsigned)(sr * 384 + sc), (size_t)32 * 384, 384 / 64, e);
        } else {
            const int v = u - U1, mt = v & 63, nt = v >> 6;
            const unsigned ao[4] = AO4(LDH);
            EpiKVup e{(bf16_t*)(ws + OFF_KN), mt * 128, nt * 256};
            row_sumsq<128>(lds, H + (size_t)mt * 128 * LDH + C_KVLAT, LDH);
            gemm_unit(lds, H + (size_t)mt * 128 * LDH + C_KVLAT, ao, 128, (const bf16_t*)(ws + OFF_WKV_T) + (size_t)nt * 256 * 128, (unsigned)(sr * 128 + sc), (size_t)32 * 128, 128 / 64, e);
        }
    }
}
__device__ __forceinline__ void phase_cmp2(const Params& p, int layer, LAS char* lds) {
    char* ws = ows(p.ws); const int tid = otid(), sr = tid >> 3, sc = (tid & 7) * 8;
    for (int u = oblk(); u < 8; u += gridDim.x) {
        const int which = u >> 2, mt = u & 3;
        bf16_t* Hc = (bf16_t*)(ws + OFF_HC) + (size_t)which * 512 * 256 + (size_t)mt * 128 * 256;
        const float* P = (const float*)(ws + OFF_HCP) + (size_t)which * 512 * 256 + (size_t)mt * 128 * 256;
        const float* b1p = (const float*)(ws + OFF_B1P) + which * 16 * 256;
        for (int e = tid * 4; e < 128 * 256; e += 1024) {
            f32x4 a = {0.f, 0.f, 0.f, 0.f};
            for (int q = 0; q < 16; ++q) a += gld<f32x4>(b1p + q * 256 + (e & 255));
            for (int q = 0; q < 8; ++q) a += gld<f32x4>(P + (size_t)q * 2 * 512 * 256 + e);
            store_bf4(Hc + e, gelu_tanh(a[0]), gelu_tanh(a[1]), gelu_tanh(a[2]), gelu_tanh(a[3]));
        }
        asm volatile("s_waitcnt vmcnt(0)" ::: "memory");
        __syncthreads();
        const unsigned ao[4] = AO4(256);
        EpiCmp2 e{(bf16_t*)(ws + (which ? OFF_VC : OFF_KC)), (const f32x2*)(ws + OFF_CS16), which == 0, mt * 128};
        gemm_unit(lds, Hc, ao, 128, (const bf16_t*)(ws + (which ? OFF_W2V_T : OFF_W2K_T)), (unsigned)(sr * 256 + sc), (size_t)32 * 256, 256 / 64, e);
    }
}
__device__ __forceinline__ void phase_out(const Params& p, int layer, LAS char* lds) {
    char* ws = ows(p.ws); const int tid = otid(), sr = tid >> 3, sc = (tid & 7) * 8;
    const bf16_t* A = (const bf16_t*)(ws + OFF_MIX); const bf16_t* Bt = (const bf16_t*)(ws + OFF_WOUT_T);
    const float* X = layer == 0 ? p.in[I_X] : (const float*)(ws + OFF_XA);
    for (int u = oblk(); u < 64 * 8; u += gridDim.x) {
        const int mt = u & 63, nt = u >> 6;
        EpiOut e{(float*)(ws + OFF_YB), X, mt * 128, nt * 256};
        const unsigned ao[4] = AO4(DM);
        gemm_unit(lds, A + (size_t)mt * 128 * DM, ao, 128, Bt + (size_t)nt * 256 * DM, (unsigned)(sr * DM + sc), (size_t)32 * DM, DM / 64, e);
    }
}

__device__ __forceinline__ void item_mla(const Params& p, int it, LAS char* lds) {
    char* ws = ows(p.ws); const int tid = otid(), lane = tid & 63, w = tid >> 6, l32 = lane & 31, hi = lane >> 5;
    const int qb = 15 - (it >> 4), h = it & 3, b = (it >> 2) & 3;
    const int token = qb * 128 + 32 * w + l32; const size_t row = (size_t)b * SEQ + token;
    bf16x8 qf[12]; load_q<192>((const bf16_t*)(ws + OFF_QM) + row * 768 + h * 192, hi, qf);
    KeySrc ks; ks.k0 = (const bf16_t*)(ws + OFF_KN) + (size_t)b * SEQ * 512 + h * 128; ks.kstride = 512;
    ks.kr = (const bf16_t*)(ws + OFF_H) + (size_t)b * SEQ * LDH + C_KROPE; ks.krstride = LDH;
    ks.v0 = (const bf16_t*)(ws + OFF_VM) + (size_t)b * SEQ * 512 + h * 128; ks.vstride = 512;
    f32x16 o[4]; zero_o(o); float m = -1e30f, l = 0.f;
    attn_run<192, false>(lds, ks, 0, 2 * qb + 2, 0u, qf, token, 0x7fffffffu, 0u, 0.07216878364870322f * LOG2E, o, m, l, tid);
    store_o((bf16_t*)(ws + OFF_MIX) + row * DM + h * 128, o, 1.f / l, hi);
}
__device__ __forceinline__ void item_dil(const Params& p, int it, LAS char* lds) {
    char* ws = ows(p.ws); const int tid = otid(), lane = tid & 63, w = tid >> 6, l32 = lane & 31, hi = lane >> 5;
    const int rem = it % 48, bh = it / 48, h = bh % 6, b = bh / 6;
    const int n = rem >> 4, r2 = rem & 15;
    const int dil = n == 0 ? 1 : (n == 1 ? 4 : 16);
    const int rho = n == 0 ? 0 : (n == 1 ? (r2 >> 2) : r2), qb = n == 0 ? r2 : (n == 1 ? (r2 & 3) : 0);
    const int i = qb * 128 + 32 * w + l32, token = rho + i * dil; const size_t row = (size_t)b * SEQ + token;
    const bf16_t* H = (const bf16_t*)(ws + OFF_H);
    bf16x8 qf[8]; load_q<128>(H + row * LDH + C_DQ + h * 128, hi, qf);
    KeySrc ks; ks.k0 = H + ((size_t)b * SEQ + rho) * LDH + C_DK + h * 128; ks.kstride = (size_t)dil * LDH; ks.kr = ks.k0; ks.krstride = 0;
    ks.v0 = H + ((size_t)b * SEQ + rho) * LDH + C_DV + h * 128; ks.vstride = (size_t)dil * LDH;
    f32x16 o[4]; zero_o(o); float m = -1e30f, l = 0.f;
    const int jlo = 2 * qb - 2 < 0 ? 0 : 2 * qb - 2;
    attn_run<128, false>(lds, ks, jlo, 2 * qb + 2, 0u, qf, i, 128u, 0u, 0.08838834764831845f * LOG2E, o, m, l, tid);
    store_o((bf16_t*)(ws + OFF_ODIL) + ((size_t)n * NT + row) * 768 + h * 128, o, 1.f / l, hi);
    if (hi == 0) gst<float>((float*)(ws + OFF_LDIL) + ((size_t)n * NT + row) * 6 + h, m + __log2f(l));
}
__device__ __forceinline__ void item_win(const Params& p, int it, LAS char* lds) {
    char* ws = ows(p.ws); const int tid = otid(), lane = tid & 63, w = tid >> 6, l32 = lane & 31, hi = lane >> 5;
    const int hp = it % 3, b = (it / 3) & 3, tb = 31 - it / 12;
    const int head = 2 * hp + (w >> 1), token = 64 * tb + 32 * (w & 1) + l32; const size_t row = (size_t)b * SEQ + token;
    const bf16_t* H = (const bf16_t*)(ws + OFF_H);
    bf16x8 qf[8]; load_q<128>(H + row * LDH + C_NQ + head * 128, hi, qf);
    KeySrc ks; ks.k0 = H + (size_t)b * SEQ * LDH + C_NKW; ks.kstride = LDH; ks.kr = ks.k0; ks.krstride = 0; ks.v0 = H + (size_t)b * SEQ * LDH + C_NVW; ks.vstride = LDH;
    f32x16 o[4]; zero_o(o); float m = -1e30f, l = 0.f;
    attn_run<128, false>(lds, ks, tb - 8 < 0 ? 0 : tb - 8, tb + 1, 0u, qf, token, 511u, 0u, 0.08838834764831845f * LOG2E, o, m, l, tid);
    store_o((bf16_t*)(ws + OFF_PW) + row * 768 + head * 128, o, 1.f / l, hi);
}
__device__ __forceinline__ void item_cmp(const Params& p, int it, LAS char* lds) {
    char* ws = ows(p.ws); const int tid = otid(), lane = tid & 63, w = tid >> 6, l32 = lane & 31, hi = lane >> 5;
    const int hp = it % 3, tb = (it / 3) % 32, b = it / 96;
    const int head = 2 * hp + (w >> 1), token = 64 * tb + 32 * (w & 1) + l32; const size_t row = (size_t)b * SEQ + token;
    const bf16_t* H = (const bf16_t*)(ws + OFF_H);
    bf16x8 qf[8]; load_q<128>(H + row * LDH + C_NQ + head * 128, hi, qf);
    KeySrc ks; ks.k0 = (const bf16_t*)(ws + OFF_KC) + (size_t)b * 128 * 128; ks.kstride = 128; ks.kr = ks.k0; ks.krstride = 0; ks.v0 = (const bf16_t*)(ws + OFF_VC) + (size_t)b * 128 * 128; ks.vstride = 128;
    const int qi = (token - 31) >> 4;
    const int qimax = (64 * tb + 63 - 31) >> 4;
    const int jhi = qimax < 0 ? 0 : (qimax >> 6) + 1;
    const float c2 = 0.08838834764831845f * LOG2E;
    f32x16 o[4]; zero_o(o); float m = -1e30f, l = 0.f;
    attn_run<128, false>(lds, ks, 0, jhi, 0u, qf, qi, 0x7fffffffu, 0u, c2, o, m, l, tid);
    const float inv = l > 0.f ? 1.f / l : 0.f;
    store_o((bf16_t*)(ws + OFF_PC) + row * 768 + head * 128, o, inv, hi);
    unsigned* imp = (unsigned*)(ws + OFF_IMP) + row * 32;
    const AttnSrc<128> asrc = attn_src<128>(ks, tid);
    for (int jt = 0; jt < jhi; ++jt) {
        attn_stage<128>(lds, asrc, jt, false, tid);
        __syncthreads();
        f32x16 p0, p1; attn_scores<128>(lds, qf, p0, p1, l32, hi);
        const int dq = qi - jt * 64 - 8 * hi;
#pragma unroll
        for (int r = 0; r < 16; ++r) { const int ko = 16 * (r >> 3) + (r & 7);
            p0[r] = (dq - ko >= 0) ? __builtin_amdgcn_exp2f(p0[r] * c2 - m) * inv : 0.f;
            p1[r] = (dq - ko - 32 >= 0) ? __builtin_amdgcn_exp2f(p1[r] * c2 - m) * inv : 0.f; }
#pragma unroll
        for (int t = 0; t < 2; ++t)
#pragma unroll
            for (int u = 0; u < 2; ++u) {
                unsigned q[8];
#pragma unroll
                for (int j = 0; j < 8; ++j) q[j] = (unsigned)((t ? p1[8 * u + j] : p0[8 * u + j]) * 16777216.f + 0.5f);
                const int j0 = (64 * jt + 32 * t + 16 * u + 8 * hi) >> 2;
                const unsigned a0 = q[0] + q[1] + q[2] + q[3], a1 = q[4] + q[5] + q[6] + q[7] + q[3], a2 = q[7];
                if (a0) atomicAdd(imp + j0, a0);
                if (a1) atomicAdd(imp + j0 + 1, a1);
                if (a2 && j0 + 2 < 32) atomicAdd(imp + j0 + 2, a2);
            }
        __syncthreads();
    }
}
__device__ __forceinline__ void item_slc(const Params& p, int it, LAS char* lds) {
    char* ws = ows(p.ws); const int tid = otid(), lane = tid & 63, w = tid >> 6, l32 = lane & 31, hi = lane >> 5;
    const int hp = it % 3, b = (it / 3) & 3, tb = 31 - it / 12;
    LAS int* sc = (LAS int*)(lds + 47104); LAS unsigned* msk = (LAS unsigned*)(lds + 47104 + 8192);
    __syncthreads();
    if (tid < 65) msk[tid] = 0u;
    const unsigned* imp = (const unsigned*)(ws + OFF_IMP) + ((size_t)b * SEQ + 64 * tb) * 32;
#pragma unroll
    for (int i = 0; i < 8; ++i) { const int e = tid + i * 256, tk = e >> 5, j = e & 31, pos = 64 * tb + tk, qblk = pos >> 6;
        const bool valid = 64 * j <= pos, forced = (j == 0) || (j == qblk) || (j == qblk - 1);
        sc[e] = valid ? (forced ? 0x7fffffff : (int)gld<unsigned>(imp + e)) : -1; }
    __syncthreads();
#pragma unroll
    for (int i = 0; i < 8; ++i) { const int e = tid + i * 256, tk = e >> 5, j = e & 31; const int s = sc[e]; int rank = 0;
        for (int k = 0; k < 32; ++k) { const int sk = sc[tk * 32 + k]; rank += (sk > s || (sk == s && k < j)) ? 1 : 0; }
        if (rank < 16) { __hip_atomic_fetch_or(&msk[tk], 1u << j, __ATOMIC_RELAXED, __HIP_MEMORY_SCOPE_WORKGROUP); __hip_atomic_fetch_or(&msk[64], 1u << j, __ATOMIC_RELAXED, __HIP_MEMORY_SCOPE_WORKGROUP); } }
    __syncthreads();
    const int head = 2 * hp + (w >> 1), tk = 32 * (w & 1) + l32, token = 64 * tb + tk; const size_t row = (size_t)b * SEQ + token;
    const unsigned sel = msk[tk], uni = msk[64];
    const bf16_t* H = (const bf16_t*)(ws + OFF_H);
    bf16x8 qf[8]; load_q<128>(H + row * LDH + C_NQ + head * 128, hi, qf);
    KeySrc ks; ks.k0 = H + (size_t)b * SEQ * LDH + C_NKS; ks.kstride = LDH; ks.kr = ks.k0; ks.krstride = 0; ks.v0 = H + (size_t)b * SEQ * LDH + C_NVS; ks.vstride = LDH;
    f32x16 o[4]; zero_o(o); float m = -1e30f, l = 0.f;
    attn_run<128, true>(lds, ks, 0, tb + 1, uni, qf, token, 0x7fffffffu, sel, 0.08838834764831845f * LOG2E, o, m, l, tid);
    const float* gp = (const float*)(ws + OFF_GATES) + row * 18 + head * 3;
    const float g0 = gld<float>(gp), g1 = gld<float>(gp + 1) / l, g2 = gld<float>(gp + 2);
    const bf16_t* pc = (const bf16_t*)(ws + OFF_PC) + row * 768 + head * 128 + 4 * hi; const bf16_t* pw = (const bf16_t*)(ws + OFF_PW) + row * 768 + head * 128 + 4 * hi;
    bf16_t* mx = (bf16_t*)(ws + OFF_MIX) + row * DM + 1280 + head * 128 + 4 * hi;
#pragma unroll
    for (int dt = 0; dt < 4; ++dt)
#pragma unroll
        for (int q = 0; q < 4; ++q) { const u32x2 a = gld<u32x2>(pc + 32 * dt + 8 * q), b = gld<u32x2>(pw + 32 * dt + 8 * q);
            store_bf4(mx + 32 * dt + 8 * q, g0 * bf_lo(a.x) + g1 * o[dt][4 * q] + g2 * bf_lo(b.x), g0 * bf_hi(a.x) + g1 * o[dt][4 * q + 1] + g2 * bf_hi(b.x),
                                            g0 * bf_lo(a.y) + g1 * o[dt][4 * q + 2] + g2 * bf_lo(b.y), g0 * bf_hi(a.y) + g1 * o[dt][4 * q + 3] + g2 * bf_hi(b.y)); }
}
__device__ __forceinline__ void item_dilmix(const Params& p, int it, LAS char* lds) {
    char* ws = ows(p.ws); const int tid = otid();
    const bf16_t* OD = (const bf16_t*)(ws + OFF_ODIL); const float* LD = (const float*)(ws + OFF_LDIL); bf16_t* MIX = (bf16_t*)(ws + OFF_MIX);
    for (int e = tid; e < 64 * 96; e += 256) {
        const size_t row = (size_t)it * 64 + e / 96; const int cc = (e % 96) * 8, h = cc >> 7;
        const float L0 = gld<float>(LD + row * 6 + h), L1 = gld<float>(LD + ((size_t)NT + row) * 6 + h), L2 = gld<float>(LD + ((size_t)2 * NT + row) * 6 + h);
        const float M = fmaxf(L0, fmaxf(L1, L2)); float w0 = __builtin_amdgcn_exp2f(L0 - M), w1 = __builtin_amdgcn_exp2f(L1 - M), w2 = __builtin_amdgcn_exp2f(L2 - M);
        const float inv = 1.f / (w0 + w1 + w2); w0 *= inv; w1 *= inv; w2 *= inv;
        const u32x4 a = gld<u32x4>(OD + row * 768 + cc), bq = gld<u32x4>(OD + ((size_t)NT + row) * 768 + cc), cq = gld<u32x4>(OD + ((size_t)2 * NT + row) * 768 + cc); u32x4 r;
#pragma unroll
        for (int j = 0; j < 4; ++j) r[j] = cvtpk(w0 * bf_lo(a[j]) + w1 * bf_lo(bq[j]) + w2 * bf_lo(cq[j]), w0 * bf_hi(a[j]) + w1 * bf_hi(bq[j]) + w2 * bf_hi(cq[j]));
        gst<u32x4>(MIX + row * DM + 512 + cc, r);
    }
}
__device__ __forceinline__ void phase_attn_d(const Params& p, int ctr_idx, LAS char* lds) {
    unsigned* ctr = (unsigned*)(ows(p.ws) + OFF_CTR) + ctr_idx;
    constexpr int NWIN = 384, NDIL = NB * 6 * 48, NCMP = 384;
    for (;;) { const int it = claim(ctr, lds); if (it >= NWIN + NDIL + NCMP) break;
        if (it < NWIN) item_win(p, it, lds); else if (it < NWIN + NDIL) item_dil(p, it - NWIN, lds); else item_cmp(p, it - NWIN - NDIL, lds); }
}
__device__ __forceinline__ void phase_attn_e(const Params& p, int ctr_idx, LAS char* lds) {
    unsigned* ctr = (unsigned*)(ows(p.ws) + OFF_CTR) + ctr_idx;
    constexpr int NMLA = 256, NSLC = 384, NMIX = NT / 64;
    const bool deal = gridDim.x == 512;
    int it = 0; bool first = deal;
    if (deal) { const int b = oblk(); it = b < NMLA ? b : 256 + (511 - b); }
    for (;;) {
        if (!first) { const int c = claim(ctr, lds); it = (deal ? 512 : 0) + c; if (it >= NMLA + NSLC + NMIX) break; }
        first = false;
        if (it < NMLA) item_mla(p, it, lds); else if (it < NMLA + NSLC) item_slc(p, it - NMLA, lds); else item_dilmix(p, it - NMLA - NSLC, lds);
    }
}
__device__ __forceinline__ void phase_combine(const Params& p) {
    char* ws = ows(p.ws);
    const bf16_t* OD = (const bf16_t*)(ws + OFF_ODIL); const float* LD = (const float*)(ws + OFF_LDIL);
    const bf16_t* PC = (const bf16_t*)(ws + OFF_PC); const bf16_t* PS = (const bf16_t*)(ws + OFF_PS); const bf16_t* PW = (const bf16_t*)(ws + OFF_PW);
    const float* G = (const float*)(ws + OFF_GATES); bf16_t* MIX = (bf16_t*)(ws + OFF_MIX);
    for (size_t e = (size_t)oblk() * 256 + otid(); e < (size_t)NT * 192; e += (size_t)gridDim.x * 256) {
        const size_t row = e / 192; const int c = (int)(e % 192), isn = c >= 96, cc = (isn ? c - 96 : c) * 8, h = cc >> 7;
        float w0, w1, w2; const bf16_t *s0, *s1, *s2;
        if (!isn) { const float L0 = gld<float>(LD + row * 6 + h), L1 = gld<float>(LD + ((size_t)NT + row) * 6 + h), L2 = gld<float>(LD + ((size_t)2 * NT + row) * 6 + h);
            const float M = fmaxf(L0, fmaxf(L1, L2)); w0 = __builtin_amdgcn_exp2f(L0 - M); w1 = __builtin_amdgcn_exp2f(L1 - M); w2 = __builtin_amdgcn_exp2f(L2 - M);
            const float inv = 1.f / (w0 + w1 + w2); w0 *= inv; w1 *= inv; w2 *= inv;
            s0 = OD + row * 768 + cc; s1 = OD + ((size_t)NT + row) * 768 + cc; s2 = OD + ((size_t)2 * NT + row) * 768 + cc;
        } else { w0 = gld<float>(G + row * 18 + h * 3); w1 = gld<float>(G + row * 18 + h * 3 + 1); w2 = gld<float>(G + row * 18 + h * 3 + 2); s0 = PC + row * 768 + cc; s1 = PS + row * 768 + cc; s2 = PW + row * 768 + cc; }
        const u32x4 a = gld<u32x4>(s0), bq = gld<u32x4>(s1), cq = gld<u32x4>(s2); u32x4 r;
#pragma unroll
        for (int j = 0; j < 4; ++j) r[j] = cvtpk(w0 * bf_lo(a[j]) + w1 * bf_lo(bq[j]) + w2 * bf_lo(cq[j]), w0 * bf_hi(a[j]) + w1 * bf_hi(bq[j]) + w2 * bf_hi(cq[j]));
        gst<u32x4>(MIX + row * DM + 512 + (isn ? 768 : 0) + cc, r);
    }
}

__device__ __forceinline__ void phase_ln(const Params& p, int layer, int mode) {
    char* ws = ows(p.ws); const int tid = otid(), lane = tid & 63, wv = (oblk() * 256 + tid) >> 6, nw = gridDim.x * 4;
    const float* g = p.in[mode ? I_LN2G : I_LN1G] + layer * DM; const float* bb = p.in[mode ? I_LN2B : I_LN1B] + layer * DM;
    for (int row = wv; row < NT; row += nw) {
        f32x4 v[8];
        if (mode == 0) { const float* y = (const float*)(ws + OFF_YB) + (size_t)row * DM;
#pragma unroll
            for (int i = 0; i < 8; ++i) v[i] = gld<f32x4>(y + (i * 64 + lane) * 4);
        } else { const float* x1 = (const float*)(ws + OFF_X1) + (size_t)row * DM; const bf16_t* y0 = (const bf16_t*)(ws + OFF_Y) + (size_t)(2 * row) * DM; const bf16_t* y1 = y0 + DM;
#pragma unroll
            for (int i = 0; i < 8; ++i) { const int c = (i * 64 + lane) * 4; const f32x4 xv = gld<f32x4>(x1 + c); const u32x2 a = gld<u32x2>(y0 + c), b2 = gld<u32x2>(y1 + c);
                v[i][0] = DN_ALPHA * xv[0] + bf_lo(a.x) + bf_lo(b2.x); v[i][1] = DN_ALPHA * xv[1] + bf_hi(a.x) + bf_hi(b2.x);
                v[i][2] = DN_ALPHA * xv[2] + bf_lo(a.y) + bf_lo(b2.y); v[i][3] = DN_ALPHA * xv[3] + bf_hi(a.y) + bf_hi(b2.y); }
        }
        float s = 0.f;
#pragma unroll
        for (int i = 0; i < 8; ++i) s += (v[i][0] + v[i][1]) + (v[i][2] + v[i][3]);
        const float mu = wave_sum(s) * (1.f / DM);
        float q = 0.f;
#pragma unroll
        for (int i = 0; i < 8; ++i) { const f32x4 d = v[i] - mu; q += (d[0] * d[0] + d[1] * d[1]) + (d[2] * d[2] + d[3] * d[3]); }
        const float rstd = 1.f / sqrtf(wave_sum(q) * (1.f / DM) + 1e-5f);
        float* of = mode == 0 ? (float*)(ws + OFF_X1) + (size_t)row * DM : (layer == DEPTH - 1 ? p.out + (size_t)row * DM : (float*)(ws + OFF_XA) + (size_t)row * DM);
        bf16_t* ob = mode == 0 ? (bf16_t*)(ws + OFF_X1B) + (size_t)row * DM : (bf16_t*)(ws + OFF_XB) + (size_t)row * DM;
#pragma unroll
        for (int i = 0; i < 8; ++i) { const int c = (i * 64 + lane) * 4; const f32x4 gv = gld<f32x4>(g + c), bv = gld<f32x4>(bb + c);
            f32x4 o = (v[i] - mu) * rstd * gv + bv; gst<f32x4>(of + c, o);
            if (mode == 0 || layer < DEPTH - 1) store_bf4(ob + c, o[0], o[1], o[2], o[3]); }
    }
}
__device__ __forceinline__ void ln1_row(char* ws, const float* g, const float* bb, int row, int lane) {
    const float* y = (const float*)(ws + OFF_YB) + (size_t)row * DM;
    f32x4 v[8];
#pragma unroll
    for (int i = 0; i < 8; ++i) v[i] = gld<f32x4>(y + (i * 64 + lane) * 4);
    float s = 0.f;
#pragma unroll
    for (int i = 0; i < 8; ++i) s += (v[i][0] + v[i][1]) + (v[i][2] + v[i][3]);
    const float mu = wave_sum(s) * (1.f / DM);
    float q = 0.f;
#pragma unroll
    for (int i = 0; i < 8; ++i) { const f32x4 d = v[i] - mu; q += (d[0] * d[0] + d[1] * d[1]) + (d[2] * d[2] + d[3] * d[3]); }
    const float rstd = 1.f / sqrtf(wave_sum(q) * (1.f / DM) + 1e-5f);
    float* of = (float*)(ws + OFF_X1) + (size_t)row * DM; bf16_t* ob = (bf16_t*)(ws + OFF_X1B) + (size_t)row * DM;
#pragma unroll
    for (int i = 0; i < 8; ++i) { const int c = (i * 64 + lane) * 4; const f32x4 gv = gld<f32x4>(g + c), bv = gld<f32x4>(bb + c);
        const f32x4 o = (v[i] - mu) * rstd * gv + bv; gst<f32x4>(of + c, o); store_bf4(ob + c, o[0], o[1], o[2], o[3]); }
}
__device__ __forceinline__ void phase_router(const Params& p, int layer, LAS char* lds) {
    char* ws = ows(p.ws); const int tid = otid(), lane = tid & 63, w = tid >> 6, l32 = lane & 31, hi = lane >> 5;
    const float* X1 = (const float*)(ws + OFF_X1); const float* We = p.in[I_WEXP] + (size_t)layer * DM * 32; const float* Wg = p.in[I_WGRP] + (size_t)layer * DM * 4;
    const float* lng = p.in[I_LN1G] + layer * DM; const float* lnb = p.in[I_LN1B] + layer * DM;
    LAS float* red = (LAS float*)lds;
    unsigned* ecnt = (unsigned*)(ws + OFF_ECNT); int* list = (int*)(ws + OFF_LIST); float* gw = (float*)(ws + OFF_GW);
    for (int it = oblk(); it < NT / 32; it += gridDim.x) {
        const int t0 = it * 32;
        for (int r = 0; r < 8; ++r) ln1_row(ws, lng, lnb, t0 + 8 * w + r, lane);
        asm volatile("s_waitcnt vmcnt(0)" ::: "memory");
        __syncthreads();
        f32x16 ae, ag;
#pragma unroll
        for (int r = 0; r < 16; ++r) { ae[r] = 0.f; ag[r] = 0.f; }
        const float* xr = X1 + (size_t)(t0 + l32) * DM + w * 512 + 4 * hi;
        const float* wer = We + (size_t)(w * 512 + 4 * hi) * 32 + l32;
        const float* wgr = Wg + (size_t)(w * 512 + 4 * hi) * 4 + (l32 & 3);
        f32x4 xa[4], xb[4]; float wea[4][4], web[4][4], wga[4][4], wgb[4][4];
#define RT_LOAD(X, WE, WG, KC) do { _Pragma("unroll") for (int i_ = 0; i_ < 4; ++i_) { X[i_] = gld<f32x4>(xr + (KC) + 8 * i_); \
            _Pragma("unroll") for (int j_ = 0; j_ < 4; ++j_) { WE[i_][j_] = gld<float>(wer + (size_t)((KC) + 8 * i_ + j_) * 32); WG[i_][j_] = l32 < 4 ? gld<float>(wgr + (size_t)((KC) + 8 * i_ + j_) * 4) : 0.f; } } } while (0)
#define RT_MMA(X, WE, WG) do { _Pragma("unroll") for (int i_ = 0; i_ < 4; ++i_) _Pragma("unroll") for (int j_ = 0; j_ < 4; ++j_) { \
            ae = __builtin_amdgcn_mfma_f32_32x32x2f32(X[i_][j_], WE[i_][j_], ae, 0, 0, 0); ag = __builtin_amdgcn_mfma_f32_32x32x2f32(X[i_][j_], WG[i_][j_], ag, 0, 0, 0); } } while (0)
        RT_LOAD(xa, wea, wga, 0);
        for (int kc = 0; kc < 512; kc += 64) {
            RT_LOAD(xb, web, wgb, kc + 32);
            RT_MMA(xa, wea, wga);
            if (kc + 64 < 512) RT_LOAD(xa, wea, wga, kc + 64);
            RT_MMA(xb, web, wgb);
        }
#undef RT_LOAD
#undef RT_MMA
        __syncthreads();
#pragma unroll
        for (int r = 0; r < 16; ++r) { const int tk = crow(r, hi); red[(w * 32 + tk) * 36 + l32] = ae[r]; if (l32 < 4) red[(w * 32 + tk) * 36 + 32 + l32] = ag[r]; }
        __syncthreads();
        if (tid < 32) {
            const int tk = tid;
            float lg[4];
#pragma unroll
            for (int j = 0; j < 4; ++j) lg[j] = (red[(0 * 32 + tk) * 36 + 32 + j] + red[(1 * 32 + tk) * 36 + 32 + j]) + (red[(2 * 32 + tk) * 36 + 32 + j] + red[(3 * 32 + tk) * 36 + 32 + j]);
            int gi = 0; float gm = lg[0];
#pragma unroll
            for (int j = 1; j < 4; ++j) if (lg[j] > gm) { gm = lg[j]; gi = j; }
            float den = 0.f;
#pragma unroll
            for (int j = 0; j < 4; ++j) den += __expf(lg[j] - gm);
            const float pg = 1.f / den;
            float b0 = -__builtin_inff(), b1 = -__builtin_inff(); int i0 = 0, i1 = 0;
#pragma unroll
            for (int j = 0; j < 8; ++j) { const int n = gi * 8 + j;
                const float v = (red[(0 * 32 + tk) * 36 + n] + red[(1 * 32 + tk) * 36 + n]) + (red[(2 * 32 + tk) * 36 + n] + red[(3 * 32 + tk) * 36 + n]);
                if (v > b0) { b1 = b0; i1 = i0; b0 = v; i0 = j; } else if (v > b1) { b1 = v; i1 = j; } }
            const float w1 = __expf(b1 - b0), g0 = pg / (1.f + w1), g1 = pg * w1 / (1.f + w1);
            const int tok = t0 + tk, e0 = gi * 8 + i0, e1 = gi * 8 + i1;
            const unsigned p0 = atomicAdd(&ecnt[e0], 1u), p1 = atomicAdd(&ecnt[e1], 1u);
            list[(size_t)e0 * NT + p0] = 2 * tok; list[(size_t)e1 * NT + p1] = 2 * tok + 1;
            gw[2 * tok] = g0; gw[2 * tok + 1] = g1;
        }
        __syncthreads();
    }
}
__device__ __forceinline__ int moe_table(const Params& p, LAS char* lds) {
    LAS int* off = (LAS int*)(lds + LDS_CTL + 128); LAS int* toff = off + 33;
    __syncthreads();
    if (otid() == 0) { const unsigned* ecnt = (const unsigned*)(ows(p.ws) + OFF_ECNT); int a = 0, t = 0;
        for (int e = 0; e < NEXP; ++e) { off[e] = a; toff[e] = t; const int c = (int)ecnt[e]; a += c; t += (c + 127) >> 7; } off[NEXP] = a; toff[NEXP] = t; }
    __syncthreads();
    return toff[NEXP];
}
__device__ __forceinline__ void phase_moe1(const Params& p, LAS char* lds) {
    char* ws = ows(p.ws); const int tid = otid(), sr = tid >> 3, sc = (tid & 7) * 8;
    const int ntile = moe_table(p, lds); const LAS int* off = (const LAS int*)(lds + LDS_CTL + 128); const LAS int* toff = off + 33;
    const unsigned* ecnt = (const unsigned*)(ws + OFF_ECNT); const int* list = (const int*)(ws + OFF_LIST);
    const bf16_t* X1B = (const bf16_t*)(ws + OFF_X1B);
    for (int u = oblk(); u < ntile * 4; u += gridDim.x) {
        int e = 0; for (int k = 1; k < NEXP; ++k) if (u >= toff[k] * 4) e = k;
        const int mte = toff[e + 1] - toff[e], v = u - toff[e] * 4, nt = v / mte, mt = v - nt * mte;
        const int cnt = (int)ecnt[e], nvalid = cnt - mt * 128 < 128 ? cnt - mt * 128 : 128;
        const int* le = list + (size_t)e * NT + mt * 128;
        unsigned ao[4];
#pragma unroll
        for (int i = 0; i < 4; ++i) { const int r = sr + 32 * i; ao[i] = (unsigned)((gld<int>(le + (r < nvalid ? r : 0)) >> 1) * DM + sc); }
        EpiMoe1 ep{(bf16_t*)(ws + OFF_HM), off[e] + mt * 128, nvalid, nt * 256};
        gemm_unit(lds, X1B, ao, 128, (const bf16_t*)(ws + OFF_WGU_T) + ((size_t)e * 1024 + nt * 256) * DM, (unsigned)(sr * DM + sc), (size_t)32 * DM, DM / 64, ep);
    }
}
__device__ __forceinline__ void phase_moe2(const Params& p, LAS char* lds) {
    char* ws = ows(p.ws); const int tid = otid(), sr = tid >> 3, sc = (tid & 7) * 8;
    const int ntile = moe_table(p, lds); const LAS int* off = (const LAS int*)(lds + LDS_CTL + 128); const LAS int* toff = off + 33;
    const unsigned* ecnt = (const unsigned*)(ws + OFF_ECNT); const int* list = (const int*)(ws + OFF_LIST);
    const bf16_t* HM = (const bf16_t*)(ws + OFF_HM);
    for (int u = oblk(); u < ntile * 8; u += gridDim.x) {
        int e = 0; for (int k = 1; k < NEXP; ++k) if (u >= toff[k] * 8) e = k;
        const int mte = toff[e + 1] - toff[e], v = u - toff[e] * 8, nt = v / mte, mt = v - nt * mte;
        const int cnt = (int)ecnt[e], nvalid = cnt - mt * 128 < 128 ? cnt - mt * 128 : 128;
        const unsigned ao[4] = AO4(EFF);
        EpiMoe2 ep{(bf16_t*)(ws + OFF_Y), list + (size_t)e * NT + mt * 128, (const float*)(ws + OFF_GW), nvalid, nt * 256};
        gemm_unit(lds, HM + (size_t)(off[e] + mt * 128) * EFF, ao, 128, (const bf16_t*)(ws + OFF_WD_T) + ((size_t)e * DM + nt * 256) * EFF, (unsigned)(sr * EFF + sc), (size_t)32 * EFF, EFF / 64, ep);
    }
}

__device__ __forceinline__ Params load_params() {
    Params q;
#if defined(__HIP_DEVICE_COMPILE__)
    const CAS Params* pp = (const CAS Params*)__builtin_amdgcn_kernarg_segment_ptr(); asm volatile("" : "+s"(pp));
#pragma unroll
    for (int i = 0; i < 22; ++i) q.in[i] = pp->in[i];
    q.out = pp->out; q.ws = pp->ws;
#endif
    return q;
}
constexpr int REP_PREP = 1, REP_GEMM = 1, REP_ATTN = 1;
__global__ void __launch_bounds__(256, 2) fwd_kernel(Params p) {
    extern __shared__ __attribute__((aligned(16))) char lds_raw[];
    LAS char* lds = (LAS char*)lds_raw;
    if (threadIdx.x == 0) { *(LAS u32x4*)(lds + LDS_CTL) = (u32x4){0u, 0u, 0u, 0u}; }
    __syncthreads();
    XcdBarrier bar = xcd_barrier_post((unsigned*)(p.ws + OFF_BAR), (volatile LAS unsigned*)(lds + LDS_CTL));
    for (int layer = 0; layer < DEPTH; ++layer) {
        for (int r = 0; r < REP_PREP; ++r) { phase_prep(load_params(), layer, lds);              xcd_barrier(bar); }
        for (int r = 0; r < REP_GEMM; ++r) { phase_win(load_params(), layer, lds);               xcd_barrier(bar); }
        phase_up(load_params(), layer, lds);                xcd_barrier(bar);
        phase_cmp2(load_params(), layer, lds);              xcd_barrier(bar);
        for (int r = 0; r < REP_ATTN; ++r) { phase_attn_d(load_params(), 64 * (2 * layer) + 16 * r, lds);       xcd_barrier(bar); }
        for (int r = 0; r < REP_ATTN; ++r) { phase_attn_e(load_params(), 64 * (2 * layer + 1) + 16 * r, lds);   xcd_barrier(bar); }
        for (int r = 0; r < REP_GEMM; ++r) { phase_out(load_params(), layer, lds);               xcd_barrier(bar); }
        phase_router(load_params(), layer, lds);            xcd_barrier(bar);
        for (int r = 0; r < REP_GEMM; ++r) { phase_moe1(load_params(), lds);                     xcd_barrier(bar); }
        for (int r = 0; r < REP_GEMM; ++r) { phase_moe2(load_params(), lds);                     xcd_barrier(bar); }
        phase_ln(load_params(), layer, 1);                  xcd_barrier(bar);
    }
}

extern "C" void kernel_launch(void* const* d_in, const int* in_sizes, int n_in, void* d_out, int out_size, void* d_ws, size_t ws_size, hipStream_t stream) {
    (void)in_sizes; (void)out_size;
    static int grid = 0;
    if (!grid) {
        int dev = 0, cus = 0, per_cu = 0;
        (void)hipGetDevice(&dev);
        (void)hipDeviceGetAttribute(&cus, hipDeviceAttributeMultiprocessorCount, dev);
        (void)hipFuncSetAttribute((const void*)fwd_kernel, hipFuncAttributeMaxDynamicSharedMemorySize, LDS_BYTES);
        (void)hipOccupancyMaxActiveBlocksPerMultiprocessor(&per_cu, (const void*)fwd_kernel, 256, LDS_BYTES);
        if (cus <= 0) cus = 256;
        if (per_cu < 1) per_cu = 1;
        grid = cus * (per_cu < 2 ? per_cu : 2);
    }
    if (n_in < 22 || ws_size < WS_TOTAL) { fprintf(stderr, "kernel_launch: bad arguments (n_in %d, ws %zu < %zu)\n", n_in, ws_size, (size_t)WS_TOTAL); return; }
    Params p;
    for (int i = 0; i < 22; ++i) p.in[i] = (const float*)d_in[i];
    p.out = (float*)d_out; p.ws = (char*)d_ws;
    (void)hipMemsetAsync(d_ws, 0, ZERO_BYTES, stream);
    fwd_kernel<<<dim3(grid), dim3(256), LDS_BYTES, stream>>>(p);
}
```

```cpp
#include <hip/hip_runtime.h>
#include <stdint.h>
#include <stdio.h>

#define LAS __attribute__((address_space(3)))
#define GAS __attribute__((address_space(1)))
#define CAS __attribute__((address_space(4)))
typedef unsigned short bf16_t;
typedef short bf16x8 __attribute__((ext_vector_type(8)));
typedef short s16x4 __attribute__((ext_vector_type(4)));
typedef float f32x16 __attribute__((ext_vector_type(16)));
typedef float f32x4 __attribute__((ext_vector_type(4)));
typedef float f32x2 __attribute__((ext_vector_type(2)));
typedef unsigned u32x4 __attribute__((ext_vector_type(4)));
typedef unsigned u32x2 __attribute__((ext_vector_type(2)));

constexpr int NB = 4, SEQ = 2048, NT = NB * SEQ, DM = 2048, DEPTH = 2;
constexpr int INC = 4434, LDH = 4608;
constexpr int C_QLAT = 0, C_KVLAT = 384, C_KROPE = 512, C_DQ = 576, C_DK = 1344, C_DV = 2112, C_NQ = 2880, C_NKC = 3648, C_NVC = 3776,
              C_NKS = 3904, C_NVS = 4032, C_NKW = 4160, C_NVW = 4288, C_GATE = 4416;
constexpr int NEXP = 32, EFF = 512;
constexpr float DN_ALPHA = 1.41421356237309515f;
constexpr float LOG2E = 1.4426950408889634f;

constexpr size_t al256(size_t x) { return (x + 255) & ~(size_t)255; }
constexpr size_t OFF_BAR = 0;
constexpr size_t OFF_CTR = 16384;
constexpr size_t ZERO_BYTES = 20480;
constexpr size_t OFF_ECNT = ZERO_BYTES;
constexpr size_t OFF_CS16 = OFF_ECNT + 256;
constexpr size_t OFF_CS32 = OFF_CS16 + (size_t)SEQ * 16 * 8;
constexpr size_t OFF_WIN_T = OFF_CS32 + (size_t)SEQ * 32 * 8;
constexpr size_t OFF_WQ_T = OFF_WIN_T + (size_t)LDH * DM * 2;
constexpr size_t OFF_WKV_T = OFF_WQ_T + (size_t)768 * 384 * 2;
constexpr size_t OFF_W1K_T = OFF_WKV_T + (size_t)1024 * 128 * 2;
constexpr size_t OFF_W1V_T = OFF_W1K_T + (size_t)256 * 4096 * 2;
constexpr size_t OFF_W2K_T = OFF_W1V_T + (size_t)256 * 4096 * 2;
constexpr size_t OFF_W2V_T = OFF_W2K_T + (size_t)256 * 256 * 2;
constexpr size_t OFF_WOUT_T = OFF_W2V_T + (size_t)256 * 256 * 2;
constexpr size_t OFF_WGU_T = OFF_WOUT_T + (size_t)DM * DM * 2;
constexpr size_t OFF_WD_T = OFF_WGU_T + (size_t)NEXP * 1024 * DM * 2;
constexpr size_t OFF_B1P = OFF_WD_T + (size_t)NEXP * DM * EFF * 2;
constexpr size_t OFF_XB = OFF_B1P + (size_t)2 * 16 * 256 * 4;
constexpr size_t OFF_H = OFF_XB + (size_t)NT * DM * 2;
constexpr size_t OFF_GATES = OFF_H + (size_t)NT * LDH * 2;
constexpr size_t OFF_QM = OFF_GATES + al256((size_t)NT * 18 * 4);
constexpr size_t OFF_KN = OFF_QM + (size_t)NT * 768 * 2;
constexpr size_t OFF_VM = OFF_KN + (size_t)NT * 512 * 2;
static_assert(OFF_VM == OFF_KN + (size_t)NT * 512 * 2, "Vm must follow Kn");
constexpr size_t OFF_HC = OFF_VM + (size_t)NT * 512 * 2;
constexpr size_t OFF_HCP = OFF_HC + (size_t)2 * 512 * 256 * 2;
constexpr size_t OFF_KC = OFF_HCP + (size_t)8 * 2 * 512 * 256 * 4;
constexpr size_t OFF_VC = OFF_KC + (size_t)512 * 128 * 2;
constexpr size_t OFF_IMP = OFF_VC + (size_t)512 * 128 * 2;
constexpr size_t OFF_ODIL = OFF_IMP + (size_t)NT * 32 * 4;
constexpr size_t OFF_LDIL = OFF_ODIL + (size_t)3 * NT * 768 * 2;
constexpr size_t OFF_PC = OFF_LDIL + (size_t)3 * NT * 6 * 4;
constexpr size_t OFF_PS = OFF_PC + (size_t)NT * 768 * 2;
constexpr size_t OFF_PW = OFF_PS + (size_t)NT * 768 * 2;
constexpr size_t OFF_MIX = OFF_PW + (size_t)NT * 768 * 2;
constexpr size_t OFF_YB = OFF_MIX + (size_t)NT * DM * 2;
constexpr size_t OFF_XA = OFF_YB + (size_t)NT * DM * 4;
constexpr size_t OFF_X1 = OFF_XA + (size_t)NT * DM * 4;
constexpr size_t OFF_X1B = OFF_X1 + (size_t)NT * DM * 4;
constexpr size_t OFF_HM = OFF_X1B + (size_t)NT * DM * 2;
constexpr size_t OFF_Y = OFF_HM + (size_t)(2 * NT + 128) * EFF * 2;
constexpr size_t OFF_LIST = OFF_Y + (size_t)2 * NT * DM * 2;
constexpr size_t OFF_GW = OFF_LIST + (size_t)NEXP * NT * 4;
constexpr size_t WS_TOTAL = OFF_GW + (size_t)2 * NT * 4;

struct Params { const float* in[22]; float* out; char* ws; };
enum { I_X = 0, I_WIN, I_QLN, I_WQUP, I_KVLN, I_WKVUP, I_PEK, I_W1K, I_W2K, I_PEV, I_W1V, I_W2V, I_WOUT, I_LN1G, I_LN1B, I_WGRP, I_WEXP, I_WGATE, I_WUP, I_WDOWN, I_LN2G, I_LN2B };

#define XB_TMO      128
#define XB_XCNT(j)  (256  + 64 * (j))
#define XB_XSUB(j)  (1280 + 64 * (j))
#define XB_XGEN(j)  (2304 + 64 * (j))
#define XB_TOP      3328
#define XB_TOPGEN   3392
#define XCD_BAR_WORDS 3456
#define XB_SPIN_CAP (1u << 18)

__device__ __forceinline__ unsigned xb_ld(unsigned* p)              { return __hip_atomic_load(p, __ATOMIC_RELAXED, __HIP_MEMORY_SCOPE_AGENT); }
__device__ __forceinline__ unsigned xb_add(unsigned* p, unsigned v) { return __hip_atomic_fetch_add(p, v, __ATOMIC_RELAXED, __HIP_MEMORY_SCOPE_AGENT); }
__device__ __forceinline__ unsigned xb_xcc_id() { return (unsigned)__builtin_amdgcn_s_getreg((3 << 11) | 20) & 0xFu; }
#define XB_SPIN(cond, bar) do { unsigned _sp = 0; while (cond) { __builtin_amdgcn_s_sleep(1); \
    if ((++_sp & 255u) == 0u) { if (xb_ld(&(bar)[XB_TMO])) break; if (_sp > XB_SPIN_CAP) { atomicAdd(&(bar)[XB_TMO], 1u); break; } } } } while (0)

struct XcdBarrier { unsigned* bar; unsigned x; volatile LAS unsigned* st; };

__device__ __forceinline__ XcdBarrier xcd_barrier_post(unsigned* bar, volatile LAS unsigned* st) {
    XcdBarrier b; b.bar = bar; b.x = xb_xcc_id(); b.st = st;
    if (threadIdx.x == 0) (void)xb_add(&bar[XB_XCNT(b.x)], 1u);
    return b;
}
__device__ __forceinline__ void xcd_barrier_complete(unsigned* bar, unsigned x, unsigned& nloc, unsigned& nx) {
    const unsigned G = gridDim.x * gridDim.y * gridDim.z;
    unsigned sum, cnt, mine, sp = 0u;
    for (;;) {
        sum = 0u; cnt = 0u; mine = 0u;
#pragma unroll
        for (unsigned j = 0; j < 16; ++j) { const unsigned c = xb_ld(&bar[XB_XCNT(j)]); sum += c; cnt += (c > 0u) ? 1u : 0u; mine = (j == x) ? c : mine; }
        if (sum == G) break;
        __builtin_amdgcn_s_sleep(1);
        if ((++sp & 255u) == 0u) { if (xb_ld(&bar[XB_TMO])) break; if (sp > XB_SPIN_CAP) { atomicAdd(&bar[XB_TMO], 1u); break; } }
    }
    nloc = mine > 0u ? mine : 1u; nx = cnt > 0u ? cnt : 1u;
}
__device__ __forceinline__ void xcd_barrier(const XcdBarrier& b) {
    asm volatile("s_waitcnt vmcnt(0)" ::: "memory");
    __syncthreads();
    if (threadIdx.x == 0) {
        unsigned* bar = b.bar;
        __builtin_amdgcn_s_waitcnt(0);
        unsigned nloc = b.st[0], nx = b.st[1];
        if (nloc == 0u) { xcd_barrier_complete(bar, b.x, nloc, nx); b.st[0] = nloc; b.st[1] = nx; }
        const unsigned old = xb_add(&bar[XB_XSUB(b.x)], 1u);
        const unsigned gen = old / nloc;
        if (old + 1u == (gen + 1u) * nloc) {
            __builtin_amdgcn_fence(__ATOMIC_RELEASE, "agent");
            asm volatile("s_waitcnt vmcnt(0)" ::: "memory");
            const unsigned og = xb_add(&bar[XB_TOP], 1u);
            const unsigned tg = og / nx;
            if (og + 1u == (tg + 1u) * nx) xb_add(&bar[XB_TOPGEN], 1u);
            else XB_SPIN(xb_ld(&bar[XB_TOPGEN]) == tg, bar);
            __builtin_amdgcn_fence(__ATOMIC_ACQUIRE, "agent");
            xb_add(&bar[XB_XGEN(b.x)], 1u);
            asm volatile("s_waitcnt vmcnt(0)" ::: "memory");
        } else {
            XB_SPIN(xb_ld(&bar[XB_XGEN(b.x)]) == gen, bar);
            __builtin_amdgcn_fence(__ATOMIC_ACQUIRE, "agent");
            asm volatile("s_waitcnt vmcnt(0)" ::: "memory");
        }
    }
    __syncthreads();
}

template <class T> __device__ __forceinline__ T gld(const void* p) { return *(const GAS T*)p; }
template <class T> __device__ __forceinline__ void gst(void* p, const T& v) { *(GAS T*)p = v; }
__device__ __forceinline__ __amdgpu_buffer_rsrc_t mk_rsrc(const void* p) {
    const unsigned long long v = (unsigned long long)p;
    const unsigned lo = __builtin_amdgcn_readfirstlane((unsigned)v), hi = __builtin_amdgcn_readfirstlane((unsigned)(v >> 32));
    return __builtin_amdgcn_make_buffer_rsrc((void*)(((unsigned long long)hi << 32) | lo), 0, 0xFFFFFFF0u, 0x00020000);
}
__device__ __forceinline__ bf16x8 bld8(__amdgpu_buffer_rsrc_t r, unsigned voff, int soff) { const u32x4 v = __builtin_amdgcn_raw_buffer_load_b128(r, (int)voff, soff, 0); return __builtin_bit_cast(bf16x8, v); }
__device__ __forceinline__ unsigned cvtpk(float lo, float hi) { unsigned r; asm volatile("v_cvt_pk_bf16_f32 %0, %1, %2" : "=v"(r) : "v"(lo), "v"(hi)); return r; }
__device__ __forceinline__ float bf_lo(unsigned u) { return __uint_as_float(u << 16); }
__device__ __forceinline__ float bf_hi(unsigned u) { return __uint_as_float(u & 0xffff0000u); }
__device__ __forceinline__ float bf2f(bf16_t b) { return __uint_as_float((unsigned)b << 16); }
__device__ __forceinline__ float wave_sum(float v) {
#pragma unroll
    for (int o = 32; o >= 1; o >>= 1) v += __shfl_xor(v, o);
    return v;
}
__device__ __forceinline__ int otid() { int t = threadIdx.x; asm volatile("" : "+v"(t)); return t; }
__device__ __forceinline__ int oblk() { int b = blockIdx.x; asm volatile("" : "+s"(b)); return b; }
__device__ __forceinline__ char* ows(const char* w) { char* q = const_cast<char*>(w); asm volatile("" : "+s"(q)); return q; }
__device__ __forceinline__ int crow(int r, int hi) { return (r & 3) + 8 * (r >> 2) + 4 * hi; }

constexpr int LDS_BYTES = 65536;
constexpr int LDS_CTL = 65024;

constexpr int GS = 72;
constexpr int G_BOFF = 128 * GS * 2;
constexpr int G_ROWSS = 384 * GS * 2;

template <int NI, class EPI>
__device__ __forceinline__ void gemm_unit_n(LAS char* lds, const bf16_t* abase, const unsigned (&aoff)[4], int ajump, const bf16_t* bbase, unsigned boff, size_t ldb32, int nkt, const EPI& epi) {
    const int tid = otid(), lane = tid & 63, w = tid >> 6, l32 = lane & 31, hi = lane >> 5;
    const int wm = w >> 1, wn = w & 1;
    const int sr = tid >> 3, sc = (tid & 7) * 8;
    const int st_off = (sr * GS + sc) * 2;
    const int a_rd = ((wm * 64 + l32) * GS + hi * 8) * 2;
    const int b_rd = G_BOFF + ((wn * 32 * NI + l32) * GS + hi * 8) * 2;
    f32x16 acc[2][NI];
#pragma unroll
    for (int i = 0; i < 2; ++i)
#pragma unroll
        for (int j = 0; j < NI; ++j)
#pragma unroll
            for (int r = 0; r < 16; ++r) acc[i][j][r] = 0.f;
    bf16x8 ra[4], rb[2 * NI];
    const __amdgpu_buffer_rsrc_t rsa = mk_rsrc(abase), rsb = mk_rsrc(bbase);
    const int lb2 = (int)(ldb32 * 2);
#pragma unroll
    for (int i = 0; i < 4; ++i) ra[i] = bld8(rsa, 2u * aoff[i], 0);
#pragma unroll
    for (int i = 0; i < 2 * NI; ++i) rb[i] = bld8(rsb, 2u * boff, i * lb2);
    for (int kt = 0; kt < nkt; ++kt) {
#pragma unroll
        for (int i = 0; i < 4; ++i) *(LAS bf16x8*)(lds + st_off + i * 32 * GS * 2) = ra[i];
#pragma unroll
        for (int i = 0; i < 2 * NI; ++i) *(LAS bf16x8*)(lds + G_BOFF + st_off + i * 32 * GS * 2) = rb[i];
        __syncthreads();
        if (kt + 1 < nkt) {
            const int k = (kt + 1) * 64;
            const int ao = (k >> 7) * ajump + (k & 127);
#pragma unroll
            for (int i = 0; i < 4; ++i) ra[i] = bld8(rsa, 2u * aoff[i], 2 * ao);
#pragma unroll
            for (int i = 0; i < 2 * NI; ++i) rb[i] = bld8(rsb, 2u * boff, i * lb2 + 2 * k);
        }
#pragma unroll
        for (int ks = 0; ks < 4; ++ks) {
            bf16x8 af[2], bfr[NI];
#pragma unroll
            for (int i = 0; i < 2; ++i) af[i] = *(const LAS bf16x8*)(lds + a_rd + i * 32 * GS * 2 + ks * 32);
#pragma unroll
            for (int j = 0; j < NI; ++j) bfr[j] = *(const LAS bf16x8*)(lds + b_rd + j * 32 * GS * 2 + ks * 32);
#pragma unroll
            for (int i = 0; i < 2; ++i)
#pragma unroll
                for (int j = 0; j < NI; ++j) acc[i][j] = __builtin_amdgcn_mfma_f32_32x32x16_bf16(bfr[j], af[i], acc[i][j], 0, 0, 0);
            if (ks & 1) asm volatile("" ::: "memory");
        }
        __syncthreads();
    }
    epi(acc, wm, wn, l32, hi, lds);
}
template <class EPI>
__device__ __forceinline__ void gemm_unit(LAS char* lds, const bf16_t* abase, const unsigned (&aoff)[4], int ajump, const bf16_t* bbase, unsigned boff, size_t ldb32, int nkt, const EPI& epi) {
    gemm_unit_n<4>(lds, abase, aoff, ajump, bbase, boff, ldb32, nkt, epi);
}
template <int K> __device__ __forceinline__ void row_sumsq(LAS char* lds, const bf16_t* A, int ld) {
    const int tid = otid(), row = tid >> 1, half = tid & 1;
    const bf16_t* ptr = A + (size_t)row * ld + half * (K / 2);
    float ss = 0.f;
#pragma unroll
    for (int c = 0; c < K / 16; ++c) { const u32x4 v = gld<u32x4>(ptr + c * 8);
#pragma unroll
        for (int j = 0; j < 4; ++j) { const float a = bf_lo(v[j]), b = bf_hi(v[j]); ss += a * a + b * b; } }
    ss += __shfl_xor(ss, 1);
    __syncthreads();
    if (half == 0) ((LAS float*)(lds + G_ROWSS))[row] = ss;
}

__device__ __forceinline__ void store_bf4(bf16_t* p, float a, float b, float c, float d) { u32x2 w; w.x = cvtpk(a, b); w.y = cvtpk(c, d); gst<u32x2>(p, w); }

__device__ __forceinline__ void store_tiles4(bf16_t* p, const f32x16 (&a)[4], float sc) {
#pragma unroll
    for (int ni = 0; ni < 4; ++ni)
#pragma unroll
        for (int q = 0; q < 4; ++q) store_bf4(p + 32 * ni + 8 * q, a[ni][4 * q] * sc, a[ni][4 * q + 1] * sc, a[ni][4 * q + 2] * sc, a[ni][4 * q + 3] * sc);
}
__device__ __forceinline__ void rope_pair32(f32x16& lo, f32x16& hi16, const f32x2* cs32, int pos, int hi, bool on = true) {
#pragma unroll
    for (int r = 0; r < 16; ++r) { f32x2 cs = {1.f, 0.f}; if (on) cs = gld<f32x2>(cs32 + pos * 32 + crow(r, hi)); const float x1 = lo[r], x2 = hi16[r]; lo[r] = x1 * cs.x - x2 * cs.y; hi16[r] = x2 * cs.x + x1 * cs.y; }
}
__device__ __forceinline__ void rope_first32(f32x16& t, const f32x2* cs16, int pos, int hi) {
#pragma unroll
    for (int r = 0; r < 8; ++r) { const f32x2 cs = gld<f32x2>(cs16 + pos * 16 + crow(r, hi)); const float x1 = t[r], x2 = t[r + 8]; t[r] = x1 * cs.x - x2 * cs.y; t[r + 8] = x2 * cs.x + x1 * cs.y; }
}
__device__ __forceinline__ bool is_rope16(int c0) {
    return (((c0 - C_DQ) & 127) == 0) && ((c0 >= C_DQ && c0 < C_DV) || (c0 >= C_NQ && c0 < C_NKC) || c0 == C_NKS || c0 == C_NKW);
}
struct EpiWin {
    bf16_t* H; float* gates; const f32x2* cs16; const f32x2* cs32; int m0, n0;
    __device__ __forceinline__ void operator()(f32x16 (&acc)[2][3], int wm, int wn, int l32, int hi, LAS char*) const {
        const int nw = n0 + 96 * wn;
#pragma unroll
        for (int mi = 0; mi < 2; ++mi) {
            const int row = m0 + 64 * wm + 32 * mi + l32, pos = row & (SEQ - 1);
            if (nw + 32 == C_KROPE) rope_pair32(acc[mi][1], acc[mi][2], cs32, pos, hi);
#pragma unroll
            for (int ni = 0; ni < 3; ++ni) if (is_rope16(nw + 32 * ni)) rope_first32(acc[mi][ni], cs16, pos, hi);
            if (nw == C_GATE) {
#pragma unroll
                for (int r = 0; r < 16; ++r) { const int c = crow(r, hi); if (c < 18) gst<float>(gates + (size_t)row * 18 + c, 1.f / (1.f + __expf(-acc[mi][0][r]))); }
            }
            bf16_t* hp = H + (size_t)row * LDH + nw + 4 * hi;
#pragma unroll
            for (int ni = 0; ni < 3; ++ni)
#pragma unroll
                for (int q = 0; q < 4; ++q) store_bf4(hp + 32 * ni + 8 * q, acc[mi][ni][4 * q], acc[mi][ni][4 * q + 1], acc[mi][ni][4 * q + 2], acc[mi][ni][4 * q + 3]);
        }
    }
};
struct EpiQup {
    bf16_t* Q; const f32x2* cs32; int m0, n0;
    __device__ __forceinline__ void operator()(f32x16 (&acc)[2][4], int wm, int wn, int l32, int hi, LAS char* lds) const {
        const int nw = n0 + 128 * wn; const LAS float* rs = (const LAS float*)(lds + G_ROWSS);
#pragma unroll
        for (int mi = 0; mi < 2; ++mi) {
            const int rl = 64 * wm + 32 * mi + l32, row = m0 + rl, pos = row & (SEQ - 1);
            const float sc = __builtin_amdgcn_rsqf(rs[rl] * (1.f / 384.f) + 1e-6f);
#pragma unroll
            for (int ni = 0; ni < 4; ++ni)
#pragma unroll
                for (int r = 0; r < 16; ++r) acc[mi][ni][r] *= sc;
            rope_pair32(acc[mi][0], acc[mi][1], cs32, pos, hi, (nw % 192) == 128);
            rope_pair32(acc[mi][2], acc[mi][3], cs32, pos, hi, ((nw + 64) % 192) == 128);
            store_tiles4(Q + (size_t)row * 768 + nw + 4 * hi, acc[mi], 1.f);
        }
    }
};
struct EpiKVup {
    bf16_t* Kn; int m0, n0;
    __device__ __forceinline__ void operator()(f32x16 (&acc)[2][4], int wm, int wn, int l32, int hi, LAS char* lds) const {
        const int nw = n0 + 128 * wn; const LAS float* rs = (const LAS float*)(lds + G_ROWSS);
        const int head = nw >> 8, within = nw & 255;
        bf16_t* base = Kn + (within < 128 ? (size_t)0 : (size_t)NT * 512) + head * 128 + 4 * hi;
#pragma unroll
        for (int mi = 0; mi < 2; ++mi) {
            const int rl = 64 * wm + 32 * mi + l32, row = m0 + rl;
            const float sc = __builtin_amdgcn_rsqf(rs[rl] * (1.f / 128.f) + 1e-6f);
            store_tiles4(base + (size_t)row * 512, acc[mi], sc);
        }
    }
};
__device__ __forceinline__ float gelu_tanh(float x) {
    const float u = 0.7978845608028654f * (x + 0.044715f * x * x * x);
    const float e = __expf(-2.f * fabsf(u)); const float t = (1.f - e) / (1.f + e);
    return 0.5f * x * (1.f + (u < 0.f ? -t : t));
}
struct EpiCmp1 {
    float* P; int m0;
    __device__ __forceinline__ void operator()(f32x16 (&acc)[2][4], int wm, int wn, int l32, int hi, LAS char*) const {
#pragma unroll
        for (int mi = 0; mi < 2; ++mi) {
            float* p = P + (size_t)(m0 + 64 * wm + 32 * mi + l32) * 256 + 128 * wn + 4 * hi;
#pragma unroll
            for (int ni = 0; ni < 4; ++ni)
#pragma unroll
                for (int q = 0; q < 4; ++q) { f32x4 v = {acc[mi][ni][4 * q], acc[mi][ni][4 * q + 1], acc[mi][ni][4 * q + 2], acc[mi][ni][4 * q + 3]}; gst<f32x4>(p + 32 * ni + 8 * q, v); }
        }
    }
};
struct EpiCmp2 {
    bf16_t* O; const f32x2* cs16; int dorope; int m0;
    __device__ __forceinline__ void operator()(f32x16 (&acc)[2][4], int wm, int wn, int l32, int hi, LAS char*) const {
        if (wn != 0) return;
#pragma unroll
        for (int mi = 0; mi < 2; ++mi) {
            const int row = m0 + 64 * wm + 32 * mi + l32, c = row & 127, pos = 16 * c + 31;
            if (dorope && c < 127) rope_first32(acc[mi][0], cs16, pos, hi);
            store_tiles4(O + (size_t)row * 128 + 4 * hi, acc[mi], c < 127 ? 1.f : 0.f);
        }
    }
};
struct EpiOut {
    float* Y; const float* X; int m0, n0;
    __device__ __forceinline__ void operator()(f32x16 (&acc)[2][4], int wm, int wn, int l32, int hi, LAS char*) const {
        const int nw = n0 + 128 * wn;
#pragma unroll
        for (int mi = 0; mi < 2; ++mi) {
            const size_t off = (size_t)(m0 + 64 * wm + 32 * mi + l32) * DM + nw + 4 * hi;
#pragma unroll
            for (int ni = 0; ni < 4; ++ni)
#pragma unroll
                for (int q = 0; q < 4; ++q) { const f32x4 xv = gld<f32x4>(X + off + 32 * ni + 8 * q);
                    f32x4 o; o[0] = DN_ALPHA * xv[0] + acc[mi][ni][4 * q]; o[1] = DN_ALPHA * xv[1] + acc[mi][ni][4 * q + 1]; o[2] = DN_ALPHA * xv[2] + acc[mi][ni][4 * q + 2]; o[3] = DN_ALPHA * xv[3] + acc[mi][ni][4 * q + 3];
                    gst<f32x4>(Y + off + 32 * ni + 8 * q, o);
                    if (q == 3) asm volatile("" ::: "memory"); }
        }
    }
};
struct EpiMoe1 {
    bf16_t* Hm; int rowbase, nvalid, n0;
    __device__ __forceinline__ void operator()(f32x16 (&acc)[2][4], int wm, int wn, int l32, int hi, LAS char*) const {
        const int ff0 = (n0 + 128 * wn) >> 1;
#pragma unroll
        for (int mi = 0; mi < 2; ++mi) {
            const int rl = 64 * wm + 32 * mi + l32;
            if (rl < nvalid) {
                bf16_t* p = Hm + (size_t)(rowbase + rl) * EFF + ff0 + 4 * hi;
#pragma unroll
                for (int h2 = 0; h2 < 2; ++h2)
#pragma unroll
                    for (int q = 0; q < 4; ++q) { float v[4];
#pragma unroll
                        for (int j = 0; j < 4; ++j) { const float g = acc[mi][2 * h2][4 * q + j], u = acc[mi][2 * h2 + 1][4 * q + j]; v[j] = g / (1.f + __expf(-g)) * u; }
                        store_bf4(p + 32 * h2 + 8 * q, v[0], v[1], v[2], v[3]); }
            }
        }
    }
};
struct EpiMoe2 {
    bf16_t* Y; const int* list; const float* gw; int nvalid, n0;
    __device__ __forceinline__ void operator()(f32x16 (&acc)[2][4], int wm, int wn, int l32, int hi, LAS char*) const {
        const int nw = n0 + 128 * wn;
#pragma unroll
        for (int mi = 0; mi < 2; ++mi) {
            const int rl = 64 * wm + 32 * mi + l32;
            if (rl < nvalid) { const int slot = gld<int>(list + rl); store_tiles4(Y + (size_t)slot * DM + nw + 4 * hi, acc[mi], gld<float>(gw + slot)); }
        }
    }
};

constexpr int VS = 160;
struct KeySrc { const bf16_t* k0; size_t kstride; const bf16_t* kr; size_t krstride; const bf16_t* v0; size_t vstride; };

template <int DQK> struct AttnRegs { bf16x8 k[DQK / 8 * 64 / 256]; bf16x8 v[4]; };
template <int DQK> struct AttnSrc { __amdgpu_buffer_rsrc_t rk, rr, rv; unsigned ko[DQK / 8 * 64 / 256]; unsigned vo[4]; unsigned ktile, rtile, vtile; };
template <int DQK> __device__ __forceinline__ AttnSrc<DQK> attn_src(const KeySrc& ks, int tid) {
    constexpr int KCH = DQK / 8, NKL = KCH * 64 / 256;
    AttnSrc<DQK> a; a.rk = mk_rsrc(ks.k0); a.rr = mk_rsrc(ks.kr); a.rv = mk_rsrc(ks.v0);
#pragma unroll
    for (int i = 0; i < NKL; ++i) { const int idx = tid + i * 256, key = idx / KCH, ch = idx - key * KCH;
        a.ko[i] = (DQK == 128 || ch < 16) ? (unsigned)(key * (unsigned)ks.kstride + ch * 8) * 2u : (unsigned)(key * (unsigned)ks.krstride + (ch - 16) * 8) * 2u; }
#pragma unroll
    for (int i = 0; i < 4; ++i) { const int idx = tid + i * 256, key = idx >> 4, ch = idx & 15; a.vo[i] = (unsigned)(key * (unsigned)ks.vstride + ch * 8) * 2u; }
    a.ktile = 128u * (unsigned)ks.kstride; a.rtile = 128u * (unsigned)ks.krstride; a.vtile = 128u * (unsigned)ks.vstride;
    return a;
}
template <int DQK> __device__ __forceinline__ void attn_gload(const AttnSrc<DQK>& a, int jt, AttnRegs<DQK>& R, bool withv, int tid) {
    constexpr int KCH = DQK / 8, NKL = KCH * 64 / 256;
#pragma unroll
    for (int i = 0; i < NKL; ++i) { const int idx = tid + i * 256, key = idx / KCH, ch = idx - key * KCH;
        R.k[i] = (DQK == 128 || ch < 16) ? bld8(a.rk, a.ko[i], (int)(jt * a.ktile)) : bld8(a.rr, a.ko[i], (int)(jt * a.rtile)); }
    if (withv) {
#pragma unroll
        for (int i = 0; i < 4; ++i) R.v[i] = bld8(a.rv, a.vo[i], (int)(jt * a.vtile));
    }
}
template <int DQK> __device__ __forceinline__ void attn_lwrite(LAS char* lds, const AttnRegs<DQK>& R, bool withv, int tid) {
    constexpr int KS = DQK + 8, KCH = DQK / 8, NKL = KCH * 64 / 256;
#pragma unroll
    for (int i = 0; i < NKL; ++i) { const int idx = tid + i * 256, key = idx / KCH, ch = idx - key * KCH; *(LAS bf16x8*)(lds + (key * KS + ch * 8) * 2) = R.k[i]; }
    if (withv) {
#pragma unroll
        for (int i = 0; i < 4; ++i) { const int idx = tid + i * 256, key = idx >> 4, ch = idx & 15; *(LAS bf16x8*)(lds + 64 * KS * 2 + (key * VS + ch * 8) * 2) = R.v[i]; }
    }
}
template <int DQK> __device__ __forceinline__ void attn_stage(LAS char* lds, const AttnSrc<DQK>& a, int jt, bool withv, int tid) { AttnRegs<DQK> R; attn_gload<DQK>(a, jt, R, withv, tid); attn_lwrite<DQK>(lds, R, withv, tid); }
template <int DQK> __device__ __forceinline__ void attn_scores(const LAS char* lds, const bf16x8 (&qf)[DQK / 16], f32x16& p0, f32x16& p1, int l32, int hi) {
    constexpr int KS = DQK + 8;
    const int sg = (l32 & ~12) | ((l32 & 4) << 1) | ((l32 & 8) >> 1);
    const LAS char* kb = lds + (sg * KS + hi * 8) * 2;
#pragma unroll
    for (int r = 0; r < 16; ++r) { p0[r] = 0.f; p1[r] = 0.f; }
#pragma unroll
    for (int ds = 0; ds < DQK / 16; ++ds) {
        const bf16x8 a0 = *(const LAS bf16x8*)(kb + ds * 32), a1 = *(const LAS bf16x8*)(kb + 32 * KS * 2 + ds * 32);
        p0 = __builtin_amdgcn_mfma_f32_32x32x16_bf16(a0, qf[ds], p0, 0, 0, 0);
        p1 = __builtin_amdgcn_mfma_f32_32x32x16_bf16(a1, qf[ds], p1, 0, 0, 0);
    }
}
template <int DQK, bool SEL>
__device__ __forceinline__ void attn_run(LAS char* lds, const KeySrc& ks, int jt_lo, int jt_hi, unsigned tile_union, const bf16x8 (&qf)[DQK / 16],
                                         int qi, unsigned maxd, unsigned sel, float c2, f32x16 (&o)[4], float& m_run, float& l_run, int tid) {
    constexpr int KS = DQK + 8;
    const int lane = tid & 63, l32 = lane & 31, hi = lane >> 5;
    const int g = lane >> 4, i16 = lane & 15;
    const LAS char* vb = (lds + 64 * KS * 2 + ((8 * hi + (i16 >> 2)) * VS + 16 * (g & 1) + 4 * (i16 & 3)) * 2);
    const float NEG = -__builtin_inff();
    int qmin = qi, qmax = qi;
#pragma unroll
    for (int sft = 32; sft >= 1; sft >>= 1) { qmin = min(qmin, __shfl_xor(qmin, sft)); qmax = max(qmax, __shfl_xor(qmax, sft)); }
    int jt = jt_lo;
    if (SEL) { while (jt < jt_hi && !((tile_union >> jt) & 1u)) ++jt; }
    if (jt >= jt_hi) return;
    AttnRegs<DQK> R;
    const AttnSrc<DQK> asrc = attn_src<DQK>(ks, tid);
    constexpr bool PF = DQK == 128;
    if (PF) attn_gload<DQK>(asrc, jt, R, true, tid);
    for (;;) {
        if (!PF) attn_gload<DQK>(asrc, jt, R, true, tid);
        attn_lwrite<DQK>(lds, R, true, tid);
        __syncthreads();
        int jn = jt + 1;
        if (SEL) { while (jn < jt_hi && !((tile_union >> jn) & 1u)) ++jn; }
        if (PF && jn < jt_hi) attn_gload<DQK>(asrc, jn, R, true, tid);
        f32x16 p0, p1;
        attn_scores<DQK>(lds, qf, p0, p1, l32, hi);
        const bool ok = SEL ? (((sel >> jt) & 1u) != 0u) : true;
        const bool interior = (qmin - (jt * 64 + 63) >= 0) && ((unsigned)(qmax - jt * 64) <= maxd) && (SEL ? __all(ok) : true);
        float mx = NEG;
        if (interior) {
#pragma unroll
            for (int r = 0; r < 16; ++r) mx = fmaxf(mx, fmaxf(p0[r], p1[r]));
        } else {
            const int dq = qi - jt * 64 - 8 * hi;
#pragma unroll
            for (int r = 0; r < 16; ++r) {
                const int ko = 16 * (r >> 3) + (r & 7);
                const float s0 = (ok && (unsigned)(dq - ko) <= maxd) ? p0[r] : NEG;
                const float s1 = (ok && (unsigned)(dq - ko - 32) <= maxd) ? p1[r] : NEG;
                p0[r] = s0; p1[r] = s1; mx = fmaxf(mx, fmaxf(s0, s1));
            }
        }
        mx = fmaxf(mx, __shfl_xor(mx, 32));
        const float mn = fmaxf(m_run, mx * c2);
        const float alpha = __builtin_amdgcn_exp2f(m_run - mn);
        const float nmn = -mn;
        float rs = 0.f;
#pragma unroll
        for (int r = 0; r < 16; ++r) { p0[r] = __builtin_amdgcn_exp2f(fmaf(p0[r], c2, nmn)); p1[r] = __builtin_amdgcn_exp2f(fmaf(p1[r], c2, nmn)); rs += p0[r] + p1[r]; }
        rs += __shfl_xor(rs, 32);
        l_run = l_run * alpha + rs; m_run = mn;
        if (!__all(alpha == 1.f)) {
#pragma unroll
            for (int dt = 0; dt < 4; ++dt)
#pragma unroll
                for (int r = 0; r < 16; ++r) o[dt][r] *= alpha;
        }
#pragma unroll
        for (int s4 = 0; s4 < 4; ++s4) {
            u32x4 pw;
            if (s4 == 0)      { pw.x = cvtpk(p0[0], p0[1]);  pw.y = cvtpk(p0[2], p0[3]);   pw.z = cvtpk(p0[4], p0[5]);   pw.w = cvtpk(p0[6], p0[7]); }
            else if (s4 == 1) { pw.x = cvtpk(p0[8], p0[9]);  pw.y = cvtpk(p0[10], p0[11]); pw.z = cvtpk(p0[12], p0[13]); pw.w = cvtpk(p0[14], p0[15]); }
            else if (s4 == 2) { pw.x = cvtpk(p1[0], p1[1]);  pw.y = cvtpk(p1[2], p1[3]);   pw.z = cvtpk(p1[4], p1[5]);   pw.w = cvtpk(p1[6], p1[7]); }
            else              { pw.x = cvtpk(p1[8], p1[9]);  pw.y = cvtpk(p1[10], p1[11]); pw.z = cvtpk(p1[12], p1[13]); pw.w = cvtpk(p1[14], p1[15]); }
            const bf16x8 pb = *reinterpret_cast<bf16x8*>(&pw);
#pragma unroll
            for (int dt = 0; dt < 4; ++dt) {
                const s16x4 v0 = __builtin_amdgcn_ds_read_tr16_b64_v4i16((LAS s16x4*)(vb + (s4 * 16 * VS + dt * 32) * 2));
                const s16x4 v1 = __builtin_amdgcn_ds_read_tr16_b64_v4i16((LAS s16x4*)(vb + (s4 * 16 * VS + 4 * VS + dt * 32) * 2));
                const bf16x8 va = {v0[0], v0[1], v0[2], v0[3], v1[0], v1[1], v1[2], v1[3]};
                o[dt] = __builtin_amdgcn_mfma_f32_32x32x16_bf16(va, pb, o[dt], 0, 0, 0);
            }
        }
        __syncthreads();
        if (jn >= jt_hi) break;
        jt = jn;
    }
}
template <int DQK> __device__ __forceinline__ void load_q(const bf16_t* qptr, int hi, bf16x8 (&qf)[DQK / 16]) {
#pragma unroll
    for (int ds = 0; ds < DQK / 16; ++ds) qf[ds] = gld<bf16x8>(qptr + ds * 16 + hi * 8);
}
__device__ __forceinline__ void store_o(bf16_t* optr, const f32x16 (&o)[4], float inv, int hi) {
#pragma unroll
    for (int dt = 0; dt < 4; ++dt)
#pragma unroll
        for (int q = 0; q < 4; ++q) store_bf4(optr + 32 * dt + 8 * q + 4 * hi, o[dt][4 * q] * inv, o[dt][4 * q + 1] * inv, o[dt][4 * q + 2] * inv, o[dt][4 * q + 3] * inv);
}
__device__ __forceinline__ void zero_o(f32x16 (&o)[4]) {
#pragma unroll
    for (int dt = 0; dt < 4; ++dt)
#pragma unroll
        for (int r = 0; r < 16; ++r) o[dt][r] = 0.f;
}

__device__ __forceinline__ int claim(unsigned* ctr, LAS char* lds) {
    volatile LAS int* slot = (volatile LAS int*)(lds + LDS_CTL + 64);
    __syncthreads();
    if (otid() == 0) *slot = (int)atomicAdd(ctr, 1u);
    __syncthreads();
    return *slot;
}

__device__ __forceinline__ void conv_tile(LAS char* lds, const float* src, int N, int k0, int n0, bf16_t* dst, int ldd, int rowmap, const float* kscale) {
    LAS float* tile = (LAS float*)lds;
    const int tid = otid();
    __syncthreads();
    {
        const int kr = tid >> 6, nc = tid & 63; const bool inb = n0 + nc < N;
#pragma unroll
        for (int i = 0; i < 16; ++i) { const int k = kr + 4 * i; float v = inb ? gld<float>(src + (size_t)(k0 + k) * N + n0 + nc) : 0.f; if (kscale) v *= gld<float>(kscale + k0 + k); tile[k * 65 + nc] = v; }
    }
    __syncthreads();
    {
        const int n = tid >> 2, kq = (tid & 3) * 16; const int c = n0 + n;
        const int drow = rowmap == 0 ? c : (128 * (c >> 6) + 64 * ((c >> 5) & 1) + 32 * (rowmap - 1) + (c & 31));
        u32x4 w0, w1;
        w0.x = cvtpk(tile[(kq + 0) * 65 + n], tile[(kq + 1) * 65 + n]);   w0.y = cvtpk(tile[(kq + 2) * 65 + n], tile[(kq + 3) * 65 + n]);
        w0.z = cvtpk(tile[(kq + 4) * 65 + n], tile[(kq + 5) * 65 + n]);   w0.w = cvtpk(tile[(kq + 6) * 65 + n], tile[(kq + 7) * 65 + n]);
        w1.x = cvtpk(tile[(kq + 8) * 65 + n], tile[(kq + 9) * 65 + n]);   w1.y = cvtpk(tile[(kq + 10) * 65 + n], tile[(kq + 11) * 65 + n]);
        w1.z = cvtpk(tile[(kq + 12) * 65 + n], tile[(kq + 13) * 65 + n]); w1.w = cvtpk(tile[(kq + 14) * 65 + n], tile[(kq + 15) * 65 + n]);
        bf16_t* d = dst + (size_t)drow * ldd + k0 + kq;
        gst<u32x4>(d, w0); gst<u32x4>(d + 8, w1);
    }
}

__device__ __forceinline__ void phase_prep(const Params& p, int layer, LAS char* lds) {
    char* ws = ows(p.ws);
    const int tid = otid();
    constexpr int N_WIN = 32 * 72, N_WQ = 6 * 12, N_WKV = 2 * 16, N_W1 = 64 * 4, N_W2 = 4 * 2, N_WOUT = 32 * 32, N_EG = NEXP * 32 * 8, N_ED = NEXP * 8 * 32;
    constexpr int E0 = 0, E1 = E0 + N_WIN, E2 = E1 + N_WQ, E3 = E2 + N_WKV, E4 = E3 + N_W1, E5 = E4 + N_W1, E6 = E5 + N_W2, E7 = E6 + N_W2, E8 = E7 + N_WOUT,
                  E9 = E8 + N_EG, E10 = E9 + N_EG, E11 = E10 + N_ED, E12 = E11 + 32  , E13 = E12 + 64  , E14 = E13 + 4096  ;
    const int total = layer == 0 ? E14 : E12;
    for (int it = oblk(); it < total; it += gridDim.x) {
        if (it < E1) { const int u = it - E0, kt = u % 32, nt = u / 32;
            conv_tile(lds, p.in[I_WIN] + (size_t)layer * DM * INC, INC, kt * 64, nt * 64, (bf16_t*)(ws + OFF_WIN_T), DM, 0, nullptr);
        } else if (it < E2) { const int u = it - E1, kt = u % 6, nt = u / 6;
            conv_tile(lds, p.in[I_WQUP] + (size_t)layer * 384 * 768, 768, kt * 64, nt * 64, (bf16_t*)(ws + OFF_WQ_T), 384, 0, p.in[I_QLN] + layer * 384);
        } else if (it < E3) { const int u = it - E2, kt = u % 2, nt = u / 2;
            conv_tile(lds, p.in[I_WKVUP] + (size_t)layer * 128 * 1024, 1024, kt * 64, nt * 64, (bf16_t*)(ws + OFF_WKV_T), 128, 0, p.in[I_KVLN] + layer * 128);
        } else if (it < E5) { const int which = it >= E4, u = it - (which ? E4 : E3), kt = u % 64, nt = u / 64;
            conv_tile(lds, p.in[which ? I_W1V : I_W1K] + (size_t)layer * 4096 * 256, 256, kt * 64, nt * 64, (bf16_t*)(ws + (which ? OFF_W1V_T : OFF_W1K_T)), 4096, 0, nullptr);
        } else if (it < E7) { const int which = it >= E6, u = it - (which ? E6 : E5), kt = u % 4, nt = u / 4;
            conv_tile(lds, p.in[which ? I_W2V : I_W2K] + (size_t)layer * 256 * 128, 128, kt * 64, nt * 64, (bf16_t*)(ws + (which ? OFF_W2V_T : OFF_W2K_T)), 256, 0, nullptr);
        } else if (it < E8) { const int u = it - E7, kt = u % 32, nt = u / 32;
            conv_tile(lds, p.in[I_WOUT] + (size_t)layer * DM * DM, DM, kt * 64, nt * 64, (bf16_t*)(ws + OFF_WOUT_T), DM, 0, nullptr);
        } else if (it < E10) { const int isup = it >= E9, u = it - (isup ? E9 : E8), e = u / 256, r = u % 256, kt = r % 32, nt = r / 32;
            conv_tile(lds, p.in[isup ? I_WUP : I_WGATE] + ((size_t)layer * NEXP + e) * DM * EFF, EFF, kt * 64, nt * 64, (bf16_t*)(ws + OFF_WGU_T) + (size_t)e * 1024 * DM, DM, 1 + isup, nullptr);
        } else if (it < E11) { const int u = it - E10, e = u / 256, r = u % 256, kt = r % 8, nt = r / 8;
            conv_tile(lds, p.in[I_WDOWN] + ((size_t)layer * NEXP + e) * EFF * DM, DM, kt * 64, nt * 64, (bf16_t*)(ws + OFF_WD_T) + (size_t)e * DM * EFF, EFF, 0, nullptr);
        } else if (it < E12) { const int u = it - E11, which = u >> 4, kc = u & 15;
            const float* pe = p.in[which ? I_PEV : I_PEK] + (size_t)layer * 4096 + kc * 256;
            const float* w1 = p.in[which ? I_W1V : I_W1K] + (size_t)layer * 4096 * 256 + (size_t)kc * 256 * 256;
            float a0 = 0.f, a1 = 0.f, a2 = 0.f, a3 = 0.f;
            for (int k = 0; k < 256; k += 4) { a0 += pe[k] * w1[(size_t)k * 256 + tid]; a1 += pe[k + 1] * w1[(size_t)(k + 1) * 256 + tid]; a2 += pe[k + 2] * w1[(size_t)(k + 2) * 256 + tid]; a3 += pe[k + 3] * w1[(size_t)(k + 3) * 256 + tid]; }
            ((float*)(ws + OFF_B1P))[(which * 16 + kc) * 256 + tid] = (a0 + a1) + (a2 + a3);
        } else if (it < E13) { const int u = it - E12;
            f32x2* cs16 = (f32x2*)(ws + OFF_CS16); f32x2* cs32 = (f32x2*)(ws + OFF_CS32);
            for (int e = tid; e < 32 * 48; e += 256) { const int pos = u * 32 + e / 48, j = e % 48;
                const int half = j < 16 ? 16 : 32, i = j < 16 ? j : j - 16;
                const float invf = exp2f(-(float)i / (float)half * 18.931568569324174f);
                const float ang = (float)pos * invf;
                f32x2 cs; cs.x = cosf(ang); cs.y = sinf(ang);
                if (j < 16) cs16[pos * 16 + i] = cs; else cs32[pos * 32 + i] = cs; }
        } else { const int u = it - E13;
            const float* x = p.in[I_X] + (size_t)u * 4096; bf16_t* xb = (bf16_t*)(ws + OFF_XB) + (size_t)u * 4096;
            for (int e = tid * 4; e < 4096; e += 1024) { const f32x4 v = gld<f32x4>(x + e); store_bf4(xb + e, v[0], v[1], v[2], v[3]); }
        }
    }
    if (oblk() == 0 && tid < NEXP) ((unsigned*)(ws + OFF_ECNT))[tid] = 0u;
    { unsigned* imp = (unsigned*)(ws + OFF_IMP); for (size_t e = (size_t)oblk() * 256 + tid; e < (size_t)NT * 32; e += (size_t)gridDim.x * 256) gst<unsigned>(imp + e, 0u); }
}

#define AO4(ld) { (unsigned)(sr * (ld) + sc), (unsigned)((sr + 32) * (ld) + sc), (unsigned)((sr + 64) * (ld) + sc), (unsigned)((sr + 96) * (ld) + sc) }
__device__ __forceinline__ void phase_win(const Params& p, int layer, LAS char* lds) {
    char* ws = ows(p.ws); const int tid = otid(), sr = tid >> 3, sc = (tid & 7) * 8;
    const bf16_t* A = (const bf16_t*)(ws + OFF_XB); const bf16_t* Bt = (const bf16_t*)(ws + OFF_WIN_T);
    for (int u = oblk(); u < 64 * 24; u += gridDim.x) {
        const int mt = u & 63, nt = u >> 6;
        EpiWin e{(bf16_t*)(ws + OFF_H), (float*)(ws + OFF_GATES), (const f32x2*)(ws + OFF_CS16), (const f32x2*)(ws + OFF_CS32), mt * 128, nt * 192};
        const unsigned ao[4] = AO4(DM);
        gemm_unit_n<3>(lds, A + (size_t)mt * 128 * DM, ao, 128, Bt + (size_t)nt * 192 * DM, (unsigned)(sr * DM + sc), (size_t)32 * DM, DM / 64, e);
    }
}
__device__ __forceinline__ void phase_up(const Params& p, int layer, LAS char* lds) {
    char* ws = ows(p.ws); const int tid = otid(), sr = tid >> 3, sc = (tid & 7) * 8;
    const bf16_t* H = (const bf16_t*)(ws + OFF_H);
    constexpr int U0 = 64, U1 = U0 + 64 * 3, U2 = U1 + 64 * 4;
    for (int u = oblk(); u < U2; u += gridDim.x) {
        if (u < U0) {
            const int which = u >> 5, mt = (u >> 3) & 3, ksp = u & 7;
            const int col = which ? C_NVC : C_NKC;
            unsigned ao[4];
#pragma unroll
            for (int i = 0; i < 4; ++i) { int c = sr + 32 * i; if (c > 126) c = 126; ao[i] = (unsigned)(16 * c * LDH + sc); }
            const bf16_t* ab = H + (size_t)(mt * SEQ + 4 * ksp) * LDH + col;
            const bf16_t* bb = (const bf16_t*)(ws + (which ? OFF_W1V_T : OFF_W1K_T)) + 512 * ksp;
            EpiCmp1 e{(float*)(ws + OFF_HCP) + ((size_t)ksp * 2 + which) * 512 * 256, mt * 128};
            gemm_unit(lds, ab, ao, LDH, bb, (unsigned)(sr * 4096 + sc), (size_t)32 * 4096, 512 / 64, e);
        } else if (u < U1) {
            const int v = u - U0, mt = v & 63, nt = v >> 6;
            const unsigned ao[4] = AO4(LDH);
            EpiQup e{(bf16_t*)(ws + OFF_QM), (const f32x2*)(ws + OFF_CS32), mt * 128, nt * 256};
            row_sumsq<384>(lds, H + (size_t)mt * 128 * LDH + C_QLAT, LDH);
            gemm_unit(lds, H + (size_t)mt * 128 * LDH + C_QLAT, ao, 128, (const bf16_t*)(ws + OFF_WQ_T) + (size_t)nt * 256 * 384, (unsigned)(sr * 384 + sc), (size_t)32 * 384, 384 / 64, e);
        } else {
            const int v = u - U1, mt = v & 63, nt = v >> 6;
            const unsigned ao[4] = AO4(LDH);
            EpiKVup e{(bf16_t*)(ws + OFF_KN), mt * 128, nt * 256};
            row_sumsq<128>(lds, H + (size_t)mt * 128 * LDH + C_KVLAT, LDH);
            gemm_unit(lds, H + (size_t)mt * 128 * LDH + C_KVLAT, ao, 128, (const bf16_t*)(ws + OFF_WKV_T) + (size_t)nt * 256 * 128, (unsigned)(sr * 128 + sc), (size_t)32 * 128, 128 / 64, e);
        }
    }
}
__device__ __forceinline__ void phase_cmpred(const Params& p, int layer) {
    char* ws = ows(p.ws);
    const float* P = (const float*)(ws + OFF_HCP); const float* b1p = (const float*)(ws + OFF_B1P); bf16_t* Hc = (bf16_t*)(ws + OFF_HC);
    for (int e4 = oblk() * 256 + otid(); e4 < 2 * 512 * 256 / 4; e4 += gridDim.x * 256) {
        const int e = e4 * 4, which = e >> 17, n = e & 255;
        f32x4 a = {0.f, 0.f, 0.f, 0.f};
#pragma unroll
        for (int q = 0; q < 16; ++q) a += gld<f32x4>(b1p + (which * 16 + q) * 256 + n);
#pragma unroll
        for (int q = 0; q < 8; ++q) a += gld<f32x4>(P + (size_t)q * 2 * 512 * 256 + e);
        store_bf4(Hc + e, gelu_tanh(a[0]), gelu_tanh(a[1]), gelu_tanh(a[2]), gelu_tanh(a[3]));
    }
}
__device__ __forceinline__ void phase_cmp2(const Params& p, int layer, LAS char* lds) {
    char* ws = ows(p.ws); const int tid = otid(), sr = tid >> 3, sc = (tid & 7) * 8;
    for (int u = oblk(); u < 8; u += gridDim.x) {
        const int which = u >> 2, mt = u & 3;
        const bf16_t* Hc = (const bf16_t*)(ws + OFF_HC) + (size_t)which * 512 * 256 + (size_t)mt * 128 * 256;
        const unsigned ao[4] = AO4(256);
        EpiCmp2 e{(bf16_t*)(ws + (which ? OFF_VC : OFF_KC)), (const f32x2*)(ws + OFF_CS16), which == 0, mt * 128};
        gemm_unit(lds, Hc, ao, 128, (const bf16_t*)(ws + (which ? OFF_W2V_T : OFF_W2K_T)), (unsigned)(sr * 256 + sc), (size_t)32 * 256, 256 / 64, e);
    }
}
__device__ __forceinline__ void phase_out(const Params& p, int layer, LAS char* lds) {
    char* ws = ows(p.ws); const int tid = otid(), sr = tid >> 3, sc = (tid & 7) * 8;
    const bf16_t* A = (const bf16_t*)(ws + OFF_MIX); const bf16_t* Bt = (const bf16_t*)(ws + OFF_WOUT_T);
    const float* X = layer == 0 ? p.in[I_X] : (const float*)(ws + OFF_XA);
    for (int u = oblk(); u < 64 * 8; u += gridDim.x) {
        const int mt = u & 63, nt = u >> 6;
        EpiOut e{(float*)(ws + OFF_YB), X, mt * 128, nt * 256};
        const unsigned ao[4] = AO4(DM);
        gemm_unit(lds, A + (size_t)mt * 128 * DM, ao, 128, Bt + (size_t)nt * 256 * DM, (unsigned)(sr * DM + sc), (size_t)32 * DM, DM / 64, e);
    }
}

__device__ __forceinline__ void item_mla(const Params& p, int it, LAS char* lds) {
    char* ws = ows(p.ws); const int tid = otid(), lane = tid & 63, w = tid >> 6, l32 = lane & 31, hi = lane >> 5;
    const int qb = 15 - (it >> 4), h = it & 3, b = (it >> 2) & 3;
    const int token = qb * 128 + 32 * w + l32; const size_t row = (size_t)b * SEQ + token;
    bf16x8 qf[12]; load_q<192>((const bf16_t*)(ws + OFF_QM) + row * 768 + h * 192, hi, qf);
    KeySrc ks; ks.k0 = (const bf16_t*)(ws + OFF_KN) + (size_t)b * SEQ * 512 + h * 128; ks.kstride = 512;
    ks.kr = (const bf16_t*)(ws + OFF_H) + (size_t)b * SEQ * LDH + C_KROPE; ks.krstride = LDH;
    ks.v0 = (const bf16_t*)(ws + OFF_VM) + (size_t)b * SEQ * 512 + h * 128; ks.vstride = 512;
    f32x16 o[4]; zero_o(o); float m = -1e30f, l = 0.f;
    attn_run<192, false>(lds, ks, 0, 2 * qb + 2, 0u, qf, token, 0x7fffffffu, 0u, 0.07216878364870322f * LOG2E, o, m, l, tid);
    store_o((bf16_t*)(ws + OFF_MIX) + row * DM + h * 128, o, 1.f / l, hi);
}
__device__ __forceinline__ void item_dil(const Params& p, int it, LAS char* lds) {
    char* ws = ows(p.ws); const int tid = otid(), lane = tid & 63, w = tid >> 6, l32 = lane & 31, hi = lane >> 5;
    const int rem = it % 48, bh = it / 48, h = bh % 6, b = bh / 6;
    const int n = rem >> 4, r2 = rem & 15;
    const int dil = n == 0 ? 1 : (n == 1 ? 4 : 16);
    const int rho = n == 0 ? 0 : (n == 1 ? (r2 >> 2) : r2), qb = n == 0 ? r2 : (n == 1 ? (r2 & 3) : 0);
    const int i = qb * 128 + 32 * w + l32, token = rho + i * dil; const size_t row = (size_t)b * SEQ + token;
    const bf16_t* H = (const bf16_t*)(ws + OFF_H);
    bf16x8 qf[8]; load_q<128>(H + row * LDH + C_DQ + h * 128, hi, qf);
    KeySrc ks; ks.k0 = H + ((size_t)b * SEQ + rho) * LDH + C_DK + h * 128; ks.kstride = (size_t)dil * LDH; ks.kr = ks.k0; ks.krstride = 0;
    ks.v0 = H + ((size_t)b * SEQ + rho) * LDH + C_DV + h * 128; ks.vstride = (size_t)dil * LDH;
    f32x16 o[4]; zero_o(o); float m = -1e30f, l = 0.f;
    const int jlo = 2 * qb - 2 < 0 ? 0 : 2 * qb - 2;
    attn_run<128, false>(lds, ks, jlo, 2 * qb + 2, 0u, qf, i, 128u, 0u, 0.08838834764831845f * LOG2E, o, m, l, tid);
    store_o((bf16_t*)(ws + OFF_ODIL) + ((size_t)n * NT + row) * 768 + h * 128, o, 1.f / l, hi);
    if (hi == 0) gst<float>((float*)(ws + OFF_LDIL) + ((size_t)n * NT + row) * 6 + h, m + __log2f(l));
}
__device__ __forceinline__ void item_win(const Params& p, int it, LAS char* lds) {
    char* ws = ows(p.ws); const int tid = otid(), lane = tid & 63, w = tid >> 6, l32 = lane & 31, hi = lane >> 5;
    const int hp = it % 3, b = (it / 3) & 3, tb = 31 - it / 12;
    const int head = 2 * hp + (w >> 1), token = 64 * tb + 32 * (w & 1) + l32; const size_t row = (size_t)b * SEQ + token;
    const bf16_t* H = (const bf16_t*)(ws + OFF_H);
    bf16x8 qf[8]; load_q<128>(H + row * LDH + C_NQ + head * 128, hi, qf);
    KeySrc ks; ks.k0 = H + (size_t)b * SEQ * LDH + C_NKW; ks.kstride = LDH; ks.kr = ks.k0; ks.krstride = 0; ks.v0 = H + (size_t)b * SEQ * LDH + C_NVW; ks.vstride = LDH;
    f32x16 o[4]; zero_o(o); float m = -1e30f, l = 0.f;
    attn_run<128, false>(lds, ks, tb - 8 < 0 ? 0 : tb - 8, tb + 1, 0u, qf, token, 511u, 0u, 0.08838834764831845f * LOG2E, o, m, l, tid);
    store_o((bf16_t*)(ws + OFF_PW) + row * 768 + head * 128, o, 1.f / l, hi);
}
__device__ __forceinline__ void item_cmp(const Params& p, int it, LAS char* lds) {
    char* ws = ows(p.ws); const int tid = otid(), lane = tid & 63, w = tid >> 6, l32 = lane & 31, hi = lane >> 5;
    const int hp = it % 3, tb = (it / 3) % 32, b = it / 96;
    const int head = 2 * hp + (w >> 1), token = 64 * tb + 32 * (w & 1) + l32; const size_t row = (size_t)b * SEQ + token;
    const bf16_t* H = (const bf16_t*)(ws + OFF_H);
    bf16x8 qf[8]; load_q<128>(H + row * LDH + C_NQ + head * 128, hi, qf);
    KeySrc ks; ks.k0 = (const bf16_t*)(ws + OFF_KC) + (size_t)b * 128 * 128; ks.kstride = 128; ks.kr = ks.k0; ks.krstride = 0; ks.v0 = (const bf16_t*)(ws + OFF_VC) + (size_t)b * 128 * 128; ks.vstride = 128;
    const int qi = (token - 31) >> 4;
    const int qimax = (64 * tb + 63 - 31) >> 4;
    const int jhi = qimax < 0 ? 0 : (qimax >> 6) + 1;
    const float c2 = 0.08838834764831845f * LOG2E;
    f32x16 o[4]; zero_o(o); float m = -1e30f, l = 0.f;
    attn_run<128, false>(lds, ks, 0, jhi, 0u, qf, qi, 0x7fffffffu, 0u, c2, o, m, l, tid);
    const float inv = l > 0.f ? 1.f / l : 0.f;
    store_o((bf16_t*)(ws + OFF_PC) + row * 768 + head * 128, o, inv, hi);
    unsigned* imp = (unsigned*)(ws + OFF_IMP) + row * 32;
    const AttnSrc<128> asrc = attn_src<128>(ks, tid);
    for (int jt = 0; jt < jhi; ++jt) {
        attn_stage<128>(lds, asrc, jt, false, tid);
        __syncthreads();
        f32x16 p0, p1; attn_scores<128>(lds, qf, p0, p1, l32, hi);
        const int dq = qi - jt * 64 - 8 * hi;
#pragma unroll
        for (int r = 0; r < 16; ++r) { const int ko = 16 * (r >> 3) + (r & 7);
            p0[r] = (dq - ko >= 0) ? __builtin_amdgcn_exp2f(p0[r] * c2 - m) * inv : 0.f;
            p1[r] = (dq - ko - 32 >= 0) ? __builtin_amdgcn_exp2f(p1[r] * c2 - m) * inv : 0.f; }
#pragma unroll
        for (int t = 0; t < 2; ++t)
#pragma unroll
            for (int u = 0; u < 2; ++u) {
                unsigned q[8];
#pragma unroll
                for (int j = 0; j < 8; ++j) q[j] = (unsigned)((t ? p1[8 * u + j] : p0[8 * u + j]) * 16777216.f + 0.5f);
                const int j0 = (64 * jt + 32 * t + 16 * u + 8 * hi) >> 2;
                const unsigned a0 = q[0] + q[1] + q[2] + q[3], a1 = q[4] + q[5] + q[6] + q[7] + q[3], a2 = q[7];
                if (a0) atomicAdd(imp + j0, a0);
                if (a1) atomicAdd(imp + j0 + 1, a1);
                if (a2 && j0 + 2 < 32) atomicAdd(imp + j0 + 2, a2);
            }
        __syncthreads();
    }
}
__device__ __forceinline__ void item_slc(const Params& p, int it, LAS char* lds) {
    char* ws = ows(p.ws); const int tid = otid(), lane = tid & 63, w = tid >> 6, l32 = lane & 31, hi = lane >> 5;
    const int hp = it % 3, b = (it / 3) & 3, tb = 31 - it / 12;
    LAS int* sc = (LAS int*)(lds + 47104); LAS unsigned* msk = (LAS unsigned*)(lds + 47104 + 8192);
    __syncthreads();
    if (tid < 65) msk[tid] = 0u;
    const unsigned* imp = (const unsigned*)(ws + OFF_IMP) + ((size_t)b * SEQ + 64 * tb) * 32;
#pragma unroll
    for (int i = 0; i < 8; ++i) { const int e = tid + i * 256, tk = e >> 5, j = e & 31, pos = 64 * tb + tk, qblk = pos >> 6;
        const bool valid = 64 * j <= pos, forced = (j == 0) || (j == qblk) || (j == qblk - 1);
        sc[e] = valid ? (forced ? 0x7fffffff : (int)gld<unsigned>(imp + e)) : -1; }
    __syncthreads();
#pragma unroll
    for (int i = 0; i < 8; ++i) { const int e = tid + i * 256, tk = e >> 5, j = e & 31; const int s = sc[e]; int rank = 0;
        for (int k = 0; k < 32; ++k) { const int sk = sc[tk * 32 + k]; rank += (sk > s || (sk == s && k < j)) ? 1 : 0; }
        if (rank < 16) { __hip_atomic_fetch_or(&msk[tk], 1u << j, __ATOMIC_RELAXED, __HIP_MEMORY_SCOPE_WORKGROUP); __hip_atomic_fetch_or(&msk[64], 1u << j, __ATOMIC_RELAXED, __HIP_MEMORY_SCOPE_WORKGROUP); } }
    __syncthreads();
    const int head = 2 * hp + (w >> 1), tk = 32 * (w & 1) + l32, token = 64 * tb + tk; const size_t row = (size_t)b * SEQ + token;
    const unsigned sel = msk[tk], uni = msk[64];
    const bf16_t* H = (const bf16_t*)(ws + OFF_H);
    bf16x8 qf[8]; load_q<128>(H + row * LDH + C_NQ + head * 128, hi, qf);
    KeySrc ks; ks.k0 = H + (size_t)b * SEQ * LDH + C_NKS; ks.kstride = LDH; ks.kr = ks.k0; ks.krstride = 0; ks.v0 = H + (size_t)b * SEQ * LDH + C_NVS; ks.vstride = LDH;
    f32x16 o[4]; zero_o(o); float m = -1e30f, l = 0.f;
    attn_run<128, true>(lds, ks, 0, tb + 1, uni, qf, token, 0x7fffffffu, sel, 0.08838834764831845f * LOG2E, o, m, l, tid);
    const float* gp = (const float*)(ws + OFF_GATES) + row * 18 + head * 3;
    const float g0 = gld<float>(gp), g1 = gld<float>(gp + 1) / l, g2 = gld<float>(gp + 2);
    const bf16_t* pc = (const bf16_t*)(ws + OFF_PC) + row * 768 + head * 128 + 4 * hi; const bf16_t* pw = (const bf16_t*)(ws + OFF_PW) + row * 768 + head * 128 + 4 * hi;
    bf16_t* mx = (bf16_t*)(ws + OFF_MIX) + row * DM + 1280 + head * 128 + 4 * hi;
#pragma unroll
    for (int dt = 0; dt < 4; ++dt)
#pragma unroll
        for (int q = 0; q < 4; ++q) { const u32x2 a = gld<u32x2>(pc + 32 * dt + 8 * q), b = gld<u32x2>(pw + 32 * dt + 8 * q);
            store_bf4(mx + 32 * dt + 8 * q, g0 * bf_lo(a.x) + g1 * o[dt][4 * q] + g2 * bf_lo(b.x), g0 * bf_hi(a.x) + g1 * o[dt][4 * q + 1] + g2 * bf_hi(b.x),
                                            g0 * bf_lo(a.y) + g1 * o[dt][4 * q + 2] + g2 * bf_lo(b.y), g0 * bf_hi(a.y) + g1 * o[dt][4 * q + 3] + g2 * bf_hi(b.y)); }
}
__device__ __forceinline__ void item_dilmix(const Params& p, int it, LAS char* lds) {
    char* ws = ows(p.ws); const int tid = otid();
    const bf16_t* OD = (const bf16_t*)(ws + OFF_ODIL); const float* LD = (const float*)(ws + OFF_LDIL); bf16_t* MIX = (bf16_t*)(ws + OFF_MIX);
    for (int e = tid; e < 64 * 96; e += 256) {
        const size_t row = (size_t)it * 64 + e / 96; const int cc = (e % 96) * 8, h = cc >> 7;
        const float L0 = gld<float>(LD + row * 6 + h), L1 = gld<float>(LD + ((size_t)NT + row) * 6 + h), L2 = gld<float>(LD + ((size_t)2 * NT + row) * 6 + h);
        const float M = fmaxf(L0, fmaxf(L1, L2)); float w0 = __builtin_amdgcn_exp2f(L0 - M), w1 = __builtin_amdgcn_exp2f(L1 - M), w2 = __builtin_amdgcn_exp2f(L2 - M);
        const float inv = 1.f / (w0 + w1 + w2); w0 *= inv; w1 *= inv; w2 *= inv;
        const u32x4 a = gld<u32x4>(OD + row * 768 + cc), bq = gld<u32x4>(OD + ((size_t)NT + row) * 768 + cc), cq = gld<u32x4>(OD + ((size_t)2 * NT + row) * 768 + cc); u32x4 r;
#pragma unroll
        for (int j = 0; j < 4; ++j) r[j] = cvtpk(w0 * bf_lo(a[j]) + w1 * bf_lo(bq[j]) + w2 * bf_lo(cq[j]), w0 * bf_hi(a[j]) + w1 * bf_hi(bq[j]) + w2 * bf_hi(cq[j]));
        gst<u32x4>(MIX + row * DM + 512 + cc, r);
    }
}
__device__ __forceinline__ void phase_attn_d(const Params& p, int ctr_idx, LAS char* lds) {
    unsigned* ctr = (unsigned*)(ows(p.ws) + OFF_CTR) + ctr_idx;
    constexpr int NWIN = 384, NDIL = NB * 6 * 48, NCMP = 384;
    for (;;) { const int it = claim(ctr, lds); if (it >= NWIN + NDIL + NCMP) break;
        if (it < NWIN) item_win(p, it, lds); else if (it < NWIN + NDIL) item_dil(p, it - NWIN, lds); else item_cmp(p, it - NWIN - NDIL, lds); }
}
__device__ __forceinline__ void phase_attn_e(const Params& p, int ctr_idx, LAS char* lds) {
    unsigned* ctr = (unsigned*)(ows(p.ws) + OFF_CTR) + ctr_idx;
    constexpr int NMLA = 256, NSLC = 384, NMIX = NT / 64;
    const bool deal = gridDim.x == 512;
    int it = 0; bool first = deal;
    if (deal) { const int b = oblk(); it = b < NMLA ? b : 256 + (511 - b); }
    for (;;) {
        if (!first) { const int c = claim(ctr, lds); it = (deal ? 512 : 0) + c; if (it >= NMLA + NSLC + NMIX) break; }
        first = false;
        if (it < NMLA) item_mla(p, it, lds); else if (it < NMLA + NSLC) item_slc(p, it - NMLA, lds); else item_dilmix(p, it - NMLA - NSLC, lds);
    }
}
__device__ __forceinline__ void phase_combine(const Params& p) {
    char* ws = ows(p.ws);
    const bf16_t* OD = (const bf16_t*)(ws + OFF_ODIL); const float* LD = (const float*)(ws + OFF_LDIL);
    const bf16_t* PC = (const bf16_t*)(ws + OFF_PC); const bf16_t* PS = (const bf16_t*)(ws + OFF_PS); const bf16_t* PW = (const bf16_t*)(ws + OFF_PW);
    const float* G = (const float*)(ws + OFF_GATES); bf16_t* MIX = (bf16_t*)(ws + OFF_MIX);
    for (size_t e = (size_t)oblk() * 256 + otid(); e < (size_t)NT * 192; e += (size_t)gridDim.x * 256) {
        const size_t row = e / 192; const int c = (int)(e % 192), isn = c >= 96, cc = (isn ? c - 96 : c) * 8, h = cc >> 7;
        float w0, w1, w2; const bf16_t *s0, *s1, *s2;
        if (!isn) { const float L0 = gld<float>(LD + row * 6 + h), L1 = gld<float>(LD + ((size_t)NT + row) * 6 + h), L2 = gld<float>(LD + ((size_t)2 * NT + row) * 6 + h);
            const float M = fmaxf(L0, fmaxf(L1, L2)); w0 = __builtin_amdgcn_exp2f(L0 - M); w1 = __builtin_amdgcn_exp2f(L1 - M); w2 = __builtin_amdgcn_exp2f(L2 - M);
            const float inv = 1.f / (w0 + w1 + w2); w0 *= inv; w1 *= inv; w2 *= inv;
            s0 = OD + row * 768 + cc; s1 = OD + ((size_t)NT + row) * 768 + cc; s2 = OD + ((size_t)2 * NT + row) * 768 + cc;
        } else { w0 = gld<float>(G + row * 18 + h * 3); w1 = gld<float>(G + row * 18 + h * 3 + 1); w2 = gld<float>(G + row * 18 + h * 3 + 2); s0 = PC + row * 768 + cc; s1 = PS + row * 768 + cc; s2 = PW + row * 768 + cc; }
        const u32x4 a = gld<u32x4>(s0), bq = gld<u32x4>(s1), cq = gld<u32x4>(s2); u32x4 r;
#pragma unroll
        for (int j = 0; j < 4; ++j) r[j] = cvtpk(w0 * bf_lo(a[j]) + w1 * bf_lo(bq[j]) + w2 * bf_lo(cq[j]), w0 * bf_hi(a[j]) + w1 * bf_hi(bq[j]) + w2 * bf_hi(cq[j]));
        gst<u32x4>(MIX + row * DM + 512 + (isn ? 768 : 0) + cc, r);
    }
}

__device__ __forceinline__ void phase_ln(const Params& p, int layer, int mode) {
    char* ws = ows(p.ws); const int tid = otid(), lane = tid & 63, wv = (oblk() * 256 + tid) >> 6, nw = gridDim.x * 4;
    const float* g = p.in[mode ? I_LN2G : I_LN1G] + layer * DM; const float* bb = p.in[mode ? I_LN2B : I_LN1B] + layer * DM;
    for (int row = wv; row < NT; row += nw) {
        f32x4 v[8];
        if (mode == 0) { const float* y = (const float*)(ws + OFF_YB) + (size_t)row * DM;
#pragma unroll
            for (int i = 0; i < 8; ++i) v[i] = gld<f32x4>(y + (i * 64 + lane) * 4);
        } else { const float* x1 = (const float*)(ws + OFF_X1) + (size_t)row * DM; const bf16_t* y0 = (const bf16_t*)(ws + OFF_Y) + (size_t)(2 * row) * DM; const bf16_t* y1 = y0 + DM;
#pragma unroll
            for (int i = 0; i < 8; ++i) { const int c = (i * 64 + lane) * 4; const f32x4 xv = gld<f32x4>(x1 + c); const u32x2 a = gld<u32x2>(y0 + c), b2 = gld<u32x2>(y1 + c);
                v[i][0] = DN_ALPHA * xv[0] + bf_lo(a.x) + bf_lo(b2.x); v[i][1] = DN_ALPHA * xv[1] + bf_hi(a.x) + bf_hi(b2.x);
                v[i][2] = DN_ALPHA * xv[2] + bf_lo(a.y) + bf_lo(b2.y); v[i][3] = DN_ALPHA * xv[3] + bf_hi(a.y) + bf_hi(b2.y); }
        }
        float s = 0.f;
#pragma unroll
        for (int i = 0; i < 8; ++i) s += (v[i][0] + v[i][1]) + (v[i][2] + v[i][3]);
        const float mu = wave_sum(s) * (1.f / DM);
        float q = 0.f;
#pragma unroll
        for (int i = 0; i < 8; ++i) { const f32x4 d = v[i] - mu; q += (d[0] * d[0] + d[1] * d[1]) + (d[2] * d[2] + d[3] * d[3]); }
        const float rstd = 1.f / sqrtf(wave_sum(q) * (1.f / DM) + 1e-5f);
        float* of = mode == 0 ? (float*)(ws + OFF_X1) + (size_t)row * DM : (layer == DEPTH - 1 ? p.out + (size_t)row * DM : (float*)(ws + OFF_XA) + (size_t)row * DM);
        bf16_t* ob = mode == 0 ? (bf16_t*)(ws + OFF_X1B) + (size_t)row * DM : (bf16_t*)(ws + OFF_XB) + (size_t)row * DM;
#pragma unroll
        for (int i = 0; i < 8; ++i) { const int c = (i * 64 + lane) * 4; const f32x4 gv = gld<f32x4>(g + c), bv = gld<f32x4>(bb + c);
            f32x4 o = (v[i] - mu) * rstd * gv + bv; gst<f32x4>(of + c, o);
            if (mode == 0 || layer < DEPTH - 1) store_bf4(ob + c, o[0], o[1], o[2], o[3]); }
    }
}
__device__ __forceinline__ void ln1_row(char* ws, const float* g, const float* bb, int row, int lane) {
    const float* y = (const float*)(ws + OFF_YB) + (size_t)row * DM;
    f32x4 v[8];
#pragma unroll
    for (int i = 0; i < 8; ++i) v[i] = gld<f32x4>(y + (i * 64 + lane) * 4);
    float s = 0.f;
#pragma unroll
    for (int i = 0; i < 8; ++i) s += (v[i][0] + v[i][1]) + (v[i][2] + v[i][3]);
    const float mu = wave_sum(s) * (1.f / DM);
    float q = 0.f;
#pragma unroll
    for (int i = 0; i < 8; ++i) { const f32x4 d = v[i] - mu; q += (d[0] * d[0] + d[1] * d[1]) + (d[2] * d[2] + d[3] * d[3]); }
    const float rstd = 1.f / sqrtf(wave_sum(q) * (1.f / DM) + 1e-5f);
    float* of = (float*)(ws + OFF_X1) + (size_t)row * DM; bf16_t* ob = (bf16_t*)(ws + OFF_X1B) + (size_t)row * DM;
#pragma unroll
    for (int i = 0; i < 8; ++i) { const int c = (i * 64 + lane) * 4; const f32x4 gv = gld<f32x4>(g + c), bv = gld<f32x4>(bb + c);
        const f32x4 o = (v[i] - mu) * rstd * gv + bv; gst<f32x4>(of + c, o); store_bf4(ob + c, o[0], o[1], o[2], o[3]); }
}
__device__ __forceinline__ void phase_router(const Params& p, int layer, LAS char* lds) {
    char* ws = ows(p.ws); const int tid = otid(), lane = tid & 63, w = tid >> 6, l32 = lane & 31, hi = lane >> 5;
    const float* X1 = (const float*)(ws + OFF_X1); const float* We = p.in[I_WEXP] + (size_t)layer * DM * 32; const float* Wg = p.in[I_WGRP] + (size_t)layer * DM * 4;
    const float* lng = p.in[I_LN1G] + layer * DM; const float* lnb = p.in[I_LN1B] + layer * DM;
    LAS float* red = (LAS float*)lds;
    unsigned* ecnt = (unsigned*)(ws + OFF_ECNT); int* list = (int*)(ws + OFF_LIST); float* gw = (float*)(ws + OFF_GW);
    for (int it = oblk(); it < NT / 32; it += gridDim.x) {
        const int t0 = it * 32;
        for (int r = 0; r < 8; ++r) ln1_row(ws, lng, lnb, t0 + 8 * w + r, lane);
        asm volatile("s_waitcnt vmcnt(0)" ::: "memory");
        __syncthreads();
        f32x16 ae, ag;
#pragma unroll
        for (int r = 0; r < 16; ++r) { ae[r] = 0.f; ag[r] = 0.f; }
        const float* xr = X1 + (size_t)(t0 + l32) * DM + w * 512 + 4 * hi;
        const float* wer = We + (size_t)(w * 512 + 4 * hi) * 32 + l32;
        const float* wgr = Wg + (size_t)(w * 512 + 4 * hi) * 4 + (l32 & 3);
        f32x4 xa[4], xb[4]; float wea[4][4], web[4][4], wga[4][4], wgb[4][4];
#define RT_LOAD(X, WE, WG, KC) do { _Pragma("unroll") for (int i_ = 0; i_ < 4; ++i_) { X[i_] = gld<f32x4>(xr + (KC) + 8 * i_); \
            _Pragma("unroll") for (int j_ = 0; j_ < 4; ++j_) { WE[i_][j_] = gld<float>(wer + (size_t)((KC) + 8 * i_ + j_) * 32); WG[i_][j_] = l32 < 4 ? gld<float>(wgr + (size_t)((KC) + 8 * i_ + j_) * 4) : 0.f; } } } while (0)
#define RT_MMA(X, WE, WG) do { _Pragma("unroll") for (int i_ = 0; i_ < 4; ++i_) _Pragma("unroll") for (int j_ = 0; j_ < 4; ++j_) { \
            ae = __builtin_amdgcn_mfma_f32_32x32x2f32(X[i_][j_], WE[i_][j_], ae, 0, 0, 0); ag = __builtin_amdgcn_mfma_f32_32x32x2f32(X[i_][j_], WG[i_][j_], ag, 0, 0, 0); } } while (0)
        RT_LOAD(xa, wea, wga, 0);
        for (int kc = 0; kc < 512; kc += 64) {
            RT_LOAD(xb, web, wgb, kc + 32);
            RT_MMA(xa, wea, wga);
            if (kc + 64 < 512) RT_LOAD(xa, wea, wga, kc + 64);
            RT_MMA(xb, web, wgb);
        }
#undef RT_LOAD
#undef RT_MMA
        __syncthreads();
#pragma unroll
        for (int r = 0; r < 16; ++r) { const int tk = crow(r, hi); red[(w * 32 + tk) * 36 + l32] = ae[r]; if (l32 < 4) red[(w * 32 + tk) * 36 + 32 + l32] = ag[r]; }
        __syncthreads();
        if (tid < 32) {
            const int tk = tid;
            float lg[4];
#pragma unroll
            for (int j = 0; j < 4; ++j) lg[j] = (red[(0 * 32 + tk) * 36 + 32 + j] + red[(1 * 32 + tk) * 36 + 32 + j]) + (red[(2 * 32 + tk) * 36 + 32 + j] + red[(3 * 32 + tk) * 36 + 32 + j]);
            int gi = 0; float gm = lg[0];
#pragma unroll
            for (int j = 1; j < 4; ++j) if (lg[j] > gm) { gm = lg[j]; gi = j; }
            float den = 0.f;
#pragma unroll
            for (int j = 0; j < 4; ++j) den += __expf(lg[j] - gm);
            const float pg = 1.f / den;
            float b0 = -__builtin_inff(), b1 = -__builtin_inff(); int i0 = 0, i1 = 0;
#pragma unroll
            for (int j = 0; j < 8; ++j) { const int n = gi * 8 + j;
                const float v = (red[(0 * 32 + tk) * 36 + n] + red[(1 * 32 + tk) * 36 + n]) + (red[(2 * 32 + tk) * 36 + n] + red[(3 * 32 + tk) * 36 + n]);
                if (v > b0) { b1 = b0; i1 = i0; b0 = v; i0 = j; } else if (v > b1) { b1 = v; i1 = j; } }
            const float w1 = __expf(b1 - b0), g0 = pg / (1.f + w1), g1 = pg * w1 / (1.f + w1);
            const int tok = t0 + tk, e0 = gi * 8 + i0, e1 = gi * 8 + i1;
            const unsigned p0 = atomicAdd(&ecnt[e0], 1u), p1 = atomicAdd(&ecnt[e1], 1u);
            list[(size_t)e0 * NT + p0] = 2 * tok; list[(size_t)e1 * NT + p1] = 2 * tok + 1;
            gw[2 * tok] = g0; gw[2 * tok + 1] = g1;
        }
        __syncthreads();
    }
}
__device__ __forceinline__ int moe_table(const Params& p, LAS char* lds) {
    LAS int* off = (LAS int*)(lds + LDS_CTL + 128); LAS int* toff = off + 33;
    __syncthreads();
    if (otid() == 0) { const unsigned* ecnt = (const unsigned*)(ows(p.ws) + OFF_ECNT); int a = 0, t = 0;
        for (int e = 0; e < NEXP; ++e) { off[e] = a; toff[e] = t; const int c = (int)ecnt[e]; a += c; t += (c + 127) >> 7; } off[NEXP] = a; toff[NEXP] = t; }
    __syncthreads();
    return toff[NEXP];
}
__device__ __forceinline__ void phase_moe1(const Params& p, LAS char* lds) {
    char* ws = ows(p.ws); const int tid = otid(), sr = tid >> 3, sc = (tid & 7) * 8;
    const int ntile = moe_table(p, lds); const LAS int* off = (const LAS int*)(lds + LDS_CTL + 128); const LAS int* toff = off + 33;
    const unsigned* ecnt = (const unsigned*)(ws + OFF_ECNT); const int* list = (const int*)(ws + OFF_LIST);
    const bf16_t* X1B = (const bf16_t*)(ws + OFF_X1B);
    for (int u = oblk(); u < ntile * 4; u += gridDim.x) {
        int e = 0; for (int k = 1; k < NEXP; ++k) if (u >= toff[k] * 4) e = k;
        const int mte = toff[e + 1] - toff[e], v = u - toff[e] * 4, nt = v / mte, mt = v - nt * mte;
        const int cnt = (int)ecnt[e], nvalid = cnt - mt * 128 < 128 ? cnt - mt * 128 : 128;
        const int* le = list + (size_t)e * NT + mt * 128;
        unsigned ao[4];
#pragma unroll
        for (int i = 0; i < 4; ++i) { const int r = sr + 32 * i; ao[i] = (unsigned)((gld<int>(le + (r < nvalid ? r : 0)) >> 1) * DM + sc); }
        EpiMoe1 ep{(bf16_t*)(ws + OFF_HM), off[e] + mt * 128, nvalid, nt * 256};
        gemm_unit(lds, X1B, ao, 128, (const bf16_t*)(ws + OFF_WGU_T) + ((size_t)e * 1024 + nt * 256) * DM, (unsigned)(sr * DM + sc), (size_t)32 * DM, DM / 64, ep);
    }
}
__device__ __forceinline__ void phase_moe2(const Params& p, LAS char* lds) {
    char* ws = ows(p.ws); const int tid = otid(), sr = tid >> 3, sc = (tid & 7) * 8;
    const int ntile = moe_table(p, lds); const LAS int* off = (const LAS int*)(lds + LDS_CTL + 128); const LAS int* toff = off + 33;
    const unsigned* ecnt = (const unsigned*)(ws + OFF_ECNT); const int* list = (const int*)(ws + OFF_LIST);
    const bf16_t* HM = (const bf16_t*)(ws + OFF_HM);
    for (int u = oblk(); u < ntile * 8; u += gridDim.x) {
        int e = 0; for (int k = 1; k < NEXP; ++k) if (u >= toff[k] * 8) e = k;
        const int mte = toff[e + 1] - toff[e], v = u - toff[e] * 8, nt = v / mte, mt = v - nt * mte;
        const int cnt = (int)ecnt[e], nvalid = cnt - mt * 128 < 128 ? cnt - mt * 128 : 128;
        const unsigned ao[4] = AO4(EFF);
        EpiMoe2 ep{(bf16_t*)(ws + OFF_Y), list + (size_t)e * NT + mt * 128, (const float*)(ws + OFF_GW), nvalid, nt * 256};
        gemm_unit(lds, HM + (size_t)(off[e] + mt * 128) * EFF, ao, 128, (const bf16_t*)(ws + OFF_WD_T) + ((size_t)e * DM + nt * 256) * EFF, (unsigned)(sr * EFF + sc), (size_t)32 * EFF, EFF / 64, ep);
    }
}

__device__ __forceinline__ Params load_params() {
    Params q;
#if defined(__HIP_DEVICE_COMPILE__)
    const CAS Params* pp = (const CAS Params*)__builtin_amdgcn_kernarg_segment_ptr(); asm volatile("" : "+s"(pp));
#pragma unroll
    for (int i = 0; i < 22; ++i) q.in[i] = pp->in[i];
    q.out = pp->out; q.ws = pp->ws;
#endif
    return q;
}
__device__ constexpr int REP[10] = {1, 1, 1, 1, 1, 1, 1, 1, 1, 1};
__global__ void __launch_bounds__(256, 2) fwd_kernel(Params p) {
    extern __shared__ __attribute__((aligned(16))) char lds_raw[];
    LAS char* lds = (LAS char*)lds_raw;
    if (threadIdx.x == 0) { *(LAS u32x4*)(lds + LDS_CTL) = (u32x4){0u, 0u, 0u, 0u}; }
    __syncthreads();
    XcdBarrier bar = xcd_barrier_post((unsigned*)(p.ws + OFF_BAR), (volatile LAS unsigned*)(lds + LDS_CTL));
    for (int layer = 0; layer < DEPTH; ++layer) {
        for (int r = 0; r < REP[0]; ++r) { phase_prep(load_params(), layer, lds);              xcd_barrier(bar); }
        for (int r = 0; r < REP[1]; ++r) { phase_win(load_params(), layer, lds);               xcd_barrier(bar); }
        for (int r = 0; r < REP[2]; ++r) { phase_up(load_params(), layer, lds);                xcd_barrier(bar); }
        phase_cmpred(load_params(), layer);                 xcd_barrier(bar);
        for (int r = 0; r < REP[3]; ++r) { phase_cmp2(load_params(), layer, lds);              xcd_barrier(bar); }
        for (int r = 0; r < REP[4]; ++r) { phase_attn_d(load_params(), 64 * (2 * layer) + 16 * r, lds);       xcd_barrier(bar); }
        for (int r = 0; r < REP[5]; ++r) { phase_attn_e(load_params(), 64 * (2 * layer + 1) + 16 * r, lds);   xcd_barrier(bar); }
        for (int r = 0; r < REP[6]; ++r) { phase_out(load_params(), layer, lds);               xcd_barrier(bar); }
        phase_router(load_params(), layer, lds);            xcd_barrier(bar);
        for (int r = 0; r < REP[7]; ++r) { phase_moe1(load_params(), lds);                     xcd_barrier(bar); }
        for (int r = 0; r < REP[8]; ++r) { phase_moe2(load_params(), lds);                     xcd_barrier(bar); }
        for (int r = 0; r < REP[9]; ++r) { phase_ln(load_params(), layer, 1);                  xcd_barrier(bar); }
    }
}

extern "C" void kernel_launch(void* const* d_in, const int* in_sizes, int n_in, void* d_out, int out_size, void* d_ws, size_t ws_size, hipStream_t stream) {
    (void)in_sizes; (void)out_size;
    static int grid = 0;
    if (!grid) {
        int dev = 0, cus = 0, per_cu = 0;
        (void)hipGetDevice(&dev);
        (void)hipDeviceGetAttribute(&cus, hipDeviceAttributeMultiprocessorCount, dev);
        (void)hipFuncSetAttribute((const void*)fwd_kernel, hipFuncAttributeMaxDynamicSharedMemorySize, LDS_BYTES);
        (void)hipOccupancyMaxActiveBlocksPerMultiprocessor(&per_cu, (const void*)fwd_kernel, 256, LDS_BYTES);
        if (cus <= 0) cus = 256;
        if (per_cu < 1) per_cu = 1;
        grid = cus * (per_cu < 2 ? per_cu : 2);
    }
    if (n_in < 22 || ws_size < WS_TOTAL) { fprintf(stderr, "kernel_launch: bad arguments (n_in %d, ws %zu < %zu)\n", n_in, ws_size, (size_t)WS_TOTAL); return; }
    Params p;
    for (int i = 0; i < 22; ++i) p.in[i] = (const float*)d_in[i];
    p.out = (float*)d_out; p.ws = (char*)d_ws;
    (void)hipMemsetAsync(d_ws, 0, ZERO_BYTES, stream);
    fwd_kernel<<<dim3(grid), dim3(256), LDS_BYTES, stream>>>(p);
}
```

```cpp
#include <hip/hip_runtime.h>
#include <stdint.h>
#include <stdio.h>

#define LAS __attribute__((address_space(3)))
#define GAS __attribute__((address_space(1)))
#define CAS __attribute__((address_space(4)))
typedef unsigned short bf16_t;
typedef short bf16x8 __attribute__((ext_vector_type(8)));
typedef short s16x4 __attribute__((ext_vector_type(4)));
typedef float f32x16 __attribute__((ext_vector_type(16)));
typedef float f32x4 __attribute__((ext_vector_type(4)));
typedef float f32x2 __attribute__((ext_vector_type(2)));
typedef unsigned u32x4 __attribute__((ext_vector_type(4)));
typedef unsigned u32x2 __attribute__((ext_vector_type(2)));

constexpr int NB = 4, SEQ = 2048, NT = NB * SEQ, DM = 2048, DEPTH = 2;
constexpr int INC = 4434, LDH = 4608;
constexpr int C_QLAT = 0, C_KVLAT = 384, C_KROPE = 512, C_DQ = 576, C_DK = 1344, C_DV = 2112, C_NQ = 2880, C_NKC = 3648, C_NVC = 3776,
              C_NKS = 3904, C_NVS = 4032, C_NKW = 4160, C_NVW = 4288, C_GATE = 4416;
constexpr int NEXP = 32, EFF = 512;
constexpr float DN_ALPHA = 1.41421356237309515f;
constexpr float LOG2E = 1.4426950408889634f;

constexpr size_t al256(size_t x) { return (x + 255) & ~(size_t)255; }
constexpr size_t OFF_BAR = 0;
constexpr size_t OFF_CTR = 16384;
constexpr size_t ZERO_BYTES = 20480;
constexpr size_t OFF_ECNT = ZERO_BYTES;
constexpr size_t OFF_CS16 = OFF_ECNT + 256;
constexpr size_t OFF_CS32 = OFF_CS16 + (size_t)SEQ * 16 * 8;
constexpr size_t OFF_WIN_T = OFF_CS32 + (size_t)SEQ * 32 * 8;
constexpr size_t OFF_WQ_T = OFF_WIN_T + (size_t)LDH * DM * 2;
constexpr size_t OFF_WKV_T = OFF_WQ_T + (size_t)768 * 384 * 2;
constexpr size_t OFF_W1K_T = OFF_WKV_T + (size_t)1024 * 128 * 2;
constexpr size_t OFF_W1V_T = OFF_W1K_T + (size_t)256 * 4096 * 2;
constexpr size_t OFF_W2K_T = OFF_W1V_T + (size_t)256 * 4096 * 2;
constexpr size_t OFF_W2V_T = OFF_W2K_T + (size_t)256 * 256 * 2;
constexpr size_t OFF_WOUT_T = OFF_W2V_T + (size_t)256 * 256 * 2;
constexpr size_t OFF_WGU_T = OFF_WOUT_T + (size_t)DM * DM * 2;
constexpr size_t OFF_WD_T = OFF_WGU_T + (size_t)NEXP * 1024 * DM * 2;
constexpr size_t OFF_B1P = OFF_WD_T + (size_t)NEXP * DM * EFF * 2;
constexpr size_t OFF_XB = OFF_B1P + (size_t)2 * 16 * 256 * 4;
constexpr size_t OFF_H = OFF_XB + (size_t)NT * DM * 2;
constexpr size_t OFF_GATES = OFF_H + (size_t)NT * LDH * 2;
constexpr size_t OFF_QM = OFF_GATES + al256((size_t)NT * 18 * 4);
constexpr size_t OFF_KN = OFF_QM + (size_t)NT * 768 * 2;
constexpr size_t OFF_VM = OFF_KN + (size_t)NT * 512 * 2;
static_assert(OFF_VM == OFF_KN + (size_t)NT * 512 * 2, "Vm must follow Kn");
constexpr size_t OFF_HC = OFF_VM + (size_t)NT * 512 * 2;
constexpr size_t OFF_HCP = OFF_HC + (size_t)2 * 512 * 256 * 2;
constexpr size_t OFF_KC = OFF_HCP + (size_t)8 * 2 * 512 * 256 * 4;
constexpr size_t OFF_VC = OFF_KC + (size_t)512 * 128 * 2;
constexpr size_t OFF_IMP = OFF_VC + (size_t)512 * 128 * 2;
constexpr size_t OFF_ODIL = OFF_IMP + (size_t)NT * 32 * 4;
constexpr size_t OFF_LDIL = OFF_ODIL + (size_t)3 * NT * 768 * 2;
constexpr size_t OFF_PC = OFF_LDIL + (size_t)3 * NT * 6 * 4;
constexpr size_t OFF_PS = OFF_PC + (size_t)NT * 768 * 2;
constexpr size_t OFF_PW = OFF_PS + (size_t)NT * 768 * 2;
constexpr size_t OFF_MIX = OFF_PW + (size_t)NT * 768 * 2;
constexpr size_t OFF_YB = OFF_MIX + (size_t)NT * DM * 2;
constexpr size_t OFF_XA = OFF_YB + (size_t)NT * DM * 4;
constexpr size_t OFF_X1 = OFF_XA + (size_t)NT * DM * 4;
constexpr size_t OFF_X1B = OFF_X1 + (size_t)NT * DM * 4;
constexpr size_t OFF_HM = OFF_X1B + (size_t)NT * DM * 2;
constexpr size_t OFF_Y = OFF_HM + (size_t)(2 * NT + 256) * EFF * 2;
constexpr size_t OFF_LIST = OFF_Y + (size_t)2 * NT * DM * 2;
constexpr size_t OFF_GW = OFF_LIST + (size_t)NEXP * NT * 4;
constexpr size_t WS_TOTAL = OFF_GW + (size_t)2 * NT * 4;

struct Params { const float* in[22]; float* out; char* ws; };
enum { I_X = 0, I_WIN, I_QLN, I_WQUP, I_KVLN, I_WKVUP, I_PEK, I_W1K, I_W2K, I_PEV, I_W1V, I_W2V, I_WOUT, I_LN1G, I_LN1B, I_WGRP, I_WEXP, I_WGATE, I_WUP, I_WDOWN, I_LN2G, I_LN2B };

#define XB_TMO      128
#define XB_XCNT(j)  (256  + 64 * (j))
#define XB_XSUB(j)  (1280 + 64 * (j))
#define XB_XGEN(j)  (2304 + 64 * (j))
#define XB_TOP      3328
#define XB_TOPGEN   3392
#define XCD_BAR_WORDS 3456
#define XB_SPIN_CAP (1u << 18)

__device__ __forceinline__ unsigned xb_ld(unsigned* p)              { return __hip_atomic_load(p, __ATOMIC_RELAXED, __HIP_MEMORY_SCOPE_AGENT); }
__device__ __forceinline__ unsigned xb_add(unsigned* p, unsigned v) { return __hip_atomic_fetch_add(p, v, __ATOMIC_RELAXED, __HIP_MEMORY_SCOPE_AGENT); }
__device__ __forceinline__ unsigned xb_xcc_id() { return (unsigned)__builtin_amdgcn_s_getreg((3 << 11) | 20) & 0xFu; }
#define XB_SPIN(cond, bar) do { unsigned _sp = 0; while (cond) { __builtin_amdgcn_s_sleep(1); \
    if ((++_sp & 255u) == 0u) { if (xb_ld(&(bar)[XB_TMO])) break; if (_sp > XB_SPIN_CAP) { atomicAdd(&(bar)[XB_TMO], 1u); break; } } } } while (0)

struct XcdBarrier { unsigned* bar; unsigned x; volatile LAS unsigned* st; };
__device__ __forceinline__ int otid();

__device__ __forceinline__ XcdBarrier xcd_barrier_post(unsigned* bar, volatile LAS unsigned* st) {
    XcdBarrier b; b.bar = bar; b.x = xb_xcc_id(); b.st = st;
    if (threadIdx.x == 0) (void)xb_add(&bar[XB_XCNT(b.x)], 1u);
    return b;
}
__device__ __forceinline__ void xcd_barrier_complete(unsigned* bar, unsigned x, unsigned& nloc, unsigned& nx) {
    const unsigned G = gridDim.x * gridDim.y * gridDim.z;
    unsigned sum, cnt, mine, sp = 0u;
    for (;;) {
        sum = 0u; cnt = 0u; mine = 0u;
#pragma unroll
        for (unsigned j = 0; j < 16; ++j) { const unsigned c = xb_ld(&bar[XB_XCNT(j)]); sum += c; cnt += (c > 0u) ? 1u : 0u; mine = (j == x) ? c : mine; }
        if (sum == G) break;
        __builtin_amdgcn_s_sleep(1);
        if ((++sp & 255u) == 0u) { if (xb_ld(&bar[XB_TMO])) break; if (sp > XB_SPIN_CAP) { atomicAdd(&bar[XB_TMO], 1u); break; } }
    }
    nloc = mine > 0u ? mine : 1u; nx = cnt > 0u ? cnt : 1u;
}
__device__ __forceinline__ void xcd_barrier(const XcdBarrier& b) {
    asm volatile("s_waitcnt vmcnt(0)" ::: "memory");
    __syncthreads();
    if (otid() == 0) {
        unsigned* bar = b.bar;
        __builtin_amdgcn_s_waitcnt(0);
        unsigned nloc = b.st[0], nx = b.st[1];
        if (nloc == 0u) { xcd_barrier_complete(bar, b.x, nloc, nx); b.st[0] = nloc; b.st[1] = nx; }
        const unsigned old = xb_add(&bar[XB_XSUB(b.x)], 1u);
        const unsigned gen = old / nloc;
        if (old + 1u == (gen + 1u) * nloc) {
            __builtin_amdgcn_fence(__ATOMIC_RELEASE, "agent");
            asm volatile("s_waitcnt vmcnt(0)" ::: "memory");
            const unsigned og = xb_add(&bar[XB_TOP], 1u);
            const unsigned tg = og / nx;
            if (og + 1u == (tg + 1u) * nx) xb_add(&bar[XB_TOPGEN], 1u);
            else XB_SPIN(xb_ld(&bar[XB_TOPGEN]) == tg, bar);
            __builtin_amdgcn_fence(__ATOMIC_ACQUIRE, "agent");
            xb_add(&bar[XB_XGEN(b.x)], 1u);
            asm volatile("s_waitcnt vmcnt(0)" ::: "memory");
        } else {
            XB_SPIN(xb_ld(&bar[XB_XGEN(b.x)]) == gen, bar);
            __builtin_amdgcn_fence(__ATOMIC_ACQUIRE, "agent");
            asm volatile("s_waitcnt vmcnt(0)" ::: "memory");
        }
    }
    __syncthreads();
}

template <class T> __device__ __forceinline__ T gld(const void* p) { return *(const GAS T*)p; }
template <class T> __device__ __forceinline__ void gst(void* p, const T& v) { *(GAS T*)p = v; }
__device__ __forceinline__ __amdgpu_buffer_rsrc_t mk_rsrc(const void* p) {
    const unsigned long long v = (unsigned long long)p;
    const unsigned lo = __builtin_amdgcn_readfirstlane((unsigned)v), hi = __builtin_amdgcn_readfirstlane((unsigned)(v >> 32));
    return __builtin_amdgcn_make_buffer_rsrc((void*)(((unsigned long long)hi << 32) | lo), 0, 0xFFFFFFF0u, 0x00020000);
}
__device__ __forceinline__ bf16x8 bld8(__amdgpu_buffer_rsrc_t r, unsigned voff, int soff) { const u32x4 v = __builtin_amdgcn_raw_buffer_load_b128(r, (int)voff, soff, 0); return __builtin_bit_cast(bf16x8, v); }
typedef __bf16 bf16x2v __attribute__((ext_vector_type(2)));
__device__ __forceinline__ unsigned cvtpk(float lo, float hi) { const f32x2 v = {lo, hi}; const bf16x2v r = __builtin_convertvector(v, bf16x2v); return __builtin_bit_cast(unsigned, r); }
__device__ __forceinline__ float bf_lo(unsigned u) { return __uint_as_float(u << 16); }
__device__ __forceinline__ float bf_hi(unsigned u) { return __uint_as_float(u & 0xffff0000u); }
__device__ __forceinline__ float bf2f(bf16_t b) { return __uint_as_float((unsigned)b << 16); }
__device__ __forceinline__ float wave_sum(float v) {
#pragma unroll
    for (int o = 32; o >= 1; o >>= 1) v += __shfl_xor(v, o);
    return v;
}
extern __shared__ __attribute__((aligned(16))) char g_lds[];
constexpr int LDS_BYTES = 163840;
constexpr int LDS_CTL = LDS_BYTES - 512;
__device__ __forceinline__ int olane() { return (int)__builtin_amdgcn_mbcnt_hi(~0u, __builtin_amdgcn_mbcnt_lo(~0u, 0u)); }
__device__ __forceinline__ int owid() { const unsigned slot = __builtin_amdgcn_s_getreg(63492) & 0x3fu; return __builtin_amdgcn_readfirstlane((int)((LAS unsigned char*)g_lds)[LDS_CTL + 416 + slot]); }
__device__ __forceinline__ int otid() { int t = (owid() << 6) | olane(); asm volatile("" : "+v"(t)); return t; }
__device__ __forceinline__ int oblk() { int b = blockIdx.x; asm volatile("" : "+s"(b)); return b; }
__device__ __forceinline__ char* ows(const char* w) { char* q = const_cast<char*>(w); asm volatile("" : "+s"(q)); return q; }
__device__ __forceinline__ int crow(int r, int hi) { return (r & 3) + 8 * (r >> 2) + 4 * hi; }


constexpr int GS = 72;
constexpr int KN_BS = 288;
constexpr int G8_BOFF = 256 * GS * 2;
constexpr int G8_STG = 2 * G8_BOFF;
constexpr int G8_ROWSS = 2 * G8_STG;
template <int NI, int MODE, bool DEEP, class EPI>
__device__ __forceinline__ void gemm8(LAS char* lds, const bf16_t* abase, const unsigned (&aoff)[4], int ajump, const bf16_t* bbase, int ldb, unsigned updelta, int nkt, const EPI& epi) {
    static_assert(MODE != 2 || NI == 4, "the gate / up interleave assumes 256-column tiles");
    const int tid = otid(), lane = tid & 63, w = tid >> 6, l32 = lane & 31, hi = lane >> 5;
    const int wm = w >> 1, wn = w & 1;
    const int sr = tid >> 3, sc = (tid & 7) * 8;
    const int st_off = (sr * GS + sc) * 2;
    const int a_rd = ((wm * 64 + l32) * GS + hi * 8) * 2;
    const int g = lane >> 4, i16 = lane & 15;
    const int b_rd = G8_BOFF + (MODE == 0 ? ((wn * 32 * NI + l32) * GS + hi * 8) * 2 : ((8 * hi + (i16 >> 2)) * KN_BS + wn * 32 * NI + 16 * (g & 1) + 4 * (i16 & 3)) * 2);
    constexpr int NB_ = NI;
    f32x16 acc[2][NI];
#pragma unroll
    for (int i = 0; i < 2; ++i)
#pragma unroll
        for (int j = 0; j < NI; ++j)
#pragma unroll
            for (int r = 0; r < 16; ++r) acc[i][j][r] = 0.f;
    bf16x8 ra[4], rb[NB_];
    const __amdgpu_buffer_rsrc_t rsa = mk_rsrc(abase), rsb = mk_rsrc(bbase);
    unsigned bvo[NB_]; int blo[NB_];
#pragma unroll
    for (int i = 0; i < NB_; ++i) {
        if (MODE == 0) { bvo[i] = (unsigned)(sr * ldb + sc) * 2u; blo[i] = G8_BOFF + st_off + i * 64 * GS * 2; }
        else { const int ch = tid + 512 * i, brow = ch / (8 * NI), bc = (ch - brow * 8 * NI) * 8;
               const unsigned bcol = MODE == 2 ? (unsigned)(32 * (bc >> 6) + (bc & 31)) + (((bc >> 5) & 1) ? updelta : 0u) : (unsigned)bc;
               bvo[i] = ((unsigned)(brow * ldb) + bcol) * 2u; blo[i] = G8_BOFF + (brow * KN_BS + bc) * 2; }
    }
    const int bstep = MODE == 0 ? 64 * ldb * 2 : 0;
#define G8_LOADR(RA, RB, KT) do { const int k_ = (KT) * 64; const int ao_ = 2 * ((k_ >> 7) * ajump + (k_ & 127)); \
        _Pragma("unroll") for (int i = 0; i < 4; ++i) RA[i] = bld8(rsa, 2u * aoff[i], ao_); \
        _Pragma("unroll") for (int i = 0; i < NB_; ++i) RB[i] = bld8(rsb, bvo[i], i * bstep + (MODE == 0 ? 2 * k_ : k_ * ldb * 2)); } while (0)
#define G8_WRITER(RA, RB, ST) do { LAS char* s_ = lds + (ST) * G8_STG; \
        _Pragma("unroll") for (int i = 0; i < 4; ++i) *(LAS bf16x8*)(s_ + st_off + i * 64 * GS * 2) = RA[i]; \
        _Pragma("unroll") for (int i = 0; i < NB_; ++i) *(LAS bf16x8*)(s_ + blo[i]) = RB[i]; } while (0)
#define G8_COMPUTE(ST) do { const LAS char* s_ = lds + (ST) * G8_STG; \
        _Pragma("unroll") for (int ks = 0; ks < 4; ++ks) { bf16x8 af[2], bfr[NI]; \
            _Pragma("unroll") for (int i = 0; i < 2; ++i) af[i] = *(const LAS bf16x8*)(s_ + a_rd + i * 32 * GS * 2 + ks * 32); \
            _Pragma("unroll") for (int j = 0; j < NI; ++j) { \
                if (MODE == 0) bfr[j] = *(const LAS bf16x8*)(s_ + b_rd + j * 32 * GS * 2 + ks * 32); \
                else { const s16x4 v0 = __builtin_amdgcn_ds_read_tr16_b64_v4i16((LAS s16x4*)(s_ + b_rd + ks * 16 * KN_BS * 2 + j * 64)); \
                       const s16x4 v1 = __builtin_amdgcn_ds_read_tr16_b64_v4i16((LAS s16x4*)(s_ + b_rd + (ks * 16 + 4) * KN_BS * 2 + j * 64)); \
                       bfr[j] = (bf16x8){v0[0], v0[1], v0[2], v0[3], v1[0], v1[1], v1[2], v1[3]}; } } \
            _Pragma("unroll") for (int i = 0; i < 2; ++i) _Pragma("unroll") for (int j = 0; j < NI; ++j) acc[i][j] = __builtin_amdgcn_mfma_f32_32x32x16_bf16(bfr[j], af[i], acc[i][j], 0, 0, 0); \
            if (ks & 1) asm volatile("" ::: "memory"); } } while (0)
    if (DEEP) {
        bf16x8 ra2[4], rb2[NB_];
        const int last = nkt - 1;
#define G8_CL(x) ((x) < last ? (x) : last)
        G8_LOADR(ra, rb, 0);
        G8_LOADR(ra2, rb2, G8_CL(1));
        G8_WRITER(ra, rb, 0);
        __syncthreads();
        G8_LOADR(ra, rb, G8_CL(2));
        for (int kt = 0; kt < nkt; kt += 2) {
            G8_WRITER(ra2, rb2, 1);
            G8_COMPUTE(0);
            __syncthreads();
            G8_LOADR(ra2, rb2, G8_CL(kt + 3));
            G8_WRITER(ra, rb, 0);
            if (kt + 1 < nkt) G8_COMPUTE(1);
            __syncthreads();
            G8_LOADR(ra, rb, G8_CL(kt + 4));
        }
        asm volatile("s_waitcnt vmcnt(0)" ::: "memory");
#undef G8_CL
    } else {
        G8_LOADR(ra, rb, 0);
        G8_WRITER(ra, rb, 0);
        __syncthreads();
        for (int kt = 0; kt < nkt; ++kt) {
            const int cur = kt & 1; const bool more = kt + 1 < nkt;
            if (more) G8_LOADR(ra, rb, kt + 1);
            G8_COMPUTE(cur);
            if (more) G8_WRITER(ra, rb, cur ^ 1);
            __syncthreads();
        }
    }
#undef G8_LOADR
#undef G8_WRITER
#undef G8_COMPUTE
    epi(acc, wm, wn, l32, hi, lds);
}
template <int K> __device__ __forceinline__ void row_sumsq(LAS char* lds, const bf16_t* A, int ld) {
    const int tid = otid(), row = tid >> 1, half = tid & 1;
    const bf16_t* ptr = A + (size_t)row * ld + half * (K / 2);
    float ss = 0.f;
#pragma unroll
    for (int c = 0; c < K / 16; ++c) { const u32x4 v = gld<u32x4>(ptr + c * 8);
#pragma unroll
        for (int j = 0; j < 4; ++j) { const float a = bf_lo(v[j]), b = bf_hi(v[j]); ss += a * a + b * b; } }
    ss += __shfl_xor(ss, 1);
    __syncthreads();
    if (half == 0) ((LAS float*)(lds + G8_ROWSS))[row] = ss;
}
__device__ __forceinline__ void store_bf4(bf16_t* p, float a, float b, float c, float d) { u32x2 w; w.x = cvtpk(a, b); w.y = cvtpk(c, d); gst<u32x2>(p, w); }

__device__ __forceinline__ void store_tiles4(bf16_t* p, const f32x16 (&a)[4], float sc) {
#pragma unroll
    for (int ni = 0; ni < 4; ++ni)
#pragma unroll
        for (int q = 0; q < 4; ++q) store_bf4(p + 32 * ni + 8 * q, a[ni][4 * q] * sc, a[ni][4 * q + 1] * sc, a[ni][4 * q + 2] * sc, a[ni][4 * q + 3] * sc);
}
__device__ __forceinline__ void rope_pair32(f32x16& lo, f32x16& hi16, const f32x2* cs32, int pos, int hi, bool on = true) {
#pragma unroll
    for (int r = 0; r < 16; ++r) { f32x2 cs = {1.f, 0.f}; if (on) cs = gld<f32x2>(cs32 + pos * 32 + crow(r, hi)); const float x1 = lo[r], x2 = hi16[r]; lo[r] = x1 * cs.x - x2 * cs.y; hi16[r] = x2 * cs.x + x1 * cs.y; }
}
__device__ __forceinline__ void rope_first32(f32x16& t, const f32x2* cs16, int pos, int hi) {
#pragma unroll
    for (int r = 0; r < 8; ++r) { const f32x2 cs = gld<f32x2>(cs16 + pos * 16 + crow(r, hi)); const float x1 = t[r], x2 = t[r + 8]; t[r] = x1 * cs.x - x2 * cs.y; t[r + 8] = x2 * cs.x + x1 * cs.y; }
}
__device__ __forceinline__ bool is_rope16(int c0) {
    return (((c0 - C_DQ) & 127) == 0) && ((c0 >= C_DQ && c0 < C_DV) || (c0 >= C_NQ && c0 < C_NKC) || c0 == C_NKS || c0 == C_NKW);
}
struct EpiWin {
    bf16_t* H; float* gates; const f32x2* cs16; const f32x2* cs32; int m0, n0;
    __device__ __forceinline__ void operator()(f32x16 (&acc)[2][3], int wm, int wn, int l32, int hi, LAS char*) const {
        const int nw = n0 + 96 * wn;
#pragma unroll
        for (int mi = 0; mi < 2; ++mi) {
            const int row = m0 + 64 * wm + 32 * mi + l32, pos = row & (SEQ - 1);
            if (nw + 32 == C_KROPE) rope_pair32(acc[mi][1], acc[mi][2], cs32, pos, hi);
#pragma unroll
            for (int ni = 0; ni < 3; ++ni) if (is_rope16(nw + 32 * ni)) rope_first32(acc[mi][ni], cs16, pos, hi);
            if (nw == C_GATE) {
#pragma unroll
                for (int r = 0; r < 16; ++r) { const int c = crow(r, hi); if (c < 18) gst<float>(gates + (size_t)row * 18 + c, 1.f / (1.f + __expf(-acc[mi][0][r]))); }
            }
            bf16_t* hp = H + (size_t)row * LDH + nw + 4 * hi;
#pragma unroll
            for (int ni = 0; ni < 3; ++ni)
#pragma unroll
                for (int q = 0; q < 4; ++q) store_bf4(hp + 32 * ni + 8 * q, acc[mi][ni][4 * q], acc[mi][ni][4 * q + 1], acc[mi][ni][4 * q + 2], acc[mi][ni][4 * q + 3]);
        }
    }
};
struct EpiQup {
    bf16_t* Q; const f32x2* cs32; int m0, n0;
    __device__ __forceinline__ void operator()(f32x16 (&acc)[2][4], int wm, int wn, int l32, int hi, LAS char* lds) const {
        const int nw = n0 + 128 * wn; const LAS float* rs = (const LAS float*)(lds + G8_ROWSS);
#pragma unroll
        for (int mi = 0; mi < 2; ++mi) {
            const int rl = 64 * wm + 32 * mi + l32, row = m0 + rl, pos = row & (SEQ - 1);
            const float sc = __builtin_amdgcn_rsqf(rs[rl] * (1.f / 384.f) + 1e-6f);
#pragma unroll
            for (int ni = 0; ni < 4; ++ni)
#pragma unroll
                for (int r = 0; r < 16; ++r) acc[mi][ni][r] *= sc;
            rope_pair32(acc[mi][0], acc[mi][1], cs32, pos, hi, (nw % 192) == 128);
            rope_pair32(acc[mi][2], acc[mi][3], cs32, pos, hi, ((nw + 64) % 192) == 128);
            store_tiles4(Q + (size_t)row * 768 + nw + 4 * hi, acc[mi], 1.f);
        }
    }
};
struct EpiKVup {
    bf16_t* Kn; int m0, n0;
    __device__ __forceinline__ void operator()(f32x16 (&acc)[2][4], int wm, int wn, int l32, int hi, LAS char* lds) const {
        const int nw = n0 + 128 * wn; const LAS float* rs = (const LAS float*)(lds + G8_ROWSS);
        const int head = nw >> 8, within = nw & 255;
        bf16_t* base = Kn + (within < 128 ? (size_t)0 : (size_t)NT * 512) + head * 128 + 4 * hi;
#pragma unroll
        for (int mi = 0; mi < 2; ++mi) {
            const int rl = 64 * wm + 32 * mi + l32, row = m0 + rl;
            const float sc = __builtin_amdgcn_rsqf(rs[rl] * (1.f / 128.f) + 1e-6f);
            store_tiles4(base + (size_t)row * 512, acc[mi], sc);
        }
    }
};
__device__ __forceinline__ float gelu_tanh(float x) {
    const float u = 0.7978845608028654f * (x + 0.044715f * x * x * x);
    const float e = __expf(-2.f * fabsf(u)); const float t = (1.f - e) / (1.f + e);
    return 0.5f * x * (1.f + (u < 0.f ? -t : t));
}
struct EpiCmp1 {
    float* P; int m0;
    __device__ __forceinline__ void operator()(f32x16 (&acc)[2][4], int wm, int wn, int l32, int hi, LAS char*) const {
#pragma unroll
        for (int mi = 0; mi < 2; ++mi) {
            float* p = P + (size_t)(m0 + 64 * wm + 32 * mi + l32) * 256 + 128 * wn + 4 * hi;
#pragma unroll
            for (int ni = 0; ni < 4; ++ni)
#pragma unroll
                for (int q = 0; q < 4; ++q) { f32x4 v = {acc[mi][ni][4 * q], acc[mi][ni][4 * q + 1], acc[mi][ni][4 * q + 2], acc[mi][ni][4 * q + 3]}; gst<f32x4>(p + 32 * ni + 8 * q, v); }
        }
    }
};
struct EpiCmp2 {
    bf16_t* O; const f32x2* cs16; int dorope; int m0;
    __device__ __forceinline__ void operator()(f32x16 (&acc)[2][4], int wm, int wn, int l32, int hi, LAS char*) const {
        if (wn != 0) return;
#pragma unroll
        for (int mi = 0; mi < 2; ++mi) {
            const int row = m0 + 64 * wm + 32 * mi + l32, c = row & 127, pos = 16 * c + 31;
            if (dorope && c < 127) rope_first32(acc[mi][0], cs16, pos, hi);
            store_tiles4(O + (size_t)row * 128 + 4 * hi, acc[mi], c < 127 ? 1.f : 0.f);
        }
    }
};
struct EpiOut {
    float* Y; const float* X; int m0, n0;
    __device__ __forceinline__ void operator()(f32x16 (&acc)[2][4], int wm, int wn, int l32, int hi, LAS char*) const {
        const int nw = n0 + 128 * wn;
#pragma unroll
        for (int mi = 0; mi < 2; ++mi) {
            const size_t off = (size_t)(m0 + 64 * wm + 32 * mi + l32) * DM + nw + 4 * hi;
#pragma unroll
            for (int ni = 0; ni < 4; ++ni)
#pragma unroll
                for (int q = 0; q < 4; ++q) { const f32x4 xv = gld<f32x4>(X + off + 32 * ni + 8 * q);
                    f32x4 o; o[0] = DN_ALPHA * xv[0] + acc[mi][ni][4 * q]; o[1] = DN_ALPHA * xv[1] + acc[mi][ni][4 * q + 1]; o[2] = DN_ALPHA * xv[2] + acc[mi][ni][4 * q + 2]; o[3] = DN_ALPHA * xv[3] + acc[mi][ni][4 * q + 3];
                    gst<f32x4>(Y + off + 32 * ni + 8 * q, o);
                    if (q == 3) asm volatile("" ::: "memory"); }
        }
    }
};
struct EpiMoe1 {
    bf16_t* Hm; int rowbase, nvalid, n0;
    __device__ __forceinline__ void operator()(f32x16 (&acc)[2][4], int wm, int wn, int l32, int hi, LAS char*) const {
        const int ff0 = (n0 + 128 * wn) >> 1;
#pragma unroll
        for (int mi = 0; mi < 2; ++mi) {
            const int rl = 64 * wm + 32 * mi + l32;
            if (rl < nvalid) {
                bf16_t* p = Hm + (size_t)(rowbase + rl) * EFF + ff0 + 4 * hi;
#pragma unroll
                for (int h2 = 0; h2 < 2; ++h2)
#pragma unroll
                    for (int q = 0; q < 4; ++q) { float v[4];
#pragma unroll
                        for (int j = 0; j < 4; ++j) { const float g = acc[mi][2 * h2][4 * q + j], u = acc[mi][2 * h2 + 1][4 * q + j]; v[j] = g / (1.f + __expf(-g)) * u; }
                        store_bf4(p + 32 * h2 + 8 * q, v[0], v[1], v[2], v[3]); }
            }
        }
    }
};
struct EpiMoe2 {
    bf16_t* Y; const int* list; const float* gw; int nvalid, n0;
    __device__ __forceinline__ void operator()(f32x16 (&acc)[2][4], int wm, int wn, int l32, int hi, LAS char*) const {
        const int nw = n0 + 128 * wn;
#pragma unroll
        for (int mi = 0; mi < 2; ++mi) {
            const int rl = 64 * wm + 32 * mi + l32;
            if (rl < nvalid) { const int slot = gld<int>(list + rl); store_tiles4(Y + (size_t)slot * DM + nw + 4 * hi, acc[mi], gld<float>(gw + slot)); }
        }
    }
};

constexpr int VS = 160;
struct KeySrc { const bf16_t* k0; size_t kstride; const bf16_t* kr; size_t krstride; const bf16_t* v0; size_t vstride; };

template <int DQK> struct AttnRegs { bf16x8 k[DQK / 8 * 64 / 256]; bf16x8 v[4]; };
template <int DQK> struct AttnSrc { __amdgpu_buffer_rsrc_t rk, rr, rv; unsigned ko[DQK / 8 * 64 / 256]; unsigned vo[4]; unsigned ktile, rtile, vtile; };
template <int DQK> __device__ __forceinline__ AttnSrc<DQK> attn_src(const KeySrc& ks, int tid) {
    constexpr int KCH = DQK / 8, NKL = KCH * 64 / 256;
    AttnSrc<DQK> a; a.rk = mk_rsrc(ks.k0); a.rr = mk_rsrc(ks.kr); a.rv = mk_rsrc(ks.v0);
#pragma unroll
    for (int i = 0; i < NKL; ++i) { const int idx = tid + i * 256, key = idx / KCH, ch = idx - key * KCH;
        a.ko[i] = (DQK == 128 || ch < 16) ? (unsigned)(key * (unsigned)ks.kstride + ch * 8) * 2u : (unsigned)(key * (unsigned)ks.krstride + (ch - 16) * 8) * 2u; }
#pragma unroll
    for (int i = 0; i < 4; ++i) { const int idx = tid + i * 256, key = idx >> 4, ch = idx & 15; a.vo[i] = (unsigned)(key * (unsigned)ks.vstride + ch * 8) * 2u; }
    a.ktile = (unsigned)__builtin_amdgcn_readfirstlane((int)(128u * (unsigned)ks.kstride)); a.rtile = (unsigned)__builtin_amdgcn_readfirstlane((int)(128u * (unsigned)ks.krstride));
    a.vtile = (unsigned)__builtin_amdgcn_readfirstlane((int)(128u * (unsigned)ks.vstride));
    return a;
}
template <int DQK> __device__ __forceinline__ void attn_gload(const AttnSrc<DQK>& a, int jt, AttnRegs<DQK>& R, bool withv, int tid) {
    constexpr int KCH = DQK / 8, NKL = KCH * 64 / 256;
#pragma unroll
    for (int i = 0; i < NKL; ++i) { const int idx = tid + i * 256, key = idx / KCH, ch = idx - key * KCH;
        R.k[i] = (DQK == 128 || ch < 16) ? bld8(a.rk, a.ko[i], (int)(jt * a.ktile)) : bld8(a.rr, a.ko[i], (int)(jt * a.rtile)); }
    if (withv) {
#pragma unroll
        for (int i = 0; i < 4; ++i) R.v[i] = bld8(a.rv, a.vo[i], (int)(jt * a.vtile));
    }
}
template <int DQK> __device__ __forceinline__ void attn_lwrite(LAS char* lds, const AttnRegs<DQK>& R, bool withv, int tid) {
    constexpr int KS = DQK + 8, KCH = DQK / 8, NKL = KCH * 64 / 256;
#pragma unroll
    for (int i = 0; i < NKL; ++i) { const int idx = tid + i * 256, key = idx / KCH, ch = idx - key * KCH; *(LAS bf16x8*)(lds + (key * KS + ch * 8) * 2) = R.k[i]; }
    if (withv) {
#pragma unroll
        for (int i = 0; i < 4; ++i) { const int idx = tid + i * 256, key = idx >> 4, ch = idx & 15; *(LAS bf16x8*)(lds + 64 * KS * 2 + (key * VS + ch * 8) * 2) = R.v[i]; }
    }
}
template <int DQK> __device__ __forceinline__ void attn_stage(LAS char* lds, const AttnSrc<DQK>& a, int jt, bool withv, int tid) { AttnRegs<DQK> R; attn_gload<DQK>(a, jt, R, withv, tid); attn_lwrite<DQK>(lds, R, withv, tid); }
template <int DQK> __device__ __forceinline__ void attn_scores(const LAS char* lds, const bf16x8 (&qf)[DQK / 16], f32x16& p0, f32x16& p1, int l32, int hi) {
    constexpr int KS = DQK + 8;
    const int sg = (l32 & ~12) | ((l32 & 4) << 1) | ((l32 & 8) >> 1);
    const LAS char* kb = lds + (sg * KS + hi * 8) * 2;
#pragma unroll
    for (int r = 0; r < 16; ++r) { p0[r] = 0.f; p1[r] = 0.f; }
#pragma unroll
    for (int ds = 0; ds < DQK / 16; ++ds) {
        const bf16x8 a0 = *(const LAS bf16x8*)(kb + ds * 32), a1 = *(const LAS bf16x8*)(kb + 32 * KS * 2 + ds * 32);
        p0 = __builtin_amdgcn_mfma_f32_32x32x16_bf16(a0, qf[ds], p0, 0, 0, 0);
        p1 = __builtin_amdgcn_mfma_f32_32x32x16_bf16(a1, qf[ds], p1, 0, 0, 0);
    }
}
constexpr int ATT_HALF = 47104;
template <int DQK, bool SEL>
__device__ __forceinline__ void attn_run(LAS char* lds, const KeySrc& ks, int jt_lo, int jt_hi, unsigned tile_union, const bf16x8 (&qf)[DQK / 16],
                                         int qi, unsigned maxd, unsigned sel, float c2, f32x16 (&o)[4], float& m_run, float& l_run, int tid) {
    constexpr int KS = DQK + 8;
    const int tl = tid & 255, kg = tid >> 8, lane = tid & 63, l32 = lane & 31, hi = lane >> 5;
    const int g = lane >> 4, i16 = lane & 15;
    LAS char* L = lds + kg * ATT_HALF;
    const LAS char* vb = (L + 64 * KS * 2 + ((8 * hi + (i16 >> 2)) * VS + 16 * (g & 1) + 4 * (i16 & 3)) * 2);
    const float NEG = -__builtin_inff();
    int qmin = qi, qmax = qi;
#pragma unroll
    for (int sft = 32; sft >= 1; sft >>= 1) { qmin = min(qmin, __shfl_xor(qmin, sft)); qmax = max(qmax, __shfl_xor(qmax, sft)); }
    const AttnSrc<DQK> asrc = attn_src<DQK>(ks, tl);
    int nmine = 0;
    if (SEL) nmine = __builtin_popcount(jt_hi >= 32 ? tile_union : (tile_union & ((1u << jt_hi) - 1u)) & ~((1u << jt_lo) - 1u)); else nmine = jt_hi > jt_lo ? jt_hi - jt_lo : 0;
    LAS int* trips = (LAS int*)(lds + LDS_CTL + 96);
    __syncthreads();
    if (tl == 0) trips[kg] = nmine;
    __syncthreads();
    const int ntrip = max(trips[0], trips[1]);
    int jt = jt_lo;
    if (SEL) { while (jt < jt_hi && !((tile_union >> jt) & 1u)) ++jt; }
    for (int trip = 0; trip < ntrip; ++trip) {
        jt = __builtin_amdgcn_readfirstlane(jt);
        const bool have = jt < jt_hi;
        if (have) attn_stage<DQK>(L, asrc, jt, true, tl);
        __syncthreads();
        if (have) {
        f32x16 p0, p1;
        attn_scores<DQK>(L, qf, p0, p1, l32, hi);
        const bool ok = SEL ? (((sel >> jt) & 1u) != 0u) : true;
        const bool interior = (qmin - (jt * 64 + 63) >= 0) && ((unsigned)(qmax - jt * 64) <= maxd) && (SEL ? __all(ok) : true);
        float mx = NEG;
        if (interior) {
#pragma unroll
            for (int r = 0; r < 16; ++r) mx = fmaxf(mx, fmaxf(p0[r], p1[r]));
        } else {
            const int dq = qi - jt * 64 - 8 * hi;
#pragma unroll
            for (int r = 0; r < 16; ++r) {
                const int ko = 16 * (r >> 3) + (r & 7);
                const float s0 = (ok && (unsigned)(dq - ko) <= maxd) ? p0[r] : NEG;
                const float s1 = (ok && (unsigned)(dq - ko - 32) <= maxd) ? p1[r] : NEG;
                p0[r] = s0; p1[r] = s1; mx = fmaxf(mx, fmaxf(s0, s1));
            }
        }
        mx = fmaxf(mx, __shfl_xor(mx, 32));
        const float mn = fmaxf(m_run, mx * c2);
        const float alpha = __builtin_amdgcn_exp2f(m_run - mn);
        const float nmn = -mn;
        float rs = 0.f;
#pragma unroll
        for (int r = 0; r < 16; ++r) { p0[r] = __builtin_amdgcn_exp2f(fmaf(p0[r], c2, nmn)); p1[r] = __builtin_amdgcn_exp2f(fmaf(p1[r], c2, nmn)); rs += p0[r] + p1[r]; }
        rs += __shfl_xor(rs, 32);
        l_run = l_run * alpha + rs; m_run = mn;
        if (!__all(alpha == 1.f)) {
#pragma unroll
            for (int dt = 0; dt < 4; ++dt)
#pragma unroll
                for (int r = 0; r < 16; ++r) o[dt][r] *= alpha;
        }
#pragma unroll
        for (int s4 = 0; s4 < 4; ++s4) {
            u32x4 pw;
            if (s4 == 0)      { pw.x = cvtpk(p0[0], p0[1]);  pw.y = cvtpk(p0[2], p0[3]);   pw.z = cvtpk(p0[4], p0[5]);   pw.w = cvtpk(p0[6], p0[7]); }
            else if (s4 == 1) { pw.x = cvtpk(p0[8], p0[9]);  pw.y = cvtpk(p0[10], p0[11]); pw.z = cvtpk(p0[12], p0[13]); pw.w = cvtpk(p0[14], p0[15]); }
            else if (s4 == 2) { pw.x = cvtpk(p1[0], p1[1]);  pw.y = cvtpk(p1[2], p1[3]);   pw.z = cvtpk(p1[4], p1[5]);   pw.w = cvtpk(p1[6], p1[7]); }
            else              { pw.x = cvtpk(p1[8], p1[9]);  pw.y = cvtpk(p1[10], p1[11]); pw.z = cvtpk(p1[12], p1[13]); pw.w = cvtpk(p1[14], p1[15]); }
            const bf16x8 pb = *reinterpret_cast<bf16x8*>(&pw);
#pragma unroll
            for (int dt = 0; dt < 4; ++dt) {
                const s16x4 v0 = __builtin_amdgcn_ds_read_tr16_b64_v4i16((LAS s16x4*)(vb + (s4 * 16 * VS + dt * 32) * 2));
                const s16x4 v1 = __builtin_amdgcn_ds_read_tr16_b64_v4i16((LAS s16x4*)(vb + (s4 * 16 * VS + 4 * VS + dt * 32) * 2));
                const bf16x8 va = {v0[0], v0[1], v0[2], v0[3], v1[0], v1[1], v1[2], v1[3]};
                o[dt] = __builtin_amdgcn_mfma_f32_32x32x16_bf16(va, pb, o[dt], 0, 0, 0);
            }
        }
        }
        __syncthreads();
        ++jt;
        if (SEL) { while (jt < jt_hi && !((tile_union >> jt) & 1u)) ++jt; }
    }
}
template <int DQK> __device__ __forceinline__ void load_q(const bf16_t* qptr, int hi, bf16x8 (&qf)[DQK / 16]) {
#pragma unroll
    for (int ds = 0; ds < DQK / 16; ++ds) qf[ds] = gld<bf16x8>(qptr + ds * 16 + hi * 8);
}
__device__ __forceinline__ void store_o(bf16_t* optr, const f32x16 (&o)[4], float inv, int hi) {
#pragma unroll
    for (int dt = 0; dt < 4; ++dt)
#pragma unroll
        for (int q = 0; q < 4; ++q) store_bf4(optr + 32 * dt + 8 * q + 4 * hi, o[dt][4 * q] * inv, o[dt][4 * q + 1] * inv, o[dt][4 * q + 2] * inv, o[dt][4 * q + 3] * inv);
}
__device__ __forceinline__ void zero_o(f32x16 (&o)[4]) {
#pragma unroll
    for (int dt = 0; dt < 4; ++dt)
#pragma unroll
        for (int r = 0; r < 16; ++r) o[dt][r] = 0.f;
}

__device__ __forceinline__ int claim(unsigned* ctr, LAS char* lds) {
    volatile LAS int* slot = (volatile LAS int*)(lds + LDS_CTL + 64);
    __syncthreads();
    if (otid() == 0) *slot = (int)atomicAdd(ctr, 1u);
    __syncthreads();
    return *slot;
}

__device__ __forceinline__ void conv_stream(const float* src, bf16_t* dst, int tid, const float* rowscale = nullptr, size_t e0 = 0, int ncols = 1) {
    f32x4 v[8];
#pragma unroll
    for (int i = 0; i < 8; ++i) v[i] = gld<f32x4>(src + i * 2048 + tid * 4);
#pragma unroll
    for (int i = 0; i < 8; ++i) { const float sc = rowscale ? gld<float>(rowscale + ((unsigned)e0 + (unsigned)(i * 2048 + tid * 4)) / (unsigned)ncols) : 1.f;
        store_bf4(dst + i * 2048 + tid * 4, v[i][0] * sc, v[i][1] * sc, v[i][2] * sc, v[i][3] * sc); }
}
__device__ __forceinline__ void phase_prep(const Params& p, int layer, LAS char* lds) {
    char* ws = ows(p.ws);
    const int tid = otid(), half = tid >> 8, tl = tid & 255;
    constexpr int N_WIN = DM, N_WQ = 384 * 768 / 16384, N_WKV = 128 * 1024 / 16384, N_W1 = 4096 * 256 / 16384, N_W2 = 256 * 128 / 16384, N_WOUT = DM * DM / 16384, N_EX = NEXP * DM * EFF / 16384;
    constexpr int E0 = 0, E1 = E0 + N_WIN, E2 = E1 + N_WQ, E3 = E2 + N_WKV, E4 = E3 + N_W1, E5 = E4 + N_W1, E6 = E5 + N_W2, E7 = E6 + N_W2, E8 = E7 + N_WOUT,
                  E9 = E8 + N_EX, E10 = E9 + N_EX, E11 = E10 + N_EX, E12 = E11 + 16  , E13 = E12 + 32  , E14 = E13 + 2048  ;
    const int total = layer == 0 ? E14 : E12;
    for (int it = oblk(); it < total; it += gridDim.x) {
        if (it < E1) { const int k = it - E0;
            const float* src = p.in[I_WIN] + ((size_t)layer * DM + k) * INC; bf16_t* dst = (bf16_t*)(ws + OFF_WIN_T) + (size_t)k * LDH;
            for (int c2 = tid; c2 < LDH / 2; c2 += 512) { const int c = 2 * c2; f32x2 v = {0.f, 0.f}; if (c < INC) v = gld<f32x2>(src + c); gst<unsigned>(dst + c, cvtpk(v.x, v.y)); }
        } else if (it < E2) { const size_t u = (size_t)(it - E1) * 16384;
            conv_stream(p.in[I_WQUP] + (size_t)layer * 384 * 768 + u, (bf16_t*)(ws + OFF_WQ_T) + u, tid, p.in[I_QLN] + layer * 384, u, 768);
        } else if (it < E3) { const size_t u = (size_t)(it - E2) * 16384;
            conv_stream(p.in[I_WKVUP] + (size_t)layer * 128 * 1024 + u, (bf16_t*)(ws + OFF_WKV_T) + u, tid, p.in[I_KVLN] + layer * 128, u, 1024);
        } else if (it < E4) { const size_t u = (size_t)(it - E3) * 16384; conv_stream(p.in[I_W1K] + (size_t)layer * 4096 * 256 + u, (bf16_t*)(ws + OFF_W1K_T) + u, tid);
        } else if (it < E5) { const size_t u = (size_t)(it - E4) * 16384; conv_stream(p.in[I_W1V] + (size_t)layer * 4096 * 256 + u, (bf16_t*)(ws + OFF_W1V_T) + u, tid);
        } else if (it < E6) { const size_t u = (size_t)(it - E5) * 16384; conv_stream(p.in[I_W2K] + (size_t)layer * 256 * 128 + u, (bf16_t*)(ws + OFF_W2K_T) + u, tid);
        } else if (it < E7) { const size_t u = (size_t)(it - E6) * 16384; conv_stream(p.in[I_W2V] + (size_t)layer * 256 * 128 + u, (bf16_t*)(ws + OFF_W2V_T) + u, tid);
        } else if (it < E8) { const size_t u = (size_t)(it - E7) * 16384; conv_stream(p.in[I_WOUT] + (size_t)layer * DM * DM + u, (bf16_t*)(ws + OFF_WOUT_T) + u, tid);
        } else if (it < E9) {
            const size_t u = (size_t)(it - E8) * 16384; conv_stream(p.in[I_WGATE] + (size_t)layer * NEXP * DM * EFF + u, (bf16_t*)(ws + OFF_WGU_T) + u, tid);
        } else if (it < E10) {
            const size_t u = (size_t)(it - E9) * 16384; conv_stream(p.in[I_WUP] + (size_t)layer * NEXP * DM * EFF + u, (bf16_t*)(ws + OFF_WGU_T) + (size_t)NEXP * DM * EFF + u, tid);
        } else if (it < E11) {
            const size_t u = (size_t)(it - E10) * 16384; conv_stream(p.in[I_WDOWN] + (size_t)layer * NEXP * DM * EFF + u, (bf16_t*)(ws + OFF_WD_T) + u, tid);
        } else if (it < E12) { const int u = it - E11, which = u >> 3, kc = 2 * (u & 7) + half;
            const float* pe = p.in[which ? I_PEV : I_PEK] + (size_t)layer * 4096 + kc * 256;
            const float* w1 = p.in[which ? I_W1V : I_W1K] + (size_t)layer * 4096 * 256 + (size_t)kc * 256 * 256;
            const int n4 = (tl & 63) * 4, kgp = tl >> 6;
            f32x4 acc = {0.f, 0.f, 0.f, 0.f};
#pragma unroll 16
            for (int k = 0; k < 64; ++k) { const int kk = kgp * 64 + k; acc += gld<float>(pe + kk) * gld<f32x4>(w1 + (size_t)kk * 256 + n4); }
            LAS f32x4* red = (LAS f32x4*)lds + half * 256;
            __syncthreads();
            red[tl] = acc;
            __syncthreads();
            if (tl < 64) { const f32x4 t = (red[tl] + red[tl + 64]) + (red[tl + 128] + red[tl + 192]); gst<f32x4>((float*)(ws + OFF_B1P) + (which * 16 + kc) * 256 + n4, t); }
        } else if (it < E13) { const int u = it - E12;
            f32x2* cs16 = (f32x2*)(ws + OFF_CS16); f32x2* cs32 = (f32x2*)(ws + OFF_CS32);
            for (int e = tid; e < 64 * 48; e += 512) { const int pos = u * 64 + e / 48, j = e % 48;
                const int hf = j < 16 ? 16 : 32, i = j < 16 ? j : j - 16;
                const float invf = exp2f(-(float)i / (float)hf * 18.931568569324174f);
                const float ang = (float)pos * invf;
                f32x2 cs; cs.x = cosf(ang); cs.y = sinf(ang);
                if (j < 16) cs16[pos * 16 + i] = cs; else cs32[pos * 32 + i] = cs; }
        } else { const int u = it - E13;
            const float* x = p.in[I_X] + (size_t)u * 8192; bf16_t* xb = (bf16_t*)(ws + OFF_XB) + (size_t)u * 8192;
            for (int e = tid * 4; e < 8192; e += 2048) { const f32x4 v = gld<f32x4>(x + e); store_bf4(xb + e, v[0], v[1], v[2], v[3]); }
        }
    }
    if (oblk() == 0 && tid < NEXP) ((unsigned*)(ws + OFF_ECNT))[tid] = 0u;
    { unsigned* imp = (unsigned*)(ws + OFF_IMP); for (size_t e = (size_t)oblk() * 512 + tid; e < (size_t)NT * 32; e += (size_t)gridDim.x * 512) gst<unsigned>(imp + e, 0u); }
}

#define AO4(ld) { (unsigned)(sr * (ld) + sc), (unsigned)((sr + 64) * (ld) + sc), (unsigned)((sr + 128) * (ld) + sc), (unsigned)((sr + 192) * (ld) + sc) }
__device__ __forceinline__ void phase_win(const Params& p, int layer, LAS char* lds) {
    char* ws = ows(p.ws); const int tid = otid(), sr = tid >> 3, sc = (tid & 7) * 8;
    const bf16_t* A = (const bf16_t*)(ws + OFF_XB); const bf16_t* Bt = (const bf16_t*)(ws + OFF_WIN_T);
    for (int u = oblk(); u < 32 * 24; u += gridDim.x) {
        const int mt = u & 31, nt = u >> 5;
        EpiWin e{(bf16_t*)(ws + OFF_H), (float*)(ws + OFF_GATES), (const f32x2*)(ws + OFF_CS16), (const f32x2*)(ws + OFF_CS32), mt * 256, nt * 192};
        const unsigned ao[4] = AO4(DM);
        gemm8<3, 1, true>(lds, A + (size_t)mt * 256 * DM, ao, 128, Bt + nt * 192, LDH, 0u, DM / 64, e);
    }
}
__device__ __forceinline__ void phase_up(const Params& p, int layer, LAS char* lds) {
    char* ws = ows(p.ws); const int tid = otid(), sr = tid >> 3, sc = (tid & 7) * 8;
    const bf16_t* H = (const bf16_t*)(ws + OFF_H);
    constexpr int U0 = 32, U1 = U0 + 32 * 3, U2 = U1 + 32 * 4;
    for (int u = oblk(); u < U2; u += gridDim.x) {
        if (u < U0) {
            const int which = u >> 4, mt = (u >> 3) & 1, ksp = u & 7;
            const int col = which ? C_NVC : C_NKC;
            unsigned ao[4];
#pragma unroll
            for (int i = 0; i < 4; ++i) { const int r = sr + 64 * i; int c = r & 127; if (c > 126) c = 126; ao[i] = (unsigned)(((2 * mt + (r >> 7)) * SEQ + 16 * c) * LDH + sc); }
            const bf16_t* ab = H + (size_t)(4 * ksp) * LDH + col;
            const bf16_t* bb = (const bf16_t*)(ws + (which ? OFF_W1V_T : OFF_W1K_T)) + (size_t)512 * ksp * 256;
            EpiCmp1 e{(float*)(ws + OFF_HCP) + ((size_t)ksp * 2 + which) * 512 * 256, mt * 256};
            gemm8<4, 1, false>(lds, ab, ao, LDH, bb, 256, 0u, 512 / 64, e);
        } else if (u < U1) {
            const int v = u - U0, mt = v & 31, nt = v >> 5;
            const unsigned ao[4] = AO4(LDH);
            EpiQup e{(bf16_t*)(ws + OFF_QM), (const f32x2*)(ws + OFF_CS32), mt * 256, nt * 256};
            row_sumsq<384>(lds, H + (size_t)mt * 256 * LDH + C_QLAT, LDH);
            gemm8<4, 1, false>(lds, H + (size_t)mt * 256 * LDH + C_QLAT, ao, 128, (const bf16_t*)(ws + OFF_WQ_T) + nt * 256, 768, 0u, 384 / 64, e);
        } else {
            const int v = u - U1, mt = v & 31, nt = v >> 5;
            const unsigned ao[4] = AO4(LDH);
            EpiKVup e{(bf16_t*)(ws + OFF_KN), mt * 256, nt * 256};
            row_sumsq<128>(lds, H + (size_t)mt * 256 * LDH + C_KVLAT, LDH);
            gemm8<4, 1, false>(lds, H + (size_t)mt * 256 * LDH + C_KVLAT, ao, 128, (const bf16_t*)(ws + OFF_WKV_T) + nt * 256, 1024, 0u, 128 / 64, e);
        }
    }
}
__device__ __forceinline__ void phase_cmpred(const Params& p, int layer) {
    char* ws = ows(p.ws);
    const float* P = (const float*)(ws + OFF_HCP); const float* b1p = (const float*)(ws + OFF_B1P); bf16_t* Hc = (bf16_t*)(ws + OFF_HC);
    for (int e4 = oblk() * 512 + otid(); e4 < 2 * 512 * 256 / 4; e4 += gridDim.x * 512) {
        const int e = e4 * 4, which = e >> 17, n = e & 255;
        f32x4 a = {0.f, 0.f, 0.f, 0.f};
#pragma unroll
        for (int q = 0; q < 16; ++q) a += gld<f32x4>(b1p + (which * 16 + q) * 256 + n);
#pragma unroll
        for (int q = 0; q < 8; ++q) a += gld<f32x4>(P + (size_t)q * 2 * 512 * 256 + e);
        store_bf4(Hc + e, gelu_tanh(a[0]), gelu_tanh(a[1]), gelu_tanh(a[2]), gelu_tanh(a[3]));
    }
}
__device__ __forceinline__ void phase_cmp2(const Params& p, int layer, LAS char* lds) {
    char* ws = ows(p.ws); const int tid = otid(), sr = tid >> 3, sc = (tid & 7) * 8;
    for (int u = oblk(); u < 4; u += gridDim.x) {
        const int which = u >> 1, mt = u & 1;
        const bf16_t* Hc = (const bf16_t*)(ws + OFF_HC) + (size_t)which * 512 * 256 + (size_t)mt * 256 * 256;
        const unsigned ao[4] = AO4(256);
        EpiCmp2 e{(bf16_t*)(ws + (which ? OFF_VC : OFF_KC)), (const f32x2*)(ws + OFF_CS16), which == 0, mt * 256};
        gemm8<4, 1, false>(lds, Hc, ao, 128, (const bf16_t*)(ws + (which ? OFF_W2V_T : OFF_W2K_T)), 128, 0u, 256 / 64, e);
    }
}
__device__ __forceinline__ void phase_out(const Params& p, int layer, LAS char* lds) {
    char* ws = ows(p.ws); const int tid = otid(), sr = tid >> 3, sc = (tid & 7) * 8;
    const bf16_t* A = (const bf16_t*)(ws + OFF_MIX); const bf16_t* Bt = (const bf16_t*)(ws + OFF_WOUT_T);
    const float* X = layer == 0 ? p.in[I_X] : (const float*)(ws + OFF_XA);
    for (int u = oblk(); u < 32 * 8; u += gridDim.x) {
        const int mt = u & 31, nt = u >> 5;
        EpiOut e{(float*)(ws + OFF_YB), X, mt * 256, nt * 256};
        const unsigned ao[4] = AO4(DM);
        gemm8<4, 1, true>(lds, A + (size_t)mt * 256 * DM, ao, 128, Bt + nt * 256, DM, 0u, DM / 64, e);
    }
}

__device__ __forceinline__ void item_mla(const Params& p, int it, LAS char* lds) {
    char* ws = ows(p.ws); const int tid = otid(), lane = tid & 63, w = (tid >> 6) & 3, kg = tid >> 8, l32 = lane & 31, hi = lane >> 5;
    const int qb = 15 - (it >> 4), h = it & 3, b = (it >> 2) & 3;
    const int token = qb * 128 + 32 * w + l32; const size_t row = (size_t)b * SEQ + token;
    bf16x8 qf[12]; load_q<192>((const bf16_t*)(ws + OFF_QM) + row * 768 + h * 192, hi, qf);
    KeySrc ks; ks.k0 = (const bf16_t*)(ws + OFF_KN) + (size_t)b * SEQ * 512 + h * 128; ks.kstride = 512;
    ks.kr = (const bf16_t*)(ws + OFF_H) + (size_t)b * SEQ * LDH + C_KROPE; ks.krstride = LDH;
    ks.v0 = (const bf16_t*)(ws + OFF_VM) + (size_t)b * SEQ * 512 + h * 128; ks.vstride = 512;
    f32x16 o[4]; zero_o(o); float m = -1e30f, l = 0.f;
    attn_run<192, false>(lds, ks, 0, 2 * qb + 2, 0u, qf, token, 0x7fffffffu, 0u, 0.07216878364870322f * LOG2E, o, m, l, tid);
    store_o((bf16_t*)(ws + OFF_MIX) + row * DM + h * 128, o, 1.f / l, hi);
}
__device__ __forceinline__ void item_dil(const Params& p, int it, LAS char* lds) {
    char* ws = ows(p.ws); const int tid = otid(), lane = tid & 63, w = (tid >> 6) & 3, kg = tid >> 8, l32 = lane & 31, hi = lane >> 5;
    const int rem = it % 48, bh = it / 48, h = bh % 6, b = bh / 6;
    const int n = rem >> 4, r2 = rem & 15;
    const int dil = n == 0 ? 1 : (n == 1 ? 4 : 16);
    const int rho = n == 0 ? 0 : (n == 1 ? (r2 >> 2) : r2), qb = n == 0 ? r2 : (n == 1 ? (r2 & 3) : 0);
    const int i = qb * 128 + 32 * w + l32, token = rho + i * dil; const size_t row = (size_t)b * SEQ + token;
    const bf16_t* H = (const bf16_t*)(ws + OFF_H);
    bf16x8 qf[8]; load_q<128>(H + row * LDH + C_DQ + h * 128, hi, qf);
    KeySrc ks; ks.k0 = H + ((size_t)b * SEQ + rho) * LDH + C_DK + h * 128; ks.kstride = (size_t)dil * LDH; ks.kr = ks.k0; ks.krstride = 0;
    ks.v0 = H + ((size_t)b * SEQ + rho) * LDH + C_DV + h * 128; ks.vstride = (size_t)dil * LDH;
    f32x16 o[4]; zero_o(o); float m = -1e30f, l = 0.f;
    const int jlo = 2 * qb - 2 < 0 ? 0 : 2 * qb - 2;
    attn_run<128, false>(lds, ks, jlo, 2 * qb + 2, 0u, qf, i, 128u, 0u, 0.08838834764831845f * LOG2E, o, m, l, tid);
    store_o((bf16_t*)(ws + OFF_ODIL) + ((size_t)n * NT + row) * 768 + h * 128, o, 1.f / l, hi);
    if (hi == 0) gst<float>((float*)(ws + OFF_LDIL) + ((size_t)n * NT + row) * 6 + h, m + __log2f(l));
}
__device__ __forceinline__ void item_win(const Params& p, int it, LAS char* lds) {
    char* ws = ows(p.ws); const int tid = otid(), lane = tid & 63, w = (tid >> 6) & 3, kg = tid >> 8, l32 = lane & 31, hi = lane >> 5;
    const int hp = it % 3, b = (it / 3) & 3, tb = 31 - it / 12;
    const int head = 2 * hp + (w >> 1), token = 64 * tb + 32 * (w & 1) + l32; const size_t row = (size_t)b * SEQ + token;
    const bf16_t* H = (const bf16_t*)(ws + OFF_H);
    bf16x8 qf[8]; load_q<128>(H + row * LDH + C_NQ + head * 128, hi, qf);
    KeySrc ks; ks.k0 = H + (size_t)b * SEQ * LDH + C_NKW; ks.kstride = LDH; ks.kr = ks.k0; ks.krstride = 0; ks.v0 = H + (size_t)b * SEQ * LDH + C_NVW; ks.vstride = LDH;
    f32x16 o[4]; zero_o(o); float m = -1e30f, l = 0.f;
    attn_run<128, false>(lds, ks, tb - 8 < 0 ? 0 : tb - 8, tb + 1, 0u, qf, token, 511u, 0u, 0.08838834764831845f * LOG2E, o, m, l, tid);
    store_o((bf16_t*)(ws + OFF_PW) + row * 768 + head * 128, o, 1.f / l, hi);
}
__device__ __forceinline__ void item_cmp(const Params& p, int it, LAS char* lds) {
    char* ws = ows(p.ws); const int tid = otid(), tl = tid & 255, lane = tid & 63, w = (tid >> 6) & 3, kg = tid >> 8, l32 = lane & 31, hi = lane >> 5;
    const int hp = it % 3, tb = (it / 3) % 32, b = it / 96;
    const int head = 2 * hp + (w >> 1), token = 64 * tb + 32 * (w & 1) + l32; const size_t row = (size_t)b * SEQ + token;
    const bf16_t* H = (const bf16_t*)(ws + OFF_H);
    bf16x8 qf[8]; load_q<128>(H + row * LDH + C_NQ + head * 128, hi, qf);
    KeySrc ks; ks.k0 = (const bf16_t*)(ws + OFF_KC) + (size_t)b * 128 * 128; ks.kstride = 128; ks.kr = ks.k0; ks.krstride = 0; ks.v0 = (const bf16_t*)(ws + OFF_VC) + (size_t)b * 128 * 128; ks.vstride = 128;
    const int qi = (token - 31) >> 4;
    const int qimax = (64 * tb + 63 - 31) >> 4;
    const int jhi = qimax < 0 ? 0 : (qimax >> 6) + 1;
    const float c2 = 0.08838834764831845f * LOG2E;
    f32x16 o[4]; zero_o(o); float m = -1e30f, l = 0.f;
    attn_run<128, false>(lds, ks, 0, jhi, 0u, qf, qi, 0x7fffffffu, 0u, c2, o, m, l, tid);
    const float inv = l > 0.f ? 1.f / l : 0.f;
    store_o((bf16_t*)(ws + OFF_PC) + row * 768 + head * 128, o, inv, hi);
    unsigned* imp = (unsigned*)(ws + OFF_IMP) + row * 32;
    const AttnSrc<128> asrc = attn_src<128>(ks, tl);
    LAS char* L = lds + kg * ATT_HALF;
    LAS int* trips = (LAS int*)(lds + LDS_CTL + 96);
    __syncthreads();
    if (tl == 0) trips[kg] = jhi;
    __syncthreads();
    const int ntrip = max(trips[0], trips[1]);
    for (int jt = 0; jt < ntrip; ++jt) {
        const bool have = jt < jhi;
        if (have) attn_stage<128>(L, asrc, jt, false, tl);
        __syncthreads();
        if (have) {
            f32x16 p0, p1; attn_scores<128>(L, qf, p0, p1, l32, hi);
            const int dq = qi - jt * 64 - 8 * hi;
#pragma unroll
            for (int r = 0; r < 16; ++r) { const int ko = 16 * (r >> 3) + (r & 7);
                p0[r] = (dq - ko >= 0) ? __builtin_amdgcn_exp2f(p0[r] * c2 - m) * inv : 0.f;
                p1[r] = (dq - ko - 32 >= 0) ? __builtin_amdgcn_exp2f(p1[r] * c2 - m) * inv : 0.f; }
#pragma unroll
            for (int t = 0; t < 2; ++t)
#pragma unroll
                for (int u = 0; u < 2; ++u) {
                    unsigned q[8];
#pragma unroll
                    for (int jj = 0; jj < 8; ++jj) q[jj] = (unsigned)((t ? p1[8 * u + jj] : p0[8 * u + jj]) * 16777216.f + 0.5f);
                    const int j0 = (64 * jt + 32 * t + 16 * u + 8 * hi) >> 2;
                    const unsigned a0 = q[0] + q[1] + q[2] + q[3], a1 = q[4] + q[5] + q[6] + q[7] + q[3], a2 = q[7];
                    if (a0) atomicAdd(imp + j0, a0);
                    if (a1) atomicAdd(imp + j0 + 1, a1);
                    if (a2 && j0 + 2 < 32) atomicAdd(imp + j0 + 2, a2);
                }
        }
        __syncthreads();
    }
}
__device__ __forceinline__ void item_slc(const Params& p, int it, LAS char* lds) {
    char* ws = ows(p.ws); const int tid = otid(), lane = tid & 63, w = (tid >> 6) & 3, kg = tid >> 8, l32 = lane & 31, hi = lane >> 5;
    const int hp = it % 3, b = (it / 3) & 3, tb = 31 - it / 12;
    const int tl = tid & 255;
    LAS int* sc = (LAS int*)(lds + 2 * ATT_HALF + kg * 8704); LAS unsigned* msk = (LAS unsigned*)(lds + 2 * ATT_HALF + kg * 8704 + 8192);
    __syncthreads();
    if (tl < 65) msk[tl] = 0u;
    const unsigned* imp = (const unsigned*)(ws + OFF_IMP) + ((size_t)b * SEQ + 64 * tb) * 32;
#pragma unroll
    for (int i = 0; i < 8; ++i) { const int e = tl + i * 256, tk = e >> 5, j = e & 31, pos = 64 * tb + tk, qblk = pos >> 6;
        const bool valid = 64 * j <= pos, forced = (j == 0) || (j == qblk) || (j == qblk - 1);
        sc[e] = valid ? (forced ? 0x7fffffff : (int)gld<unsigned>(imp + e)) : -1; }
    __syncthreads();
#pragma unroll
    for (int i = 0; i < 8; ++i) { const int e = tl + i * 256, tk = e >> 5, j = e & 31; const int s = sc[e]; int rank = 0;
        for (int k = 0; k < 32; ++k) { const int sk = sc[tk * 32 + k]; rank += (sk > s || (sk == s && k < j)) ? 1 : 0; }
        if (rank < 16) { __hip_atomic_fetch_or(&msk[tk], 1u << j, __ATOMIC_RELAXED, __HIP_MEMORY_SCOPE_WORKGROUP); __hip_atomic_fetch_or(&msk[64], 1u << j, __ATOMIC_RELAXED, __HIP_MEMORY_SCOPE_WORKGROUP); } }
    __syncthreads();
    const int head = 2 * hp + (w >> 1), tk = 32 * (w & 1) + l32, token = 64 * tb + tk; const size_t row = (size_t)b * SEQ + token;
    const unsigned sel = msk[tk], uni = msk[64];
    const bf16_t* H = (const bf16_t*)(ws + OFF_H);
    bf16x8 qf[8]; load_q<128>(H + row * LDH + C_NQ + head * 128, hi, qf);
    KeySrc ks; ks.k0 = H + (size_t)b * SEQ * LDH + C_NKS; ks.kstride = LDH; ks.kr = ks.k0; ks.krstride = 0; ks.v0 = H + (size_t)b * SEQ * LDH + C_NVS; ks.vstride = LDH;
    f32x16 o[4]; zero_o(o); float m = -1e30f, l = 0.f;
    attn_run<128, true>(lds, ks, 0, tb + 1, uni, qf, token, 0x7fffffffu, sel, 0.08838834764831845f * LOG2E, o, m, l, tid);
    const float* gp = (const float*)(ws + OFF_GATES) + row * 18 + head * 3;
    const float g0 = gld<float>(gp), g1 = gld<float>(gp + 1) / l, g2 = gld<float>(gp + 2);
    const bf16_t* pc = (const bf16_t*)(ws + OFF_PC) + row * 768 + head * 128 + 4 * hi; const bf16_t* pw = (const bf16_t*)(ws + OFF_PW) + row * 768 + head * 128 + 4 * hi;
    bf16_t* mx = (bf16_t*)(ws + OFF_MIX) + row * DM + 1280 + head * 128 + 4 * hi;
#pragma unroll
    for (int dt = 0; dt < 4; ++dt)
#pragma unroll
        for (int q = 0; q < 4; ++q) { const u32x2 a = gld<u32x2>(pc + 32 * dt + 8 * q), b = gld<u32x2>(pw + 32 * dt + 8 * q);
            store_bf4(mx + 32 * dt + 8 * q, g0 * bf_lo(a.x) + g1 * o[dt][4 * q] + g2 * bf_lo(b.x), g0 * bf_hi(a.x) + g1 * o[dt][4 * q + 1] + g2 * bf_hi(b.x),
                                            g0 * bf_lo(a.y) + g1 * o[dt][4 * q + 2] + g2 * bf_lo(b.y), g0 * bf_hi(a.y) + g1 * o[dt][4 * q + 3] + g2 * bf_hi(b.y)); }
}
__device__ __forceinline__ void item_dilmix(const Params& p, int it, LAS char* lds) {
    char* ws = ows(p.ws); const int tid = otid();
    const bf16_t* OD = (const bf16_t*)(ws + OFF_ODIL); const float* LD = (const float*)(ws + OFF_LDIL); bf16_t* MIX = (bf16_t*)(ws + OFF_MIX);
    for (int e = tid; e < 64 * 96; e += 512) {
        const size_t row = (size_t)it * 64 + e / 96; const int cc = (e % 96) * 8, h = cc >> 7;
        const float L0 = gld<float>(LD + row * 6 + h), L1 = gld<float>(LD + ((size_t)NT + row) * 6 + h), L2 = gld<float>(LD + ((size_t)2 * NT + row) * 6 + h);
        const float M = fmaxf(L0, fmaxf(L1, L2)); float w0 = __builtin_amdgcn_exp2f(L0 - M), w1 = __builtin_amdgcn_exp2f(L1 - M), w2 = __builtin_amdgcn_exp2f(L2 - M);
        const float inv = 1.f / (w0 + w1 + w2); w0 *= inv; w1 *= inv; w2 *= inv;
        const u32x4 a = gld<u32x4>(OD + row * 768 + cc), bq = gld<u32x4>(OD + ((size_t)NT + row) * 768 + cc), cq = gld<u32x4>(OD + ((size_t)2 * NT + row) * 768 + cc); u32x4 r;
#pragma unroll
        for (int j = 0; j < 4; ++j) r[j] = cvtpk(w0 * bf_lo(a[j]) + w1 * bf_lo(bq[j]) + w2 * bf_lo(cq[j]), w0 * bf_hi(a[j]) + w1 * bf_hi(bq[j]) + w2 * bf_hi(cq[j]));
        gst<u32x4>(MIX + row * DM + 512 + cc, r);
    }
}
__device__ __forceinline__ void phase_attn_d(const Params& p, int ctr_idx, LAS char* lds) {
    unsigned* ctr = (unsigned*)(ows(p.ws) + OFF_CTR) + ctr_idx;
    constexpr int NWIN = 384, NDIL = NB * 6 * 48, NCMP = 384;
    const int kg = otid() >> 8;
    for (;;) { const int pr = claim(ctr, lds); const int it = __builtin_amdgcn_readfirstlane(2 * pr + kg); if (2 * pr >= NWIN + NDIL + NCMP) break;
        if (it < NWIN) item_win(p, it, lds); else if (it < NWIN + NDIL) item_dil(p, it - NWIN, lds); else item_cmp(p, it - NWIN - NDIL, lds); }
}
__device__ __forceinline__ void phase_attn_e(const Params& p, int ctr_idx, LAS char* lds) {
    unsigned* ctr = (unsigned*)(ows(p.ws) + OFF_CTR) + ctr_idx;
    constexpr int NMLA = 256, NSLC = 384, NMIX = NT / 64;
    const int kg = otid() >> 8;
    for (;;) {
        const int pr = claim(ctr, lds); if (pr >= (NMLA + NSLC) / 2 + NMIX) break;
        const int it = __builtin_amdgcn_readfirstlane(2 * pr + kg);
        if (pr >= (NMLA + NSLC) / 2) item_dilmix(p, pr - (NMLA + NSLC) / 2, lds); else if (it < NMLA) item_mla(p, it, lds); else item_slc(p, it - NMLA, lds);
    }
}
__device__ __forceinline__ void phase_ln(const Params& p, int layer, int mode) {
    char* ws = ows(p.ws); const int tid = otid(), lane = tid & 63, wv = (oblk() * 512 + tid) >> 6, nw = gridDim.x * 8;
    const float* g = p.in[mode ? I_LN2G : I_LN1G] + layer * DM; const float* bb = p.in[mode ? I_LN2B : I_LN1B] + layer * DM;
    for (int row = wv; row < NT; row += nw) {
        f32x4 v[8];
        if (mode == 0) { const float* y = (const float*)(ws + OFF_YB) + (size_t)row * DM;
#pragma unroll
            for (int i = 0; i < 8; ++i) v[i] = gld<f32x4>(y + (i * 64 + lane) * 4);
        } else { const float* x1 = (const float*)(ws + OFF_X1) + (size_t)row * DM; const bf16_t* y0 = (const bf16_t*)(ws + OFF_Y) + (size_t)(2 * row) * DM; const bf16_t* y1 = y0 + DM;
#pragma unroll
            for (int i = 0; i < 8; ++i) { const int c = (i * 64 + lane) * 4; const f32x4 xv = gld<f32x4>(x1 + c); const u32x2 a = gld<u32x2>(y0 + c), b2 = gld<u32x2>(y1 + c);
                v[i][0] = DN_ALPHA * xv[0] + bf_lo(a.x) + bf_lo(b2.x); v[i][1] = DN_ALPHA * xv[1] + bf_hi(a.x) + bf_hi(b2.x);
                v[i][2] = DN_ALPHA * xv[2] + bf_lo(a.y) + bf_lo(b2.y); v[i][3] = DN_ALPHA * xv[3] + bf_hi(a.y) + bf_hi(b2.y); }
        }
        float s = 0.f;
#pragma unroll
        for (int i = 0; i < 8; ++i) s += (v[i][0] + v[i][1]) + (v[i][2] + v[i][3]);
        const float mu = wave_sum(s) * (1.f / DM);
        float q = 0.f;
#pragma unroll
        for (int i = 0; i < 8; ++i) { const f32x4 d = v[i] - mu; q += (d[0] * d[0] + d[1] * d[1]) + (d[2] * d[2] + d[3] * d[3]); }
        const float rstd = 1.f / sqrtf(wave_sum(q) * (1.f / DM) + 1e-5f);
        float* of = mode == 0 ? (float*)(ws + OFF_X1) + (size_t)row * DM : (layer == DEPTH - 1 ? p.out + (size_t)row * DM : (float*)(ws + OFF_XA) + (size_t)row * DM);
        bf16_t* ob = mode == 0 ? (bf16_t*)(ws + OFF_X1B) + (size_t)row * DM : (bf16_t*)(ws + OFF_XB) + (size_t)row * DM;
#pragma unroll
        for (int i = 0; i < 8; ++i) { const int c = (i * 64 + lane) * 4; const f32x4 gv = gld<f32x4>(g + c), bv = gld<f32x4>(bb + c);
            f32x4 o = (v[i] - mu) * rstd * gv + bv; gst<f32x4>(of + c, o);
            if (mode == 0 || layer < DEPTH - 1) store_bf4(ob + c, o[0], o[1], o[2], o[3]); }
    }
}
__device__ __forceinline__ void ln1_rows4(char* ws, const float* g, const float* bb, int row0, int lane) {
    f32x4 v[4][8];
#pragma unroll
    for (int r = 0; r < 4; ++r) { const float* y = (const float*)(ws + OFF_YB) + (size_t)(row0 + r) * DM;
#pragma unroll
        for (int i = 0; i < 8; ++i) v[r][i] = gld<f32x4>(y + (i * 64 + lane) * 4); }
#pragma unroll
    for (int r = 0; r < 4; ++r) {
        float s = 0.f;
#pragma unroll
        for (int i = 0; i < 8; ++i) s += (v[r][i][0] + v[r][i][1]) + (v[r][i][2] + v[r][i][3]);
        const float mu = wave_sum(s) * (1.f / DM);
        float q = 0.f;
#pragma unroll
        for (int i = 0; i < 8; ++i) { const f32x4 d = v[r][i] - mu; q += (d[0] * d[0] + d[1] * d[1]) + (d[2] * d[2] + d[3] * d[3]); }
        const float rstd = 1.f / sqrtf(wave_sum(q) * (1.f / DM) + 1e-5f);
        float* of = (float*)(ws + OFF_X1) + (size_t)(row0 + r) * DM; bf16_t* ob = (bf16_t*)(ws + OFF_X1B) + (size_t)(row0 + r) * DM;
#pragma unroll
        for (int i = 0; i < 8; ++i) { const int c = (i * 64 + lane) * 4; const f32x4 gv = gld<f32x4>(g + c), bv = gld<f32x4>(bb + c);
            const f32x4 o = (v[r][i] - mu) * rstd * gv + bv; gst<f32x4>(of + c, o); store_bf4(ob + c, o[0], o[1], o[2], o[3]); }
    }
}
__device__ __forceinline__ void phase_router(const Params& p, int layer, LAS char* lds) {
    char* ws = ows(p.ws); const int tid = otid(), lane = tid & 63, w = tid >> 6, l32 = lane & 31, hi = lane >> 5;
    const float* X1 = (const float*)(ws + OFF_X1); const float* We = p.in[I_WEXP] + (size_t)layer * DM * 32; const float* Wg = p.in[I_WGRP] + (size_t)layer * DM * 4;
    const float* lng = p.in[I_LN1G] + layer * DM; const float* lnb = p.in[I_LN1B] + layer * DM;
    LAS float* red = (LAS float*)lds;
    unsigned* ecnt = (unsigned*)(ws + OFF_ECNT); int* list = (int*)(ws + OFF_LIST); float* gw = (float*)(ws + OFF_GW);
    for (int it = oblk(); it < NT / 32; it += gridDim.x) {
        const int t0 = it * 32;
        { LAS f32x4* wl = (LAS f32x4*)(lds + 40960);
#pragma unroll
          for (int i = 0; i < 4; ++i) wl[tid + 512 * i] = gld<f32x4>(Wg + (size_t)(tid + 512 * i) * 4); }
        ln1_rows4(ws, lng, lnb, t0 + 4 * w, lane);
        asm volatile("s_waitcnt vmcnt(0)" ::: "memory");
        __syncthreads();
        f32x16 ae;
#pragma unroll
        for (int r = 0; r < 16; ++r) ae[r] = 0.f;
        f32x4 gacc = {0.f, 0.f, 0.f, 0.f};
        const float* xr = X1 + (size_t)(t0 + l32) * DM + w * 256 + 4 * hi;
        const float* wer = We + (size_t)(w * 256 + 4 * hi) * 32 + l32;
        const LAS f32x4* wgl = (const LAS f32x4*)(lds + 40960) + w * 256 + 4 * hi;
        f32x4 xa[4], xb[4]; float wea[4][4], web[4][4];
#define RT_LOAD(X, WE, KC) do { _Pragma("unroll") for (int i_ = 0; i_ < 4; ++i_) { X[i_] = gld<f32x4>(xr + (KC) + 8 * i_); \
            _Pragma("unroll") for (int j_ = 0; j_ < 4; ++j_) WE[i_][j_] = gld<float>(wer + (size_t)((KC) + 8 * i_ + j_) * 32); } } while (0)
#define RT_MMA(X, WE, KC) do { _Pragma("unroll") for (int i_ = 0; i_ < 4; ++i_) _Pragma("unroll") for (int j_ = 0; j_ < 4; ++j_) { \
            ae = __builtin_amdgcn_mfma_f32_32x32x2f32(X[i_][j_], WE[i_][j_], ae, 0, 0, 0); gacc += X[i_][j_] * wgl[(KC) + 8 * i_ + j_]; } } while (0)
        RT_LOAD(xa, wea, 0);
#pragma unroll 1
        for (int kc = 0; kc < 256; kc += 64) {
            RT_LOAD(xb, web, kc + 32);
            RT_MMA(xa, wea, kc);
            if (kc + 64 < 256) RT_LOAD(xa, wea, kc + 64);
            RT_MMA(xb, web, kc + 32);
        }
#undef RT_LOAD
#undef RT_MMA
        gacc[0] += __shfl_xor(gacc[0], 32); gacc[1] += __shfl_xor(gacc[1], 32); gacc[2] += __shfl_xor(gacc[2], 32); gacc[3] += __shfl_xor(gacc[3], 32);
        __syncthreads();
#pragma unroll
        for (int r = 0; r < 16; ++r) { const int tk = crow(r, hi); red[(w * 32 + tk) * 36 + l32] = ae[r]; }
        if (hi == 0) *(LAS f32x4*)(red + (w * 32 + l32) * 36 + 32) = gacc;
        __syncthreads();
        if (tid < 32) {
            const int tk = tid;
            float lg[4];
#pragma unroll
            for (int j = 0; j < 4; ++j) { float a = 0.f;
#pragma unroll
                for (int ww = 0; ww < 8; ++ww) a += red[(ww * 32 + tk) * 36 + 32 + j];
                lg[j] = a; }
            int gi = 0; float gm = lg[0];
#pragma unroll
            for (int j = 1; j < 4; ++j) if (lg[j] > gm) { gm = lg[j]; gi = j; }
            float den = 0.f;
#pragma unroll
            for (int j = 0; j < 4; ++j) den += __expf(lg[j] - gm);
            const float pg = 1.f / den;
            float b0 = -__builtin_inff(), b1 = -__builtin_inff(); int i0 = 0, i1 = 0;
#pragma unroll
            for (int j = 0; j < 8; ++j) { const int n = gi * 8 + j; float v = 0.f;
#pragma unroll
                for (int ww = 0; ww < 8; ++ww) v += red[(ww * 32 + tk) * 36 + n];
                if (v > b0) { b1 = b0; i1 = i0; b0 = v; i0 = j; } else if (v > b1) { b1 = v; i1 = j; } }
            const float w1 = __expf(b1 - b0), g0 = pg / (1.f + w1), g1 = pg * w1 / (1.f + w1);
            const int tok = t0 + tk, e0 = gi * 8 + i0, e1 = gi * 8 + i1;
            const unsigned p0 = atomicAdd(&ecnt[e0], 1u), p1 = atomicAdd(&ecnt[e1], 1u);
            list[(size_t)e0 * NT + p0] = 2 * tok; list[(size_t)e1 * NT + p1] = 2 * tok + 1;
            gw[2 * tok] = g0; gw[2 * tok + 1] = g1;
        }
        __syncthreads();
    }
}
__device__ __forceinline__ int moe_table(const Params& p, LAS char* lds) {
    LAS int* off = (LAS int*)(lds + LDS_CTL + 128); LAS int* toff = off + 33; LAS int* cnt = (LAS int*)(lds + 1024);
    const int tid = otid();
    __syncthreads();
    if (tid < NEXP) cnt[tid] = (int)gld<unsigned>((const unsigned*)(ows(p.ws) + OFF_ECNT) + tid);
    __syncthreads();
    if (tid == 0) { int a = 0, t = 0;
        for (int e = 0; e < NEXP; ++e) { off[e] = a; toff[e] = t; const int c = cnt[e]; a += c; t += (c + 255) >> 8; } off[NEXP] = a; toff[NEXP] = t; }
    __syncthreads();
    return toff[NEXP];
}
__device__ __forceinline__ void phase_moe1(const Params& p, LAS char* lds) {
    char* ws = ows(p.ws); const int tid = otid(), sr = tid >> 3, sc = (tid & 7) * 8;
    const int ntile = moe_table(p, lds); const LAS int* off = (const LAS int*)(lds + LDS_CTL + 128); const LAS int* toff = off + 33;
    const unsigned* ecnt = (const unsigned*)(ws + OFF_ECNT); const int* list = (const int*)(ws + OFF_LIST);
    const bf16_t* X1B = (const bf16_t*)(ws + OFF_X1B);
    for (int u = oblk(); u < ntile * 4; u += gridDim.x) {
        int e = 0; for (int k = 1; k < NEXP; ++k) if (u >= toff[k] * 4) e = k;
        const int mte = toff[e + 1] - toff[e], v = u - toff[e] * 4, nt = v / mte, mt = v - nt * mte;
        const int cnt = (int)ecnt[e], nvalid = cnt - mt * 256 < 256 ? cnt - mt * 256 : 256;
        const int* le = list + (size_t)e * NT + mt * 256;
        unsigned ao[4];
#pragma unroll
        for (int i = 0; i < 4; ++i) { const int r = sr + 64 * i; ao[i] = (unsigned)((gld<int>(le + (r < nvalid ? r : 0)) >> 1) * DM + sc); }
        EpiMoe1 ep{(bf16_t*)(ws + OFF_HM), off[e] + mt * 256, nvalid, nt * 256};
        gemm8<4, 2, true>(lds, X1B, ao, 128, (const bf16_t*)(ws + OFF_WGU_T) + (size_t)e * DM * EFF + nt * 128, EFF, (unsigned)((size_t)NEXP * DM * EFF), DM / 64, ep);
    }
}
__device__ __forceinline__ void phase_moe2(const Params& p, LAS char* lds) {
    char* ws = ows(p.ws); const int tid = otid(), sr = tid >> 3, sc = (tid & 7) * 8;
    const int ntile = moe_table(p, lds); const LAS int* off = (const LAS int*)(lds + LDS_CTL + 128); const LAS int* toff = off + 33;
    const unsigned* ecnt = (const unsigned*)(ws + OFF_ECNT); const int* list = (const int*)(ws + OFF_LIST);
    const bf16_t* HM = (const bf16_t*)(ws + OFF_HM);
    for (int u = oblk(); u < ntile * 8; u += gridDim.x) {
        int e = 0; for (int k = 1; k < NEXP; ++k) if (u >= toff[k] * 8) e = k;
        const int mte = toff[e + 1] - toff[e], v = u - toff[e] * 8, nt = v / mte, mt = v - nt * mte;
        const int cnt = (int)ecnt[e], nvalid = cnt - mt * 256 < 256 ? cnt - mt * 256 : 256;
        const unsigned ao[4] = AO4(EFF);
        EpiMoe2 ep{(bf16_t*)(ws + OFF_Y), list + (size_t)e * NT + mt * 256, (const float*)(ws + OFF_GW), nvalid, nt * 256};
        gemm8<4, 1, true>(lds, HM + (size_t)(off[e] + mt * 256) * EFF, ao, 128, (const bf16_t*)(ws + OFF_WD_T) + (size_t)e * EFF * DM + nt * 256, DM, 0u, EFF / 64, ep);
    }
}

__device__ __forceinline__ Params load_params() {
    Params q;
#if defined(__HIP_DEVICE_COMPILE__)
    const CAS Params* pp = (const CAS Params*)__builtin_amdgcn_kernarg_segment_ptr(); asm volatile("" : "+s"(pp));
#pragma unroll
    for (int i = 0; i < 22; ++i) q.in[i] = pp->in[i];
    q.out = pp->out; q.ws = pp->ws;
#endif
    return q;
}
__device__ constexpr int REP[10] = {1, 1, 1, 1, 1, 1, 1, 1, 1, 1};
__global__ void __launch_bounds__(512, 2) fwd_kernel(Params p) {
    LAS char* lds = (LAS char*)g_lds;
    {
        const unsigned t = threadIdx.x;
        if ((t & 63u) == 0u) ((LAS unsigned char*)lds)[LDS_CTL + 416 + (__builtin_amdgcn_s_getreg(63492) & 0x3fu)] = (unsigned char)(t >> 6);
        if (t == 0u) *(LAS u32x4*)(lds + LDS_CTL) = (u32x4){0u, 0u, 0u, 0u};
    }
    __syncthreads();
    XcdBarrier bar = xcd_barrier_post((unsigned*)(p.ws + OFF_BAR), (volatile LAS unsigned*)(lds + LDS_CTL));
    for (int layer = 0; layer < DEPTH; ++layer) {
        for (int r = 0; r < REP[0]; ++r) { phase_prep(load_params(), layer, lds);              xcd_barrier(bar); }
        for (int r = 0; r < REP[1]; ++r) { phase_win(load_params(), layer, lds);               xcd_barrier(bar); }
        for (int r = 0; r < REP[2]; ++r) { phase_up(load_params(), layer, lds);                xcd_barrier(bar); }
        phase_cmpred(load_params(), layer);                 xcd_barrier(bar);
        for (int r = 0; r < REP[3]; ++r) { phase_cmp2(load_params(), layer, lds);              xcd_barrier(bar); }
        for (int r = 0; r < REP[4]; ++r) { phase_attn_d(load_params(), 64 * (2 * layer) + 16 * r, lds);       xcd_barrier(bar); }
        for (int r = 0; r < REP[5]; ++r) { phase_attn_e(load_params(), 64 * (2 * layer + 1) + 16 * r, lds);   xcd_barrier(bar); }
        for (int r = 0; r < REP[6]; ++r) { phase_out(load_params(), layer, lds);               xcd_barrier(bar); }
        phase_router(load_params(), layer, lds);            xcd_barrier(bar);
        for (int r = 0; r < REP[7]; ++r) { phase_moe1(load_params(), lds);                     xcd_barrier(bar); }
        for (int r = 0; r < REP[8]; ++r) { phase_moe2(load_params(), lds);                     xcd_barrier(bar); }
        for (int r = 0; r < REP[9]; ++r) { phase_ln(load_params(), layer, 1);                  xcd_barrier(bar); }
    }
}

extern "C" void kernel_launch(void* const* d_in, const int* in_sizes, int n_in, void* d_out, int out_size, void* d_ws, size_t ws_size, hipStream_t stream) {
    (void)in_sizes; (void)out_size;
    static int grid = 0;
    if (!grid) {
        int dev = 0, cus = 0, per_cu = 0;
        (void)hipGetDevice(&dev);
        (void)hipDeviceGetAttribute(&cus, hipDeviceAttributeMultiprocessorCount, dev);
        (void)hipFuncSetAttribute((const void*)fwd_kernel, hipFuncAttributeMaxDynamicSharedMemorySize, LDS_BYTES);
        (void)hipOccupancyMaxActiveBlocksPerMultiprocessor(&per_cu, (const void*)fwd_kernel, 512, LDS_BYTES);
        if (cus <= 0) cus = 256;
        if (per_cu < 1) per_cu = 1;
        grid = cus;
    }
    if (n_in < 22 || ws_size < WS_TOTAL) { fprintf(stderr, "kernel_launch: bad arguments (n_in %d, ws %zu < %zu)\n", n_in, ws_size, (size_t)WS_TOTAL); return; }
    Params p;
    for (int i = 0; i < 22; ++i) p.in[i] = (const float*)d_in[i];
    p.out = (float*)d_out; p.ws = (char*)d_ws;
    (void)hipMemsetAsync(d_ws, 0, ZERO_BYTES, stream);
    fwd_kernel<<<dim3(grid), dim3(512), LDS_BYTES, stream>>>(p);
}
```

```cpp
#include <hip/hip_runtime.h>
#include <stdint.h>
#include <stdio.h>

#define LAS __attribute__((address_space(3)))
#define GAS __attribute__((address_space(1)))
#define CAS __attribute__((address_space(4)))
typedef unsigned short bf16_t;
typedef short bf16x8 __attribute__((ext_vector_type(8)));
typedef short s16x4 __attribute__((ext_vector_type(4)));
typedef float f32x16 __attribute__((ext_vector_type(16)));
typedef float f32x4 __attribute__((ext_vector_type(4)));
typedef float f32x2 __attribute__((ext_vector_type(2)));
typedef unsigned u32x4 __attribute__((ext_vector_type(4)));
typedef unsigned u32x2 __attribute__((ext_vector_type(2)));

constexpr int NB = 4, SEQ = 2048, NT = NB * SEQ, DM = 2048, DEPTH = 2;
constexpr int INC = 4434, LDH = 4608;
constexpr int C_QLAT = 0, C_KVLAT = 384, C_KROPE = 512, C_DQ = 576, C_DK = 1344, C_DV = 2112, C_NQ = 2880, C_NKC = 3648, C_NVC = 3776,
              C_NKS = 3904, C_NVS = 4032, C_NKW = 4160, C_NVW = 4288, C_GATE = 4416;
constexpr int NEXP = 32, EFF = 512;
constexpr float DN_ALPHA = 1.41421356237309515f;
constexpr float LOG2E = 1.4426950408889634f;

constexpr size_t al256(size_t x) { return (x + 255) & ~(size_t)255; }
constexpr size_t OFF_BAR = 0;
constexpr size_t OFF_CTR = 16384;
constexpr size_t ZERO_BYTES = 20480;
constexpr size_t OFF_ECNT = ZERO_BYTES;
constexpr size_t OFF_CS16 = OFF_ECNT + 256;
constexpr size_t OFF_CS32 = OFF_CS16 + (size_t)SEQ * 16 * 8;
constexpr size_t OFF_WIN_T = OFF_CS32 + (size_t)SEQ * 32 * 8;
constexpr size_t OFF_WQ_T = OFF_WIN_T + (size_t)LDH * DM * 2;
constexpr size_t OFF_WKV_T = OFF_WQ_T + (size_t)768 * 384 * 2;
constexpr size_t OFF_W1K_T = OFF_WKV_T + (size_t)1024 * 128 * 2;
constexpr size_t OFF_W1V_T = OFF_W1K_T + (size_t)256 * 4096 * 2;
constexpr size_t OFF_W2K_T = OFF_W1V_T + (size_t)256 * 4096 * 2;
constexpr size_t OFF_W2V_T = OFF_W2K_T + (size_t)256 * 256 * 2;
constexpr size_t OFF_WOUT_T = OFF_W2V_T + (size_t)256 * 256 * 2;
constexpr size_t OFF_WGU_T = OFF_WOUT_T + (size_t)DM * DM * 2;
constexpr size_t OFF_WD_T = OFF_WGU_T + (size_t)NEXP * 1024 * DM * 2;
constexpr size_t OFF_B1P = OFF_WD_T + (size_t)NEXP * DM * EFF * 2;
constexpr size_t OFF_XB = OFF_B1P + (size_t)2 * 16 * 256 * 4;
constexpr size_t OFF_H = OFF_XB + (size_t)NT * DM * 2;
constexpr size_t OFF_GATES = OFF_H + (size_t)NT * LDH * 2;
constexpr size_t OFF_QM = OFF_GATES + al256((size_t)NT * 18 * 4);
constexpr size_t OFF_KN = OFF_QM + (size_t)NT * 768 * 2;
constexpr size_t OFF_VM = OFF_KN + (size_t)NT * 512 * 2;
static_assert(OFF_VM == OFF_KN + (size_t)NT * 512 * 2, "Vm must follow Kn");
constexpr size_t OFF_HC = OFF_VM + (size_t)NT * 512 * 2;
constexpr size_t OFF_HCP = OFF_HC + (size_t)2 * 512 * 256 * 2;
constexpr size_t OFF_KC = OFF_HCP + (size_t)8 * 2 * 512 * 256 * 4;
constexpr size_t OFF_VC = OFF_KC + (size_t)512 * 128 * 2;
constexpr size_t OFF_IMP = OFF_VC + (size_t)512 * 128 * 2;
constexpr size_t OFF_ODIL = OFF_IMP + (size_t)NT * 32 * 4;
constexpr size_t OFF_LDIL = OFF_ODIL + (size_t)3 * NT * 768 * 2;
constexpr size_t OFF_PC = OFF_LDIL + (size_t)3 * NT * 6 * 4;
constexpr size_t OFF_PS = OFF_PC + (size_t)NT * 768 * 2;
constexpr size_t OFF_PW = OFF_PS + (size_t)NT * 768 * 2;
constexpr size_t OFF_MIX = OFF_PW + (size_t)NT * 768 * 2;
constexpr size_t OFF_YB = OFF_MIX + (size_t)NT * DM * 2;
constexpr size_t OFF_XA = OFF_YB + (size_t)NT * DM * 4;
constexpr size_t OFF_X1 = OFF_XA + (size_t)NT * DM * 4;
constexpr size_t OFF_X1B = OFF_X1 + (size_t)NT * DM * 4;
constexpr size_t OFF_HM = OFF_X1B + (size_t)NT * DM * 2;
constexpr size_t OFF_Y = OFF_HM + (size_t)(2 * NT + 256) * EFF * 2;
constexpr size_t OFF_LIST = OFF_Y + (size_t)2 * NT * DM * 2;
constexpr size_t OFF_GW = OFF_LIST + (size_t)NEXP * NT * 4;
constexpr size_t OFF_EID = OFF_GW + (size_t)2 * NT * 4;
constexpr size_t WS_TOTAL = OFF_EID + (size_t)2 * NT * 4;

struct Params { const float* in[22]; float* out; char* ws; };
enum { I_X = 0, I_WIN, I_QLN, I_WQUP, I_KVLN, I_WKVUP, I_PEK, I_W1K, I_W2K, I_PEV, I_W1V, I_W2V, I_WOUT, I_LN1G, I_LN1B, I_WGRP, I_WEXP, I_WGATE, I_WUP, I_WDOWN, I_LN2G, I_LN2B };

#define XB_TMO      128
#define XB_XCNT(j)  (256  + 64 * (j))
#define XB_XSUB(j)  (1280 + 64 * (j))
#define XB_XGEN(j)  (2304 + 64 * (j))
#define XB_TOP      3328
#define XB_TOPGEN   3392
#define XCD_BAR_WORDS 3456
#define XB_SPIN_CAP (1u << 18)

__device__ __forceinline__ unsigned xb_ld(unsigned* p)              { return __hip_atomic_load(p, __ATOMIC_RELAXED, __HIP_MEMORY_SCOPE_AGENT); }
__device__ __forceinline__ unsigned xb_add(unsigned* p, unsigned v) { return __hip_atomic_fetch_add(p, v, __ATOMIC_RELAXED, __HIP_MEMORY_SCOPE_AGENT); }
__device__ __forceinline__ unsigned xb_xcc_id() { return (unsigned)__builtin_amdgcn_s_getreg((3 << 11) | 20) & 0xFu; }
#define XB_SPIN(cond, bar) do { unsigned _sp = 0; while (cond) { __builtin_amdgcn_s_sleep(1); \
    if ((++_sp & 255u) == 0u) { if (xb_ld(&(bar)[XB_TMO])) break; if (_sp > XB_SPIN_CAP) { atomicAdd(&(bar)[XB_TMO], 1u); break; } } } } while (0)

struct XcdBarrier { unsigned* bar; unsigned x; volatile LAS unsigned* st; };
__device__ __forceinline__ int otid();

__device__ __forceinline__ XcdBarrier xcd_barrier_post(unsigned* bar, volatile LAS unsigned* st) {
    XcdBarrier b; b.bar = bar; b.x = xb_xcc_id(); b.st = st;
    if (threadIdx.x == 0) (void)xb_add(&bar[XB_XCNT(b.x)], 1u);
    return b;
}
__device__ __forceinline__ void xcd_barrier_complete(unsigned* bar, unsigned x, unsigned& nloc, unsigned& nx) {
    const unsigned G = gridDim.x * gridDim.y * gridDim.z;
    unsigned sum, cnt, mine, sp = 0u;
    for (;;) {
        sum = 0u; cnt = 0u; mine = 0u;
#pragma unroll
        for (unsigned j = 0; j < 16; ++j) { const unsigned c = xb_ld(&bar[XB_XCNT(j)]); sum += c; cnt += (c > 0u) ? 1u : 0u; mine = (j == x) ? c : mine; }
        if (sum == G) break;
        __builtin_amdgcn_s_sleep(1);
        if ((++sp & 255u) == 0u) { if (xb_ld(&bar[XB_TMO])) break; if (sp > XB_SPIN_CAP) { atomicAdd(&bar[XB_TMO], 1u); break; } }
    }
    nloc = mine > 0u ? mine : 1u; nx = cnt > 0u ? cnt : 1u;
}
__device__ __forceinline__ void xcd_barrier(const XcdBarrier& b) {
    asm volatile("s_waitcnt vmcnt(0)" ::: "memory");
    __syncthreads();
    if (otid() == 0) {
        unsigned* bar = b.bar;
        __builtin_amdgcn_s_waitcnt(0);
        unsigned nloc = b.st[0], nx = b.st[1];
        if (nloc == 0u) { xcd_barrier_complete(bar, b.x, nloc, nx); b.st[0] = nloc; b.st[1] = nx; }
        const unsigned old = xb_add(&bar[XB_XSUB(b.x)], 1u);
        const unsigned gen = old / nloc;
        if (old + 1u == (gen + 1u) * nloc) {
            __builtin_amdgcn_fence(__ATOMIC_RELEASE, "agent");
            asm volatile("s_waitcnt vmcnt(0)" ::: "memory");
            const unsigned og = xb_add(&bar[XB_TOP], 1u);
            const unsigned tg = og / nx;
            if (og + 1u == (tg + 1u) * nx) xb_add(&bar[XB_TOPGEN], 1u);
            else XB_SPIN(xb_ld(&bar[XB_TOPGEN]) == tg, bar);
            __builtin_amdgcn_fence(__ATOMIC_ACQUIRE, "agent");
            xb_add(&bar[XB_XGEN(b.x)], 1u);
            asm volatile("s_waitcnt vmcnt(0)" ::: "memory");
        } else {
            XB_SPIN(xb_ld(&bar[XB_XGEN(b.x)]) == gen, bar);
            __builtin_amdgcn_fence(__ATOMIC_ACQUIRE, "agent");
            asm volatile("s_waitcnt vmcnt(0)" ::: "memory");
        }
    }
    __syncthreads();
}

template <class T> __device__ __forceinline__ T gld(const void* p) { return *(const GAS T*)p; }
template <class T> __device__ __forceinline__ void gst(void* p, const T& v) { *(GAS T*)p = v; }
__device__ __forceinline__ __amdgpu_buffer_rsrc_t mk_rsrc(const void* p) {
    const unsigned long long v = (unsigned long long)p;
    const unsigned lo = __builtin_amdgcn_readfirstlane((unsigned)v), hi = __builtin_amdgcn_readfirstlane((unsigned)(v >> 32));
    return __builtin_amdgcn_make_buffer_rsrc((void*)(((unsigned long long)hi << 32) | lo), 0, 0xFFFFFFF0u, 0x00020000);
}
__device__ __forceinline__ bf16x8 bld8(__amdgpu_buffer_rsrc_t r, unsigned voff, int soff) { const u32x4 v = __builtin_amdgcn_raw_buffer_load_b128(r, (int)voff, soff, 0); return __builtin_bit_cast(bf16x8, v); }
typedef __bf16 bf16x2v __attribute__((ext_vector_type(2)));
__device__ __forceinline__ unsigned cvtpk(float lo, float hi) { const f32x2 v = {lo, hi}; const bf16x2v r = __builtin_convertvector(v, bf16x2v); return __builtin_bit_cast(unsigned, r); }
__device__ __forceinline__ float bf_lo(unsigned u) { return __uint_as_float(u << 16); }
__device__ __forceinline__ float bf_hi(unsigned u) { return __uint_as_float(u & 0xffff0000u); }
__device__ __forceinline__ float bf2f(bf16_t b) { return __uint_as_float((unsigned)b << 16); }
__device__ __forceinline__ float wave_sum(float v) {
#pragma unroll
    for (int o = 32; o >= 1; o >>= 1) v += __shfl_xor(v, o);
    return v;
}
extern __shared__ __attribute__((aligned(16))) char g_lds[];
constexpr int LDS_BYTES = 163840;
constexpr int LDS_CTL = LDS_BYTES - 512;
__device__ __forceinline__ int olane() { return (int)__builtin_amdgcn_mbcnt_hi(~0u, __builtin_amdgcn_mbcnt_lo(~0u, 0u)); }
__device__ __forceinline__ int owid() { const unsigned slot = __builtin_amdgcn_s_getreg(63492) & 0x3fu; return __builtin_amdgcn_readfirstlane((int)((LAS unsigned char*)g_lds)[LDS_CTL + 416 + slot]); }
__device__ __forceinline__ int otid() { int t = (owid() << 6) | olane(); asm volatile("" : "+v"(t)); return t; }
__device__ __forceinline__ int oblk() { int b = blockIdx.x; asm volatile("" : "+s"(b)); return b; }
__device__ __forceinline__ char* ows(const char* w) { char* q = const_cast<char*>(w); asm volatile("" : "+s"(q)); return q; }
__device__ __forceinline__ int crow(int r, int hi) { return (r & 3) + 8 * (r >> 2) + 4 * hi; }


constexpr int GS = 72;
constexpr int KN_BS = 288;
constexpr int G8_BOFF = 256 * GS * 2;
constexpr int G8_STG = 2 * G8_BOFF;
constexpr int G8_ROWSS = 2 * G8_STG;
template <int NI, int MODE, bool DEEP, class EPI>
__device__ __forceinline__ void gemm8(LAS char* lds, const bf16_t* abase, const unsigned (&aoff)[4], int ajump, const bf16_t* bbase, int ldb, unsigned updelta, int nkt, const EPI& epi) {
    static_assert(MODE != 2 || NI == 4, "the gate / up interleave assumes 256-column tiles");
    const int tid = otid(), lane = tid & 63, w = tid >> 6, l32 = lane & 31, hi = lane >> 5;
    const int wm = w >> 1, wn = w & 1;
    const int sr = tid >> 3, sc = (tid & 7) * 8;
    const int st_off = (sr * GS + sc) * 2;
    const int a_rd = ((wm * 64 + l32) * GS + hi * 8) * 2;
    const int g = lane >> 4, i16 = lane & 15;
    const int b_rd = G8_BOFF + (MODE == 0 ? ((wn * 32 * NI + l32) * GS + hi * 8) * 2 : ((8 * hi + (i16 >> 2)) * KN_BS + wn * 32 * NI + 16 * (g & 1) + 4 * (i16 & 3)) * 2);
    constexpr int NB_ = NI;
    f32x16 acc[2][NI];
#pragma unroll
    for (int i = 0; i < 2; ++i)
#pragma unroll
        for (int j = 0; j < NI; ++j)
#pragma unroll
            for (int r = 0; r < 16; ++r) acc[i][j][r] = 0.f;
    bf16x8 ra[4], rb[NB_];
    const __amdgpu_buffer_rsrc_t rsa = mk_rsrc(abase), rsb = mk_rsrc(bbase);
    unsigned bvo[NB_]; int blo[NB_];
#pragma unroll
    for (int i = 0; i < NB_; ++i) {
        if (MODE == 0) { bvo[i] = (unsigned)(sr * ldb + sc) * 2u; blo[i] = G8_BOFF + st_off + i * 64 * GS * 2; }
        else { const int ch = tid + 512 * i, brow = ch / (8 * NI), bc = (ch - brow * 8 * NI) * 8;
               const unsigned bcol = MODE == 2 ? (unsigned)(32 * (bc >> 6) + (bc & 31)) + (((bc >> 5) & 1) ? updelta : 0u) : (unsigned)bc;
               bvo[i] = ((unsigned)(brow * ldb) + bcol) * 2u; blo[i] = G8_BOFF + (brow * KN_BS + bc) * 2; }
    }
    const int bstep = MODE == 0 ? 64 * ldb * 2 : 0;
#define G8_LOADR(RA, RB, KT) do { const int k_ = (KT) * 64; const int ao_ = 2 * ((k_ >> 7) * ajump + (k_ & 127)); \
        _Pragma("unroll") for (int i = 0; i < 4; ++i) RA[i] = bld8(rsa, 2u * aoff[i], ao_); \
        _Pragma("unroll") for (int i = 0; i < NB_; ++i) RB[i] = bld8(rsb, bvo[i], i * bstep + (MODE == 0 ? 2 * k_ : k_ * ldb * 2)); } while (0)
#define G8_WRITER(RA, RB, ST) do { LAS char* s_ = lds + (ST) * G8_STG; \
        _Pragma("unroll") for (int i = 0; i < 4; ++i) *(LAS bf16x8*)(s_ + st_off + i * 64 * GS * 2) = RA[i]; \
        _Pragma("unroll") for (int i = 0; i < NB_; ++i) *(LAS bf16x8*)(s_ + blo[i]) = RB[i]; } while (0)
#define G8_COMPUTE(ST) do { const LAS char* s_ = lds + (ST) * G8_STG; \
        _Pragma("unroll") for (int ks = 0; ks < 4; ++ks) { bf16x8 af[2], bfr[NI]; \
            _Pragma("unroll") for (int i = 0; i < 2; ++i) af[i] = *(const LAS bf16x8*)(s_ + a_rd + i * 32 * GS * 2 + ks * 32); \
            _Pragma("unroll") for (int j = 0; j < NI; ++j) { \
                if (MODE == 0) bfr[j] = *(const LAS bf16x8*)(s_ + b_rd + j * 32 * GS * 2 + ks * 32); \
                else { const s16x4 v0 = __builtin_amdgcn_ds_read_tr16_b64_v4i16((LAS s16x4*)(s_ + b_rd + ks * 16 * KN_BS * 2 + j * 64)); \
                       const s16x4 v1 = __builtin_amdgcn_ds_read_tr16_b64_v4i16((LAS s16x4*)(s_ + b_rd + (ks * 16 + 4) * KN_BS * 2 + j * 64)); \
                       bfr[j] = (bf16x8){v0[0], v0[1], v0[2], v0[3], v1[0], v1[1], v1[2], v1[3]}; } } \
            _Pragma("unroll") for (int i = 0; i < 2; ++i) _Pragma("unroll") for (int j = 0; j < NI; ++j) acc[i][j] = __builtin_amdgcn_mfma_f32_32x32x16_bf16(bfr[j], af[i], acc[i][j], 0, 0, 0); \
            if (ks & 1) asm volatile("" ::: "memory"); } } while (0)
    if (DEEP) {
        bf16x8 ra2[4], rb2[NB_];
        const int last = nkt - 1;
#define G8_CL(x) ((x) < last ? (x) : last)
        G8_LOADR(ra, rb, 0);
        G8_LOADR(ra2, rb2, G8_CL(1));
        G8_WRITER(ra, rb, 0);
        __syncthreads();
        G8_LOADR(ra, rb, G8_CL(2));
        for (int kt = 0; kt < nkt; kt += 2) {
            G8_WRITER(ra2, rb2, 1);
            G8_COMPUTE(0);
            __syncthreads();
            G8_LOADR(ra2, rb2, G8_CL(kt + 3));
            G8_WRITER(ra, rb, 0);
            if (kt + 1 < nkt) G8_COMPUTE(1);
            __syncthreads();
            G8_LOADR(ra, rb, G8_CL(kt + 4));
        }
        asm volatile("s_waitcnt vmcnt(0)" ::: "memory");
#undef G8_CL
    } else {
        G8_LOADR(ra, rb, 0);
        G8_WRITER(ra, rb, 0);
        __syncthreads();
        for (int kt = 0; kt < nkt; ++kt) {
            const int cur = kt & 1; const bool more = kt + 1 < nkt;
            if (more) G8_LOADR(ra, rb, kt + 1);
            G8_COMPUTE(cur);
            if (more) G8_WRITER(ra, rb, cur ^ 1);
            __syncthreads();
        }
    }
#undef G8_LOADR
#undef G8_WRITER
#undef G8_COMPUTE
    epi(acc, wm, wn, l32, hi, lds);
}
template <int K> __device__ __forceinline__ void row_sumsq(LAS char* lds, const bf16_t* A, int ld) {
    const int tid = otid(), row = tid >> 1, half = tid & 1;
    const bf16_t* ptr = A + (size_t)row * ld + half * (K / 2);
    float ss = 0.f;
#pragma unroll
    for (int c = 0; c < K / 16; ++c) { const u32x4 v = gld<u32x4>(ptr + c * 8);
#pragma unroll
        for (int j = 0; j < 4; ++j) { const float a = bf_lo(v[j]), b = bf_hi(v[j]); ss += a * a + b * b; } }
    ss += __shfl_xor(ss, 1);
    __syncthreads();
    if (half == 0) ((LAS float*)(lds + G8_ROWSS))[row] = ss;
}
__device__ __forceinline__ void store_bf4(bf16_t* p, float a, float b, float c, float d) { u32x2 w; w.x = cvtpk(a, b); w.y = cvtpk(c, d); gst<u32x2>(p, w); }

__device__ __forceinline__ void store_tiles4(bf16_t* p, const f32x16 (&a)[4], float sc) {
#pragma unroll
    for (int ni = 0; ni < 4; ++ni)
#pragma unroll
        for (int q = 0; q < 4; ++q) store_bf4(p + 32 * ni + 8 * q, a[ni][4 * q] * sc, a[ni][4 * q + 1] * sc, a[ni][4 * q + 2] * sc, a[ni][4 * q + 3] * sc);
}
__device__ __forceinline__ void rope_pair32(f32x16& lo, f32x16& hi16, const f32x2* cs32, int pos, int hi, bool on = true) {
#pragma unroll
    for (int r = 0; r < 16; ++r) { f32x2 cs = {1.f, 0.f}; if (on) cs = gld<f32x2>(cs32 + pos * 32 + crow(r, hi)); const float x1 = lo[r], x2 = hi16[r]; lo[r] = x1 * cs.x - x2 * cs.y; hi16[r] = x2 * cs.x + x1 * cs.y; }
}
__device__ __forceinline__ void rope_first32(f32x16& t, const f32x2* cs16, int pos, int hi) {
#pragma unroll
    for (int r = 0; r < 8; ++r) { const f32x2 cs = gld<f32x2>(cs16 + pos * 16 + crow(r, hi)); const float x1 = t[r], x2 = t[r + 8]; t[r] = x1 * cs.x - x2 * cs.y; t[r + 8] = x2 * cs.x + x1 * cs.y; }
}
__device__ __forceinline__ bool is_rope16(int c0) {
    return (((c0 - C_DQ) & 127) == 0) && ((c0 >= C_DQ && c0 < C_DV) || (c0 >= C_NQ && c0 < C_NKC) || c0 == C_NKS || c0 == C_NKW);
}
struct EpiWin {
    bf16_t* H; float* gates; const f32x2* cs16; const f32x2* cs32; int m0, n0;
    __device__ __forceinline__ void operator()(f32x16 (&acc)[2][3], int wm, int wn, int l32, int hi, LAS char*) const {
        const int nw = n0 + 96 * wn;
#pragma unroll
        for (int mi = 0; mi < 2; ++mi) {
            const int row = m0 + 64 * wm + 32 * mi + l32, pos = row & (SEQ - 1);
            if (nw + 32 == C_KROPE) rope_pair32(acc[mi][1], acc[mi][2], cs32, pos, hi);
#pragma unroll
            for (int ni = 0; ni < 3; ++ni) if (is_rope16(nw + 32 * ni)) rope_first32(acc[mi][ni], cs16, pos, hi);
            if (nw == C_GATE) {
#pragma unroll
                for (int r = 0; r < 16; ++r) { const int c = crow(r, hi); if (c < 18) gst<float>(gates + (size_t)row * 18 + c, 1.f / (1.f + __expf(-acc[mi][0][r]))); }
            }
            bf16_t* hp = H + (size_t)row * LDH + nw + 4 * hi;
#pragma unroll
            for (int ni = 0; ni < 3; ++ni)
#pragma unroll
                for (int q = 0; q < 4; ++q) store_bf4(hp + 32 * ni + 8 * q, acc[mi][ni][4 * q], acc[mi][ni][4 * q + 1], acc[mi][ni][4 * q + 2], acc[mi][ni][4 * q + 3]);
        }
    }
};
struct EpiQup {
    bf16_t* Q; const f32x2* cs32; int m0, n0;
    __device__ __forceinline__ void operator()(f32x16 (&acc)[2][4], int wm, int wn, int l32, int hi, LAS char* lds) const {
        const int nw = n0 + 128 * wn; const LAS float* rs = (const LAS float*)(lds + G8_ROWSS);
#pragma unroll
        for (int mi = 0; mi < 2; ++mi) {
            const int rl = 64 * wm + 32 * mi + l32, row = m0 + rl, pos = row & (SEQ - 1);
            const float sc = __builtin_amdgcn_rsqf(rs[rl] * (1.f / 384.f) + 1e-6f);
#pragma unroll
            for (int ni = 0; ni < 4; ++ni)
#pragma unroll
                for (int r = 0; r < 16; ++r) acc[mi][ni][r] *= sc;
            rope_pair32(acc[mi][0], acc[mi][1], cs32, pos, hi, (nw % 192) == 128);
            rope_pair32(acc[mi][2], acc[mi][3], cs32, pos, hi, ((nw + 64) % 192) == 128);
            store_tiles4(Q + (size_t)row * 768 + nw + 4 * hi, acc[mi], 1.f);
        }
    }
};
struct EpiKVup {
    bf16_t* Kn; int m0, n0;
    __device__ __forceinline__ void operator()(f32x16 (&acc)[2][4], int wm, int wn, int l32, int hi, LAS char* lds) const {
        const int nw = n0 + 128 * wn; const LAS float* rs = (const LAS float*)(lds + G8_ROWSS);
        const int head = nw >> 8, within = nw & 255;
        bf16_t* base = Kn + (within < 128 ? (size_t)0 : (size_t)NT * 512) + head * 128 + 4 * hi;
#pragma unroll
        for (int mi = 0; mi < 2; ++mi) {
            const int rl = 64 * wm + 32 * mi + l32, row = m0 + rl;
            const float sc = __builtin_amdgcn_rsqf(rs[rl] * (1.f / 128.f) + 1e-6f);
            store_tiles4(base + (size_t)row * 512, acc[mi], sc);
        }
    }
};
__device__ __forceinline__ float gelu_tanh(float x) {
    const float u = 0.7978845608028654f * (x + 0.044715f * x * x * x);
    const float e = __expf(-2.f * fabsf(u)); const float t = (1.f - e) / (1.f + e);
    return 0.5f * x * (1.f + (u < 0.f ? -t : t));
}
struct EpiCmp1 {
    float* P; int m0;
    __device__ __forceinline__ void operator()(f32x16 (&acc)[2][4], int wm, int wn, int l32, int hi, LAS char*) const {
#pragma unroll
        for (int mi = 0; mi < 2; ++mi) {
            float* p = P + (size_t)(m0 + 64 * wm + 32 * mi + l32) * 256 + 128 * wn + 4 * hi;
#pragma unroll
            for (int ni = 0; ni < 4; ++ni)
#pragma unroll
                for (int q = 0; q < 4; ++q) { f32x4 v = {acc[mi][ni][4 * q], acc[mi][ni][4 * q + 1], acc[mi][ni][4 * q + 2], acc[mi][ni][4 * q + 3]}; gst<f32x4>(p + 32 * ni + 8 * q, v); }
        }
    }
};
struct EpiCmp2 {
    bf16_t* O; const f32x2* cs16; int dorope; int m0;
    __device__ __forceinline__ void operator()(f32x16 (&acc)[2][4], int wm, int wn, int l32, int hi, LAS char*) const {
        if (wn != 0) return;
#pragma unroll
        for (int mi = 0; mi < 2; ++mi) {
            const int row = m0 + 64 * wm + 32 * mi + l32, c = row & 127, pos = 16 * c + 31;
            if (dorope && c < 127) rope_first32(acc[mi][0], cs16, pos, hi);
            store_tiles4(O + (size_t)row * 128 + 4 * hi, acc[mi], c < 127 ? 1.f : 0.f);
        }
    }
};
struct EpiOut {
    float* Y; const float* X; int m0, n0;
    __device__ __forceinline__ void operator()(f32x16 (&acc)[2][4], int wm, int wn, int l32, int hi, LAS char*) const {
        const int nw = n0 + 128 * wn;
#pragma unroll
        for (int mi = 0; mi < 2; ++mi) {
            const size_t off = (size_t)(m0 + 64 * wm + 32 * mi + l32) * DM + nw + 4 * hi;
#pragma unroll
            for (int ni = 0; ni < 4; ++ni)
#pragma unroll
                for (int q = 0; q < 4; ++q) { const f32x4 xv = gld<f32x4>(X + off + 32 * ni + 8 * q);
                    f32x4 o; o[0] = DN_ALPHA * xv[0] + acc[mi][ni][4 * q]; o[1] = DN_ALPHA * xv[1] + acc[mi][ni][4 * q + 1]; o[2] = DN_ALPHA * xv[2] + acc[mi][ni][4 * q + 2]; o[3] = DN_ALPHA * xv[3] + acc[mi][ni][4 * q + 3];
                    gst<f32x4>(Y + off + 32 * ni + 8 * q, o);
                    if (q == 3) asm volatile("" ::: "memory"); }
        }
    }
};
struct EpiMoe1 {
    bf16_t* Hm; int rowbase, nvalid, n0;
    __device__ __forceinline__ void operator()(f32x16 (&acc)[2][4], int wm, int wn, int l32, int hi, LAS char*) const {
        const int ff0 = (n0 + 128 * wn) >> 1;
#pragma unroll
        for (int mi = 0; mi < 2; ++mi) {
            const int rl = 64 * wm + 32 * mi + l32;
            if (rl < nvalid) {
                bf16_t* p = Hm + (size_t)(rowbase + rl) * EFF + ff0 + 4 * hi;
#pragma unroll
                for (int h2 = 0; h2 < 2; ++h2)
#pragma unroll
                    for (int q = 0; q < 4; ++q) { float v[4];
#pragma unroll
                        for (int j = 0; j < 4; ++j) { const float g = acc[mi][2 * h2][4 * q + j], u = acc[mi][2 * h2 + 1][4 * q + j]; v[j] = g / (1.f + __expf(-g)) * u; }
                        store_bf4(p + 32 * h2 + 8 * q, v[0], v[1], v[2], v[3]); }
            }
        }
    }
};
struct EpiMoe2 {
    bf16_t* Y; const int* list; const float* gw; int nvalid, n0;
    __device__ __forceinline__ void operator()(f32x16 (&acc)[2][4], int wm, int wn, int l32, int hi, LAS char*) const {
        const int nw = n0 + 128 * wn;
#pragma unroll
        for (int mi = 0; mi < 2; ++mi) {
            const int rl = 64 * wm + 32 * mi + l32;
            if (rl < nvalid) { const int slot = gld<int>(list + rl); store_tiles4(Y + (size_t)slot * DM + nw + 4 * hi, acc[mi], gld<float>(gw + slot)); }
        }
    }
};

constexpr int VS = 160;
struct KeySrc { const bf16_t* k0; size_t kstride; const bf16_t* kr; size_t krstride; const bf16_t* v0; size_t vstride; };

template <int DQK> struct AttnRegs { bf16x8 k[DQK / 8 * 64 / 256]; bf16x8 v[4]; };
template <int DQK> struct AttnSrc { __amdgpu_buffer_rsrc_t rk, rr, rv; unsigned ko[DQK / 8 * 64 / 256]; unsigned vo[4]; unsigned ktile, rtile, vtile; };
template <int DQK> __device__ __forceinline__ AttnSrc<DQK> attn_src(const KeySrc& ks, int tid) {
    constexpr int KCH = DQK / 8, NKL = KCH * 64 / 256;
    AttnSrc<DQK> a; a.rk = mk_rsrc(ks.k0); a.rr = mk_rsrc(ks.kr); a.rv = mk_rsrc(ks.v0);
#pragma unroll
    for (int i = 0; i < NKL; ++i) { const int idx = tid + i * 256, key = idx / KCH, ch = idx - key * KCH;
        a.ko[i] = (DQK == 128 || ch < 16) ? (unsigned)(key * (unsigned)ks.kstride + ch * 8) * 2u : (unsigned)(key * (unsigned)ks.krstride + (ch - 16) * 8) * 2u; }
#pragma unroll
    for (int i = 0; i < 4; ++i) { const int idx = tid + i * 256, key = idx >> 4, ch = idx & 15; a.vo[i] = (unsigned)(key * (unsigned)ks.vstride + ch * 8) * 2u; }
    a.ktile = (unsigned)__builtin_amdgcn_readfirstlane((int)(128u * (unsigned)ks.kstride)); a.rtile = (unsigned)__builtin_amdgcn_readfirstlane((int)(128u * (unsigned)ks.krstride));
    a.vtile = (unsigned)__builtin_amdgcn_readfirstlane((int)(128u * (unsigned)ks.vstride));
    return a;
}
template <int DQK> __device__ __forceinline__ void attn_gload(const AttnSrc<DQK>& a, int jt, AttnRegs<DQK>& R, bool withv, int tid) {
    constexpr int KCH = DQK / 8, NKL = KCH * 64 / 256;
#pragma unroll
    for (int i = 0; i < NKL; ++i) { const int idx = tid + i * 256, key = idx / KCH, ch = idx - key * KCH;
        R.k[i] = (DQK == 128 || ch < 16) ? bld8(a.rk, a.ko[i], (int)(jt * a.ktile)) : bld8(a.rr, a.ko[i], (int)(jt * a.rtile)); }
    if (withv) {
#pragma unroll
        for (int i = 0; i < 4; ++i) R.v[i] = bld8(a.rv, a.vo[i], (int)(jt * a.vtile));
    }
}
template <int DQK> __device__ __forceinline__ void attn_lwrite(LAS char* lds, const AttnRegs<DQK>& R, bool withv, int tid) {
    constexpr int KS = DQK + 8, KCH = DQK / 8, NKL = KCH * 64 / 256;
#pragma unroll
    for (int i = 0; i < NKL; ++i) { const int idx = tid + i * 256, key = idx / KCH, ch = idx - key * KCH; *(LAS bf16x8*)(lds + (key * KS + ch * 8) * 2) = R.k[i]; }
    if (withv) {
#pragma unroll
        for (int i = 0; i < 4; ++i) { const int idx = tid + i * 256, key = idx >> 4, ch = idx & 15; *(LAS bf16x8*)(lds + 64 * KS * 2 + (key * VS + ch * 8) * 2) = R.v[i]; }
    }
}
template <int DQK> __device__ __forceinline__ void attn_stage(LAS char* lds, const AttnSrc<DQK>& a, int jt, bool withv, int tid) { AttnRegs<DQK> R; attn_gload<DQK>(a, jt, R, withv, tid); attn_lwrite<DQK>(lds, R, withv, tid); }
template <int DQK> __device__ __forceinline__ void attn_scores(const LAS char* lds, const bf16x8 (&qf)[DQK / 16], f32x16& p0, f32x16& p1, int l32, int hi) {
    constexpr int KS = DQK + 8;
    const int sg = (l32 & ~12) | ((l32 & 4) << 1) | ((l32 & 8) >> 1);
    const LAS char* kb = lds + (sg * KS + hi * 8) * 2;
#pragma unroll
    for (int r = 0; r < 16; ++r) { p0[r] = 0.f; p1[r] = 0.f; }
#pragma unroll
    for (int ds = 0; ds < DQK / 16; ++ds) {
        const bf16x8 a0 = *(const LAS bf16x8*)(kb + ds * 32), a1 = *(const LAS bf16x8*)(kb + 32 * KS * 2 + ds * 32);
        p0 = __builtin_amdgcn_mfma_f32_32x32x16_bf16(a0, qf[ds], p0, 0, 0, 0);
        p1 = __builtin_amdgcn_mfma_f32_32x32x16_bf16(a1, qf[ds], p1, 0, 0, 0);
    }
}
constexpr int ATT_HALF = 47104;
template <int DQK, bool SEL>
__device__ __forceinline__ void attn_run(LAS char* lds, const KeySrc& ks, int jt_lo, int jt_hi, unsigned tile_union, const bf16x8 (&qf)[DQK / 16],
                                         int qi, unsigned maxd, unsigned sel, float c2, f32x16 (&o)[4], float& m_run, float& l_run, int tid) {
    constexpr int KS = DQK + 8;
    const int tl = tid & 255, kg = tid >> 8, lane = tid & 63, l32 = lane & 31, hi = lane >> 5;
    const int g = lane >> 4, i16 = lane & 15;
    LAS char* L = lds + kg * ATT_HALF;
    const LAS char* vb = (L + 64 * KS * 2 + ((8 * hi + (i16 >> 2)) * VS + 16 * (g & 1) + 4 * (i16 & 3)) * 2);
    const float NEG = -__builtin_inff();
    int qmin = qi, qmax = qi;
#pragma unroll
    for (int sft = 32; sft >= 1; sft >>= 1) { qmin = min(qmin, __shfl_xor(qmin, sft)); qmax = max(qmax, __shfl_xor(qmax, sft)); }
    const AttnSrc<DQK> asrc = attn_src<DQK>(ks, tl);
    int nmine = 0;
    if (SEL) nmine = __builtin_popcount(jt_hi >= 32 ? tile_union : (tile_union & ((1u << jt_hi) - 1u)) & ~((1u << jt_lo) - 1u)); else nmine = jt_hi > jt_lo ? jt_hi - jt_lo : 0;
    LAS int* trips = (LAS int*)(lds + LDS_CTL + 96);
    __syncthreads();
    if (tl == 0) trips[kg] = nmine;
    __syncthreads();
    const int ntrip = max(trips[0], trips[1]);
    int jt = jt_lo;
    if (SEL) { while (jt < jt_hi && !((tile_union >> jt) & 1u)) ++jt; }
    for (int trip = 0; trip < ntrip; ++trip) {
        jt = __builtin_amdgcn_readfirstlane(jt);
        const bool have = jt < jt_hi;
        if (have) attn_stage<DQK>(L, asrc, jt, true, tl);
        __syncthreads();
        if (have) {
        f32x16 p0, p1;
        attn_scores<DQK>(L, qf, p0, p1, l32, hi);
        const bool ok = SEL ? (((sel >> jt) & 1u) != 0u) : true;
        const bool interior = (qmin - (jt * 64 + 63) >= 0) && ((unsigned)(qmax - jt * 64) <= maxd) && (SEL ? __all(ok) : true);
        float mx = NEG;
        if (interior) {
#pragma unroll
            for (int r = 0; r < 16; ++r) mx = fmaxf(mx, fmaxf(p0[r], p1[r]));
        } else {
            const int dq = qi - jt * 64 - 8 * hi;
#pragma unroll
            for (int r = 0; r < 16; ++r) {
                const int ko = 16 * (r >> 3) + (r & 7);
                const float s0 = (ok && (unsigned)(dq - ko) <= maxd) ? p0[r] : NEG;
                const float s1 = (ok && (unsigned)(dq - ko - 32) <= maxd) ? p1[r] : NEG;
                p0[r] = s0; p1[r] = s1; mx = fmaxf(mx, fmaxf(s0, s1));
            }
        }
        mx = fmaxf(mx, __shfl_xor(mx, 32));
        const float mn = fmaxf(m_run, mx * c2);
        const float alpha = __builtin_amdgcn_exp2f(m_run - mn);
        const float nmn = -mn;
        float rs = 0.f;
#pragma unroll
        for (int r = 0; r < 16; ++r) { p0[r] = __builtin_amdgcn_exp2f(fmaf(p0[r], c2, nmn)); p1[r] = __builtin_amdgcn_exp2f(fmaf(p1[r], c2, nmn)); rs += p0[r] + p1[r]; }
        rs += __shfl_xor(rs, 32);
        l_run = l_run * alpha + rs; m_run = mn;
        if (!__all(alpha == 1.f)) {
#pragma unroll
            for (int dt = 0; dt < 4; ++dt)
#pragma unroll
                for (int r = 0; r < 16; ++r) o[dt][r] *= alpha;
        }
#pragma unroll
        for (int s4 = 0; s4 < 4; ++s4) {
            u32x4 pw;
            if (s4 == 0)      { pw.x = cvtpk(p0[0], p0[1]);  pw.y = cvtpk(p0[2], p0[3]);   pw.z = cvtpk(p0[4], p0[5]);   pw.w = cvtpk(p0[6], p0[7]); }
            else if (s4 == 1) { pw.x = cvtpk(p0[8], p0[9]);  pw.y = cvtpk(p0[10], p0[11]); pw.z = cvtpk(p0[12], p0[13]); pw.w = cvtpk(p0[14], p0[15]); }
            else if (s4 == 2) { pw.x = cvtpk(p1[0], p1[1]);  pw.y = cvtpk(p1[2], p1[3]);   pw.z = cvtpk(p1[4], p1[5]);   pw.w = cvtpk(p1[6], p1[7]); }
            else              { pw.x = cvtpk(p1[8], p1[9]);  pw.y = cvtpk(p1[10], p1[11]); pw.z = cvtpk(p1[12], p1[13]); pw.w = cvtpk(p1[14], p1[15]); }
            const bf16x8 pb = *reinterpret_cast<bf16x8*>(&pw);
#pragma unroll
            for (int dt = 0; dt < 4; ++dt) {
                const s16x4 v0 = __builtin_amdgcn_ds_read_tr16_b64_v4i16((LAS s16x4*)(vb + (s4 * 16 * VS + dt * 32) * 2));
                const s16x4 v1 = __builtin_amdgcn_ds_read_tr16_b64_v4i16((LAS s16x4*)(vb + (s4 * 16 * VS + 4 * VS + dt * 32) * 2));
                const bf16x8 va = {v0[0], v0[1], v0[2], v0[3], v1[0], v1[1], v1[2], v1[3]};
                o[dt] = __builtin_amdgcn_mfma_f32_32x32x16_bf16(va, pb, o[dt], 0, 0, 0);
            }
        }
        }
        __syncthreads();
        ++jt;
        if (SEL) { while (jt < jt_hi && !((tile_union >> jt) & 1u)) ++jt; }
    }
}
template <int DQK> __device__ __forceinline__ void load_q(const bf16_t* qptr, int hi, bf16x8 (&qf)[DQK / 16]) {
#pragma unroll
    for (int ds = 0; ds < DQK / 16; ++ds) qf[ds] = gld<bf16x8>(qptr + ds * 16 + hi * 8);
}
__device__ __forceinline__ void store_o(bf16_t* optr, const f32x16 (&o)[4], float inv, int hi) {
#pragma unroll
    for (int dt = 0; dt < 4; ++dt)
#pragma unroll
        for (int q = 0; q < 4; ++q) store_bf4(optr + 32 * dt + 8 * q + 4 * hi, o[dt][4 * q] * inv, o[dt][4 * q + 1] * inv, o[dt][4 * q + 2] * inv, o[dt][4 * q + 3] * inv);
}
__device__ __forceinline__ void zero_o(f32x16 (&o)[4]) {
#pragma unroll
    for (int dt = 0; dt < 4; ++dt)
#pragma unroll
        for (int r = 0; r < 16; ++r) o[dt][r] = 0.f;
}

__device__ __forceinline__ int claim(unsigned* ctr, LAS char* lds) {
    volatile LAS int* slot = (volatile LAS int*)(lds + LDS_CTL + 64);
    __syncthreads();
    if (otid() == 0) *slot = (int)atomicAdd(ctr, 1u);
    __syncthreads();
    return *slot;
}

__device__ __forceinline__ void conv_stream(const float* src, bf16_t* dst, int tid, const float* rowscale = nullptr, size_t e0 = 0, int ncols = 1) {
    f32x4 v[8];
#pragma unroll
    for (int i = 0; i < 8; ++i) v[i] = gld<f32x4>(src + i * 2048 + tid * 4);
#pragma unroll
    for (int i = 0; i < 8; ++i) { const float sc = rowscale ? gld<float>(rowscale + ((unsigned)e0 + (unsigned)(i * 2048 + tid * 4)) / (unsigned)ncols) : 1.f;
        store_bf4(dst + i * 2048 + tid * 4, v[i][0] * sc, v[i][1] * sc, v[i][2] * sc, v[i][3] * sc); }
}
__device__ __forceinline__ void phase_prep(const Params& p, int layer, LAS char* lds) {
    char* ws = ows(p.ws);
    const int tid = otid(), half = tid >> 8, tl = tid & 255;
    constexpr int N_WIN = DM, N_WQ = 384 * 768 / 16384, N_WKV = 128 * 1024 / 16384, N_W1 = 4096 * 256 / 16384, N_W2 = 256 * 128 / 16384, N_WOUT = DM * DM / 16384, N_EX = NEXP * DM * EFF / 16384;
    constexpr int E0 = 0, E1 = E0 + N_WIN, E2 = E1 + N_WQ, E3 = E2 + N_WKV, E4 = E3 + N_W1, E5 = E4 + N_W1, E6 = E5 + N_W2, E7 = E6 + N_W2, E8 = E7 + N_WOUT,
                  E9 = E8 + N_EX, E10 = E9 + N_EX, E11 = E10 + N_EX, E12 = E11 + 16  , E13 = E12 + 32  , E14 = E13 + 2048  ;
    const int total = layer == 0 ? E14 : E12;
    for (int it = oblk(); it < total; it += gridDim.x) {
        if (it < E1) { const int k = it - E0;
            const float* src = p.in[I_WIN] + ((size_t)layer * DM + k) * INC; bf16_t* dst = (bf16_t*)(ws + OFF_WIN_T) + (size_t)k * LDH;
            for (int c2 = tid; c2 < LDH / 2; c2 += 512) { const int c = 2 * c2; f32x2 v = {0.f, 0.f}; if (c < INC) v = gld<f32x2>(src + c); gst<unsigned>(dst + c, cvtpk(v.x, v.y)); }
        } else if (it < E2) { const size_t u = (size_t)(it - E1) * 16384;
            conv_stream(p.in[I_WQUP] + (size_t)layer * 384 * 768 + u, (bf16_t*)(ws + OFF_WQ_T) + u, tid, p.in[I_QLN] + layer * 384, u, 768);
        } else if (it < E3) { const size_t u = (size_t)(it - E2) * 16384;
            conv_stream(p.in[I_WKVUP] + (size_t)layer * 128 * 1024 + u, (bf16_t*)(ws + OFF_WKV_T) + u, tid, p.in[I_KVLN] + layer * 128, u, 1024);
        } else if (it < E4) { const size_t u = (size_t)(it - E3) * 16384; conv_stream(p.in[I_W1K] + (size_t)layer * 4096 * 256 + u, (bf16_t*)(ws + OFF_W1K_T) + u, tid);
        } else if (it < E5) { const size_t u = (size_t)(it - E4) * 16384; conv_stream(p.in[I_W1V] + (size_t)layer * 4096 * 256 + u, (bf16_t*)(ws + OFF_W1V_T) + u, tid);
        } else if (it < E6) { const size_t u = (size_t)(it - E5) * 16384; conv_stream(p.in[I_W2K] + (size_t)layer * 256 * 128 + u, (bf16_t*)(ws + OFF_W2K_T) + u, tid);
        } else if (it < E7) { const size_t u = (size_t)(it - E6) * 16384; conv_stream(p.in[I_W2V] + (size_t)layer * 256 * 128 + u, (bf16_t*)(ws + OFF_W2V_T) + u, tid);
        } else if (it < E8) { const size_t u = (size_t)(it - E7) * 16384; conv_stream(p.in[I_WOUT] + (size_t)layer * DM * DM + u, (bf16_t*)(ws + OFF_WOUT_T) + u, tid);
        } else if (it < E9) {
            const size_t u = (size_t)(it - E8) * 16384; conv_stream(p.in[I_WGATE] + (size_t)layer * NEXP * DM * EFF + u, (bf16_t*)(ws + OFF_WGU_T) + u, tid);
        } else if (it < E10) {
            const size_t u = (size_t)(it - E9) * 16384; conv_stream(p.in[I_WUP] + (size_t)layer * NEXP * DM * EFF + u, (bf16_t*)(ws + OFF_WGU_T) + (size_t)NEXP * DM * EFF + u, tid);
        } else if (it < E11) {
            const size_t u = (size_t)(it - E10) * 16384; conv_stream(p.in[I_WDOWN] + (size_t)layer * NEXP * DM * EFF + u, (bf16_t*)(ws + OFF_WD_T) + u, tid);
        } else if (it < E12) { const int u = it - E11, which = u >> 3, kc = 2 * (u & 7) + half;
            const float* pe = p.in[which ? I_PEV : I_PEK] + (size_t)layer * 4096 + kc * 256;
            const float* w1 = p.in[which ? I_W1V : I_W1K] + (size_t)layer * 4096 * 256 + (size_t)kc * 256 * 256;
            const int n4 = (tl & 63) * 4, kgp = tl >> 6;
            f32x4 acc = {0.f, 0.f, 0.f, 0.f};
#pragma unroll 16
            for (int k = 0; k < 64; ++k) { const int kk = kgp * 64 + k; acc += gld<float>(pe + kk) * gld<f32x4>(w1 + (size_t)kk * 256 + n4); }
            LAS f32x4* red = (LAS f32x4*)lds + half * 256;
            __syncthreads();
            red[tl] = acc;
            __syncthreads();
            if (tl < 64) { const f32x4 t = (red[tl] + red[tl + 64]) + (red[tl + 128] + red[tl + 192]); gst<f32x4>((float*)(ws + OFF_B1P) + (which * 16 + kc) * 256 + n4, t); }
        } else if (it < E13) { const int u = it - E12;
            f32x2* cs16 = (f32x2*)(ws + OFF_CS16); f32x2* cs32 = (f32x2*)(ws + OFF_CS32);
            for (int e = tid; e < 64 * 48; e += 512) { const int pos = u * 64 + e / 48, j = e % 48;
                const int hf = j < 16 ? 16 : 32, i = j < 16 ? j : j - 16;
                const float invf = exp2f(-(float)i / (float)hf * 18.931568569324174f);
                const float ang = (float)pos * invf;
                f32x2 cs; cs.x = cosf(ang); cs.y = sinf(ang);
                if (j < 16) cs16[pos * 16 + i] = cs; else cs32[pos * 32 + i] = cs; }
        } else { const int u = it - E13;
            const float* x = p.in[I_X] + (size_t)u * 8192; bf16_t* xb = (bf16_t*)(ws + OFF_XB) + (size_t)u * 8192;
            for (int e = tid * 4; e < 8192; e += 2048) { const f32x4 v = gld<f32x4>(x + e); store_bf4(xb + e, v[0], v[1], v[2], v[3]); }
        }
    }
    if (oblk() == 0 && tid < NEXP) ((unsigned*)(ws + OFF_ECNT))[tid] = 0u;
    { unsigned* imp = (unsigned*)(ws + OFF_IMP); for (size_t e = (size_t)oblk() * 512 + tid; e < (size_t)NT * 32; e += (size_t)gridDim.x * 512) gst<unsigned>(imp + e, 0u); }
}

#define AO4(ld) { (unsigned)(sr * (ld) + sc), (unsigned)((sr + 64) * (ld) + sc), (unsigned)((sr + 128) * (ld) + sc), (unsigned)((sr + 192) * (ld) + sc) }
__device__ __forceinline__ void phase_win(const Params& p, int layer, LAS char* lds) {
    char* ws = ows(p.ws); const int tid = otid(), sr = tid >> 3, sc = (tid & 7) * 8;
    const bf16_t* A = (const bf16_t*)(ws + OFF_XB); const bf16_t* Bt = (const bf16_t*)(ws + OFF_WIN_T);
    for (int u = oblk(); u < 32 * 24; u += gridDim.x) {
        const int mt = u & 31, nt = u >> 5;
        EpiWin e{(bf16_t*)(ws + OFF_H), (float*)(ws + OFF_GATES), (const f32x2*)(ws + OFF_CS16), (const f32x2*)(ws + OFF_CS32), mt * 256, nt * 192};
        const unsigned ao[4] = AO4(DM);
        gemm8<3, 1, true>(lds, A + (size_t)mt * 256 * DM, ao, 128, Bt + nt * 192, LDH, 0u, DM / 64, e);
    }
}
__device__ __forceinline__ void phase_up(const Params& p, int layer, LAS char* lds) {
    char* ws = ows(p.ws); const int tid = otid(), sr = tid >> 3, sc = (tid & 7) * 8;
    const bf16_t* H = (const bf16_t*)(ws + OFF_H);
    constexpr int U0 = 32, U1 = U0 + 32 * 3, U2 = U1 + 32 * 4;
    for (int u = oblk(); u < U2; u += gridDim.x) {
        if (u < U0) {
            const int which = u >> 4, mt = (u >> 3) & 1, ksp = u & 7;
            const int col = which ? C_NVC : C_NKC;
            unsigned ao[4];
#pragma unroll
            for (int i = 0; i < 4; ++i) { const int r = sr + 64 * i; int c = r & 127; if (c > 126) c = 126; ao[i] = (unsigned)(((2 * mt + (r >> 7)) * SEQ + 16 * c) * LDH + sc); }
            const bf16_t* ab = H + (size_t)(4 * ksp) * LDH + col;
            const bf16_t* bb = (const bf16_t*)(ws + (which ? OFF_W1V_T : OFF_W1K_T)) + (size_t)512 * ksp * 256;
            EpiCmp1 e{(float*)(ws + OFF_HCP) + ((size_t)ksp * 2 + which) * 512 * 256, mt * 256};
            gemm8<4, 1, false>(lds, ab, ao, LDH, bb, 256, 0u, 512 / 64, e);
        } else if (u < U1) {
            const int v = u - U0, mt = v & 31, nt = v >> 5;
            const unsigned ao[4] = AO4(LDH);
            EpiQup e{(bf16_t*)(ws + OFF_QM), (const f32x2*)(ws + OFF_CS32), mt * 256, nt * 256};
            row_sumsq<384>(lds, H + (size_t)mt * 256 * LDH + C_QLAT, LDH);
            gemm8<4, 1, false>(lds, H + (size_t)mt * 256 * LDH + C_QLAT, ao, 128, (const bf16_t*)(ws + OFF_WQ_T) + nt * 256, 768, 0u, 384 / 64, e);
        } else {
            const int v = u - U1, mt = v & 31, nt = v >> 5;
            const unsigned ao[4] = AO4(LDH);
            EpiKVup e{(bf16_t*)(ws + OFF_KN), mt * 256, nt * 256};
            row_sumsq<128>(lds, H + (size_t)mt * 256 * LDH + C_KVLAT, LDH);
            gemm8<4, 1, false>(lds, H + (size_t)mt * 256 * LDH + C_KVLAT, ao, 128, (const bf16_t*)(ws + OFF_WKV_T) + nt * 256, 1024, 0u, 128 / 64, e);
        }
    }
}
__device__ __forceinline__ void phase_cmpred(const Params& p, int layer) {
    char* ws = ows(p.ws);
    const float* P = (const float*)(ws + OFF_HCP); const float* b1p = (const float*)(ws + OFF_B1P); bf16_t* Hc = (bf16_t*)(ws + OFF_HC);
    for (int e4 = oblk() * 512 + otid(); e4 < 2 * 512 * 256 / 4; e4 += gridDim.x * 512) {
        const int e = e4 * 4, which = e >> 17, n = e & 255;
        f32x4 a = {0.f, 0.f, 0.f, 0.f};
#pragma unroll
        for (int q = 0; q < 16; ++q) a += gld<f32x4>(b1p + (which * 16 + q) * 256 + n);
#pragma unroll
        for (int q = 0; q < 8; ++q) a += gld<f32x4>(P + (size_t)q * 2 * 512 * 256 + e);
        store_bf4(Hc + e, gelu_tanh(a[0]), gelu_tanh(a[1]), gelu_tanh(a[2]), gelu_tanh(a[3]));
    }
}
__device__ __forceinline__ void phase_cmp2(const Params& p, int layer, LAS char* lds) {
    char* ws = ows(p.ws); const int tid = otid(), sr = tid >> 3, sc = (tid & 7) * 8;
    for (int u = oblk(); u < 4; u += gridDim.x) {
        const int which = u >> 1, mt = u & 1;
        const bf16_t* Hc = (const bf16_t*)(ws + OFF_HC) + (size_t)which * 512 * 256 + (size_t)mt * 256 * 256;
        const unsigned ao[4] = AO4(256);
        EpiCmp2 e{(bf16_t*)(ws + (which ? OFF_VC : OFF_KC)), (const f32x2*)(ws + OFF_CS16), which == 0, mt * 256};
        gemm8<4, 1, false>(lds, Hc, ao, 128, (const bf16_t*)(ws + (which ? OFF_W2V_T : OFF_W2K_T)), 128, 0u, 256 / 64, e);
    }
}
__device__ __forceinline__ void phase_out(const Params& p, int layer, LAS char* lds) {
    char* ws = ows(p.ws); const int tid = otid(), sr = tid >> 3, sc = (tid & 7) * 8;
    const bf16_t* A = (const bf16_t*)(ws + OFF_MIX); const bf16_t* Bt = (const bf16_t*)(ws + OFF_WOUT_T);
    const float* X = layer == 0 ? p.in[I_X] : (const float*)(ws + OFF_XA);
    for (int u = oblk(); u < 32 * 8; u += gridDim.x) {
        const int mt = u & 31, nt = u >> 5;
        EpiOut e{(float*)(ws + OFF_YB), X, mt * 256, nt * 256};
        const unsigned ao[4] = AO4(DM);
        gemm8<4, 1, true>(lds, A + (size_t)mt * 256 * DM, ao, 128, Bt + nt * 256, DM, 0u, DM / 64, e);
    }
}

__device__ __forceinline__ void item_mla(const Params& p, int it, LAS char* lds) {
    char* ws = ows(p.ws); const int tid = otid(), lane = tid & 63, w = (tid >> 6) & 3, kg = tid >> 8, l32 = lane & 31, hi = lane >> 5;
    const int qb = 15 - (it >> 4), h = it & 3, b = (it >> 2) & 3;
    const int token = qb * 128 + 32 * w + l32; const size_t row = (size_t)b * SEQ + token;
    bf16x8 qf[12]; load_q<192>((const bf16_t*)(ws + OFF_QM) + row * 768 + h * 192, hi, qf);
    KeySrc ks; ks.k0 = (const bf16_t*)(ws + OFF_KN) + (size_t)b * SEQ * 512 + h * 128; ks.kstride = 512;
    ks.kr = (const bf16_t*)(ws + OFF_H) + (size_t)b * SEQ * LDH + C_KROPE; ks.krstride = LDH;
    ks.v0 = (const bf16_t*)(ws + OFF_VM) + (size_t)b * SEQ * 512 + h * 128; ks.vstride = 512;
    f32x16 o[4]; zero_o(o); float m = -1e30f, l = 0.f;
    attn_run<192, false>(lds, ks, 0, 2 * qb + 2, 0u, qf, token, 0x7fffffffu, 0u, 0.07216878364870322f * LOG2E, o, m, l, tid);
    store_o((bf16_t*)(ws + OFF_MIX) + row * DM + h * 128, o, 1.f / l, hi);
}
__device__ __forceinline__ void item_dil(const Params& p, int it, LAS char* lds) {
    char* ws = ows(p.ws); const int tid = otid(), lane = tid & 63, w = (tid >> 6) & 3, kg = tid >> 8, l32 = lane & 31, hi = lane >> 5;
    const int rem = it % 48, bh = it / 48, h = bh % 6, b = bh / 6;
    const int n = rem >> 4, r2 = rem & 15;
    const int dil = n == 0 ? 1 : (n == 1 ? 4 : 16);
    const int rho = n == 0 ? 0 : (n == 1 ? (r2 >> 2) : r2), qb = n == 0 ? r2 : (n == 1 ? (r2 & 3) : 0);
    const int i = qb * 128 + 32 * w + l32, token = rho + i * dil; const size_t row = (size_t)b * SEQ + token;
    const bf16_t* H = (const bf16_t*)(ws + OFF_H);
    bf16x8 qf[8]; load_q<128>(H + row * LDH + C_DQ + h * 128, hi, qf);
    KeySrc ks; ks.k0 = H + ((size_t)b * SEQ + rho) * LDH + C_DK + h * 128; ks.kstride = (size_t)dil * LDH; ks.kr = ks.k0; ks.krstride = 0;
    ks.v0 = H + ((size_t)b * SEQ + rho) * LDH + C_DV + h * 128; ks.vstride = (size_t)dil * LDH;
    f32x16 o[4]; zero_o(o); float m = -1e30f, l = 0.f;
    const int jlo = 2 * qb - 2 < 0 ? 0 : 2 * qb - 2;
    attn_run<128, false>(lds, ks, jlo, 2 * qb + 2, 0u, qf, i, 128u, 0u, 0.08838834764831845f * LOG2E, o, m, l, tid);
    store_o((bf16_t*)(ws + OFF_ODIL) + ((size_t)n * NT + row) * 768 + h * 128, o, 1.f / l, hi);
    if (hi == 0) gst<float>((float*)(ws + OFF_LDIL) + ((size_t)n * NT + row) * 6 + h, m + __log2f(l));
}
__device__ __forceinline__ void item_win(const Params& p, int it, LAS char* lds) {
    char* ws = ows(p.ws); const int tid = otid(), lane = tid & 63, w = (tid >> 6) & 3, kg = tid >> 8, l32 = lane & 31, hi = lane >> 5;
    const int hp = it % 3, b = (it / 3) & 3, tb = 31 - it / 12;
    const int head = 2 * hp + (w >> 1), token = 64 * tb + 32 * (w & 1) + l32; const size_t row = (size_t)b * SEQ + token;
    const bf16_t* H = (const bf16_t*)(ws + OFF_H);
    bf16x8 qf[8]; load_q<128>(H + row * LDH + C_NQ + head * 128, hi, qf);
    KeySrc ks; ks.k0 = H + (size_t)b * SEQ * LDH + C_NKW; ks.kstride = LDH; ks.kr = ks.k0; ks.krstride = 0; ks.v0 = H + (size_t)b * SEQ * LDH + C_NVW; ks.vstride = LDH;
    f32x16 o[4]; zero_o(o); float m = -1e30f, l = 0.f;
    attn_run<128, false>(lds, ks, tb - 8 < 0 ? 0 : tb - 8, tb + 1, 0u, qf, token, 511u, 0u, 0.08838834764831845f * LOG2E, o, m, l, tid);
    store_o((bf16_t*)(ws + OFF_PW) + row * 768 + head * 128, o, 1.f / l, hi);
}
__device__ __forceinline__ void item_cmp(const Params& p, int it, LAS char* lds) {
    char* ws = ows(p.ws); const int tid = otid(), tl = tid & 255, lane = tid & 63, w = (tid >> 6) & 3, kg = tid >> 8, l32 = lane & 31, hi = lane >> 5;
    const int hp = it % 3, tb = (it / 3) % 32, b = it / 96;
    const int head = 2 * hp + (w >> 1), token = 64 * tb + 32 * (w & 1) + l32; const size_t row = (size_t)b * SEQ + token;
    const bf16_t* H = (const bf16_t*)(ws + OFF_H);
    bf16x8 qf[8]; load_q<128>(H + row * LDH + C_NQ + head * 128, hi, qf);
    KeySrc ks; ks.k0 = (const bf16_t*)(ws + OFF_KC) + (size_t)b * 128 * 128; ks.kstride = 128; ks.kr = ks.k0; ks.krstride = 0; ks.v0 = (const bf16_t*)(ws + OFF_VC) + (size_t)b * 128 * 128; ks.vstride = 128;
    const int qi = (token - 31) >> 4;
    const int qimax = (64 * tb + 63 - 31) >> 4;
    const int jhi = qimax < 0 ? 0 : (qimax >> 6) + 1;
    const float c2 = 0.08838834764831845f * LOG2E;
    f32x16 o[4]; zero_o(o); float m = -1e30f, l = 0.f;
    attn_run<128, false>(lds, ks, 0, jhi, 0u, qf, qi, 0x7fffffffu, 0u, c2, o, m, l, tid);
    const float inv = l > 0.f ? 1.f / l : 0.f;
    store_o((bf16_t*)(ws + OFF_PC) + row * 768 + head * 128, o, inv, hi);
    unsigned* imp = (unsigned*)(ws + OFF_IMP) + row * 32;
    const AttnSrc<128> asrc = attn_src<128>(ks, tl);
    LAS char* L = lds + kg * ATT_HALF;
    LAS int* trips = (LAS int*)(lds + LDS_CTL + 96);
    __syncthreads();
    if (tl == 0) trips[kg] = jhi;
    __syncthreads();
    const int ntrip = max(trips[0], trips[1]);
    for (int jt = 0; jt < ntrip; ++jt) {
        const bool have = jt < jhi;
        if (have) attn_stage<128>(L, asrc, jt, false, tl);
        __syncthreads();
        if (have) {
            f32x16 p0, p1; attn_scores<128>(L, qf, p0, p1, l32, hi);
            const int dq = qi - jt * 64 - 8 * hi;
#pragma unroll
            for (int r = 0; r < 16; ++r) { const int ko = 16 * (r >> 3) + (r & 7);
                p0[r] = (dq - ko >= 0) ? __builtin_amdgcn_exp2f(p0[r] * c2 - m) * inv : 0.f;
                p1[r] = (dq - ko - 32 >= 0) ? __builtin_amdgcn_exp2f(p1[r] * c2 - m) * inv : 0.f; }
#pragma unroll
            for (int t = 0; t < 2; ++t)
#pragma unroll
                for (int u = 0; u < 2; ++u) {
                    unsigned q[8];
#pragma unroll
                    for (int jj = 0; jj < 8; ++jj) q[jj] = (unsigned)((t ? p1[8 * u + jj] : p0[8 * u + jj]) * 16777216.f + 0.5f);
                    const int j0 = (64 * jt + 32 * t + 16 * u + 8 * hi) >> 2;
                    const unsigned a0 = q[0] + q[1] + q[2] + q[3], a1 = q[4] + q[5] + q[6] + q[7] + q[3], a2 = q[7];
                    if (a0) atomicAdd(imp + j0, a0);
                    if (a1) atomicAdd(imp + j0 + 1, a1);
                    if (a2 && j0 + 2 < 32) atomicAdd(imp + j0 + 2, a2);
                }
        }
        __syncthreads();
    }
}
__device__ __forceinline__ void item_slc(const Params& p, int it, LAS char* lds) {
    char* ws = ows(p.ws); const int tid = otid(), lane = tid & 63, w = (tid >> 6) & 3, kg = tid >> 8, l32 = lane & 31, hi = lane >> 5;
    const int hp = it % 3, b = (it / 3) & 3, tb = 31 - it / 12;
    const int tl = tid & 255;
    LAS int* sc = (LAS int*)(lds + 2 * ATT_HALF + kg * 8704); LAS unsigned* msk = (LAS unsigned*)(lds + 2 * ATT_HALF + kg * 8704 + 8192);
    __syncthreads();
    if (tl < 65) msk[tl] = 0u;
    const unsigned* imp = (const unsigned*)(ws + OFF_IMP) + ((size_t)b * SEQ + 64 * tb) * 32;
#pragma unroll
    for (int i = 0; i < 8; ++i) { const int e = tl + i * 256, tk = e >> 5, j = e & 31, pos = 64 * tb + tk, qblk = pos >> 6;
        const bool valid = 64 * j <= pos, forced = (j == 0) || (j == qblk) || (j == qblk - 1);
        sc[e] = valid ? (forced ? 0x7fffffff : (int)gld<unsigned>(imp + e)) : -1; }
    __syncthreads();
#pragma unroll
    for (int i = 0; i < 8; ++i) { const int e = tl + i * 256, tk = e >> 5, j = e & 31; const int s = sc[e]; int rank = 0;
        for (int k = 0; k < 32; ++k) { const int sk = sc[tk * 32 + k]; rank += (sk > s || (sk == s && k < j)) ? 1 : 0; }
        if (rank < 16) { __hip_atomic_fetch_or(&msk[tk], 1u << j, __ATOMIC_RELAXED, __HIP_MEMORY_SCOPE_WORKGROUP); __hip_atomic_fetch_or(&msk[64], 1u << j, __ATOMIC_RELAXED, __HIP_MEMORY_SCOPE_WORKGROUP); } }
    __syncthreads();
    const int head = 2 * hp + (w >> 1), tk = 32 * (w & 1) + l32, token = 64 * tb + tk; const size_t row = (size_t)b * SEQ + token;
    const unsigned sel = msk[tk], uni = msk[64];
    const bf16_t* H = (const bf16_t*)(ws + OFF_H);
    bf16x8 qf[8]; load_q<128>(H + row * LDH + C_NQ + head * 128, hi, qf);
    KeySrc ks; ks.k0 = H + (size_t)b * SEQ * LDH + C_NKS; ks.kstride = LDH; ks.kr = ks.k0; ks.krstride = 0; ks.v0 = H + (size_t)b * SEQ * LDH + C_NVS; ks.vstride = LDH;
    f32x16 o[4]; zero_o(o); float m = -1e30f, l = 0.f;
    attn_run<128, true>(lds, ks, 0, tb + 1, uni, qf, token, 0x7fffffffu, sel, 0.08838834764831845f * LOG2E, o, m, l, tid);
    const float* gp = (const float*)(ws + OFF_GATES) + row * 18 + head * 3;
    const float g0 = gld<float>(gp), g1 = gld<float>(gp + 1) / l, g2 = gld<float>(gp + 2);
    const bf16_t* pc = (const bf16_t*)(ws + OFF_PC) + row * 768 + head * 128 + 4 * hi; const bf16_t* pw = (const bf16_t*)(ws + OFF_PW) + row * 768 + head * 128 + 4 * hi;
    bf16_t* mx = (bf16_t*)(ws + OFF_MIX) + row * DM + 1280 + head * 128 + 4 * hi;
#pragma unroll
    for (int dt = 0; dt < 4; ++dt)
#pragma unroll
        for (int q = 0; q < 4; ++q) { const u32x2 a = gld<u32x2>(pc + 32 * dt + 8 * q), b = gld<u32x2>(pw + 32 * dt + 8 * q);
            store_bf4(mx + 32 * dt + 8 * q, g0 * bf_lo(a.x) + g1 * o[dt][4 * q] + g2 * bf_lo(b.x), g0 * bf_hi(a.x) + g1 * o[dt][4 * q + 1] + g2 * bf_hi(b.x),
                                            g0 * bf_lo(a.y) + g1 * o[dt][4 * q + 2] + g2 * bf_lo(b.y), g0 * bf_hi(a.y) + g1 * o[dt][4 * q + 3] + g2 * bf_hi(b.y)); }
}
__device__ __forceinline__ void item_dilmix(const Params& p, int it, LAS char* lds) {
    char* ws = ows(p.ws); const int tid = otid();
    const bf16_t* OD = (const bf16_t*)(ws + OFF_ODIL); const float* LD = (const float*)(ws + OFF_LDIL); bf16_t* MIX = (bf16_t*)(ws + OFF_MIX);
    for (int e = tid; e < 64 * 96; e += 512) {
        const size_t row = (size_t)it * 64 + e / 96; const int cc = (e % 96) * 8, h = cc >> 7;
        const float L0 = gld<float>(LD + row * 6 + h), L1 = gld<float>(LD + ((size_t)NT + row) * 6 + h), L2 = gld<float>(LD + ((size_t)2 * NT + row) * 6 + h);
        const float M = fmaxf(L0, fmaxf(L1, L2)); float w0 = __builtin_amdgcn_exp2f(L0 - M), w1 = __builtin_amdgcn_exp2f(L1 - M), w2 = __builtin_amdgcn_exp2f(L2 - M);
        const float inv = 1.f / (w0 + w1 + w2); w0 *= inv; w1 *= inv; w2 *= inv;
        const u32x4 a = gld<u32x4>(OD + row * 768 + cc), bq = gld<u32x4>(OD + ((size_t)NT + row) * 768 + cc), cq = gld<u32x4>(OD + ((size_t)2 * NT + row) * 768 + cc); u32x4 r;
#pragma unroll
        for (int j = 0; j < 4; ++j) r[j] = cvtpk(w0 * bf_lo(a[j]) + w1 * bf_lo(bq[j]) + w2 * bf_lo(cq[j]), w0 * bf_hi(a[j]) + w1 * bf_hi(bq[j]) + w2 * bf_hi(cq[j]));
        gst<u32x4>(MIX + row * DM + 512 + cc, r);
    }
}
__device__ __forceinline__ void phase_attn_d(const Params& p, int ctr_idx, LAS char* lds) {
    unsigned* ctr = (unsigned*)(ows(p.ws) + OFF_CTR) + ctr_idx;
    constexpr int NWIN = 384, NDIL = NB * 6 * 48, NCMP = 384;
    const int kg = otid() >> 8;
    for (;;) { const int pr = claim(ctr, lds); const int it = __builtin_amdgcn_readfirstlane(2 * pr + kg); if (2 * pr >= NWIN + NDIL + NCMP) break;
        if (it < NWIN) item_win(p, it, lds); else if (it < NWIN + NDIL) item_dil(p, it - NWIN, lds); else item_cmp(p, it - NWIN - NDIL, lds); }
}
__device__ __forceinline__ void phase_attn_e(const Params& p, int ctr_idx, LAS char* lds) {
    unsigned* ctr = (unsigned*)(ows(p.ws) + OFF_CTR) + ctr_idx;
    constexpr int NMLA = 256, NSLC = 384, NMIX = NT / 64;
    const int kg = otid() >> 8;
    for (;;) {
        const int pr = claim(ctr, lds); if (pr >= (NMLA + NSLC) / 2 + NMIX) break;
        const int it = __builtin_amdgcn_readfirstlane(2 * pr + kg);
        if (pr >= (NMLA + NSLC) / 2) item_dilmix(p, pr - (NMLA + NSLC) / 2, lds); else if (it < NMLA) item_mla(p, it, lds); else item_slc(p, it - NMLA, lds);
    }
}
__device__ __forceinline__ void phase_ln(const Params& p, int layer, int mode) {
    char* ws = ows(p.ws); const int tid = otid(), lane = tid & 63, wv = (oblk() * 512 + tid) >> 6, nw = gridDim.x * 8;
    const float* g = p.in[mode ? I_LN2G : I_LN1G] + layer * DM; const float* bb = p.in[mode ? I_LN2B : I_LN1B] + layer * DM;
    for (int row = wv; row < NT; row += nw) {
        f32x4 v[8];
        if (mode == 0) { const float* y = (const float*)(ws + OFF_YB) + (size_t)row * DM;
#pragma unroll
            for (int i = 0; i < 8; ++i) v[i] = gld<f32x4>(y + (i * 64 + lane) * 4);
        } else { const float* x1 = (const float*)(ws + OFF_X1) + (size_t)row * DM; const bf16_t* y0 = (const bf16_t*)(ws + OFF_Y) + (size_t)(2 * row) * DM; const bf16_t* y1 = y0 + DM;
#pragma unroll
            for (int i = 0; i < 8; ++i) { const int c = (i * 64 + lane) * 4; const f32x4 xv = gld<f32x4>(x1 + c); const u32x2 a = gld<u32x2>(y0 + c), b2 = gld<u32x2>(y1 + c);
                v[i][0] = DN_ALPHA * xv[0] + bf_lo(a.x) + bf_lo(b2.x); v[i][1] = DN_ALPHA * xv[1] + bf_hi(a.x) + bf_hi(b2.x);
                v[i][2] = DN_ALPHA * xv[2] + bf_lo(a.y) + bf_lo(b2.y); v[i][3] = DN_ALPHA * xv[3] + bf_hi(a.y) + bf_hi(b2.y); }
        }
        float s = 0.f;
#pragma unroll
        for (int i = 0; i < 8; ++i) s += (v[i][0] + v[i][1]) + (v[i][2] + v[i][3]);
        const float mu = wave_sum(s) * (1.f / DM);
        float q = 0.f;
#pragma unroll
        for (int i = 0; i < 8; ++i) { const f32x4 d = v[i] - mu; q += (d[0] * d[0] + d[1] * d[1]) + (d[2] * d[2] + d[3] * d[3]); }
        const float rstd = 1.f / sqrtf(wave_sum(q) * (1.f / DM) + 1e-5f);
        float* of = mode == 0 ? (float*)(ws + OFF_X1) + (size_t)row * DM : (layer == DEPTH - 1 ? p.out + (size_t)row * DM : (float*)(ws + OFF_XA) + (size_t)row * DM);
        bf16_t* ob = mode == 0 ? (bf16_t*)(ws + OFF_X1B) + (size_t)row * DM : (bf16_t*)(ws + OFF_XB) + (size_t)row * DM;
#pragma unroll
        for (int i = 0; i < 8; ++i) { const int c = (i * 64 + lane) * 4; const f32x4 gv = gld<f32x4>(g + c), bv = gld<f32x4>(bb + c);
            f32x4 o = (v[i] - mu) * rstd * gv + bv; gst<f32x4>(of + c, o);
            if (mode == 0 || layer < DEPTH - 1) store_bf4(ob + c, o[0], o[1], o[2], o[3]); }
    }
}
__device__ __forceinline__ void ln1_rows4(char* ws, const float* g, const float* bb, int row0, int lane) {
    f32x4 v[4][8];
#pragma unroll
    for (int r = 0; r < 4; ++r) { const float* y = (const float*)(ws + OFF_YB) + (size_t)(row0 + r) * DM;
#pragma unroll
        for (int i = 0; i < 8; ++i) v[r][i] = gld<f32x4>(y + (i * 64 + lane) * 4); }
#pragma unroll
    for (int r = 0; r < 4; ++r) {
        float s = 0.f;
#pragma unroll
        for (int i = 0; i < 8; ++i) s += (v[r][i][0] + v[r][i][1]) + (v[r][i][2] + v[r][i][3]);
        const float mu = wave_sum(s) * (1.f / DM);
        float q = 0.f;
#pragma unroll
        for (int i = 0; i < 8; ++i) { const f32x4 d = v[r][i] - mu; q += (d[0] * d[0] + d[1] * d[1]) + (d[2] * d[2] + d[3] * d[3]); }
        const float rstd = 1.f / sqrtf(wave_sum(q) * (1.f / DM) + 1e-5f);
        float* of = (float*)(ws + OFF_X1) + (size_t)(row0 + r) * DM; bf16_t* ob = (bf16_t*)(ws + OFF_X1B) + (size_t)(row0 + r) * DM;
#pragma unroll
        for (int i = 0; i < 8; ++i) { const int c = (i * 64 + lane) * 4; const f32x4 gv = gld<f32x4>(g + c), bv = gld<f32x4>(bb + c);
            const f32x4 o = (v[r][i] - mu) * rstd * gv + bv; gst<f32x4>(of + c, o); store_bf4(ob + c, o[0], o[1], o[2], o[3]); }
    }
}
__device__ __forceinline__ void phase_router(const Params& p, int layer, LAS char* lds) {
    char* ws = ows(p.ws); const int tid = otid(), lane = tid & 63, w = tid >> 6, l32 = lane & 31, hi = lane >> 5;
    const float* X1 = (const float*)(ws + OFF_X1); const float* We = p.in[I_WEXP] + (size_t)layer * DM * 32; const float* Wg = p.in[I_WGRP] + (size_t)layer * DM * 4;
    const float* lng = p.in[I_LN1G] + layer * DM; const float* lnb = p.in[I_LN1B] + layer * DM;
    LAS float* red = (LAS float*)lds;
    float* gw = (float*)(ws + OFF_GW);
    for (int it = oblk(); it < NT / 32; it += gridDim.x) {
        const int t0 = it * 32;
        { LAS f32x4* wl = (LAS f32x4*)(lds + 40960);
#pragma unroll
          for (int i = 0; i < 4; ++i) wl[tid + 512 * i] = gld<f32x4>(Wg + (size_t)(tid + 512 * i) * 4); }
        ln1_rows4(ws, lng, lnb, t0 + 4 * w, lane);
        asm volatile("s_waitcnt vmcnt(0)" ::: "memory");
        __syncthreads();
        f32x16 ae;
#pragma unroll
        for (int r = 0; r < 16; ++r) ae[r] = 0.f;
        f32x4 gacc = {0.f, 0.f, 0.f, 0.f};
        const float* xr = X1 + (size_t)(t0 + l32) * DM + w * 256 + 4 * hi;
        const float* wer = We + (size_t)(w * 256 + 4 * hi) * 32 + l32;
        const LAS f32x4* wgl = (const LAS f32x4*)(lds + 40960) + w * 256 + 4 * hi;
        f32x4 xa[4], xb[4]; float wea[4][4], web[4][4];
#define RT_LOAD(X, WE, KC) do { _Pragma("unroll") for (int i_ = 0; i_ < 4; ++i_) { X[i_] = gld<f32x4>(xr + (KC) + 8 * i_); \
            _Pragma("unroll") for (int j_ = 0; j_ < 4; ++j_) WE[i_][j_] = gld<float>(wer + (size_t)((KC) + 8 * i_ + j_) * 32); } } while (0)
#define RT_MMA(X, WE, KC) do { _Pragma("unroll") for (int i_ = 0; i_ < 4; ++i_) _Pragma("unroll") for (int j_ = 0; j_ < 4; ++j_) { \
            ae = __builtin_amdgcn_mfma_f32_32x32x2f32(X[i_][j_], WE[i_][j_], ae, 0, 0, 0); gacc += X[i_][j_] * wgl[(KC) + 8 * i_ + j_]; } } while (0)
        RT_LOAD(xa, wea, 0);
#pragma unroll 1
        for (int kc = 0; kc < 256; kc += 64) {
            RT_LOAD(xb, web, kc + 32);
            RT_MMA(xa, wea, kc);
            if (kc + 64 < 256) RT_LOAD(xa, wea, kc + 64);
            RT_MMA(xb, web, kc + 32);
        }
#undef RT_LOAD
#undef RT_MMA
        gacc[0] += __shfl_xor(gacc[0], 32); gacc[1] += __shfl_xor(gacc[1], 32); gacc[2] += __shfl_xor(gacc[2], 32); gacc[3] += __shfl_xor(gacc[3], 32);
        __syncthreads();
#pragma unroll
        for (int r = 0; r < 16; ++r) { const int tk = crow(r, hi); red[(w * 32 + tk) * 36 + l32] = ae[r]; }
        if (hi == 0) *(LAS f32x4*)(red + (w * 32 + l32) * 36 + 32) = gacc;
        __syncthreads();
        if (tid < 32) {
            const int tk = tid;
            float lg[4];
#pragma unroll
            for (int j = 0; j < 4; ++j) { float a = 0.f;
#pragma unroll
                for (int ww = 0; ww < 8; ++ww) a += red[(ww * 32 + tk) * 36 + 32 + j];
                lg[j] = a; }
            int gi = 0; float gm = lg[0];
#pragma unroll
            for (int j = 1; j < 4; ++j) if (lg[j] > gm) { gm = lg[j]; gi = j; }
            float den = 0.f;
#pragma unroll
            for (int j = 0; j < 4; ++j) den += __expf(lg[j] - gm);
            const float pg = 1.f / den;
            float b0 = -__builtin_inff(), b1 = -__builtin_inff(); int i0 = 0, i1 = 0;
#pragma unroll
            for (int j = 0; j < 8; ++j) { const int n = gi * 8 + j; float v = 0.f;
#pragma unroll
                for (int ww = 0; ww < 8; ++ww) v += red[(ww * 32 + tk) * 36 + n];
                if (v > b0) { b1 = b0; i1 = i0; b0 = v; i0 = j; } else if (v > b1) { b1 = v; i1 = j; } }
            const float w1 = __expf(b1 - b0), g0 = pg / (1.f + w1), g1 = pg * w1 / (1.f + w1);
            const int tok = t0 + tk, e0 = gi * 8 + i0, e1 = gi * 8 + i1;
            int* eid = (int*)(ws + OFF_EID);
            eid[2 * tok] = e0; eid[2 * tok + 1] = e1;
            gw[2 * tok] = g0; gw[2 * tok + 1] = g1;
        }
        __syncthreads();
    }
}
__device__ __forceinline__ void phase_lists(const Params& p, LAS char* lds) {
    char* ws = ows(p.ws); const int tid = otid(), lane = tid & 63, w = tid >> 6;
    const int* eid = (const int*)(ws + OFF_EID);
    LAS int* wcnt = (LAS int*)lds;
    for (int e = oblk(); e < NEXP; e += gridDim.x) {
        int* le = (int*)(ws + OFF_LIST) + (size_t)e * NT;
        int base = 0;
        for (int s0 = 0; s0 < 2 * NT; s0 += 512) {
            const int sl = s0 + tid; const bool mine = gld<int>(eid + sl) == e;
            const unsigned long long bal = __ballot(mine);
            const int wpre = __builtin_popcountll(bal & ((1ull << lane) - 1ull)), wtot = __builtin_popcountll(bal);
            __syncthreads();
            if (lane == 0) wcnt[w] = wtot;
            __syncthreads();
            int off = base, tot = 0;
#pragma unroll
            for (int ww = 0; ww < 8; ++ww) { const int c = wcnt[ww]; if (ww < w) off += c; tot += c; }
            if (mine) le[off + wpre] = sl;
            base += tot;
        }
        if (tid == 0) ((unsigned*)(ws + OFF_ECNT))[e] = (unsigned)base;
    }
}
__device__ __forceinline__ int moe_table(const Params& p, LAS char* lds) {
    LAS int* off = (LAS int*)(lds + LDS_CTL + 128); LAS int* toff = off + 33; LAS int* cnt = (LAS int*)(lds + 1024);
    const int tid = otid();
    __syncthreads();
    if (tid < NEXP) cnt[tid] = (int)gld<unsigned>((const unsigned*)(ows(p.ws) + OFF_ECNT) + tid);
    __syncthreads();
    if (tid == 0) { int a = 0, t = 0;
        for (int e = 0; e < NEXP; ++e) { off[e] = a; toff[e] = t; const int c = cnt[e]; a += c; t += (c + 255) >> 8; } off[NEXP] = a; toff[NEXP] = t; }
    __syncthreads();
    return toff[NEXP];
}
__device__ __forceinline__ void phase_moe1(const Params& p, LAS char* lds) {
    char* ws = ows(p.ws); const int tid = otid(), sr = tid >> 3, sc = (tid & 7) * 8;
    const int ntile = moe_table(p, lds); const LAS int* off = (const LAS int*)(lds + LDS_CTL + 128); const LAS int* toff = off + 33;
    const unsigned* ecnt = (const unsigned*)(ws + OFF_ECNT); const int* list = (const int*)(ws + OFF_LIST);
    const bf16_t* X1B = (const bf16_t*)(ws + OFF_X1B);
    for (int u = oblk(); u < ntile * 4; u += gridDim.x) {
        int e = 0; for (int k = 1; k < NEXP; ++k) if (u >= toff[k] * 4) e = k;
        const int mte = toff[e + 1] - toff[e], v = u - toff[e] * 4, nt = v / mte, mt = v - nt * mte;
        const int cnt = (int)ecnt[e], nvalid = cnt - mt * 256 < 256 ? cnt - mt * 256 : 256;
        const int* le = list + (size_t)e * NT + mt * 256;
        unsigned ao[4];
#pragma unroll
        for (int i = 0; i < 4; ++i) { const int r = sr + 64 * i; ao[i] = (unsigned)((gld<int>(le + (r < nvalid ? r : 0)) >> 1) * DM + sc); }
        EpiMoe1 ep{(bf16_t*)(ws + OFF_HM), off[e] + mt * 256, nvalid, nt * 256};
        gemm8<4, 2, true>(lds, X1B, ao, 128, (const bf16_t*)(ws + OFF_WGU_T) + (size_t)e * DM * EFF + nt * 128, EFF, (unsigned)((size_t)NEXP * DM * EFF), DM / 64, ep);
    }
}
__device__ __forceinline__ void phase_moe2(const Params& p, LAS char* lds) {
    char* ws = ows(p.ws); const int tid = otid(), sr = tid >> 3, sc = (tid & 7) * 8;
    const int ntile = moe_table(p, lds); const LAS int* off = (const LAS int*)(lds + LDS_CTL + 128); const LAS int* toff = off + 33;
    const unsigned* ecnt = (const unsigned*)(ws + OFF_ECNT); const int* list = (const int*)(ws + OFF_LIST);
    const bf16_t* HM = (const bf16_t*)(ws + OFF_HM);
    for (int u = oblk(); u < ntile * 8; u += gridDim.x) {
        int e = 0; for (int k = 1; k < NEXP; ++k) if (u >= toff[k] * 8) e = k;
        const int mte = toff[e + 1] - toff[e], v = u - toff[e] * 8, nt = v / mte, mt = v - nt * mte;
        const int cnt = (int)ecnt[e], nvalid = cnt - mt * 256 < 256 ? cnt - mt * 256 : 256;
        const unsigned ao[4] = AO4(EFF);
        EpiMoe2 ep{(bf16_t*)(ws + OFF_Y), list + (size_t)e * NT + mt * 256, (const float*)(ws + OFF_GW), nvalid, nt * 256};
        gemm8<4, 1, true>(lds, HM + (size_t)(off[e] + mt * 256) * EFF, ao, 128, (const bf16_t*)(ws + OFF_WD_T) + (size_t)e * EFF * DM + nt * 256, DM, 0u, EFF / 64, ep);
    }
}

__device__ __forceinline__ Params load_params() {
    Params q;
#if defined(__HIP_DEVICE_COMPILE__)
    const CAS Params* pp = (const CAS Params*)__builtin_amdgcn_kernarg_segment_ptr(); asm volatile("" : "+s"(pp));
#pragma unroll
    for (int i = 0; i < 22; ++i) q.in[i] = pp->in[i];
    q.out = pp->out; q.ws = pp->ws;
#endif
    return q;
}
__device__ constexpr int REP[10] = {1, 1, 1, 1, 1, 1, 1, 1, 1, 1};
__global__ void __launch_bounds__(512, 2) fwd_kernel(Params p) {
    LAS char* lds = (LAS char*)g_lds;
    {
        const unsigned t = threadIdx.x;
        if ((t & 63u) == 0u) ((LAS unsigned char*)lds)[LDS_CTL + 416 + (__builtin_amdgcn_s_getreg(63492) & 0x3fu)] = (unsigned char)(t >> 6);
        if (t == 0u) *(LAS u32x4*)(lds + LDS_CTL) = (u32x4){0u, 0u, 0u, 0u};
    }
    __syncthreads();
    XcdBarrier bar = xcd_barrier_post((unsigned*)(p.ws + OFF_BAR), (volatile LAS unsigned*)(lds + LDS_CTL));
    for (int layer = 0; layer < DEPTH; ++layer) {
        for (int r = 0; r < REP[0]; ++r) { phase_prep(load_params(), layer, lds);              xcd_barrier(bar); }
        for (int r = 0; r < REP[1]; ++r) { phase_win(load_params(), layer, lds);               xcd_barrier(bar); }
        for (int r = 0; r < REP[2]; ++r) { phase_up(load_params(), layer, lds);                xcd_barrier(bar); }
        phase_cmpred(load_params(), layer);                 xcd_barrier(bar);
        for (int r = 0; r < REP[3]; ++r) { phase_cmp2(load_params(), layer, lds);              xcd_barrier(bar); }
        for (int r = 0; r < REP[4]; ++r) { phase_attn_d(load_params(), 64 * (2 * layer) + 16 * r, lds);       xcd_barrier(bar); }
        for (int r = 0; r < REP[5]; ++r) { phase_attn_e(load_params(), 64 * (2 * layer + 1) + 16 * r, lds);   xcd_barrier(bar); }
        for (int r = 0; r < REP[6]; ++r) { phase_out(load_params(), layer, lds);               xcd_barrier(bar); }
        phase_router(load_params(), layer, lds);            xcd_barrier(bar);
        phase_lists(load_params(), lds);                    xcd_barrier(bar);
        for (int r = 0; r < REP[7]; ++r) { phase_moe1(load_params(), lds);                     xcd_barrier(bar); }
        for (int r = 0; r < REP[8]; ++r) { phase_moe2(load_params(), lds);                     xcd_barrier(bar); }
        for (int r = 0; r < REP[9]; ++r) { phase_ln(load_params(), layer, 1);                  xcd_barrier(bar); }
    }
}

extern "C" void kernel_launch(void* const* d_in, const int* in_sizes, int n_in, void* d_out, int out_size, void* d_ws, size_t ws_size, hipStream_t stream) {
    (void)in_sizes; (void)out_size;
    static int grid = 0;
    if (!grid) {
        int dev = 0, cus = 0, per_cu = 0;
        (void)hipGetDevice(&dev);
        (void)hipDeviceGetAttribute(&cus, hipDeviceAttributeMultiprocessorCount, dev);
        (void)hipFuncSetAttribute((const void*)fwd_kernel, hipFuncAttributeMaxDynamicSharedMemorySize, LDS_BYTES);
        (void)hipOccupancyMaxActiveBlocksPerMultiprocessor(&per_cu, (const void*)fwd_kernel, 512, LDS_BYTES);
        if (cus <= 0) cus = 256;
        if (per_cu < 1) per_cu = 1;
        grid = cus;
    }
    if (n_in < 22 || ws_size < WS_TOTAL) { fprintf(stderr, "kernel_launch: bad arguments (n_in %d, ws %zu < %zu)\n", n_in, ws_size, (size_t)WS_TOTAL); return; }
    Params p;
    for (int i = 0; i < 22; ++i) p.in[i] = (const float*)d_in[i];
    p.out = (float*)d_out; p.ws = (char*)d_ws;
    (void)hipMemsetAsync(d_ws, 0, ZERO_BYTES, stream);
    fwd_kernel<<<dim3(grid), dim3(512), LDS_BYTES, stream>>>(p);
}
```

```cpp
#include <hip/hip_runtime.h>
#include <stdint.h>
#include <stdio.h>

#define LAS __attribute__((address_space(3)))
#define GAS __attribute__((address_space(1)))
#define CAS __attribute__((address_space(4)))
typedef unsigned short bf16_t;
typedef short bf16x8 __attribute__((ext_vector_type(8)));
typedef short s16x4 __attribute__((ext_vector_type(4)));
typedef float f32x16 __attribute__((ext_vector_type(16)));
typedef float f32x4 __attribute__((ext_vector_type(4)));
typedef float f32x2 __attribute__((ext_vector_type(2)));
typedef unsigned u32x4 __attribute__((ext_vector_type(4)));
typedef unsigned u32x2 __attribute__((ext_vector_type(2)));

constexpr int NB = 4, SEQ = 2048, NT = NB * SEQ, DM = 2048, DEPTH = 2;
constexpr int INC = 4434, LDH = 4608;
constexpr int C_QLAT = 0, C_KVLAT = 384, C_KROPE = 512, C_DQ = 576, C_DK = 1344, C_DV = 2112, C_NQ = 2880, C_NKC = 3648, C_NVC = 3776,
              C_NKS = 3904, C_NVS = 4032, C_NKW = 4160, C_NVW = 4288, C_GATE = 4416;
constexpr int NEXP = 32, EFF = 512;
constexpr float DN_ALPHA = 1.41421356237309515f;
constexpr float LOG2E = 1.4426950408889634f;

constexpr size_t al256(size_t x) { return (x + 255) & ~(size_t)255; }
constexpr size_t OFF_BAR = 0;
constexpr size_t OFF_CTR = 16384;
constexpr size_t ZERO_BYTES = 20480;
constexpr size_t OFF_ECNT = ZERO_BYTES;
constexpr size_t OFF_CS16 = OFF_ECNT + 256;
constexpr size_t OFF_CS32 = OFF_CS16 + (size_t)SEQ * 16 * 8;
constexpr size_t OFF_WIN_T = OFF_CS32 + (size_t)SEQ * 32 * 8;
constexpr size_t OFF_WQ_T = OFF_WIN_T + (size_t)LDH * DM * 2;
constexpr size_t OFF_WKV_T = OFF_WQ_T + (size_t)768 * 384 * 2;
constexpr size_t OFF_W1K_T = OFF_WKV_T + (size_t)1024 * 128 * 2;
constexpr size_t OFF_W1V_T = OFF_W1K_T + (size_t)256 * 4096 * 2;
constexpr size_t OFF_W2K_T = OFF_W1V_T + (size_t)256 * 4096 * 2;
constexpr size_t OFF_W2V_T = OFF_W2K_T + (size_t)256 * 256 * 2;
constexpr size_t OFF_WOUT_T = OFF_W2V_T + (size_t)256 * 256 * 2;
constexpr size_t OFF_WGU_T = OFF_WOUT_T + (size_t)DM * DM * 2;
constexpr size_t OFF_WD_T = OFF_WGU_T + (size_t)NEXP * 1024 * DM * 2;
constexpr size_t OFF_B1P = OFF_WD_T + (size_t)NEXP * DM * EFF * 2;
constexpr size_t OFF_XB = OFF_B1P + (size_t)2 * 16 * 256 * 4;
constexpr size_t OFF_H = OFF_XB + (size_t)NT * DM * 2;
constexpr size_t OFF_GATES = OFF_H + (size_t)NT * LDH * 2;
constexpr size_t OFF_QM = OFF_GATES + al256((size_t)NT * 18 * 4);
constexpr size_t OFF_KN = OFF_QM + (size_t)NT * 768 * 2;
constexpr size_t OFF_VM = OFF_KN + (size_t)NT * 512 * 2;
static_assert(OFF_VM == OFF_KN + (size_t)NT * 512 * 2, "Vm must follow Kn");
constexpr size_t OFF_HC = OFF_VM + (size_t)NT * 512 * 2;
constexpr size_t OFF_HCP = OFF_HC + (size_t)2 * 512 * 256 * 2;
constexpr size_t OFF_KC = OFF_HCP + (size_t)8 * 2 * 512 * 256 * 4;
constexpr size_t OFF_VC = OFF_KC + (size_t)512 * 128 * 2;
constexpr size_t OFF_IMP = OFF_VC + (size_t)512 * 128 * 2;
constexpr size_t OFF_ODIL = OFF_IMP + (size_t)NT * 32 * 4;
constexpr size_t OFF_LDIL = OFF_ODIL + (size_t)3 * NT * 768 * 2;
constexpr size_t OFF_PC = OFF_LDIL + (size_t)3 * NT * 6 * 4;
constexpr size_t OFF_PS = OFF_PC + (size_t)NT * 768 * 2;
constexpr size_t OFF_PW = OFF_PS + (size_t)NT * 768 * 2;
constexpr size_t OFF_MIX = OFF_PW + (size_t)NT * 768 * 2;
constexpr size_t OFF_YB = OFF_MIX + (size_t)NT * DM * 2;
constexpr size_t OFF_XA = OFF_YB + (size_t)NT * DM * 4;
constexpr size_t OFF_X1 = OFF_XA + (size_t)NT * DM * 4;
constexpr size_t OFF_X1B = OFF_X1 + (size_t)NT * DM * 4;
constexpr size_t OFF_HM = OFF_X1B + (size_t)NT * DM * 2;
constexpr size_t OFF_Y = OFF_HM + (size_t)(2 * NT + 256) * EFF * 2;
constexpr size_t OFF_LIST = OFF_Y + (size_t)2 * NT * DM * 2;
constexpr size_t OFF_GW = OFF_LIST + (size_t)NEXP * NT * 4;
constexpr size_t OFF_EID = OFF_GW + (size_t)2 * NT * 4;
constexpr size_t OFF_STAT = OFF_EID + (size_t)2 * NT * 4;
constexpr size_t WS_TOTAL = OFF_STAT + (size_t)32 * 8 * 256 * 8;

struct Params { const float* in[22]; float* out; char* ws; };
enum { I_X = 0, I_WIN, I_QLN, I_WQUP, I_KVLN, I_WKVUP, I_PEK, I_W1K, I_W2K, I_PEV, I_W1V, I_W2V, I_WOUT, I_LN1G, I_LN1B, I_WGRP, I_WEXP, I_WGATE, I_WUP, I_WDOWN, I_LN2G, I_LN2B };

#define XB_TMO      128
#define XB_XCNT(j)  (256  + 64 * (j))
#define XB_XSUB(j)  (1280 + 64 * (j))
#define XB_XGEN(j)  (2304 + 64 * (j))
#define XB_TOP      3328
#define XB_TOPGEN   3392
#define XCD_BAR_WORDS 3456
#define XB_SPIN_CAP (1u << 18)

__device__ __forceinline__ unsigned xb_ld(unsigned* p)              { return __hip_atomic_load(p, __ATOMIC_RELAXED, __HIP_MEMORY_SCOPE_AGENT); }
__device__ __forceinline__ unsigned xb_add(unsigned* p, unsigned v) { return __hip_atomic_fetch_add(p, v, __ATOMIC_RELAXED, __HIP_MEMORY_SCOPE_AGENT); }
__device__ __forceinline__ unsigned xb_xcc_id() { return (unsigned)__builtin_amdgcn_s_getreg((3 << 11) | 20) & 0xFu; }
#define XB_SPIN(cond, bar) do { unsigned _sp = 0; while (cond) { __builtin_amdgcn_s_sleep(1); \
    if ((++_sp & 255u) == 0u) { if (xb_ld(&(bar)[XB_TMO])) break; if (_sp > XB_SPIN_CAP) { atomicAdd(&(bar)[XB_TMO], 1u); break; } } } } while (0)

struct XcdBarrier { unsigned* bar; unsigned x; volatile LAS unsigned* st; };
__device__ __forceinline__ int otid();

__device__ __forceinline__ XcdBarrier xcd_barrier_post(unsigned* bar, volatile LAS unsigned* st) {
    XcdBarrier b; b.bar = bar; b.x = xb_xcc_id(); b.st = st;
    if (threadIdx.x == 0) (void)xb_add(&bar[XB_XCNT(b.x)], 1u);
    return b;
}
__device__ __forceinline__ void xcd_barrier_complete(unsigned* bar, unsigned x, unsigned& nloc, unsigned& nx) {
    const unsigned G = gridDim.x * gridDim.y * gridDim.z;
    unsigned sum, cnt, mine, sp = 0u;
    for (;;) {
        sum = 0u; cnt = 0u; mine = 0u;
#pragma unroll
        for (unsigned j = 0; j < 16; ++j) { const unsigned c = xb_ld(&bar[XB_XCNT(j)]); sum += c; cnt += (c > 0u) ? 1u : 0u; mine = (j == x) ? c : mine; }
        if (sum == G) break;
        __builtin_amdgcn_s_sleep(1);
        if ((++sp & 255u) == 0u) { if (xb_ld(&bar[XB_TMO])) break; if (sp > XB_SPIN_CAP) { atomicAdd(&bar[XB_TMO], 1u); break; } }
    }
    nloc = mine > 0u ? mine : 1u; nx = cnt > 0u ? cnt : 1u;
}
__device__ __forceinline__ void xcd_barrier(const XcdBarrier& b) {
    asm volatile("s_waitcnt vmcnt(0)" ::: "memory");
    __syncthreads();
    if (otid() == 0) {
        unsigned* bar = b.bar;
        __builtin_amdgcn_s_waitcnt(0);
        unsigned nloc = b.st[0], nx = b.st[1];
        if (nloc == 0u) { xcd_barrier_complete(bar, b.x, nloc, nx); b.st[0] = nloc; b.st[1] = nx; }
        const unsigned old = xb_add(&bar[XB_XSUB(b.x)], 1u);
        const unsigned gen = old / nloc;
        if (old + 1u == (gen + 1u) * nloc) {
            __builtin_amdgcn_fence(__ATOMIC_RELEASE, "agent");
            asm volatile("s_waitcnt vmcnt(0)" ::: "memory");
            const unsigned og = xb_add(&bar[XB_TOP], 1u);
            const unsigned tg = og / nx;
            if (og + 1u == (tg + 1u) * nx) xb_add(&bar[XB_TOPGEN], 1u);
            else XB_SPIN(xb_ld(&bar[XB_TOPGEN]) == tg, bar);
            __builtin_amdgcn_fence(__ATOMIC_ACQUIRE, "agent");
            xb_add(&bar[XB_XGEN(b.x)], 1u);
            asm volatile("s_waitcnt vmcnt(0)" ::: "memory");
        } else {
            XB_SPIN(xb_ld(&bar[XB_XGEN(b.x)]) == gen, bar);
            __builtin_amdgcn_fence(__ATOMIC_ACQUIRE, "agent");
            asm volatile("s_waitcnt vmcnt(0)" ::: "memory");
        }
    }
    __syncthreads();
}

template <class T> __device__ __forceinline__ T gld(const void* p) { return *(const GAS T*)p; }
template <class T> __device__ __forceinline__ void gst(void* p, const T& v) { *(GAS T*)p = v; }
__device__ __forceinline__ __amdgpu_buffer_rsrc_t mk_rsrc(const void* p) {
    const unsigned long long v = (unsigned long long)p;
    const unsigned lo = __builtin_amdgcn_readfirstlane((unsigned)v), hi = __builtin_amdgcn_readfirstlane((unsigned)(v >> 32));
    return __builtin_amdgcn_make_buffer_rsrc((void*)(((unsigned long long)hi << 32) | lo), 0, 0xFFFFFFF0u, 0x00020000);
}
__device__ __forceinline__ bf16x8 bld8(__amdgpu_buffer_rsrc_t r, unsigned voff, int soff) { const u32x4 v = __builtin_amdgcn_raw_buffer_load_b128(r, (int)voff, soff, 0); return __builtin_bit_cast(bf16x8, v); }
typedef __bf16 bf16x2v __attribute__((ext_vector_type(2)));
__device__ __forceinline__ unsigned cvtpk(float lo, float hi) { const f32x2 v = {lo, hi}; const bf16x2v r = __builtin_convertvector(v, bf16x2v); return __builtin_bit_cast(unsigned, r); }
__device__ __forceinline__ float bf_lo(unsigned u) { return __uint_as_float(u << 16); }
__device__ __forceinline__ float bf_hi(unsigned u) { return __uint_as_float(u & 0xffff0000u); }
__device__ __forceinline__ float bf2f(bf16_t b) { return __uint_as_float((unsigned)b << 16); }
__device__ __forceinline__ float wave_sum(float v) {
#pragma unroll
    for (int o = 32; o >= 1; o >>= 1) v += __shfl_xor(v, o);
    return v;
}
extern __shared__ __attribute__((aligned(16))) char g_lds[];
constexpr int LDS_BYTES = 163840;
constexpr int LDS_CTL = LDS_BYTES - 512;
__device__ __forceinline__ int olane() { return (int)__builtin_amdgcn_mbcnt_hi(~0u, __builtin_amdgcn_mbcnt_lo(~0u, 0u)); }
__device__ __forceinline__ int owid() { const unsigned slot = __builtin_amdgcn_s_getreg(63492) & 0x3fu; return __builtin_amdgcn_readfirstlane((int)((LAS unsigned char*)g_lds)[LDS_CTL + 416 + slot]); }
__device__ __forceinline__ int otid() { int t = (owid() << 6) | olane(); asm volatile("" : "+v"(t)); return t; }
__device__ __forceinline__ int oblk() { int b = blockIdx.x; asm volatile("" : "+s"(b)); return b; }
__device__ __forceinline__ char* ows(const char* w) { char* q = const_cast<char*>(w); asm volatile("" : "+s"(q)); return q; }
__device__ __forceinline__ int crow(int r, int hi) { return (r & 3) + 8 * (r >> 2) + 4 * hi; }


constexpr int GS = 72;
constexpr int KN_BS = 288;
constexpr int G8_BOFF = 256 * GS * 2;
constexpr int G8_STG = 2 * G8_BOFF;
constexpr int G8_ROWSS = 2 * G8_STG;
template <int MODE> struct BStage { bf16x8 v; };
template <> struct BStage<3> { f32x4 lo, hi; };
template <int MODE> __device__ __forceinline__ void load_b(BStage<MODE>& r, __amdgpu_buffer_rsrc_t rs, unsigned voff, int soff) { r.v = bld8(rs, voff, soff); }
template <> __device__ __forceinline__ void load_b<3>(BStage<3>& r, __amdgpu_buffer_rsrc_t rs, unsigned voff, int soff) {
    r.lo = __builtin_bit_cast(f32x4, __builtin_amdgcn_raw_buffer_load_b128(rs, (int)voff, soff, 0)); r.hi = __builtin_bit_cast(f32x4, __builtin_amdgcn_raw_buffer_load_b128(rs, (int)voff + 16, soff, 0)); }
template <> struct BStage<4> { f32x4 lo, hi; };
template <> __device__ __forceinline__ void load_b<4>(BStage<4>& r, __amdgpu_buffer_rsrc_t rs, unsigned voff, int soff) {
    r.lo = __builtin_bit_cast(f32x4, __builtin_amdgcn_raw_buffer_load_b128(rs, (int)voff, soff, 0)); r.hi = __builtin_bit_cast(f32x4, __builtin_amdgcn_raw_buffer_load_b128(rs, (int)voff + 16, soff, 0)); }
template <int MODE> __device__ __forceinline__ bf16x8 pack_b(const BStage<MODE>& r) { return r.v; }
template <> __device__ __forceinline__ bf16x8 pack_b<4>(const BStage<4>& r) {
    const u32x4 w = {cvtpk(r.lo[0], r.lo[1]), cvtpk(r.lo[2], r.lo[3]), cvtpk(r.hi[0], r.hi[1]), cvtpk(r.hi[2], r.hi[3])}; return __builtin_bit_cast(bf16x8, w); }
template <> __device__ __forceinline__ bf16x8 pack_b<3>(const BStage<3>& r) {
    const u32x4 w = {cvtpk(r.lo[0], r.lo[1]), cvtpk(r.lo[2], r.lo[3]), cvtpk(r.hi[0], r.hi[1]), cvtpk(r.hi[2], r.hi[3])}; return __builtin_bit_cast(bf16x8, w); }
template <int NI, int MODE, bool DEEP, bool AUNI, class EPI>
__device__ __forceinline__ void gemm8(LAS char* lds, const bf16_t* abase, const unsigned (&aoff)[4], int ajump, const bf16_t* bbase, int ldb, unsigned updelta, int nkt, const EPI& epi, int mrows = 256, GAS unsigned* next_ctr = nullptr, const void* bbase2 = nullptr) {
    static_assert((MODE != 2 && MODE != 4) || NI == 4, "the gate / up interleave assumes 256-column tiles");
    const int tid = otid(), lane = tid & 63, w = tid >> 6, l32 = lane & 31, hi = lane >> 5;
    const int wm = w >> 1, wn = w & 1;
    const bool act = 64 * wm < mrows;
    const int sr = tid >> 3, sc = (tid & 7) * 8;
    const int st_off = (sr * GS + sc) * 2;
    const int a_rd = ((wm * 64 + l32) * GS + hi * 8) * 2;
    const int g = lane >> 4, i16 = lane & 15;
    const int b_rd = G8_BOFF + (MODE == 0 ? ((wn * 32 * NI + l32) * GS + hi * 8) * 2 : ((8 * hi + (i16 >> 2)) * KN_BS + wn * 32 * NI + 16 * (g & 1) + 4 * (i16 & 3)) * 2);
    constexpr int NB_ = NI;
    const int adelta = AUNI ? __builtin_amdgcn_readfirstlane((int)(aoff[1] - aoff[0])) : 0;
    constexpr bool BUNI = MODE != 0 && MODE != 4 && NI == 4;
    f32x16 acc[2][NI];
#pragma unroll
    for (int i = 0; i < 2; ++i)
#pragma unroll
        for (int j = 0; j < NI; ++j)
#pragma unroll
            for (int r = 0; r < 16; ++r) acc[i][j][r] = 0.f;
    constexpr int BES = MODE >= 3 ? 4 : 2;
    bf16x8 ra[4]; BStage<MODE> rb[NB_];
    const __amdgpu_buffer_rsrc_t rsa = mk_rsrc(abase), rsb = mk_rsrc(bbase), rsb2 = mk_rsrc(MODE == 4 ? bbase2 : (const void*)bbase);
    unsigned bvo[NB_]; int blo[NB_];
#pragma unroll
    for (int i = 0; i < NB_; ++i) {
        if (MODE == 4) { const int c_ = (tid & 15) * 8; bvo[i] = (unsigned)((tid >> 4) * ldb + c_) * 4u; blo[i] = G8_BOFF + ((tid >> 4) * KN_BS + 64 * (c_ >> 5) + (c_ & 31)) * 2; }
        else if (MODE == 0) { bvo[i] = (unsigned)(sr * ldb + sc) * 2u; blo[i] = G8_BOFF + st_off + i * 64 * GS * 2; }
        else { const int ch = tid + 512 * i, brow = ch / (8 * NI), bc = (ch - brow * 8 * NI) * 8;
               const unsigned bcol = MODE == 2 ? (unsigned)(32 * (bc >> 6) + (bc & 31)) + (((bc >> 5) & 1) ? updelta : 0u) : (unsigned)bc;
               bvo[i] = ((unsigned)(brow * ldb) + bcol) * (unsigned)BES; blo[i] = G8_BOFF + (brow * KN_BS + bc) * 2; }
    }
    const int bstep = MODE == 0 ? 64 * ldb * 2 : 0;
#define G8_LOADR(RA, RB, KT) do { const int k_ = (KT) * 64; const int ao_ = 2 * ((k_ >> 7) * ajump + (k_ & 127)); \
        _Pragma("unroll") for (int i = 0; i < 4; ++i) RA[i] = bld8(rsa, 2u * (AUNI ? aoff[0] : aoff[i]), ao_ + (AUNI ? 2 * i * adelta : 0)); \
        _Pragma("unroll") for (int i = 0; i < NB_; ++i) { \
            if (MODE == 4) load_b<MODE>(RB[i], (i & 1) ? rsb2 : rsb, bvo[0], ((i >> 1) * 32 + k_) * ldb * 4); \
            else load_b<MODE>(RB[i], rsb, BUNI ? bvo[0] : bvo[i], i * bstep + (BUNI ? i * 16 * ldb * BES : 0) + (MODE == 0 ? 2 * k_ : k_ * ldb * BES)); } } while (0)
#define G8_WRITER(RA, RB, ST) do { LAS char* s_ = lds + (ST) * G8_STG; \
        _Pragma("unroll") for (int i = 0; i < 4; ++i) *(LAS bf16x8*)(s_ + st_off + i * 64 * GS * 2) = RA[i]; \
        _Pragma("unroll") for (int i = 0; i < NB_; ++i) *(LAS bf16x8*)(s_ + (MODE == 4 ? blo[0] + ((i >> 1) * 32 * KN_BS + 32 * (i & 1)) * 2 : (BUNI ? blo[0] + i * 16 * KN_BS * 2 : blo[i]))) = pack_b<MODE>(RB[i]); } while (0)
#define G8_RDF(AF, BF, KS) do { \
        _Pragma("unroll") for (int i = 0; i < 2; ++i) AF[i] = *(const LAS bf16x8*)(s_ + a_rd + i * 32 * GS * 2 + (KS) * 32); \
        _Pragma("unroll") for (int j = 0; j < NI; ++j) { \
            if (MODE == 0) BF[j] = *(const LAS bf16x8*)(s_ + b_rd + j * 32 * GS * 2 + (KS) * 32); \
            else { const s16x4 v0 = __builtin_amdgcn_ds_read_tr16_b64_v4i16((LAS s16x4*)(s_ + b_rd + (KS) * 16 * KN_BS * 2 + j * 64)); \
                   const s16x4 v1 = __builtin_amdgcn_ds_read_tr16_b64_v4i16((LAS s16x4*)(s_ + b_rd + ((KS) * 16 + 4) * KN_BS * 2 + j * 64)); \
                   BF[j] = (bf16x8){v0[0], v0[1], v0[2], v0[3], v1[0], v1[1], v1[2], v1[3]}; } } } while (0)
#define G8_MMA(AF, BF) do { _Pragma("unroll") for (int i = 0; i < 2; ++i) _Pragma("unroll") for (int j = 0; j < NI; ++j) acc[i][j] = __builtin_amdgcn_mfma_f32_32x32x16_bf16(BF[j], AF[i], acc[i][j], 0, 0, 0); } while (0)
#define G8_ILV do { if (BUNI && AUNI && MODE < 3) { _Pragma("unroll") for (int q_ = 0; q_ < 2 * NI; ++q_) { __builtin_amdgcn_sched_group_barrier(0x008, 1, 0); __builtin_amdgcn_sched_group_barrier(0x100, 2, 0); } } } while (0)
#define G8_STEP(DOW, RA, RB, WST, CST, NXT) do { const LAS char* s_ = lds + (CST) * G8_STG; LAS char* w_ = lds + (WST) * G8_STG; \
        bf16x8 af0[2], bf0[NI]; \
        G8_RDF(af0, bf0, 0); \
        __builtin_amdgcn_sched_barrier(0); \
        if (DOW) { _Pragma("unroll") for (int i = 0; i < 4; ++i) *(LAS bf16x8*)(w_ + st_off + i * 64 * GS * 2) = RA[i]; \
                   _Pragma("unroll") for (int i = 0; i < NB_; ++i) *(LAS bf16x8*)(w_ + (MODE == 4 ? blo[0] + ((i >> 1) * 32 * KN_BS + 32 * (i & 1)) * 2 : (BUNI ? blo[0] + i * 16 * KN_BS * 2 : blo[i]))) = pack_b<MODE>(RB[i]); \
                   G8_LOADR(RA, RB, NXT); } \
        __builtin_amdgcn_sched_barrier(0); \
        if (MODE >= 3) {                        \
            G8_MMA(af0, bf0); \
            _Pragma("unroll") for (int ks_ = 1; ks_ < 4; ++ks_) { __builtin_amdgcn_sched_barrier(0); G8_RDF(af0, bf0, ks_); G8_MMA(af0, bf0); } \
        } else { bf16x8 af1[2], bf1[NI]; \
        G8_RDF(af1, bf1, 1); G8_MMA(af0, bf0); G8_ILV; \
        __builtin_amdgcn_sched_barrier(0); \
        G8_RDF(af0, bf0, 2); G8_MMA(af1, bf1); G8_ILV; \
        __builtin_amdgcn_sched_barrier(0); \
        G8_RDF(af1, bf1, 3); G8_MMA(af0, bf0); G8_ILV; \
        __builtin_amdgcn_sched_barrier(0); \
        G8_MMA(af1, bf1); } } while (0)
    if (DEEP) {
        const int last = nkt - 1;
#define G8_CL(x) ((x) < last ? (x) : last)
        G8_LOADR(ra, rb, 0);
        G8_WRITER(ra, rb, 0);
        __syncthreads();
        G8_LOADR(ra, rb, G8_CL(1));
        for (int kt = 0; kt < nkt; kt += 2) {
            G8_STEP(1, ra, rb, 1, 0, G8_CL(kt + 2));
            __syncthreads();
            G8_STEP(1, ra, rb, 0, 1, G8_CL(kt + 3));
            __syncthreads();
        }
        asm volatile("s_waitcnt vmcnt(0)" ::: "memory");
#undef G8_CL
    } else {
        G8_LOADR(ra, rb, 0);
        G8_WRITER(ra, rb, 0);
        __syncthreads();
        for (int kt = 0; kt < nkt; ++kt) {
            const int cur = kt & 1; const bool more = kt + 1 < nkt;
            if (more) G8_LOADR(ra, rb, kt + 1);
            G8_STEP(0, ra, rb, 0, cur, 0);
            if (more) G8_WRITER(ra, rb, cur ^ 1);
            __syncthreads();
        }
    }
#undef G8_LOADR
#undef G8_WRITER
#undef G8_STEP
#undef G8_ILV
#undef G8_MMA
#undef G8_RDF
    int nx = 0;
    if (next_ctr && tid == 0) nx = (int)__hip_atomic_fetch_add(next_ctr, 1u, __ATOMIC_RELAXED, __HIP_MEMORY_SCOPE_AGENT);
    epi(acc, wm, wn, l32, hi, lds);
    if (next_ctr && tid == 0) *(volatile LAS int*)(lds + LDS_CTL + 64) = nx;
}
template <int K> __device__ __forceinline__ void row_sumsq(LAS char* lds, const bf16_t* A, int ld) {
    const int tid = otid(), row = tid >> 1, half = tid & 1;
    const bf16_t* ptr = A + (size_t)row * ld + half * (K / 2);
    float ss = 0.f;
#pragma unroll
    for (int c = 0; c < K / 16; ++c) { const u32x4 v = gld<u32x4>(ptr + c * 8);
#pragma unroll
        for (int j = 0; j < 4; ++j) { const float a = bf_lo(v[j]), b = bf_hi(v[j]); ss += a * a + b * b; } }
    ss += __shfl_xor(ss, 1);
    __syncthreads();
    if (half == 0) ((LAS float*)(lds + G8_ROWSS))[row] = ss;
}
__device__ __forceinline__ void store_bf4(bf16_t* p, float a, float b, float c, float d) { u32x2 w; w.x = cvtpk(a, b); w.y = cvtpk(c, d); gst<u32x2>(p, w); }

__device__ __forceinline__ void store_bf4_wt(bf16_t* p, float a, float b, float c, float d) {
    const unsigned long long w = (unsigned long long)cvtpk(a, b) | ((unsigned long long)cvtpk(c, d) << 32);
    __hip_atomic_store((GAS unsigned long long*)p, w, __ATOMIC_RELAXED, __HIP_MEMORY_SCOPE_AGENT);
}
__device__ __forceinline__ void tile_to_lds(LAS bf16_t* T, const f32x16 (&a)[4], int rl, int wn, int hi, float sc) {
    LAS bf16_t* tp = T + rl * 264 + 128 * wn + 4 * hi;
#pragma unroll
    for (int ni = 0; ni < 4; ++ni)
#pragma unroll
        for (int q = 0; q < 4; ++q) { u32x2 w2; w2.x = cvtpk(a[ni][4 * q] * sc, a[ni][4 * q + 1] * sc); w2.y = cvtpk(a[ni][4 * q + 2] * sc, a[ni][4 * q + 3] * sc); *(LAS u32x2*)(tp + 32 * ni + 8 * q) = w2; }
}
__device__ __forceinline__ void store_tiles4(bf16_t* p, const f32x16 (&a)[4], float sc) {
#pragma unroll
    for (int ni = 0; ni < 4; ++ni)
#pragma unroll
        for (int q = 0; q < 4; ++q) store_bf4(p + 32 * ni + 8 * q, a[ni][4 * q] * sc, a[ni][4 * q + 1] * sc, a[ni][4 * q + 2] * sc, a[ni][4 * q + 3] * sc);
}
__device__ __forceinline__ void rope_pair32(f32x16& lo, f32x16& hi16, const f32x2* cs32, int pos, int hi, bool on = true) {
#pragma unroll
    for (int r = 0; r < 16; ++r) { f32x2 cs = {1.f, 0.f}; if (on) cs = gld<f32x2>(cs32 + pos * 32 + crow(r, hi)); const float x1 = lo[r], x2 = hi16[r]; lo[r] = x1 * cs.x - x2 * cs.y; hi16[r] = x2 * cs.x + x1 * cs.y; }
}
__device__ __forceinline__ void rope_first32(f32x16& t, const f32x2* cs16, int pos, int hi) {
#pragma unroll
    for (int r = 0; r < 8; ++r) { const f32x2 cs = gld<f32x2>(cs16 + pos * 16 + crow(r, hi)); const float x1 = t[r], x2 = t[r + 8]; t[r] = x1 * cs.x - x2 * cs.y; t[r + 8] = x2 * cs.x + x1 * cs.y; }
}
__device__ __forceinline__ bool is_rope16(int c0) {
    return (((c0 - C_DQ) & 127) == 0) && ((c0 >= C_DQ && c0 < C_DV) || (c0 >= C_NQ && c0 < C_NKC) || c0 == C_NKS || c0 == C_NKW);
}
struct EpiWin {
    bf16_t* H; float* gates; const f32x2* cs16; const f32x2* cs32; int m0, n0;
    __device__ __forceinline__ void operator()(f32x16 (&acc)[2][3], int wm, int wn, int l32, int hi, LAS char* lds) const {
        const int nw = n0 + 96 * wn;
        LAS bf16_t* T = (LAS bf16_t*)lds;
#pragma unroll
        for (int mi = 0; mi < 2; ++mi) {
            const int row = m0 + 64 * wm + 32 * mi + l32, pos = row & (SEQ - 1);
            if (nw + 32 == C_KROPE) rope_pair32(acc[mi][1], acc[mi][2], cs32, pos, hi);
#pragma unroll
            for (int ni = 0; ni < 3; ++ni) if (is_rope16(nw + 32 * ni)) rope_first32(acc[mi][ni], cs16, pos, hi);
            if (nw == C_GATE) {
#pragma unroll
                for (int r = 0; r < 16; ++r) { const int c = crow(r, hi); if (c < 18) gst<float>(gates + (size_t)row * 18 + c, 1.f / (1.f + __expf(-acc[mi][0][r]))); }
            }
            LAS bf16_t* tp = T + (64 * wm + 32 * mi + l32) * 200 + 96 * wn + 4 * hi;
#pragma unroll
            for (int ni = 0; ni < 3; ++ni)
#pragma unroll
                for (int q = 0; q < 4; ++q) { u32x2 w2; w2.x = cvtpk(acc[mi][ni][4 * q], acc[mi][ni][4 * q + 1]); w2.y = cvtpk(acc[mi][ni][4 * q + 2], acc[mi][ni][4 * q + 3]); *(LAS u32x2*)(tp + 32 * ni + 8 * q) = w2; }
        }
        __syncthreads();
        const int tid = otid();
#pragma unroll
        for (int k = 0; k < 12; ++k) { const int idx = tid + 512 * k, r = idx / 24, c = idx - r * 24;
            const u32x4 v = *(const LAS u32x4*)(T + r * 200 + 8 * c); gst<u32x4>(H + (size_t)(m0 + r) * LDH + n0 + 8 * c, v); }
        __syncthreads();
    }
};
struct EpiQup {
    bf16_t* Q; const f32x2* cs32; int m0, n0;
    __device__ __forceinline__ void operator()(f32x16 (&acc)[2][4], int wm, int wn, int l32, int hi, LAS char* lds) const {
        const int nw = n0 + 128 * wn; const LAS float* rs = (const LAS float*)(lds + G8_ROWSS);
#pragma unroll
        for (int mi = 0; mi < 2; ++mi) {
            const int rl = 64 * wm + 32 * mi + l32, row = m0 + rl, pos = row & (SEQ - 1);
            const float sc = __builtin_amdgcn_rsqf(rs[rl] * (1.f / 384.f) + 1e-6f);
#pragma unroll
            for (int ni = 0; ni < 4; ++ni)
#pragma unroll
                for (int r = 0; r < 16; ++r) acc[mi][ni][r] *= sc;
            rope_pair32(acc[mi][0], acc[mi][1], cs32, pos, hi, (nw % 192) == 128);
            rope_pair32(acc[mi][2], acc[mi][3], cs32, pos, hi, ((nw + 64) % 192) == 128);
            tile_to_lds((LAS bf16_t*)lds, acc[mi], rl, wn, hi, 1.f);
        }
        __syncthreads();
        const int tid = otid();
#pragma unroll
        for (int k = 0; k < 16; ++k) { const int idx = tid + 512 * k, r = idx >> 5, c = idx & 31;
            const u32x4 v = *(const LAS u32x4*)((LAS bf16_t*)lds + r * 264 + 8 * c); gst<u32x4>(Q + (size_t)(m0 + r) * 768 + n0 + 8 * c, v); }
        __syncthreads();
    }
};
struct EpiKVup {
    bf16_t* Kn; int m0, n0;
    __device__ __forceinline__ void operator()(f32x16 (&acc)[2][4], int wm, int wn, int l32, int hi, LAS char* lds) const {
        const int nw = n0 + 128 * wn; const LAS float* rs = (const LAS float*)(lds + G8_ROWSS);
        const int head = nw >> 8, within = nw & 255;
        (void)within;
#pragma unroll
        for (int mi = 0; mi < 2; ++mi) {
            const int rl = 64 * wm + 32 * mi + l32;
            const float sc = __builtin_amdgcn_rsqf(rs[rl] * (1.f / 128.f) + 1e-6f);
            tile_to_lds((LAS bf16_t*)lds, acc[mi], rl, wn, hi, sc);
        }
        __syncthreads();
        const int tid = otid();
#pragma unroll
        for (int k = 0; k < 16; ++k) { const int idx = tid + 512 * k, r = idx >> 5, c = idx & 31;
            const u32x4 v = *(const LAS u32x4*)((LAS bf16_t*)lds + r * 264 + 8 * c);
            gst<u32x4>(Kn + (c < 16 ? (size_t)0 : (size_t)NT * 512) + (size_t)(m0 + r) * 512 + head * 128 + 8 * (c & 15), v); }
        __syncthreads();
    }
};
__device__ __forceinline__ float gelu_tanh(float x) {
    const float u = 0.7978845608028654f * (x + 0.044715f * x * x * x);
    const float e = __expf(-2.f * fabsf(u)); const float t = (1.f - e) / (1.f + e);
    return 0.5f * x * (1.f + (u < 0.f ? -t : t));
}
struct EpiCmp1 {
    float* P; int m0;
    __device__ __forceinline__ void operator()(f32x16 (&acc)[2][4], int wm, int wn, int l32, int hi, LAS char*) const {
#pragma unroll
        for (int mi = 0; mi < 2; ++mi) {
            float* p = P + (size_t)(m0 + 64 * wm + 32 * mi + l32) * 256 + 128 * wn + 4 * hi;
#pragma unroll
            for (int ni = 0; ni < 4; ++ni)
#pragma unroll
                for (int q = 0; q < 4; ++q) { f32x4 v = {acc[mi][ni][4 * q], acc[mi][ni][4 * q + 1], acc[mi][ni][4 * q + 2], acc[mi][ni][4 * q + 3]}; gst<f32x4>(p + 32 * ni + 8 * q, v); }
        }
    }
};
struct EpiCmp2 {
    bf16_t* O; const f32x2* cs16; int dorope; int m0;
    __device__ __forceinline__ void operator()(f32x16 (&acc)[2][4], int wm, int wn, int l32, int hi, LAS char*) const {
        if (wn != 0) return;
#pragma unroll
        for (int mi = 0; mi < 2; ++mi) {
            const int row = m0 + 64 * wm + 32 * mi + l32, c = row & 127, pos = 16 * c + 31;
            if (dorope && c < 127) rope_first32(acc[mi][0], cs16, pos, hi);
            store_tiles4(O + (size_t)row * 128 + 4 * hi, acc[mi], c < 127 ? 1.f : 0.f);
        }
    }
};
constexpr int CTR_RT = 288;
constexpr int CTR_LN1 = 320;
struct EpiOut {
    float* X1; bf16_t* X1B; const float* X; const float* g; const float* bb; f32x2* stat; GAS unsigned* ctr; int m0, n0;
    __device__ __forceinline__ void operator()(f32x16 (&acc)[2][4], int wm, int wn, int l32, int hi, LAS char* lds) const {
        const int nw = n0 + 128 * wn, mt = m0 >> 8, nt = n0 >> 8;
        float s1[2], s2[2];
#pragma unroll
        for (int mi = 0; mi < 2; ++mi) {
            const size_t off = (size_t)(m0 + 64 * wm + 32 * mi + l32) * DM + nw + 4 * hi;
            float a1 = 0.f, a2 = 0.f;
#pragma unroll
            for (int ni = 0; ni < 4; ++ni)
#pragma unroll
                for (int q = 0; q < 4; ++q) { const f32x4 xv = gld<f32x4>(X + off + 32 * ni + 8 * q);
#pragma unroll
                    for (int j = 0; j < 4; ++j) { const float y = DN_ALPHA * xv[j] + acc[mi][ni][4 * q + j]; acc[mi][ni][4 * q + j] = y; a1 += y; a2 += y * y; }
                    if (q == 3) asm volatile("" ::: "memory"); }
            s1[mi] = a1 + __shfl_xor(a1, 32); s2[mi] = a2 + __shfl_xor(a2, 32);
        }
        LAS f32x2* red = (LAS f32x2*)lds;
        if (hi == 0) {
#pragma unroll
            for (int mi = 0; mi < 2; ++mi) red[(64 * wm + 32 * mi + l32) * 2 + wn] = (f32x2){s1[mi], s2[mi]};
        }
        __syncthreads();
        if (wn == 0 && hi == 0) {
#pragma unroll
            for (int mi = 0; mi < 2; ++mi) { const int rl = 64 * wm + 32 * mi + l32; const f32x2 a = red[rl * 2], b = red[rl * 2 + 1];
                const unsigned long long w = (unsigned long long)__float_as_uint(a.x + b.x) | ((unsigned long long)__float_as_uint(a.y + b.y) << 32);
                __hip_atomic_store((GAS unsigned long long*)(stat + ((size_t)(mt * 8 + nt) * 256 + rl)), w, __ATOMIC_RELAXED, __HIP_MEMORY_SCOPE_AGENT); }
        }
        asm volatile("s_waitcnt vmcnt(0)" ::: "memory");
        __syncthreads();
        if (otid() == 0) { (void)__hip_atomic_fetch_add(ctr + mt, 1u, __ATOMIC_RELAXED, __HIP_MEMORY_SCOPE_AGENT);
            unsigned sp = 0u; while (__hip_atomic_load(ctr + mt, __ATOMIC_RELAXED, __HIP_MEMORY_SCOPE_AGENT) < 8u) { __builtin_amdgcn_s_sleep(1); if (++sp > (1u << 24)) break; }
            __builtin_amdgcn_fence(__ATOMIC_ACQUIRE, "agent"); }
        __syncthreads();
        LAS float* T = (LAS float*)lds; LAS f32x2* MR = (LAS f32x2*)(lds + 128 * 260 * 4);
        const int tid = otid(), c4 = tid & 63;
        const f32x4 gv = gld<f32x4>(g + n0 + 4 * c4), bv = gld<f32x4>(bb + n0 + 4 * c4);
#pragma unroll
        for (int mi = 0; mi < 2; ++mi) {
            const int rl = 64 * wm + 32 * mi + l32, lr = 32 * wm + l32;
            float t1 = 0.f, t2 = 0.f;
#pragma unroll
            for (int k = 0; k < 8; ++k) { const f32x2 v = gld<f32x2>(stat + ((size_t)(mt * 8 + k) * 256 + rl)); t1 += v.x; t2 += v.y; }
            const float mu = t1 * (1.f / DM), var = t2 * (1.f / DM) - mu * mu, rstd = 1.f / sqrtf(fmaxf(var, 0.f) + 1e-5f);
            if (mi == 1) __syncthreads();
            if (wn == 0 && hi == 0) MR[lr] = (f32x2){mu, rstd};
#pragma unroll
            for (int ni = 0; ni < 4; ++ni)
#pragma unroll
                for (int q = 0; q < 4; ++q) *(LAS f32x4*)(T + lr * 260 + 128 * wn + 32 * ni + 8 * q + 4 * hi) = (f32x4){acc[mi][ni][4 * q], acc[mi][ni][4 * q + 1], acc[mi][ni][4 * q + 2], acc[mi][ni][4 * q + 3]};
            __syncthreads();
#pragma unroll
            for (int k = 0; k < 16; ++k) { const int lrow = (tid >> 6) + 8 * k;
                const f32x4 y = *(const LAS f32x4*)(T + lrow * 260 + 4 * c4); const f32x2 mr = MR[lrow];
                f32x4 o;
#pragma unroll
                for (int j = 0; j < 4; ++j) o[j] = (y[j] - mr.x) * mr.y * gv[j] + bv[j];
                const size_t off = (size_t)(m0 + 64 * (lrow >> 5) + 32 * mi + (lrow & 31)) * DM + n0 + 4 * c4;
                gst<f32x4>(X1 + off, o); store_bf4(X1B + off, o[0], o[1], o[2], o[3]); }
        }
    }
};
struct EpiMoe1 {
    bf16_t* Hm; int rowbase, nvalid, n0;
    __device__ __forceinline__ void operator()(f32x16 (&acc)[2][4], int wm, int wn, int l32, int hi, LAS char*) const {
        const int ff0 = (n0 + 128 * wn) >> 1;
#pragma unroll
        for (int mi = 0; mi < 2; ++mi) {
            const int rl = 64 * wm + 32 * mi + l32;
            if (rl < nvalid) {
                bf16_t* p = Hm + (size_t)(rowbase + rl) * EFF + ff0 + 4 * hi;
#pragma unroll
                for (int h2 = 0; h2 < 2; ++h2)
#pragma unroll
                    for (int q = 0; q < 4; ++q) { float v[4];
#pragma unroll
                        for (int j = 0; j < 4; ++j) { const float g = acc[mi][2 * h2][4 * q + j], u = acc[mi][2 * h2 + 1][4 * q + j]; v[j] = g / (1.f + __expf(-g)) * u; }
                        store_bf4_wt(p + 32 * h2 + 8 * q, v[0], v[1], v[2], v[3]); }
            }
        }
    }
};
struct EpiMoe2 {
    bf16_t* Y; const int* list; const float* gw; int nvalid, n0;
    __device__ __forceinline__ void operator()(f32x16 (&acc)[2][4], int wm, int wn, int l32, int hi, LAS char* lds) const {
        LAS bf16_t* T = (LAS bf16_t*)lds; LAS int* SL = (LAS int*)(lds + 256 * 264 * 2);
        const int tid = otid();
        if (tid < 256) SL[tid] = gld<int>(list + (tid < nvalid ? tid : 0));
#pragma unroll
        for (int mi = 0; mi < 2; ++mi) {
            const int rl = 64 * wm + 32 * mi + l32;
            const float sc = gld<float>(gw + gld<int>(list + (rl < nvalid ? rl : 0)));
            LAS bf16_t* tp = T + rl * 264 + 128 * wn + 4 * hi;
#pragma unroll
            for (int ni = 0; ni < 4; ++ni)
#pragma unroll
                for (int q = 0; q < 4; ++q) { u32x2 w2; w2.x = cvtpk(acc[mi][ni][4 * q] * sc, acc[mi][ni][4 * q + 1] * sc); w2.y = cvtpk(acc[mi][ni][4 * q + 2] * sc, acc[mi][ni][4 * q + 3] * sc);
                    *(LAS u32x2*)(tp + 32 * ni + 8 * q) = w2; }
        }
        __syncthreads();
#pragma unroll
        for (int k = 0; k < 16; ++k) { const int idx = tid + 512 * k, r = idx >> 5, c = idx & 31;
            if (r < nvalid) { const u32x4 v = *(const LAS u32x4*)(T + r * 264 + 8 * c); gst<u32x4>(Y + (size_t)SL[r] * DM + n0 + 8 * c, v); } }
        __syncthreads();
    }
};

constexpr int VS = 160;
struct KeySrc { const bf16_t* k0; size_t kstride; const bf16_t* kr; size_t krstride; const bf16_t* v0; size_t vstride; };

template <int DQK> struct AttnRegs { bf16x8 k[DQK / 8 * 64 / 256]; bf16x8 v[4]; };
template <int DQK> struct AttnSrc { __amdgpu_buffer_rsrc_t rk, rr, rv; unsigned ko[DQK / 8 * 64 / 256]; unsigned vo[4]; unsigned ktile, rtile, vtile; };
template <int DQK> __device__ __forceinline__ AttnSrc<DQK> attn_src(const KeySrc& ks, int tid) {
    constexpr int KCH = DQK / 8, NKL = KCH * 64 / 256;
    AttnSrc<DQK> a; a.rk = mk_rsrc(ks.k0); a.rr = mk_rsrc(ks.kr); a.rv = mk_rsrc(ks.v0);
#pragma unroll
    for (int i = 0; i < NKL; ++i) { const int idx = tid + i * 256, key = idx / KCH, ch = idx - key * KCH;
        a.ko[i] = (DQK == 128 || ch < 16) ? (unsigned)(key * (unsigned)ks.kstride + ch * 8) * 2u : (unsigned)(key * (unsigned)ks.krstride + (ch - 16) * 8) * 2u; }
#pragma unroll
    for (int i = 0; i < 4; ++i) { const int idx = tid + i * 256, key = idx >> 4, ch = idx & 15; a.vo[i] = (unsigned)(key * (unsigned)ks.vstride + ch * 8) * 2u; }
    a.ktile = (unsigned)__builtin_amdgcn_readfirstlane((int)(128u * (unsigned)ks.kstride)); a.rtile = (unsigned)__builtin_amdgcn_readfirstlane((int)(128u * (unsigned)ks.krstride));
    a.vtile = (unsigned)__builtin_amdgcn_readfirstlane((int)(128u * (unsigned)ks.vstride));
    return a;
}
template <int DQK> __device__ __forceinline__ void attn_gload(const AttnSrc<DQK>& a, int jt, AttnRegs<DQK>& R, bool withv, int tid) {
    constexpr int KCH = DQK / 8, NKL = KCH * 64 / 256;
#pragma unroll
    for (int i = 0; i < NKL; ++i) { const int idx = tid + i * 256, key = idx / KCH, ch = idx - key * KCH;
        R.k[i] = (DQK == 128 || ch < 16) ? bld8(a.rk, a.ko[i], (int)(jt * a.ktile)) : bld8(a.rr, a.ko[i], (int)(jt * a.rtile)); }
    if (withv) {
#pragma unroll
        for (int i = 0; i < 4; ++i) R.v[i] = bld8(a.rv, a.vo[i], (int)(jt * a.vtile));
    }
}
template <int DQK> __device__ __forceinline__ void attn_lwrite(LAS char* lds, const AttnRegs<DQK>& R, bool withv, int tid) {
    constexpr int KS = DQK + 8, KCH = DQK / 8, NKL = KCH * 64 / 256;
#pragma unroll
    for (int i = 0; i < NKL; ++i) { const int idx = tid + i * 256, key = idx / KCH, ch = idx - key * KCH; *(LAS bf16x8*)(lds + (key * KS + ch * 8) * 2) = R.k[i]; }
    if (withv) {
#pragma unroll
        for (int i = 0; i < 4; ++i) { const int idx = tid + i * 256, key = idx >> 4, ch = idx & 15; *(LAS bf16x8*)(lds + 64 * KS * 2 + (key * VS + ch * 8) * 2) = R.v[i]; }
    }
}
template <int DQK> __device__ __forceinline__ void attn_stage(LAS char* lds, const AttnSrc<DQK>& a, int jt, bool withv, int tid) { AttnRegs<DQK> R; attn_gload<DQK>(a, jt, R, withv, tid); attn_lwrite<DQK>(lds, R, withv, tid); }
template <int DQK> __device__ __forceinline__ void attn_scores(const LAS char* lds, const bf16x8 (&qf)[DQK / 16], f32x16& p0, f32x16& p1, int l32, int hi) {
    constexpr int KS = DQK + 8;
    const int sg = (l32 & ~12) | ((l32 & 4) << 1) | ((l32 & 8) >> 1);
    const LAS char* kb = lds + (sg * KS + hi * 8) * 2;
#pragma unroll
    for (int r = 0; r < 16; ++r) { p0[r] = 0.f; p1[r] = 0.f; }
#pragma unroll
    for (int ds = 0; ds < DQK / 16; ++ds) {
        const bf16x8 a0 = *(const LAS bf16x8*)(kb + ds * 32), a1 = *(const LAS bf16x8*)(kb + 32 * KS * 2 + ds * 32);
        p0 = __builtin_amdgcn_mfma_f32_32x32x16_bf16(a0, qf[ds], p0, 0, 0, 0);
        p1 = __builtin_amdgcn_mfma_f32_32x32x16_bf16(a1, qf[ds], p1, 0, 0, 0);
    }
}
constexpr int ATT_HALF = 47104;
template <int DQK, bool SEL>
__device__ __forceinline__ void attn_run(LAS char* lds, const KeySrc& ks, int jt_lo, int jt_hi, unsigned tile_union, const bf16x8 (&qf)[DQK / 16],
                                         int qi, unsigned maxd, unsigned sel, float c2, f32x16 (&o)[4], float& m_run, float& l_run, int tid, int jstep = 1) {
    constexpr int KS = DQK + 8;
    const int tl = tid & 255, kg = tid >> 8, lane = tid & 63, l32 = lane & 31, hi = lane >> 5;
    const int g = lane >> 4, i16 = lane & 15;
    LAS char* L = lds + kg * ATT_HALF;
    const LAS char* vb = (L + 64 * KS * 2 + ((8 * hi + (i16 >> 2)) * VS + 16 * (g & 1) + 4 * (i16 & 3)) * 2);
    const float NEG = -__builtin_inff();
    int qmin = qi, qmax = qi;
#pragma unroll
    for (int sft = 32; sft >= 1; sft >>= 1) { qmin = min(qmin, __shfl_xor(qmin, sft)); qmax = max(qmax, __shfl_xor(qmax, sft)); }
    const AttnSrc<DQK> asrc = attn_src<DQK>(ks, tl);
    int nmine = 0;
    if (SEL) { nmine = __builtin_popcount(jt_hi >= 32 ? tile_union : (tile_union & ((1u << jt_hi) - 1u)) & ~((1u << jt_lo) - 1u)); if (jstep == 2) nmine = (nmine + 1 - kg) >> 1; } else nmine = jt_hi > jt_lo ? (jt_hi - jt_lo + jstep - 1) / jstep : 0;
    LAS int* trips = (LAS int*)(lds + LDS_CTL + 96);
    __syncthreads();
    if (tl == 0) trips[kg] = nmine;
    __syncthreads();
    const int ntrip = max(trips[0], trips[1]);
    int jt = jt_lo;
    if (SEL) { while (jt < jt_hi && !((tile_union >> jt) & 1u)) ++jt;
        if (jstep == 2 && kg == 1) { ++jt; while (jt < jt_hi && !((tile_union >> jt) & 1u)) ++jt; } }
    for (int trip = 0; trip < ntrip; ++trip) {
        jt = __builtin_amdgcn_readfirstlane(jt);
        const bool have = jt < jt_hi;
        if (have) attn_stage<DQK>(L, asrc, jt, true, tl);
        __syncthreads();
        if (have) {
        f32x16 p0, p1;
        attn_scores<DQK>(L, qf, p0, p1, l32, hi);
        const bool ok = SEL ? (((sel >> jt) & 1u) != 0u) : true;
        const bool interior = (qmin - (jt * 64 + 63) >= 0) && ((unsigned)(qmax - jt * 64) <= maxd) && (SEL ? __all(ok) : true);
        float mx = NEG;
        if (interior) {
#pragma unroll
            for (int r = 0; r < 16; ++r) mx = fmaxf(mx, fmaxf(p0[r], p1[r]));
        } else {
            const int dq = qi - jt * 64 - 8 * hi;
#pragma unroll
            for (int r = 0; r < 16; ++r) {
                const int ko = 16 * (r >> 3) + (r & 7);
                const float s0 = (ok && (unsigned)(dq - ko) <= maxd) ? p0[r] : NEG;
                const float s1 = (ok && (unsigned)(dq - ko - 32) <= maxd) ? p1[r] : NEG;
                p0[r] = s0; p1[r] = s1; mx = fmaxf(mx, fmaxf(s0, s1));
            }
        }
        mx = fmaxf(mx, __shfl_xor(mx, 32));
        const float mn = fmaxf(m_run, mx * c2);
        const float alpha = __builtin_amdgcn_exp2f(m_run - mn);
        const float nmn = -mn;
        float rs = 0.f;
#pragma unroll
        for (int r = 0; r < 16; ++r) { p0[r] = __builtin_amdgcn_exp2f(fmaf(p0[r], c2, nmn)); p1[r] = __builtin_amdgcn_exp2f(fmaf(p1[r], c2, nmn)); rs += p0[r] + p1[r]; }
        rs += __shfl_xor(rs, 32);
        l_run = l_run * alpha + rs; m_run = mn;
        if (!__all(alpha == 1.f)) {
#pragma unroll
            for (int dt = 0; dt < 4; ++dt)
#pragma unroll
                for (int r = 0; r < 16; ++r) o[dt][r] *= alpha;
        }
#pragma unroll
        for (int s4 = 0; s4 < 4; ++s4) {
            u32x4 pw;
            if (s4 == 0)      { pw.x = cvtpk(p0[0], p0[1]);  pw.y = cvtpk(p0[2], p0[3]);   pw.z = cvtpk(p0[4], p0[5]);   pw.w = cvtpk(p0[6], p0[7]); }
            else if (s4 == 1) { pw.x = cvtpk(p0[8], p0[9]);  pw.y = cvtpk(p0[10], p0[11]); pw.z = cvtpk(p0[12], p0[13]); pw.w = cvtpk(p0[14], p0[15]); }
            else if (s4 == 2) { pw.x = cvtpk(p1[0], p1[1]);  pw.y = cvtpk(p1[2], p1[3]);   pw.z = cvtpk(p1[4], p1[5]);   pw.w = cvtpk(p1[6], p1[7]); }
            else              { pw.x = cvtpk(p1[8], p1[9]);  pw.y = cvtpk(p1[10], p1[11]); pw.z = cvtpk(p1[12], p1[13]); pw.w = cvtpk(p1[14], p1[15]); }
            const bf16x8 pb = *reinterpret_cast<bf16x8*>(&pw);
#pragma unroll
            for (int dt = 0; dt < 4; ++dt) {
                const s16x4 v0 = __builtin_amdgcn_ds_read_tr16_b64_v4i16((LAS s16x4*)(vb + (s4 * 16 * VS + dt * 32) * 2));
                const s16x4 v1 = __builtin_amdgcn_ds_read_tr16_b64_v4i16((LAS s16x4*)(vb + (s4 * 16 * VS + 4 * VS + dt * 32) * 2));
                const bf16x8 va = {v0[0], v0[1], v0[2], v0[3], v1[0], v1[1], v1[2], v1[3]};
                o[dt] = __builtin_amdgcn_mfma_f32_32x32x16_bf16(va, pb, o[dt], 0, 0, 0);
            }
        }
        }
        __syncthreads();
        if (SEL) { ++jt; while (jt < jt_hi && !((tile_union >> jt) & 1u)) ++jt;
            if (jstep == 2) { ++jt; while (jt < jt_hi && !((tile_union >> jt) & 1u)) ++jt; } }
        else jt += jstep;
    }
}
template <int DQK> __device__ __forceinline__ void load_q(const bf16_t* qptr, int hi, bf16x8 (&qf)[DQK / 16]) {
#pragma unroll
    for (int ds = 0; ds < DQK / 16; ++ds) qf[ds] = gld<bf16x8>(qptr + ds * 16 + hi * 8);
}
__device__ __forceinline__ void load_q_t(const bf16_t* p0, size_t rstride, int l32, int hi, bf16x8 (&qf)[8], LAS char* wl) {
    const int lane = l32 + 32 * hi;
    u32x4 v[8];
#pragma unroll
    for (int k = 0; k < 8; ++k) { const int idx = lane + 64 * k, r = idx >> 4, c = idx & 15; v[k] = gld<u32x4>(p0 + (size_t)r * rstride + 8 * c); }
#pragma unroll
    for (int k = 0; k < 8; ++k) { const int idx = lane + 64 * k, r = idx >> 4, c = idx & 15; *(LAS u32x4*)(wl + (r * 136 + 8 * c) * 2) = v[k]; }
#pragma unroll
    for (int ds = 0; ds < 8; ++ds) qf[ds] = *(const LAS bf16x8*)(wl + (l32 * 136 + ds * 16 + hi * 8) * 2);
}
__device__ __forceinline__ void store_o(bf16_t* optr, const f32x16 (&o)[4], float inv, int hi) {
#pragma unroll
    for (int dt = 0; dt < 4; ++dt)
#pragma unroll
        for (int q = 0; q < 4; ++q) store_bf4(optr + 32 * dt + 8 * q + 4 * hi, o[dt][4 * q] * inv, o[dt][4 * q + 1] * inv, o[dt][4 * q + 2] * inv, o[dt][4 * q + 3] * inv);
}
__device__ __forceinline__ void store_o_t(bf16_t* p0, size_t rstride, const f32x16 (&o)[4], float inv, int l32, int hi, LAS char* wl) {
#pragma unroll
    for (int dt = 0; dt < 4; ++dt)
#pragma unroll
        for (int q = 0; q < 4; ++q) { u32x2 w2; w2.x = cvtpk(o[dt][4 * q] * inv, o[dt][4 * q + 1] * inv); w2.y = cvtpk(o[dt][4 * q + 2] * inv, o[dt][4 * q + 3] * inv);
            *(LAS u32x2*)(wl + (l32 * 136 + 32 * dt + 8 * q + 4 * hi) * 2) = w2; }
    const int lane = l32 + 32 * hi;
#pragma unroll
    for (int k = 0; k < 8; ++k) { const int idx = lane + 64 * k, r = idx >> 4, c = idx & 15;
        const u32x4 v = *(const LAS u32x4*)(wl + (r * 136 + 8 * c) * 2); gst<u32x4>(p0 + (size_t)r * rstride + 8 * c, v); }
}
__device__ __forceinline__ void zero_o(f32x16 (&o)[4]) {
#pragma unroll
    for (int dt = 0; dt < 4; ++dt)
#pragma unroll
        for (int r = 0; r < 16; ++r) o[dt][r] = 0.f;
}

__device__ __forceinline__ int claim(unsigned* ctr, LAS char* lds) {
    volatile LAS int* slot = (volatile LAS int*)(lds + LDS_CTL + 64);
    __syncthreads();
    if (otid() == 0) *slot = (int)atomicAdd(ctr, 1u);
    __syncthreads();
    return *slot;
}

__device__ __forceinline__ void conv_stream(const float* src, bf16_t* dst, int tid, const float* rowscale = nullptr, size_t e0 = 0, int ncols = 1) {
    f32x4 v[8];
#pragma unroll
    for (int i = 0; i < 8; ++i) v[i] = __builtin_nontemporal_load((const GAS f32x4*)(src + i * 2048 + tid * 4));
#pragma unroll
    for (int i = 0; i < 8; ++i) { const float sc = rowscale ? gld<float>(rowscale + ((unsigned)e0 + (unsigned)(i * 2048 + tid * 4)) / (unsigned)ncols) : 1.f;
        store_bf4(dst + i * 2048 + tid * 4, v[i][0] * sc, v[i][1] * sc, v[i][2] * sc, v[i][3] * sc); }
}
constexpr int NFILL = 2 * (NEXP * DM * EFF / 16384);
__device__ __forceinline__ void fill_item(const Params& p, char* ws, int layer, int it, int tid) {
    constexpr int N_EX = NFILL / 2; const size_t lo = (size_t)layer * NEXP * DM * EFF;
    if (it < N_EX) { const size_t u = (size_t)it * 16384; conv_stream(p.in[I_WGATE] + lo + u, (bf16_t*)(ws + OFF_WGU_T) + u, tid); }
    else { const size_t u = (size_t)(it - N_EX) * 16384; conv_stream(p.in[I_WUP] + lo + u, (bf16_t*)(ws + OFF_WGU_T) + (size_t)NEXP * DM * EFF + u, tid); }
}
__device__ __forceinline__ void phase_expconv(const Params& p, int layer) {
    char* ws = ows(p.ws); const int tid = otid();
    if (oblk() >= NEXP) for (int it = oblk() - NEXP; it < NFILL; it += gridDim.x - NEXP) fill_item(p, ws, layer, it, tid);
}
__device__ __forceinline__ void phase_prep(const Params& p, int layer, LAS char* lds) {
    char* ws = ows(p.ws);
    const int tid = otid(), half = tid >> 8, tl = tid & 255;
    constexpr int N_WIN = DM / 2, N_WQ = 384 * 768 / 16384, N_WKV = 128 * 1024 / 16384, N_W1 = 4096 * 256 / 16384, N_W2 = 256 * 128 / 16384, N_WOUT = DM * DM / 16384, N_EX = NEXP * DM * EFF / 16384;
    constexpr int E0 = 0, E1 = E0 + N_WIN, E2 = E1 + N_WQ, E3 = E2 + N_WKV, E4 = E3 + N_W1, E5 = E4 + N_W1, E6 = E5 + N_W2, E7 = E6 + N_W2, E8 = E7 + N_WOUT,
                  E11 = E8, E12 = E11, E13 = E12 + 32  , E14 = E13 + NT * DM / 16384  ;
    static_assert(N_EX * 2 == NFILL, "gate and up chunks");
    const int total = layer == 0 ? E14 : E12;
    if (oblk() + 32 >= (int)gridDim.x) {
        const int kc = oblk() + 32 - (int)gridDim.x, which = kc >> 4, ch = kc & 15;
        const float* pe = p.in[which ? I_PEV : I_PEK] + (size_t)layer * 4096 + ch * 256;
        const float* w1 = p.in[which ? I_W1V : I_W1K] + (size_t)layer * 4096 * 256 + (size_t)ch * 256 * 256;
        const int n4 = (tid & 63) * 4, kgp = tid >> 6;
        f32x4 acc = {0.f, 0.f, 0.f, 0.f};
#pragma unroll
        for (int k = 0; k < 32; ++k) { const int kk = kgp * 32 + k; acc += gld<float>(pe + kk) * gld<f32x4>(w1 + (size_t)kk * 256 + n4); }
        LAS f32x4* red = (LAS f32x4*)lds;
        __syncthreads();
        red[tid] = acc;
        __syncthreads();
        if (tid < 64) { const f32x4 t = ((red[tid] + red[tid + 64]) + (red[tid + 128] + red[tid + 192])) + ((red[tid + 256] + red[tid + 320]) + (red[tid + 384] + red[tid + 448]));
            gst<f32x4>((float*)(ws + OFF_B1P) + (which * 16 + ch) * 256 + n4, t); }
    }
    for (int it = oblk(); it < total; it += gridDim.x) {
        if (it < E1) { const int k = 2 * (it - E0);
            const float* src = p.in[I_WIN] + ((size_t)layer * DM + k) * INC; bf16_t* dst = (bf16_t*)(ws + OFF_WIN_T) + (size_t)k * LDH;
            f32x2 v[2][5];
#pragma unroll
            for (int r = 0; r < 2; ++r)
#pragma unroll
                for (int j = 0; j < 5; ++j) { const int c = 2 * (tid + 512 * j); v[r][j] = gld<f32x2>(src + r * INC + (c < INC ? c : 0)); }
#pragma unroll
            for (int r = 0; r < 2; ++r)
#pragma unroll
                for (int j = 0; j < 5; ++j) { const int c = 2 * (tid + 512 * j); if (c < LDH) gst<unsigned>(dst + r * LDH + c, c < INC ? cvtpk(v[r][j].x, v[r][j].y) : 0u); }
        } else if (it < E2) { const size_t u = (size_t)(it - E1) * 16384;
            conv_stream(p.in[I_WQUP] + (size_t)layer * 384 * 768 + u, (bf16_t*)(ws + OFF_WQ_T) + u, tid, p.in[I_QLN] + layer * 384, u, 768);
        } else if (it < E3) { const size_t u = (size_t)(it - E2) * 16384;
            conv_stream(p.in[I_WKVUP] + (size_t)layer * 128 * 1024 + u, (bf16_t*)(ws + OFF_WKV_T) + u, tid, p.in[I_KVLN] + layer * 128, u, 1024);
        } else if (it < E4) { const size_t u = (size_t)(it - E3) * 16384; conv_stream(p.in[I_W1K] + (size_t)layer * 4096 * 256 + u, (bf16_t*)(ws + OFF_W1K_T) + u, tid);
        } else if (it < E5) { const size_t u = (size_t)(it - E4) * 16384; conv_stream(p.in[I_W1V] + (size_t)layer * 4096 * 256 + u, (bf16_t*)(ws + OFF_W1V_T) + u, tid);
        } else if (it < E6) { const size_t u = (size_t)(it - E5) * 16384; conv_stream(p.in[I_W2K] + (size_t)layer * 256 * 128 + u, (bf16_t*)(ws + OFF_W2K_T) + u, tid);
        } else if (it < E7) { const size_t u = (size_t)(it - E6) * 16384; conv_stream(p.in[I_W2V] + (size_t)layer * 256 * 128 + u, (bf16_t*)(ws + OFF_W2V_T) + u, tid);
        } else if (it < E8) { const size_t u = (size_t)(it - E7) * 16384; conv_stream(p.in[I_WOUT] + (size_t)layer * DM * DM + u, (bf16_t*)(ws + OFF_WOUT_T) + u, tid);
        } else if (it < E13) { const int u = it - E12;
            f32x2* cs16 = (f32x2*)(ws + OFF_CS16); f32x2* cs32 = (f32x2*)(ws + OFF_CS32);
            for (int e = tid; e < 64 * 48; e += 512) { const int pos = u * 64 + e / 48, j = e % 48;
                const int hf = j < 16 ? 16 : 32, i = j < 16 ? j : j - 16;
                const float invf = exp2f(-(float)i / (float)hf * 18.931568569324174f);
                const float ang = (float)pos * invf;
                f32x2 cs; cs.x = cosf(ang); cs.y = sinf(ang);
                if (j < 16) cs16[pos * 16 + i] = cs; else cs32[pos * 32 + i] = cs; }
        } else { const size_t u = (size_t)(it - E13) * 16384;
            conv_stream(p.in[I_X] + u, (bf16_t*)(ws + OFF_XB) + u, tid);
        }
    }
    if (oblk() == 0 && tid < NEXP) ((unsigned*)(ws + OFF_ECNT))[tid] = 0u;
    { unsigned* imp = (unsigned*)(ws + OFF_IMP); for (size_t e = (size_t)oblk() * 512 + tid; e < (size_t)NT * 32; e += (size_t)gridDim.x * 512) gst<unsigned>(imp + e, 0u); }
}

#define AO4(ld) { (unsigned)(sr * (ld) + sc), (unsigned)((sr + 64) * (ld) + sc), (unsigned)((sr + 128) * (ld) + sc), (unsigned)((sr + 192) * (ld) + sc) }
__device__ __forceinline__ void phase_win(const Params& p, int layer, LAS char* lds) {
    char* ws = ows(p.ws); const int tid = otid(), sr = tid >> 3, sc = (tid & 7) * 8;
    const bf16_t* A = (const bf16_t*)(ws + OFF_XB); const bf16_t* Bt = (const bf16_t*)(ws + OFF_WIN_T);
    for (int u = oblk(); u < 32 * 24; u += gridDim.x) {
        const int mt = u & 31, nt = u >> 5;
        EpiWin e{(bf16_t*)(ws + OFF_H), (float*)(ws + OFF_GATES), (const f32x2*)(ws + OFF_CS16), (const f32x2*)(ws + OFF_CS32), mt * 256, nt * 192};
        const unsigned ao[4] = AO4(DM);
        gemm8<3, 1, true, true>(lds, A + (size_t)mt * 256 * DM, ao, 128, Bt + nt * 192, LDH, 0u, DM / 64, e);
    }
}
__device__ __forceinline__ void phase_up(const Params& p, int layer, LAS char* lds) {
    char* ws = ows(p.ws); const int tid = otid(), sr = tid >> 3, sc = (tid & 7) * 8;
    const bf16_t* H = (const bf16_t*)(ws + OFF_H);
    constexpr int U0 = 32, U1 = U0 + 32 * 3, U2 = U1 + 32 * 4;
    for (int u = oblk(); u < U2; u += gridDim.x) {
        if (u < U0) {
            const int which = u >> 4, mt = (u >> 3) & 1, ksp = u & 7;
            const int col = which ? C_NVC : C_NKC;
            unsigned ao[4];
#pragma unroll
            for (int i = 0; i < 4; ++i) { const int r = sr + 64 * i; int c = r & 127; if (c > 126) c = 126; ao[i] = (unsigned)(((2 * mt + (r >> 7)) * SEQ + 16 * c) * LDH + sc); }
            const bf16_t* ab = H + (size_t)(4 * ksp) * LDH + col;
            const bf16_t* bb = (const bf16_t*)(ws + (which ? OFF_W1V_T : OFF_W1K_T)) + (size_t)512 * ksp * 256;
            EpiCmp1 e{(float*)(ws + OFF_HCP) + ((size_t)ksp * 2 + which) * 512 * 256, mt * 256};
            gemm8<4, 1, false, false>(lds, ab, ao, LDH, bb, 256, 0u, 512 / 64, e);
        } else if (u < U1) {
            const int v = u - U0, mt = v & 31, nt = v >> 5;
            const unsigned ao[4] = AO4(LDH);
            EpiQup e{(bf16_t*)(ws + OFF_QM), (const f32x2*)(ws + OFF_CS32), mt * 256, nt * 256};
            row_sumsq<384>(lds, H + (size_t)mt * 256 * LDH + C_QLAT, LDH);
            gemm8<4, 1, false, true>(lds, H + (size_t)mt * 256 * LDH + C_QLAT, ao, 128, (const bf16_t*)(ws + OFF_WQ_T) + nt * 256, 768, 0u, 384 / 64, e);
        } else {
            const int v = u - U1, mt = v & 31, nt = v >> 5;
            const unsigned ao[4] = AO4(LDH);
            EpiKVup e{(bf16_t*)(ws + OFF_KN), mt * 256, nt * 256};
            row_sumsq<128>(lds, H + (size_t)mt * 256 * LDH + C_KVLAT, LDH);
            gemm8<4, 1, false, true>(lds, H + (size_t)mt * 256 * LDH + C_KVLAT, ao, 128, (const bf16_t*)(ws + OFF_WKV_T) + nt * 256, 1024, 0u, 128 / 64, e);
        }
    }
}
__device__ __forceinline__ void phase_cmpred(const Params& p, int layer) {
    char* ws = ows(p.ws);
    const float* P = (const float*)(ws + OFF_HCP); const float* b1p = (const float*)(ws + OFF_B1P); bf16_t* Hc = (bf16_t*)(ws + OFF_HC);
    for (int e4 = oblk() * 512 + otid(); e4 < 2 * 512 * 256 / 4; e4 += gridDim.x * 512) {
        const int e = e4 * 4, which = e >> 17, n = e & 255;
        f32x4 a = {0.f, 0.f, 0.f, 0.f};
#pragma unroll
        for (int q = 0; q < 16; ++q) a += gld<f32x4>(b1p + (which * 16 + q) * 256 + n);
#pragma unroll
        for (int q = 0; q < 8; ++q) a += gld<f32x4>(P + (size_t)q * 2 * 512 * 256 + e);
        store_bf4(Hc + e, gelu_tanh(a[0]), gelu_tanh(a[1]), gelu_tanh(a[2]), gelu_tanh(a[3]));
    }
}
__device__ __forceinline__ void phase_cmp2(const Params& p, int layer, LAS char* lds) {
    char* ws = ows(p.ws); const int tid = otid(), sr = tid >> 3, sc = (tid & 7) * 8;
    for (int u = oblk(); u < 4; u += gridDim.x) {
        const int which = u >> 1, mt = u & 1;
        const bf16_t* Hc = (const bf16_t*)(ws + OFF_HC) + (size_t)which * 512 * 256 + (size_t)mt * 256 * 256;
        const unsigned ao[4] = AO4(256);
        EpiCmp2 e{(bf16_t*)(ws + (which ? OFF_VC : OFF_KC)), (const f32x2*)(ws + OFF_CS16), which == 0, mt * 256};
        gemm8<4, 1, false, true>(lds, Hc, ao, 128, (const bf16_t*)(ws + (which ? OFF_W2V_T : OFF_W2K_T)), 128, 0u, 256 / 64, e);
    }
}
__device__ __forceinline__ void phase_out(const Params& p, int layer, LAS char* lds) {
    char* ws = ows(p.ws); const int tid = otid(), sr = tid >> 3, sc = (tid & 7) * 8;
    const bf16_t* A = (const bf16_t*)(ws + OFF_MIX); const bf16_t* Bt = (const bf16_t*)(ws + OFF_WOUT_T);
    const float* X = layer == 0 ? p.in[I_X] : (const float*)(ws + OFF_XA);
    for (int u = oblk(); u < 32 * 8; u += gridDim.x) {
        const int mt = u & 31, nt = u >> 5;
        EpiOut e{(float*)(ws + OFF_X1), (bf16_t*)(ws + OFF_X1B), X, p.in[I_LN1G] + layer * DM, p.in[I_LN1B] + layer * DM, (f32x2*)(ws + OFF_STAT), (GAS unsigned*)(ws + OFF_CTR) + CTR_LN1 + 32 * layer, mt * 256, nt * 256};
        const unsigned ao[4] = AO4(DM);
        gemm8<4, 1, true, true>(lds, A + (size_t)mt * 256 * DM, ao, 128, Bt + nt * 256, DM, 0u, DM / 64, e);
    }
}

__device__ __forceinline__ void item_mla(const Params& p, int it, LAS char* lds) {
    char* ws = ows(p.ws); const int tid = otid(), lane = tid & 63, w = (tid >> 6) & 3, kg = tid >> 8, l32 = lane & 31, hi = lane >> 5;
    const int qb = 15 - (it >> 4), h = it & 3, b = (it >> 2) & 3;
    const int token = qb * 128 + 32 * w + l32; const size_t row = (size_t)b * SEQ + token;
    bf16x8 qf[12]; load_q<192>((const bf16_t*)(ws + OFF_QM) + row * 768 + h * 192, hi, qf);
    KeySrc ks; ks.k0 = (const bf16_t*)(ws + OFF_KN) + (size_t)b * SEQ * 512 + h * 128; ks.kstride = 512;
    ks.kr = (const bf16_t*)(ws + OFF_H) + (size_t)b * SEQ * LDH + C_KROPE; ks.krstride = LDH;
    ks.v0 = (const bf16_t*)(ws + OFF_VM) + (size_t)b * SEQ * 512 + h * 128; ks.vstride = 512;
    f32x16 o[4]; zero_o(o); float m = -1e30f, l = 0.f;
    attn_run<192, false>(lds, ks, kg, 2 * qb + 2, 0u, qf, token, 0x7fffffffu, 0u, 0.07216878364870322f * LOG2E, o, m, l, tid, 2);
    LAS f32x4* X = (LAS f32x4*)(lds + 2 * ATT_HALF); LAS float* XM = (LAS float*)(lds + 2 * ATT_HALF + 65536); const int tl = tid & 255;
    if (kg == 1) {
#pragma unroll
        for (int dt = 0; dt < 4; ++dt)
#pragma unroll
            for (int q = 0; q < 4; ++q) X[(dt * 4 + q) * 256 + tl] = (f32x4){o[dt][4 * q], o[dt][4 * q + 1], o[dt][4 * q + 2], o[dt][4 * q + 3]};
        XM[tl] = m; XM[256 + tl] = l;
    }
    __syncthreads();
    if (kg == 0) {
        const float m1 = XM[tl], l1 = XM[256 + tl], M = fmaxf(m, m1), a0 = __builtin_amdgcn_exp2f(m - M), a1 = __builtin_amdgcn_exp2f(m1 - M);
        const float inv = 1.f / (l * a0 + l1 * a1), c0 = a0 * inv, c1 = a1 * inv;
#pragma unroll
        for (int dt = 0; dt < 4; ++dt)
#pragma unroll
            for (int q = 0; q < 4; ++q) { const f32x4 x = X[(dt * 4 + q) * 256 + tl];
#pragma unroll
                for (int j = 0; j < 4; ++j) o[dt][4 * q + j] = o[dt][4 * q + j] * c0 + x[j] * c1; }
        store_o_t((bf16_t*)(ws + OFF_MIX) + (row - l32) * DM + h * 128, DM, o, 1.f, l32, hi, lds + w * 8704);
    }
}
__device__ __forceinline__ void item_dil(const Params& p, int it, LAS char* lds) {
    char* ws = ows(p.ws); const int tid = otid(), lane = tid & 63, w = (tid >> 6) & 3, kg = tid >> 8, l32 = lane & 31, hi = lane >> 5;
    const int rem = it % 48, bh = it / 48, h = bh % 6, b = bh / 6;
    const int n = rem >> 4, r2 = rem & 15;
    const int dil = n == 0 ? 1 : (n == 1 ? 4 : 16);
    const int rho = n == 0 ? 0 : (n == 1 ? (r2 >> 2) : r2), qb = n == 0 ? r2 : (n == 1 ? (r2 & 3) : 0);
    const int i = qb * 128 + 32 * w + l32, token = rho + i * dil; const size_t row = (size_t)b * SEQ + token;
    const bf16_t* H = (const bf16_t*)(ws + OFF_H);
    bf16x8 qf[8]; load_q_t(H + (row - (size_t)l32 * dil) * LDH + C_DQ + h * 128, (size_t)dil * LDH, l32, hi, qf, lds + kg * ATT_HALF + w * 8704);
    KeySrc ks; ks.k0 = H + ((size_t)b * SEQ + rho) * LDH + C_DK + h * 128; ks.kstride = (size_t)dil * LDH; ks.kr = ks.k0; ks.krstride = 0;
    ks.v0 = H + ((size_t)b * SEQ + rho) * LDH + C_DV + h * 128; ks.vstride = (size_t)dil * LDH;
    f32x16 o[4]; zero_o(o); float m = -1e30f, l = 0.f;
    const int jlo = 2 * qb - 2 < 0 ? 0 : 2 * qb - 2;
    attn_run<128, false>(lds, ks, jlo, 2 * qb + 2, 0u, qf, i, 128u, 0u, 0.08838834764831845f * LOG2E, o, m, l, tid);
    store_o_t((bf16_t*)(ws + OFF_ODIL) + ((size_t)n * NT + row - (size_t)l32 * dil) * 768 + h * 128, (size_t)dil * 768, o, 1.f / l, l32, hi, lds + kg * ATT_HALF + w * 8704);
    if (hi == 0) gst<float>((float*)(ws + OFF_LDIL) + ((size_t)n * NT + row) * 6 + h, m + __log2f(l));
}
__device__ __forceinline__ void item_win(const Params& p, int it, LAS char* lds) {
    char* ws = ows(p.ws); const int tid = otid(), lane = tid & 63, w = (tid >> 6) & 3, kg = tid >> 8, l32 = lane & 31, hi = lane >> 5;
    const int hp = it % 3, b = (it / 3) & 3, tb = 31 - it / 12;
    const int head = 2 * hp + (w >> 1), token = 64 * tb + 32 * (w & 1) + l32; const size_t row = (size_t)b * SEQ + token;
    const bf16_t* H = (const bf16_t*)(ws + OFF_H);
    bf16x8 qf[8]; load_q_t(H + (row - l32) * LDH + C_NQ + head * 128, LDH, l32, hi, qf, lds + kg * ATT_HALF + w * 8704);
    KeySrc ks; ks.k0 = H + (size_t)b * SEQ * LDH + C_NKW; ks.kstride = LDH; ks.kr = ks.k0; ks.krstride = 0; ks.v0 = H + (size_t)b * SEQ * LDH + C_NVW; ks.vstride = LDH;
    f32x16 o[4]; zero_o(o); float m = -1e30f, l = 0.f;
    attn_run<128, false>(lds, ks, tb - 8 < 0 ? 0 : tb - 8, tb + 1, 0u, qf, token, 511u, 0u, 0.08838834764831845f * LOG2E, o, m, l, tid);
    store_o_t((bf16_t*)(ws + OFF_PW) + (row - l32) * 768 + head * 128, 768, o, 1.f / l, l32, hi, lds + kg * ATT_HALF + w * 8704);
}
__device__ __forceinline__ void item_cmp(const Params& p, int it, LAS char* lds) {
    char* ws = ows(p.ws); const int tid = otid(), tl = tid & 255, lane = tid & 63, w = (tid >> 6) & 3, kg = tid >> 8, l32 = lane & 31, hi = lane >> 5;
    const int hp = it % 3, tb = (it / 3) % 32, b = it / 96;
    const int head = 2 * hp + (w >> 1), token = 64 * tb + 32 * (w & 1) + l32; const size_t row = (size_t)b * SEQ + token;
    const bf16_t* H = (const bf16_t*)(ws + OFF_H);
    bf16x8 qf[8]; load_q_t(H + (row - l32) * LDH + C_NQ + head * 128, LDH, l32, hi, qf, lds + kg * ATT_HALF + w * 8704);
    KeySrc ks; ks.k0 = (const bf16_t*)(ws + OFF_KC) + (size_t)b * 128 * 128; ks.kstride = 128; ks.kr = ks.k0; ks.krstride = 0; ks.v0 = (const bf16_t*)(ws + OFF_VC) + (size_t)b * 128 * 128; ks.vstride = 128;
    const int qi = (token - 31) >> 4;
    const int qimax = (64 * tb + 63 - 31) >> 4;
    const int jhi = qimax < 0 ? 0 : (qimax >> 6) + 1;
    const float c2 = 0.08838834764831845f * LOG2E;
    f32x16 o[4]; zero_o(o); float m = -1e30f, l = 0.f;
    attn_run<128, false>(lds, ks, 0, jhi, 0u, qf, qi, 0x7fffffffu, 0u, c2, o, m, l, tid);
    const float inv = l > 0.f ? 1.f / l : 0.f;
    store_o_t((bf16_t*)(ws + OFF_PC) + (row - l32) * 768 + head * 128, 768, o, inv, l32, hi, lds + kg * ATT_HALF + w * 8704);
    const AttnSrc<128> asrc = attn_src<128>(ks, tl);
    LAS char* L = lds + kg * ATT_HALF;
    LAS unsigned* IL = (LAS unsigned*)(L + 36864); LAS unsigned* imp = IL + (32 * (w & 1) + l32) * 32;
#pragma unroll
    for (int i = 0; i < 8; ++i) IL[tl + 256 * i] = 0u;
    LAS int* trips = (LAS int*)(lds + LDS_CTL + 96);
    __syncthreads();
    const int jimp = tb > 15 ? jhi : 0;
    if (tl == 0) trips[kg] = jimp;
    __syncthreads();
    const int ntrip = max(trips[0], trips[1]);
    for (int jt = 0; jt < ntrip; ++jt) {
        const bool have = jt < jimp;
        if (have) attn_stage<128>(L, asrc, jt, false, tl);
        __syncthreads();
        if (have) {
            f32x16 p0, p1; attn_scores<128>(L, qf, p0, p1, l32, hi);
            const int dq = qi - jt * 64 - 8 * hi;
#pragma unroll
            for (int r = 0; r < 16; ++r) { const int ko = 16 * (r >> 3) + (r & 7);
                p0[r] = (dq - ko >= 0) ? __builtin_amdgcn_exp2f(p0[r] * c2 - m) * inv : 0.f;
                p1[r] = (dq - ko - 32 >= 0) ? __builtin_amdgcn_exp2f(p1[r] * c2 - m) * inv : 0.f; }
#pragma unroll
            for (int t = 0; t < 2; ++t)
#pragma unroll
                for (int u = 0; u < 2; ++u) {
                    unsigned q[8];
#pragma unroll
                    for (int jj = 0; jj < 8; ++jj) q[jj] = (unsigned)((t ? p1[8 * u + jj] : p0[8 * u + jj]) * 16777216.f + 0.5f);
                    const int j0 = (64 * jt + 32 * t + 16 * u + 8 * hi) >> 2;
                    const unsigned a0 = q[0] + q[1] + q[2] + q[3], a1 = q[4] + q[5] + q[6] + q[7] + q[3], a2 = q[7];
                    if (a0) (void)__hip_atomic_fetch_add(imp + j0, a0, __ATOMIC_RELAXED, __HIP_MEMORY_SCOPE_WORKGROUP);
                    if (a1) (void)__hip_atomic_fetch_add(imp + j0 + 1, a1, __ATOMIC_RELAXED, __HIP_MEMORY_SCOPE_WORKGROUP);
                    if (a2 && j0 + 2 < 32) (void)__hip_atomic_fetch_add(imp + j0 + 2, a2, __ATOMIC_RELAXED, __HIP_MEMORY_SCOPE_WORKGROUP);
                }
        }
        __syncthreads();
    }
    { unsigned* gimp = (unsigned*)(ws + OFF_IMP) + ((size_t)b * SEQ + 64 * tb) * 32;
#pragma unroll
      for (int i = 0; i < 8; ++i) { const unsigned v = IL[tl + 256 * i]; if (v) atomicAdd(gimp + tl + 256 * i, v); } }
}
__device__ __forceinline__ void item_slc(const Params& p, int it, LAS char* lds) {
    char* ws = ows(p.ws); const int tid = otid(), lane = tid & 63, w = (tid >> 6) & 3, kg = tid >> 8, l32 = lane & 31, hi = lane >> 5;
    const int hp = it % 3, b = (it / 3) & 3, tb = 31 - it / 12;
    const int tl = tid & 255;
    LAS int* sc = (LAS int*)(lds + 2 * ATT_HALF + kg * 8704); LAS unsigned* msk = (LAS unsigned*)(lds + 2 * ATT_HALF + kg * 8704 + 8192);
    if (tb > 15) {
    __syncthreads();
    if (tl < 65) msk[tl] = 0u;
    const unsigned* imp = (const unsigned*)(ws + OFF_IMP) + ((size_t)b * SEQ + 64 * tb) * 32;
#pragma unroll
    for (int i = 0; i < 8; ++i) { const int e = tl + i * 256, tk = e >> 5, j = e & 31, pos = 64 * tb + tk, qblk = pos >> 6;
        const bool valid = 64 * j <= pos, forced = (j == 0) || (j == qblk) || (j == qblk - 1);
        sc[e] = valid ? (forced ? 0x7fffffff : (int)gld<unsigned>(imp + e)) : -1; }
    __syncthreads();
#pragma unroll
    for (int i = 0; i < 8; ++i) { const int e = tl + i * 256, tk = e >> 5, j = e & 31; const int s = sc[e]; int rank = 0;
        for (int k = 0; k < 32; ++k) { const int sk = sc[tk * 32 + k]; rank += (sk > s || (sk == s && k < j)) ? 1 : 0; }
        if (rank < 16) { __hip_atomic_fetch_or(&msk[tk], 1u << j, __ATOMIC_RELAXED, __HIP_MEMORY_SCOPE_WORKGROUP); __hip_atomic_fetch_or(&msk[64], 1u << j, __ATOMIC_RELAXED, __HIP_MEMORY_SCOPE_WORKGROUP); } }
    __syncthreads();
    }
    const int head = 2 * hp + (w >> 1), tk = 32 * (w & 1) + l32, token = 64 * tb + tk; const size_t row = (size_t)b * SEQ + token;
    const unsigned sel = tb > 15 ? msk[tk] : (2u << tb) - 1u, uni = tb > 15 ? msk[64] : (2u << tb) - 1u;
    const bf16_t* H = (const bf16_t*)(ws + OFF_H);
    bf16x8 qf[8]; load_q_t(H + (row - l32) * LDH + C_NQ + head * 128, LDH, l32, hi, qf, lds + kg * ATT_HALF + w * 8704);
    KeySrc ks; ks.k0 = H + (size_t)b * SEQ * LDH + C_NKS; ks.kstride = LDH; ks.kr = ks.k0; ks.krstride = 0; ks.v0 = H + (size_t)b * SEQ * LDH + C_NVS; ks.vstride = LDH;
    f32x16 o[4]; zero_o(o); float m = -1e30f, l = 0.f;
    attn_run<128, true>(lds, ks, 0, tb + 1, uni, qf, token, 0x7fffffffu, sel, 0.08838834764831845f * LOG2E, o, m, l, tid, 2);
    { LAS f32x4* X = (LAS f32x4*)(lds + 2 * ATT_HALF); LAS float* XM = (LAS float*)(lds + 2 * ATT_HALF + 65536);
      if (kg == 1) {
#pragma unroll
          for (int dt = 0; dt < 4; ++dt)
#pragma unroll
              for (int q = 0; q < 4; ++q) X[(dt * 4 + q) * 256 + tl] = (f32x4){o[dt][4 * q], o[dt][4 * q + 1], o[dt][4 * q + 2], o[dt][4 * q + 3]};
          XM[tl] = m; XM[256 + tl] = l;
      }
      __syncthreads();
      if (kg == 1) return;
      const float m1 = XM[tl], l1 = XM[256 + tl], M = fmaxf(m, m1), a0 = __builtin_amdgcn_exp2f(m - M), a1 = __builtin_amdgcn_exp2f(m1 - M);
      l = l * a0 + l1 * a1;
#pragma unroll
      for (int dt = 0; dt < 4; ++dt)
#pragma unroll
          for (int q = 0; q < 4; ++q) { const f32x4 x = X[(dt * 4 + q) * 256 + tl];
#pragma unroll
              for (int j = 0; j < 4; ++j) o[dt][4 * q + j] = o[dt][4 * q + j] * a0 + x[j] * a1; } }
    { LAS char* wl = lds + w * 8704;
      const float g1 = gld<float>((const float*)(ws + OFF_GATES) + row * 18 + head * 3 + 1) / l;
#pragma unroll
      for (int dt = 0; dt < 4; ++dt)
#pragma unroll
          for (int q = 0; q < 4; ++q) { u32x2 w2; w2.x = cvtpk(o[dt][4 * q] * g1, o[dt][4 * q + 1] * g1); w2.y = cvtpk(o[dt][4 * q + 2] * g1, o[dt][4 * q + 3] * g1);
              *(LAS u32x2*)(wl + (l32 * 136 + 32 * dt + 8 * q + 4 * hi) * 2) = w2; }
      const size_t row0 = row - l32;
#pragma unroll
      for (int k = 0; k < 8; ++k) { const int idx = lane + 64 * k, r = idx >> 4, c = idx & 15; const size_t rr = row0 + r;
          const float* gp = (const float*)(ws + OFF_GATES) + rr * 18 + head * 3; const float g0 = gld<float>(gp), g2 = gld<float>(gp + 2);
          const u32x4 sv = *(const LAS u32x4*)(wl + (r * 136 + 8 * c) * 2);
          const u32x4 a = gld<u32x4>((const bf16_t*)(ws + OFF_PC) + rr * 768 + head * 128 + 8 * c), b4 = gld<u32x4>((const bf16_t*)(ws + OFF_PW) + rr * 768 + head * 128 + 8 * c);
          u32x4 out;
#pragma unroll
          for (int j = 0; j < 4; ++j) out[j] = cvtpk(g0 * bf_lo(a[j]) + bf_lo(sv[j]) + g2 * bf_lo(b4[j]), g0 * bf_hi(a[j]) + bf_hi(sv[j]) + g2 * bf_hi(b4[j]));
          gst<u32x4>((bf16_t*)(ws + OFF_MIX) + rr * DM + 1280 + head * 128 + 8 * c, out); } }
}
__device__ __forceinline__ void item_dilmix(const Params& p, int it, LAS char* lds) {
    char* ws = ows(p.ws); const int tid = otid();
    const bf16_t* OD = (const bf16_t*)(ws + OFF_ODIL); const float* LD = (const float*)(ws + OFF_LDIL); bf16_t* MIX = (bf16_t*)(ws + OFF_MIX);
    for (int e = tid; e < 64 * 96; e += 512) {
        const size_t row = (size_t)it * 64 + e / 96; const int cc = (e % 96) * 8, h = cc >> 7;
        const float L0 = gld<float>(LD + row * 6 + h), L1 = gld<float>(LD + ((size_t)NT + row) * 6 + h), L2 = gld<float>(LD + ((size_t)2 * NT + row) * 6 + h);
        const float M = fmaxf(L0, fmaxf(L1, L2)); float w0 = __builtin_amdgcn_exp2f(L0 - M), w1 = __builtin_amdgcn_exp2f(L1 - M), w2 = __builtin_amdgcn_exp2f(L2 - M);
        const float inv = 1.f / (w0 + w1 + w2); w0 *= inv; w1 *= inv; w2 *= inv;
        const u32x4 a = gld<u32x4>(OD + row * 768 + cc), bq = gld<u32x4>(OD + ((size_t)NT + row) * 768 + cc), cq = gld<u32x4>(OD + ((size_t)2 * NT + row) * 768 + cc); u32x4 r;
#pragma unroll
        for (int j = 0; j < 4; ++j) r[j] = cvtpk(w0 * bf_lo(a[j]) + w1 * bf_lo(bq[j]) + w2 * bf_lo(cq[j]), w0 * bf_hi(a[j]) + w1 * bf_hi(bq[j]) + w2 * bf_hi(cq[j]));
        gst<u32x4>(MIX + row * DM + 512 + cc, r);
    }
}
__device__ __forceinline__ void phase_attn_d(const Params& p, int ctr_idx, LAS char* lds) {
    unsigned* ctr = (unsigned*)(ows(p.ws) + OFF_CTR) + ctr_idx;
    constexpr int NWIN = 384, NDIL = NB * 6 * 48, NCMP = 384;
    const int kg = otid() >> 8;
    for (int n = 0;; ++n) { const int pr = n == 0 ? oblk() : claim(ctr, lds) + (int)gridDim.x; const int it = __builtin_amdgcn_readfirstlane(2 * pr + kg); if (2 * pr >= NWIN + NDIL + NCMP) break;
        if (it < NCMP) item_cmp(p, it, lds); else if (it < NCMP + NWIN) item_win(p, it - NCMP, lds); else item_dil(p, it - NCMP - NWIN, lds); }
}
__device__ __forceinline__ void phase_attn_e(const Params& p, int ctr_idx, LAS char* lds) {
    unsigned* ctr = (unsigned*)(ows(p.ws) + OFF_CTR) + ctr_idx;
    constexpr int NMLA = 256, NSLC = 384, NMIX = NT / 64;
    static_assert(NMLA == 256 && NSLC == 384, "claim order below");
    for (int n = 0;; ++n) {
        const int pr = n == 0 ? oblk() : __builtin_amdgcn_readfirstlane(claim(ctr, lds)) + (int)gridDim.x; if (pr >= 640 + NMIX) break;
        int type = 2, idx = pr - 640;
        if (pr < 192) { type = 1; idx = pr; }
        else if (pr < 640) { const int c = pr - 192, lev = c / 28, r = c - lev * 28;
            if (r < 16) { type = 0; idx = lev * 16 + r; } else { type = 1; idx = (16 + lev) * 12 + (r - 16); } }
        idx = __builtin_amdgcn_readfirstlane(idx);
        if (type == 0) item_mla(p, idx, lds); else if (type == 1) item_slc(p, idx, lds); else item_dilmix(p, idx, lds);
    }
}
__device__ __forceinline__ void phase_ln(const Params& p, int layer, int mode) {
    (void)mode;
    char* ws = ows(p.ws); const int tid = otid(), lane = tid & 63, wv = (oblk() * 512 + tid) >> 6, nw = gridDim.x * 8;
    const float* g = p.in[I_LN2G] + layer * DM; const float* bb = p.in[I_LN2B] + layer * DM;
    f32x4 gv[8], bv[8];
#pragma unroll
    for (int i = 0; i < 8; ++i) { gv[i] = gld<f32x4>(g + (i * 64 + lane) * 4); bv[i] = gld<f32x4>(bb + (i * 64 + lane) * 4); }
    f32x4 xv[8]; u32x2 ya[8], yb[8];
#define LN_LOAD(ROW) do { const int row_ = (ROW) < NT ? (ROW) : NT - 1; const float* x1_ = (const float*)(ws + OFF_X1) + (size_t)row_ * DM; const bf16_t* y0_ = (const bf16_t*)(ws + OFF_Y) + (size_t)(2 * row_) * DM; \
        _Pragma("unroll") for (int i = 0; i < 8; ++i) { const int c = (i * 64 + lane) * 4; xv[i] = gld<f32x4>(x1_ + c); ya[i] = gld<u32x2>(y0_ + c); yb[i] = gld<u32x2>(y0_ + DM + c); } } while (0)
    LN_LOAD(wv);
    for (int row = wv; row < NT; row += nw) {
        f32x4 v[8];
#pragma unroll
        for (int i = 0; i < 8; ++i) {
            v[i][0] = DN_ALPHA * xv[i][0] + bf_lo(ya[i].x) + bf_lo(yb[i].x); v[i][1] = DN_ALPHA * xv[i][1] + bf_hi(ya[i].x) + bf_hi(yb[i].x);
            v[i][2] = DN_ALPHA * xv[i][2] + bf_lo(ya[i].y) + bf_lo(yb[i].y); v[i][3] = DN_ALPHA * xv[i][3] + bf_hi(ya[i].y) + bf_hi(yb[i].y); }
        LN_LOAD(row + nw);
        float s = 0.f;
#pragma unroll
        for (int i = 0; i < 8; ++i) s += (v[i][0] + v[i][1]) + (v[i][2] + v[i][3]);
        const float mu = wave_sum(s) * (1.f / DM);
        float q = 0.f;
#pragma unroll
        for (int i = 0; i < 8; ++i) { const f32x4 d = v[i] - mu; q += (d[0] * d[0] + d[1] * d[1]) + (d[2] * d[2] + d[3] * d[3]); }
        const float rstd = 1.f / sqrtf(wave_sum(q) * (1.f / DM) + 1e-5f);
        float* of = layer == DEPTH - 1 ? p.out + (size_t)row * DM : (float*)(ws + OFF_XA) + (size_t)row * DM;
        bf16_t* ob = (bf16_t*)(ws + OFF_XB) + (size_t)row * DM;
#pragma unroll
        for (int i = 0; i < 8; ++i) { const int c = (i * 64 + lane) * 4;
            f32x4 o = (v[i] - mu) * rstd * gv[i] + bv[i]; gst<f32x4>(of + c, o);
            if (layer < DEPTH - 1) store_bf4(ob + c, o[0], o[1], o[2], o[3]); }
    }
#undef LN_LOAD
}
__device__ __forceinline__ void phase_router(const Params& p, int layer, LAS char* lds) {
    char* ws = ows(p.ws); const int tid = otid(), lane = tid & 63, w = tid >> 6, l32 = lane & 31, hi = lane >> 5;
    const float* X1 = (const float*)(ws + OFF_X1); const float* We = p.in[I_WEXP] + (size_t)layer * DM * 32; const float* Wg = p.in[I_WGRP] + (size_t)layer * DM * 4;
    const float* lng = p.in[I_LN1G] + layer * DM; const float* lnb = p.in[I_LN1B] + layer * DM;
    LAS float* red = (LAS float*)lds;
    float* gw = (float*)(ws + OFF_GW);
    for (int it = oblk(); it < NT / 32; it += gridDim.x) {
        const int t0 = it * 32;
        { LAS f32x4* wl = (LAS f32x4*)(lds + 40960);
#pragma unroll
          for (int i = 0; i < 4; ++i) wl[tid + 512 * i] = gld<f32x4>(Wg + (size_t)(tid + 512 * i) * 4); }
        __syncthreads();
        f32x16 ae;
#pragma unroll
        for (int r = 0; r < 16; ++r) ae[r] = 0.f;
        f32x4 gacc = {0.f, 0.f, 0.f, 0.f};
        const float* xr = X1 + (size_t)(t0 + l32) * DM + w * 256 + 4 * hi;
        const float* wer = We + (size_t)(w * 256 + 4 * hi) * 32 + l32;
        const LAS f32x4* wgl = (const LAS f32x4*)(lds + 40960) + w * 256 + 4 * hi;
        f32x4 xa[4], xb[4]; float wea[4][4], web[4][4];
#define RT_LOAD(X, WE, KC) do { _Pragma("unroll") for (int i_ = 0; i_ < 4; ++i_) { X[i_] = gld<f32x4>(xr + (KC) + 8 * i_); \
            _Pragma("unroll") for (int j_ = 0; j_ < 4; ++j_) WE[i_][j_] = gld<float>(wer + (size_t)((KC) + 8 * i_ + j_) * 32); } } while (0)
#define RT_MMA(X, WE, KC) do { _Pragma("unroll") for (int i_ = 0; i_ < 4; ++i_) _Pragma("unroll") for (int j_ = 0; j_ < 4; ++j_) { \
            ae = __builtin_amdgcn_mfma_f32_32x32x2f32(X[i_][j_], WE[i_][j_], ae, 0, 0, 0); gacc += X[i_][j_] * wgl[(KC) + 8 * i_ + j_]; } } while (0)
        RT_LOAD(xa, wea, 0);
#pragma unroll 1
        for (int kc = 0; kc < 256; kc += 64) {
            RT_LOAD(xb, web, kc + 32);
            RT_MMA(xa, wea, kc);
            if (kc + 64 < 256) RT_LOAD(xa, wea, kc + 64);
            RT_MMA(xb, web, kc + 32);
        }
#undef RT_LOAD
#undef RT_MMA
        gacc[0] += __shfl_xor(gacc[0], 32); gacc[1] += __shfl_xor(gacc[1], 32); gacc[2] += __shfl_xor(gacc[2], 32); gacc[3] += __shfl_xor(gacc[3], 32);
        __syncthreads();
#pragma unroll
        for (int r = 0; r < 16; ++r) { const int tk = crow(r, hi); red[(w * 32 + tk) * 36 + l32] = ae[r]; }
        if (hi == 0) *(LAS f32x4*)(red + (w * 32 + l32) * 36 + 32) = gacc;
        __syncthreads();
        if (tid < 32) {
            const int tk = tid;
            float lg[4];
#pragma unroll
            for (int j = 0; j < 4; ++j) { float a = 0.f;
#pragma unroll
                for (int ww = 0; ww < 8; ++ww) a += red[(ww * 32 + tk) * 36 + 32 + j];
                lg[j] = a; }
            int gi = 0; float gm = lg[0];
#pragma unroll
            for (int j = 1; j < 4; ++j) if (lg[j] > gm) { gm = lg[j]; gi = j; }
            float den = 0.f;
#pragma unroll
            for (int j = 0; j < 4; ++j) den += __expf(lg[j] - gm);
            const float pg = 1.f / den;
            float b0 = -__builtin_inff(), b1 = -__builtin_inff(); int i0 = 0, i1 = 0;
#pragma unroll
            for (int j = 0; j < 8; ++j) { const int n = gi * 8 + j; float v = 0.f;
#pragma unroll
                for (int ww = 0; ww < 8; ++ww) v += red[(ww * 32 + tk) * 36 + n];
                if (v > b0) { b1 = b0; i1 = i0; b0 = v; i0 = j; } else if (v > b1) { b1 = v; i1 = j; } }
            const float w1 = __expf(b1 - b0), g0 = pg / (1.f + w1), g1 = pg * w1 / (1.f + w1);
            const int tok = t0 + tk, e0 = gi * 8 + i0, e1 = gi * 8 + i1;
            int* eid = (int*)(ws + OFF_EID);
            __hip_atomic_store((GAS int*)(eid + 2 * tok), e0, __ATOMIC_RELAXED, __HIP_MEMORY_SCOPE_AGENT);
            __hip_atomic_store((GAS int*)(eid + 2 * tok + 1), e1, __ATOMIC_RELAXED, __HIP_MEMORY_SCOPE_AGENT);
            gw[2 * tok] = g0; gw[2 * tok + 1] = g1;
        }
        asm volatile("s_waitcnt vmcnt(0)" ::: "memory");
        __syncthreads();
        if (tid == 0) (void)__hip_atomic_fetch_add((GAS unsigned*)(ws + OFF_CTR) + CTR_RT + 8 * layer + (it >> 5), 1u, __ATOMIC_RELAXED, __HIP_MEMORY_SCOPE_AGENT);
    }
}
__device__ __forceinline__ void phase_lists(const Params& p, int layer, LAS char* lds) {
    char* ws = ows(p.ws); const int tid = otid(), lane = tid & 63, w = tid >> 6;
    const int* eid = (const int*)(ws + OFF_EID);
    LAS int* wcnt = (LAS int*)lds;
    for (int item = oblk(); item < NEXP * 8; item += gridDim.x) {
        const int e = item >> 3, seg = item & 7;
        int* le = (int*)(ws + OFF_LIST) + (size_t)e * NT;
        bool mine[4]; int wpre[4];
        if (tid == 0) { unsigned sp = 0u; GAS unsigned* c = (GAS unsigned*)(ws + OFF_CTR) + CTR_RT + 8 * layer + seg;
            while (__hip_atomic_load(c, __ATOMIC_RELAXED, __HIP_MEMORY_SCOPE_AGENT) < 32u) { __builtin_amdgcn_s_sleep(1); if (++sp > (1u << 24)) break; }
            __builtin_amdgcn_fence(__ATOMIC_ACQUIRE, "agent"); }
        __syncthreads();
#pragma unroll
        for (int st = 0; st < 4; ++st) { const int sl = seg * 2048 + st * 512 + tid; mine[st] = gld<int>(eid + sl) == e;
            const unsigned long long bal = __ballot(mine[st]);
            wpre[st] = __builtin_popcountll(bal & ((1ull << lane) - 1ull));
            if (lane == 0) wcnt[st * 8 + w] = __builtin_popcountll(bal); }
        __syncthreads();
        int off[4], run = 0;
#pragma unroll
        for (int st = 0; st < 4; ++st) { off[st] = run;
#pragma unroll
            for (int ww = 0; ww < 8; ++ww) { const int c = wcnt[st * 8 + ww]; if (ww < w) off[st] += c; run += c; } }
        if (tid == 0) wcnt[32] = run > 0 ? (int)atomicAdd((unsigned*)(ws + OFF_ECNT) + e, (unsigned)run) : 0;
        __syncthreads();
        const int base = wcnt[32];
#pragma unroll
        for (int st = 0; st < 4; ++st) if (mine[st]) le[base + off[st] + wpre[st]] = seg * 2048 + st * 512 + tid;
    }
}
__device__ __forceinline__ int moe_table(const Params& p, LAS char* lds) {
    LAS int* off = (LAS int*)(lds + LDS_CTL + 128); LAS int* toff = off + 33; LAS int* cnt = (LAS int*)(lds + 1024);
    const int tid = otid();
    __syncthreads();
    if (tid < NEXP) cnt[tid] = (int)gld<unsigned>((const unsigned*)(ows(p.ws) + OFF_ECNT) + tid);
    __syncthreads();
    if (tid == 0) { int a = 0, t = 0;
        for (int e = 0; e < NEXP; ++e) { off[e] = a; toff[e] = t; const int c = cnt[e]; a += c; t += (c + 255) >> 8; } off[NEXP] = a; toff[NEXP] = t; }
    __syncthreads();
    return toff[NEXP];
}
constexpr int CTR_MOE = 260, CTR_DONE = 512, CTR_MOEQ = 400;
__device__ __forceinline__ void phase_moe(const Params& p, int layer, LAS char* lds) {
    char* ws = ows(p.ws);
    const int ntile = __builtin_amdgcn_readfirstlane(moe_table(p, lds)); const LAS int* off = (const LAS int*)(lds + LDS_CTL + 128); const LAS int* toff = off + 33;
    const unsigned* ecnt = (const unsigned*)(ws + OFF_ECNT); const int* list = (const int*)(ws + OFF_LIST);
    GAS unsigned* done = (GAS unsigned*)(ws + OFF_CTR) + CTR_DONE + 128 * layer;
    (void)ntile;
    volatile LAS int* slot = (volatile LAS int*)(lds + LDS_CTL + 64);
    int q = (int)(xb_xcc_id() & 7u), hops = 0;
    GAS unsigned* ctr = (GAS unsigned*)(ws + OFF_CTR) + CTR_MOEQ + 8 * layer + q;
    int u = __builtin_amdgcn_readfirstlane(claim((unsigned*)(ws + OFF_CTR) + CTR_MOEQ + 8 * layer + q, lds));
    for (;;) {
        const int tid = otid(), sr = tid >> 3, sc = (tid & 7) * 8;
        int nq = 0;
#pragma unroll
        for (int k = 0; k < 4; ++k) nq += toff[q + 8 * k + 1] - toff[q + 8 * k];
        nq = __builtin_amdgcn_readfirstlane(nq);
        if (u >= 12 * nq) {
            if (++hops == 8) break;
            q = (q + 1) & 7; ctr = (GAS unsigned*)(ws + OFF_CTR) + CTR_MOEQ + 8 * layer + q;
            u = __builtin_amdgcn_readfirstlane(claim((unsigned*)(ws + OFF_CTR) + CTR_MOEQ + 8 * layer + q, lds));
            continue;
        }
        const bool first = u < 4 * nq; int tl = first ? u >> 2 : (u - 4 * nq) >> 3; const int nt = first ? u & 3 : (u - 4 * nq) & 7;
        int e = q;
#pragma unroll
        for (int k = 0; k < 3; ++k) { const int c = toff[q + 8 * k + 1] - toff[q + 8 * k]; if (e == q + 8 * k && tl >= c) { tl -= c; e += 8; } }
        const int mt = tl, t = toff[e] + mt;
        const int cnt = (int)ecnt[e], nvalid = cnt - mt * 256 < 256 ? cnt - mt * 256 : 256;
        const int* le = list + (size_t)e * NT + mt * 256;
        if (first) {
            unsigned ao[4];
#pragma unroll
            for (int i = 0; i < 4; ++i) { const int r = sr + 64 * i; ao[i] = (unsigned)((gld<int>(le + (r < nvalid ? r : 0)) >> 1) * DM + sc); }
            EpiMoe1 ep{(bf16_t*)(ws + OFF_HM), off[e] + mt * 256, nvalid, nt * 256};
            gemm8<4, 4, true, false>(lds, (const bf16_t*)(ws + OFF_X1B), ao, 128, (const bf16_t*)(p.in[I_WGATE] + ((size_t)layer * NEXP + e) * DM * EFF + nt * 128), EFF, 0u, DM / 64, ep, nvalid, ctr,
                                     p.in[I_WUP] + ((size_t)layer * NEXP + e) * DM * EFF + nt * 128);
            asm volatile("s_waitcnt vmcnt(0)" ::: "memory");
            __syncthreads();
            if (tid == 0) (void)__hip_atomic_fetch_add(done + t, 1u, __ATOMIC_RELAXED, __HIP_MEMORY_SCOPE_AGENT);
        } else {
            if (tid == 0) { unsigned sp = 0u;
                while (__hip_atomic_load(done + t, __ATOMIC_RELAXED, __HIP_MEMORY_SCOPE_AGENT) < 4u) { __builtin_amdgcn_s_sleep(2); if (++sp > (1u << 24)) break; }
                __builtin_amdgcn_fence(__ATOMIC_ACQUIRE, "agent"); }
            __syncthreads();
            const unsigned ao[4] = AO4(EFF);
            EpiMoe2 ep{(bf16_t*)(ws + OFF_Y), le, (const float*)(ws + OFF_GW), nvalid, nt * 256};
            gemm8<4, 3, true, true>(lds, (const bf16_t*)(ws + OFF_HM) + (size_t)(off[e] + mt * 256) * EFF, ao, 128, (const bf16_t*)(p.in[I_WDOWN] + ((size_t)layer * NEXP + e) * EFF * DM + nt * 256), DM, 0u, EFF / 64, ep, nvalid, ctr);
        }
        __syncthreads();
        u = __builtin_amdgcn_readfirstlane(*slot);
    }
}

__device__ __forceinline__ Params load_params() {
    Params q;
#if defined(__HIP_DEVICE_COMPILE__)
    const CAS Params* pp = (const CAS Params*)__builtin_amdgcn_kernarg_segment_ptr(); asm volatile("" : "+s"(pp));
#pragma unroll
    for (int i = 0; i < 22; ++i) q.in[i] = pp->in[i];
    q.out = pp->out; q.ws = pp->ws;
#endif
    return q;
}
__global__ void __launch_bounds__(512, 2) fwd_kernel(Params p) {
    LAS char* lds = (LAS char*)g_lds;
    {
        const unsigned t = threadIdx.x;
        if ((t & 63u) == 0u) ((LAS unsigned char*)lds)[LDS_CTL + 416 + (__builtin_amdgcn_s_getreg(63492) & 0x3fu)] = (unsigned char)(t >> 6);
        if (t == 0u) *(LAS u32x4*)(lds + LDS_CTL) = (u32x4){0u, 0u, 0u, 0u};
    }
    __syncthreads();
    XcdBarrier bar = xcd_barrier_post((unsigned*)(p.ws + OFF_BAR), (volatile LAS unsigned*)(lds + LDS_CTL));
    for (int layer = 0; layer < DEPTH; ++layer) {
        if (layer == 0) { phase_prep(load_params(), 0, lds);  xcd_barrier(bar); }
        phase_win(load_params(), layer, lds);               xcd_barrier(bar);
        phase_up(load_params(), layer, lds);                xcd_barrier(bar);
        phase_cmpred(load_params(), layer);                 xcd_barrier(bar);
        phase_cmp2(load_params(), layer, lds);              xcd_barrier(bar);
        phase_attn_d(load_params(), 64 * (2 * layer), lds);       xcd_barrier(bar);
        phase_attn_e(load_params(), 64 * (2 * layer + 1), lds);   xcd_barrier(bar);
        phase_out(load_params(), layer, lds);               xcd_barrier(bar);
        phase_router(load_params(), layer, lds);  phase_lists(load_params(), layer, lds);      xcd_barrier(bar);
        phase_moe(load_params(), layer, lds);               xcd_barrier(bar);
        phase_ln(load_params(), layer, 1);
        if (layer + 1 < DEPTH) phase_prep(load_params(), layer + 1, lds);
        xcd_barrier(bar);
    }
}

extern "C" void kernel_launch(void* const* d_in, const int* in_sizes, int n_in, void* d_out, int out_size, void* d_ws, size_t ws_size, hipStream_t stream) {
    (void)in_sizes; (void)out_size;
    static int grid = 0;
    if (!grid) {
        int dev = 0, cus = 0, per_cu = 0;
        (void)hipGetDevice(&dev);
        (void)hipDeviceGetAttribute(&cus, hipDeviceAttributeMultiprocessorCount, dev);
        (void)hipFuncSetAttribute((const void*)fwd_kernel, hipFuncAttributeMaxDynamicSharedMemorySize, LDS_BYTES);
        (void)hipOccupancyMaxActiveBlocksPerMultiprocessor(&per_cu, (const void*)fwd_kernel, 512, LDS_BYTES);
        if (cus <= 0) cus = 256;
        if (per_cu < 1) per_cu = 1;
        grid = cus;
    }
    if (n_in < 22 || ws_size < WS_TOTAL) { fprintf(stderr, "kernel_launch: bad arguments (n_in %d, ws %zu < %zu)\n", n_in, ws_size, (size_t)WS_TOTAL); return; }
    Params p;
    for (int i = 0; i < 22; ++i) p.in[i] = (const float*)d_in[i];
    p.out = (float*)d_out; p.ws = (char*)d_ws;
    (void)hipMemsetAsync(d_ws, 0, ZERO_BYTES, stream);
    fwd_kernel<<<dim3(grid), dim3(512), LDS_BYTES, stream>>>(p);
}
```
